# Optimizing an MI355X kernel written in HIP

```python
import math
import numpy as np
import jax
import jax.numpy as jnp
from jax import lax

D_MODEL = 1024
BATCH = 4
SEQ = 8192
DEPTH = 4

GRID_W = 64
CTX_LEN = 256

A_HEADS = 4
A_HD = 64
A_WIDTH = A_HEADS * 2 * A_HD
B_HEADS = 8
B_HD = 64
B_WIDTH = B_HEADS * B_HD
B_DECAY_RANK = 64
B_ICL_RANK = 64
B_GATE_RANK = 128
C_WIDTH = 512
N_BRANCH = 3
IN_SIZES = (A_WIDTH, A_WIDTH, A_WIDTH,
            B_WIDTH, B_WIDTH, B_WIDTH,
            B_DECAY_RANK, B_ICL_RANK, B_GATE_RANK,
            C_WIDTH, C_WIDTH, C_WIDTH,
            N_BRANCH * D_MODEL)
N_IN = 3 * A_WIDTH + 3 * B_WIDTH + B_DECAY_RANK + B_ICL_RANK + B_GATE_RANK + 3 * C_WIDTH + N_BRANCH * D_MODEL
N_EXPERTS = 16
EXPERT_FF = 1024
CAPACITY_FACTOR = 2

ROPE_THETA = 10000.0
Q_BLOCK = 128
NORM_EPS = 1e-6
GN_EPS = 64e-5

kernel_name = "hybrid_diffusion_trunk"


def _split(t, sizes):
    cuts = [int(v) for v in np.cumsum(sizes)[:-1]]
    return jnp.split(t, cuts, axis=-1)


def _rmsnorm(x, g):
    xf = x.astype(jnp.float32)
    y = xf * lax.rsqrt(jnp.mean(xf * xf, axis=-1, keepdims=True) + NORM_EPS)
    return (y * g.astype(jnp.float32)).astype(x.dtype)


def _adaln_params(cond, w, b):
    return jnp.split(jax.nn.silu(cond) @ w + b, 6, axis=-1)


def _dwconv3(x, w):
    xp = jnp.pad(x, ((0, 0), (1, 1), (0, 0)))
    return w[0] * xp[:, :-2] + w[1] * xp[:, 1:-1] + w[2] * xp[:, 2:]


def _axial_rope_tables(rows):
    half = A_HD // 2
    inv = jnp.power(ROPE_THETA, -jnp.arange(0, half, 2, dtype=jnp.float32) / half)
    r = jnp.repeat(jnp.arange(rows, dtype=jnp.float32), GRID_W)
    col = jnp.tile(jnp.arange(GRID_W, dtype=jnp.float32), rows)
    ang = jnp.concatenate([r[:, None] * inv, col[:, None] * inv], axis=-1)
    return jnp.cos(ang), jnp.sin(ang)


def _rope(x, cos, sin):
    half = A_HD // 2
    xf = x.astype(jnp.float32)
    x1, x2 = xf[..., :half], xf[..., half:]
    c = cos[None, :, None, None, :]
    s = sin[None, :, None, None, :]
    return jnp.concatenate([x1 * c - x2 * s, x2 * c + x1 * s], axis=-1).astype(x.dtype)


def _diff_softmax_attn(q, k, v, lam):
    s = jnp.einsum('bqhmd,bkhmd->bhmqk', q, k, preferred_element_type=jnp.float32) * (A_HD ** -0.5)
    p = jax.nn.softmax(s, axis=-1)
    w = p[:, :, 0] - lam * p[:, :, 1]
    return jnp.einsum('bhqk,bkhe->bqhe', w.astype(v.dtype), v)


def _branch_diff_attn(pc, pl, cos, sin, q_g, k_g, lam_vec, subln_g, lam_init, need_ctx):
    def q_heads(p):
        b, t, _ = p[0].shape
        return _rmsnorm(p[0].reshape(b, t, A_HEADS, 2, A_HD), q_g)

    def kv_heads(p):
        b, t, _ = p[1].shape
        k = _rmsnorm(p[1].reshape(b, t, A_HEADS, 2, A_HD), k_g)
        v = p[2].reshape(b, t, A_HEADS, 2 * A_HD)
        return k, v

    kc, vc = kv_heads(pc)
    kl, vl = kv_heads(pl)
    ql = _rope(q_heads(pl), cos, sin)
    kl = _rope(kl, cos, sin)
    lv = lam_vec.astype(jnp.float32)
    lam = jnp.exp(jnp.sum(lv[0] * lv[1])) - jnp.exp(jnp.sum(lv[2] * lv[3])) + lam_init

    k_all = jnp.concatenate([kc, kl], axis=1)
    v_all = jnp.concatenate([vc, vl], axis=1)
    b, t = ql.shape[:2]
    nblk = t // Q_BLOCK
    qb = jnp.moveaxis(ql.reshape(b, nblk, Q_BLOCK, A_HEADS, 2, A_HD), 1, 0)
    ob = lax.map(lambda qq: _diff_softmax_attn(qq, k_all, v_all, lam), qb)
    ol = jnp.moveaxis(ob, 0, 1).reshape(b, t, A_HEADS, 2 * A_HD)

    def post(o):
        return (_rmsnorm(o, subln_g) * (1.0 - lam_init)).reshape(o.shape[0], o.shape[1], A_WIDTH)

    yc = post(_diff_softmax_attn(q_heads(pc), kc, vc, lam)) if need_ctx else None
    return yc, post(ol)


def _bheads(t):
    return t.astype(jnp.float32).reshape(t.shape[0], t.shape[1], B_HEADS, B_HD)


def _rwkv_prep(p, conv_w, k_k):
    r, k, v = jnp.split(_dwconv3(jnp.concatenate(p[:3], axis=-1), conv_w), 3, axis=-1)
    kk = _bheads(k * k_k)
    kk = kk / jnp.maximum(jnp.sqrt(jnp.sum(kk * kk, axis=-1, keepdims=True)), 1e-12)
    return r, k, v, kk


def _rwkv_direction(k, wl, al, w0, w_up, a0, a_up, k_a):
    w = -jax.nn.softplus(-(w0 + jnp.tanh(wl) @ w_up)) - 0.5
    decay = jnp.exp(-jnp.exp(w.astype(jnp.float32)))
    a = jax.nn.sigmoid(a0 + al @ a_up)
    kd = k * (1.0 + (a - 1.0) * k_a)
    return _bheads(decay), _bheads(a), _bheads(kd)


def _rwkv_scan(s0, decay, kk, a, k, v, r, reverse):
    emit = r is not None
    xs = (decay, kk, a, k, v) + ((r,) if emit else ())
    xs = tuple(jnp.moveaxis(t, 1, 0) for t in xs)

    def step(s, inp):
        wt, kkt, at, kt, vt = inp[:5]
        sa = jnp.einsum('bhvk,bhk->bhv', s, kkt)
        s = s * wt[:, :, None, :] - sa[..., None] * (kkt * at)[:, :, None, :] + vt[..., None] * kt[:, :, None, :]
        y = jnp.einsum('bhvk,bhk->bhv', s, inp[5]) if emit else None
        return s, y

    s_fin, ys = lax.scan(step, s0, xs, reverse=reverse)
    return s_fin, (jnp.moveaxis(ys, 0, 1) if emit else None)


def _rwkv_readout(o, r, kd, v, r_k, ln_g, ln_b):
    mu = jnp.mean(o, axis=-1, keepdims=True)
    dlt = o - mu
    on = dlt * lax.rsqrt(jnp.mean(dlt * dlt, axis=-1, keepdims=True) + GN_EPS)
    bonus = jnp.sum(r * kd * r_k.astype(jnp.float32), axis=-1, keepdims=True) * v
    y = on * ln_g.astype(jnp.float32).reshape(B_HEADS, B_HD) + ln_b.astype(jnp.float32).reshape(B_HEADS, B_HD) + bonus
    return y.reshape(o.shape[0], o.shape[1], B_WIDTH)


def _branch_rwkv(pc, pl, conv_w, w0, w_up, a0, a_up, g_up, k_k, k_a, r_k, ln_g, ln_b, need_ctx):
    rc, kc, vc, kkc = _rwkv_prep(pc, conv_w, k_k)
    rl, kl, vl, kkl = _rwkv_prep(pl, conv_w, k_k)
    vc_h = _bheads(vc)
    rl_h, vl_h = _bheads(rl), _bheads(vl)
    rc_h = _bheads(rc) if need_ctx else None
    s0 = jnp.zeros((pl[0].shape[0], B_HEADS, B_HD, B_HD), jnp.float32)
    y_l = 0.0
    y_c = 0.0
    for d in range(2):
        rev = d == 1
        dec_c, a_c, kd_c = _rwkv_direction(kc, pc[3], pc[4], w0[d], w_up[d], a0[d], a_up[d], k_a)
        s_c, o_c = _rwkv_scan(s0, dec_c, kkc, a_c, kd_c, vc_h, rc_h, rev)
        dec_l, a_l, kd_l = _rwkv_direction(kl, pl[3], pl[4], w0[d], w_up[d], a0[d], a_up[d], k_a)
        _, o_l = _rwkv_scan(s_c, dec_l, kkl, a_l, kd_l, vl_h, rl_h, rev)
        y_l = y_l + _rwkv_readout(o_l, rl_h, kd_l, vl_h, r_k, ln_g, ln_b)
        if need_ctx:
            y_c = y_c + _rwkv_readout(o_c, rc_h, kd_c, vc_h, r_k, ln_g, ln_b)
    out_l = (y_l * (jax.nn.sigmoid(pl[5]) @ g_up)).astype(pl[0].dtype)
    out_c = (y_c * (jax.nn.sigmoid(pc[5]) @ g_up)).astype(pc[0].dtype) if need_ctx else None
    return out_c, out_l


def _branch_conv(p, w):
    bg, cg, xv = p
    return bg * _dwconv3(cg * xv, w)


def _merge(ys, gates, w_branch, w_out):
    gs = jnp.split(jax.nn.sigmoid(gates), N_BRANCH, axis=-1)
    m = gs[0] * (ys[0] @ w_branch[0]) + gs[1] * (ys[1] @ w_branch[1]) + gs[2] * (ys[2] @ w_branch[2])
    return m @ w_out


def _mixer(hc, hl, lp, lam_init, cos, sin, need_ctx):
    pc = _split(hc @ lp['w_in'], IN_SIZES)
    pl = _split(hl @ lp['w_in'], IN_SIZES)
    ac, al = _branch_diff_attn(pc[0:3], pl[0:3], cos, sin, lp['q_norm_g'], lp['k_norm_g'],
                               lp['diff_lambda'], lp['diff_subln_g'], lam_init, need_ctx)
    bc, bl = _branch_rwkv(pc[3:9], pl[3:9], lp['rwkv_conv_w'], lp['rwkv_w0'], lp['rwkv_w_up'],
                          lp['rwkv_a0'], lp['rwkv_a_up'], lp['rwkv_g_up'], lp['rwkv_k_k'],
                          lp['rwkv_k_a'], lp['rwkv_r_k'], lp['rwkv_ln_g'], lp['rwkv_ln_b'], need_ctx)
    cl = _branch_conv(pl[9:12], lp['conv_w'])
    yl = _merge((al, bl, cl), pl[12], lp['w_branch'], lp['w_out'])
    yc = None
    if need_ctx:
        cc = _branch_conv(pc[9:12], lp['conv_w'])
        yc = _merge((ac, bc, cc), pc[12], lp['w_branch'], lp['w_out'])
    return yc, yl


def _expert_choice(h, router_w, w1, w3, w2):
    b, n, dm = h.shape
    cap = CAPACITY_FACTOR * n // N_EXPERTS
    aff = jax.nn.softmax((h @ router_w).astype(jnp.float32), axis=-1)
    gate, idx = lax.top_k(jnp.swapaxes(aff, 1, 2), cap)
    xin = jax.vmap(lambda hb, ib: hb[ib])(h, idx)
    hid = jax.nn.silu(jnp.einsum('becd,edf->becf', xin, w1)) * jnp.einsum('becd,edf->becf', xin, w3)
    out = jnp.einsum('becf,efd->becd', hid, w2) * gate[..., None].astype(h.dtype)
    return jax.vmap(lambda ob, ib: jnp.zeros((n, dm), ob.dtype).at[ib.reshape(-1)].add(ob.reshape(-1, dm)))(out, idx)


def _layer(xc, xl, c, c_ctx, lp, lam_init, cos, sin, last):
    need_ctx = not last
    sh1l, sc1l, g1l, sh2l, sc2l, g2l = [m[:, None, :] for m in _adaln_params(c, lp['ada_w'], lp['ada_b'])]
    sh1c, sc1c, g1c, sh2c, sc2c, g2c = _adaln_params(c_ctx, lp['ada_w'], lp['ada_b'])
    hl = _rmsnorm(xl, lp['norm1_g']) * (1.0 + sc1l) + sh1l
    hc = _rmsnorm(xc, lp['norm1_g']) * (1.0 + sc1c) + sh1c
    yc, yl = _mixer(hc, hl, lp, lam_init, cos, sin, need_ctx)
    xl = xl + g1l * yl
    hl = _rmsnorm(xl, lp['norm2_g']) * (1.0 + sc2l) + sh2l
    xl = xl + g2l * _expert_choice(hl, lp['router_w'], lp['exp_w1'], lp['exp_w3'], lp['exp_w2'])
    if need_ctx:
        xc = xc + g1c * yc
        hc = _rmsnorm(xc, lp['norm2_g']) * (1.0 + sc2c) + sh2c
        xc = xc + g2c * _expert_choice(hc, lp['router_w'], lp['exp_w1'], lp['exp_w3'], lp['exp_w2'])
    return xc, xl


def setup_inputs(seed: int = 0) -> dict:
    key = jax.random.key(seed)
    ks = list(jax.random.split(key, 40))
    f32 = jnp.float32

    def nrm(shape, scale):
        return jax.random.normal(ks.pop(), shape, f32) * scale

    D = D_MODEL
    return {
        "x": nrm((BATCH, SEQ, D), 1.0),
        "c": nrm((BATCH, D), 1.0),
        "ctx": nrm((BATCH, CTX_LEN, D), 1.0),
        "c_ctx": nrm((D,), 1.0),
        "norm1_g": 1.0 + nrm((DEPTH, D), 0.05),
        "norm2_g": 1.0 + nrm((DEPTH, D), 0.05),
        "ada_w": nrm((DEPTH, D, 6 * D), 0.3 * D ** -0.5),
        "ada_b": nrm((DEPTH, 6 * D), 0.01),
        "w_in": nrm((DEPTH, D, N_IN), D ** -0.5),
        "q_norm_g": 1.0 + nrm((DEPTH, A_HD), 0.05),
        "k_norm_g": 1.0 + nrm((DEPTH, A_HD), 0.05),
        "diff_lambda": nrm((DEPTH, 4, A_HD), 0.1),
        "diff_subln_g": 1.0 + nrm((DEPTH, 2 * A_HD), 0.05),
        "rwkv_conv_w": jnp.array([0.2, 0.6, 0.2], f32)[None, :, None] + nrm((DEPTH, 3, 3 * B_WIDTH), 0.05),
        "rwkv_w0": jnp.linspace(-6.0, -1.0, B_WIDTH, dtype=f32)[None, None, :] + nrm((DEPTH, 2, B_WIDTH), 0.3),
        "rwkv_w_up": nrm((DEPTH, 2, B_DECAY_RANK, B_WIDTH), 0.1 * B_DECAY_RANK ** -0.5),
        "rwkv_a0": nrm((DEPTH, 2, B_WIDTH), 0.1),
        "rwkv_a_up": nrm((DEPTH, 2, B_ICL_RANK, B_WIDTH), 0.3 * B_ICL_RANK ** -0.5),
        "rwkv_g_up": nrm((DEPTH, B_GATE_RANK, B_WIDTH), B_GATE_RANK ** -0.5),
        "rwkv_k_k": 0.85 + nrm((DEPTH, B_WIDTH), 0.05),
        "rwkv_k_a": 1.0 + nrm((DEPTH, B_WIDTH), 0.05),
        "rwkv_r_k": nrm((DEPTH, B_HEADS, B_HD), 0.1),
        "rwkv_ln_g": 1.0 + nrm((DEPTH, B_WIDTH), 0.05),
        "rwkv_ln_b": nrm((DEPTH, B_WIDTH), 0.01),
        "conv_w": nrm((DEPTH, 3, C_WIDTH), 3 ** -0.5),
        "w_branch": nrm((DEPTH, N_BRANCH, A_WIDTH, D), A_WIDTH ** -0.5),
        "w_out": nrm((DEPTH, D, D), D ** -0.5),
        "router_w": nrm((DEPTH, D, N_EXPERTS), D ** -0.5),
        "exp_w1": nrm((DEPTH, N_EXPERTS, D, EXPERT_FF), D ** -0.5),
        "exp_w3": nrm((DEPTH, N_EXPERTS, D, EXPERT_FF), D ** -0.5),
        "exp_w2": nrm((DEPTH, N_EXPERTS, EXPERT_FF, D), EXPERT_FF ** -0.5),
    }


def reference(x, c, ctx, c_ctx, norm1_g, norm2_g, ada_w, ada_b, w_in, q_norm_g, k_norm_g,
              diff_lambda, diff_subln_g, rwkv_conv_w, rwkv_w0, rwkv_w_up, rwkv_a0, rwkv_a_up,
              rwkv_g_up, rwkv_k_k, rwkv_k_a, rwkv_r_k, rwkv_ln_g, rwkv_ln_b, conv_w, w_branch,
              w_out, router_w, exp_w1, exp_w3, exp_w2):
    n_lat = x.shape[1]
    rows = n_lat // GRID_W
    cos, sin = _axial_rope_tables(rows)
    xc, xl = ctx, x
    for i in range(DEPTH):
        lp = {
            'norm1_g': norm1_g[i], 'norm2_g': norm2_g[i], 'ada_w': ada_w[i], 'ada_b': ada_b[i],
            'w_in': w_in[i], 'q_norm_g': q_norm_g[i], 'k_norm_g': k_norm_g[i],
            'diff_lambda': diff_lambda[i], 'diff_subln_g': diff_subln_g[i],
            'rwkv_conv_w': rwkv_conv_w[i], 'rwkv_w0': rwkv_w0[i], 'rwkv_w_up': rwkv_w_up[i],
            'rwkv_a0': rwkv_a0[i], 'rwkv_a_up': rwkv_a_up[i], 'rwkv_g_up': rwkv_g_up[i],
            'rwkv_k_k': rwkv_k_k[i], 'rwkv_k_a': rwkv_k_a[i], 'rwkv_r_k': rwkv_r_k[i],
            'rwkv_ln_g': rwkv_ln_g[i], 'rwkv_ln_b': rwkv_ln_b[i], 'conv_w': conv_w[i],
            'w_branch': w_branch[i], 'w_out': w_out[i], 'router_w': router_w[i],
            'exp_w1': exp_w1[i], 'exp_w3': exp_w3[i], 'exp_w2': exp_w2[i],
        }
        lam_init = 0.8 - 0.6 * math.exp(-0.3 * i)
        xc, xl = _layer(xc, xl, c, c_ctx, lp, lam_init, cos, sin, i == DEPTH - 1)
    return xl
```

```cpp
#include <hip/hip_runtime.h>
#include <stdint.h>

#define LAS __attribute__((address_space(3)))
typedef unsigned short bf16_t;
typedef short bf16x8 __attribute__((ext_vector_type(8)));
typedef float f32x4 __attribute__((ext_vector_type(4)));
typedef float f32x16 __attribute__((ext_vector_type(16)));
typedef float f32x2v __attribute__((ext_vector_type(2)));
typedef __bf16 bf16x2v __attribute__((ext_vector_type(2)));
typedef unsigned u32x4 __attribute__((ext_vector_type(4)));
typedef unsigned u32x2 __attribute__((ext_vector_type(2)));

#define DI __device__ __forceinline__
DI float bf2f(bf16_t v) { return __uint_as_float(((unsigned)v) << 16); }
DI float bflo(unsigned w) { return __uint_as_float(w << 16); }
DI float bfhi(unsigned w) { return __uint_as_float(w & 0xffff0000u); }
DI unsigned pk2(float a, float b) { f32x2v v = {a, b}; return __builtin_bit_cast(unsigned, __builtin_convertvector(v, bf16x2v)); }
DI bf16_t f2bf(float a) { return (bf16_t)(pk2(a, 0.f) & 0xffffu); }
DI float sigmoidf_(float x) { return __builtin_amdgcn_rcpf(1.f + __expf(-x)); }
DI float wave_sum(float v) { v += __shfl_xor(v, 32); v += __shfl_xor(v, 16); v += __shfl_xor(v, 8); v += __shfl_xor(v, 4); v += __shfl_xor(v, 2); v += __shfl_xor(v, 1); return v; }
template <int CTRL> DI float dppmov(float x) { return __builtin_bit_cast(float, __builtin_amdgcn_update_dpp(0, __builtin_bit_cast(int, x), CTRL, 0xf, 0xf, true)); }
DI float allsum16(float x) { x += dppmov<0xB1>(x); x += dppmov<0x4E>(x); x += dppmov<0x141>(x); x += dppmov<0x140>(x); return x; }
DI float allsum8(float x) { x += dppmov<0xB1>(x); x += dppmov<0x4E>(x); x += dppmov<0x141>(x); return x; }

constexpr int NB = 4, SEQ = 8192, NCTX = 256, TT = SEQ + NCTX, RR = NB * TT, DM = 1024, NIN = 7936, NL = 4;
constexpr int NE = 16, CAPL = 1024, CAPC = 32, ESLOT = 4352, EROWS = NE * ESLOT;
static_assert(RR == 33792 && RR % 256 == 0 && EROWS % 256 == 0, "shape");

constexpr size_t MB1 = 1u << 20;
constexpr size_t alignup(size_t x) { return (x + MB1 - 1) / MB1 * MB1; }
constexpr size_t SZ_T = (size_t)RR * 512 * 2;
constexpr size_t OFF_BAR = 0;
constexpr size_t OFF_CTR = 32768;
constexpr size_t OFF_MOD = 65536;
constexpr size_t OFF_ROPE = OFF_MOD + (size_t)NL * 5 * 6144 * 4;
constexpr size_t OFF_AFFL = MB1;
constexpr size_t OFF_AFFC = OFF_AFFL + (size_t)4 * 16 * 8192 * 4;
constexpr size_t OFF_SROW = OFF_AFFC + (size_t)4 * 16 * 256 * 4;
constexpr size_t OFF_SGATE = OFF_SROW + (size_t)EROWS * 4;
constexpr size_t OFF_INV = OFF_SGATE + (size_t)EROWS * 4;
constexpr size_t OFF_X = alignup(OFF_INV + (size_t)RR * 16 * 4);
constexpr size_t OFF_H = alignup(OFF_X + (size_t)RR * 1024 * 4);
constexpr size_t OFF_VT = OFF_H;
constexpr size_t OFF_YB0 = OFF_H + SZ_T;
constexpr size_t OFF_M = OFF_H;
constexpr size_t OFF_WIN = alignup(OFF_H + 2 * SZ_T);
constexpr size_t OFF_WBR = alignup(OFF_WIN + (size_t)NIN * 1024 * 2);
constexpr size_t OFF_WOUT = alignup(OFF_WBR + (size_t)3 * 1024 * 512 * 2);
constexpr size_t OFF_PA = alignup(OFF_WOUT + (size_t)1024 * 1024 * 2);
constexpr size_t OFF_PR = alignup(OFF_PA + (size_t)RR * 1536 * 2);
constexpr size_t OFF_PC = alignup(OFF_PR + (size_t)RR * 1792 * 2);
constexpr size_t OFF_PG = alignup(OFF_PC + (size_t)RR * 1536 * 2);
constexpr size_t OFF_PEND = alignup(OFF_PG + (size_t)RR * 3072 * 2);
constexpr size_t OFF_OS = OFF_PR;
constexpr size_t OFF_OA = OFF_OS + 2 * SZ_T;
constexpr size_t OFF_YA = alignup(OFF_OA + 2 * SZ_T);
constexpr size_t OFF_YB = alignup(OFF_YA + SZ_T);
static_assert(OFF_YB + SZ_T <= OFF_PG, "overlay");
constexpr size_t OFF_W13 = OFF_PA;
constexpr size_t OFF_W2 = OFF_W13 + (size_t)16 * 2048 * 1024 * 2;
static_assert(OFF_W2 + (size_t)16 * 1024 * 1024 * 2 <= OFF_PR, "overlay");
constexpr size_t OFF_XG = OFF_PR;
constexpr size_t OFF_HID = alignup(OFF_XG + (size_t)EROWS * 1024 * 2);
constexpr size_t OFF_OUT = alignup(OFF_HID + (size_t)EROWS * 1024 * 2);
static_assert(OFF_OUT + (size_t)EROWS * 1024 * 2 <= OFF_PEND, "overlay");
constexpr size_t OFF_EW = OFF_PEND;
constexpr size_t OFF_AA = OFF_EW + 2 * SZ_T;
constexpr size_t OFF_KK = OFF_AA + 2 * SZ_T;
constexpr size_t OFF_KC = OFF_KK + SZ_T;
constexpr size_t OFF_RC = OFF_KC + SZ_T;
constexpr size_t OFF_VC = OFF_RC + SZ_T;
constexpr size_t OFF_YC = alignup(OFF_VC + SZ_T);
constexpr size_t OFF_G = alignup(OFF_YC + SZ_T);
constexpr size_t WS_NEEDED = alignup(OFF_G + SZ_T);
constexpr int YTILE = 262144;
static_assert((OFF_YB - OFF_YA) % YTILE == 0 && (OFF_YC - OFF_YA) % YTILE == 0 && OFF_YC > OFF_YA, "merge A tiles");

struct Params {
    const float *x, *c, *ctx, *c_ctx, *norm1_g, *norm2_g, *ada_w, *ada_b, *w_in, *q_norm_g, *k_norm_g, *diff_lambda, *diff_subln_g,
        *rwkv_conv_w, *rwkv_w0, *rwkv_w_up, *rwkv_a0, *rwkv_a_up, *rwkv_g_up, *rwkv_k_k, *rwkv_k_a, *rwkv_r_k, *rwkv_ln_g, *rwkv_ln_b,
        *conv_w, *w_branch, *w_out, *router_w, *exp_w1, *exp_w3, *exp_w2;
    float* out;
    unsigned char* ws;
};
#define XB_TMO      128
#define XB_XCNT(j)  (256  + 64 * (j))
#define XB_XSUB(j)  (1280 + 64 * (j))
#define XB_XGEN(j)  (2304 + 64 * (j))
#define XB_TOP      3328
#define XB_TOPGEN   3392
#define XCD_BAR_WORDS 3456
#define XB_SPIN_CAP (1u << 18)

__device__ __forceinline__ unsigned xb_ld(unsigned* p)              { return __hip_atomic_load(p, __ATOMIC_RELAXED, __HIP_MEMORY_SCOPE_AGENT); }
__device__ __forceinline__ unsigned xb_add(unsigned* p, unsigned v) { return __hip_atomic_fetch_add(p, v, __ATOMIC_RELAXED, __HIP_MEMORY_SCOPE_AGENT); }
__device__ __forceinline__ unsigned xb_xcc_id() { return (unsigned)__builtin_amdgcn_s_getreg((3 << 11) | 20) & 0xFu; }
#define XB_SPIN(cond, bar) do { unsigned _sp = 0; while (cond) { __builtin_amdgcn_s_sleep(1); \
    if ((++_sp & 255u) == 0u) { if (xb_ld(&(bar)[XB_TMO])) break; if (_sp > XB_SPIN_CAP) { atomicAdd(&(bar)[XB_TMO], 1u); break; } } } } while (0)

struct XcdBarrier {
    unsigned* bar; unsigned x;
    volatile LAS unsigned* st;
};

__device__ __forceinline__ XcdBarrier xcd_barrier_post(unsigned* bar, volatile LAS unsigned* st) {
    XcdBarrier b; b.bar = bar; b.x = xb_xcc_id(); b.st = st;
    if (threadIdx.x == 0) (void)xb_add(&bar[XB_XCNT(b.x)], 1u);
    return b;
}
__device__ __forceinline__ void xcd_barrier_complete(unsigned* bar, unsigned x, unsigned& nloc, unsigned& nx) {
    const unsigned G = gridDim.x * gridDim.y * gridDim.z;
    unsigned sum, cnt, mine, sp = 0u;
    for (;;) {
        sum = 0u; cnt = 0u; mine = 0u;
#pragma unroll
        for (unsigned j = 0; j < 16; ++j) { const unsigned c = xb_ld(&bar[XB_XCNT(j)]); sum += c; cnt += (c > 0u) ? 1u : 0u; mine = (j == x) ? c : mine; }
        if (sum == G) break;
        __builtin_amdgcn_s_sleep(1);
        if ((++sp & 255u) == 0u) { if (xb_ld(&bar[XB_TMO])) break; if (sp > XB_SPIN_CAP) { atomicAdd(&bar[XB_TMO], 1u); break; } }
    }
    nloc = mine > 0u ? mine : 1u; nx = cnt > 0u ? cnt : 1u;
}

__device__ __forceinline__ void xcd_barrier(const XcdBarrier& b) {
    asm volatile("s_waitcnt vmcnt(0)" ::: "memory");
    __syncthreads();
    if (threadIdx.x == 0) {
        unsigned* bar = b.bar;
        __builtin_amdgcn_s_waitcnt(0);
        unsigned nloc = b.st[0], nx = b.st[1];
        if (nloc == 0u) { xcd_barrier_complete(bar, b.x, nloc, nx); b.st[0] = nloc; b.st[1] = nx; }
        const unsigned old = xb_add(&bar[XB_XSUB(b.x)], 1u);
        const unsigned gen = old / nloc;
        if (old + 1u == (gen + 1u) * nloc) {
            __builtin_amdgcn_fence(__ATOMIC_RELEASE, "agent");
            asm volatile("s_waitcnt vmcnt(0)" ::: "memory");
            const unsigned og = xb_add(&bar[XB_TOP], 1u);
            const unsigned tg = og / nx;
            if (og + 1u == (tg + 1u) * nx) xb_add(&bar[XB_TOPGEN], 1u);
            else XB_SPIN(xb_ld(&bar[XB_TOPGEN]) == tg, bar);
            __builtin_amdgcn_fence(__ATOMIC_ACQUIRE, "agent");
            xb_add(&bar[XB_XGEN(b.x)], 1u);
            asm volatile("s_waitcnt vmcnt(0)" ::: "memory");
        } else {
            XB_SPIN(xb_ld(&bar[XB_XGEN(b.x)]) == gen, bar);
            __builtin_amdgcn_fence(__ATOMIC_ACQUIRE, "agent");
            asm volatile("s_waitcnt vmcnt(0)" ::: "memory");
        }
    }
    __syncthreads();
}
namespace pg8 {
#define PG8_LAS __attribute__((address_space(3)))
constexpr int BM = 256, BK = 64, HALF = 128, HTB = HALF * BK * 2  , STAGE_BYTES = 8 * HTB, NXCD = 8, WGM = 8;
__host__ __device__ __forceinline__ int lds_byte(int r, int c) { const int st = (r >> 4) * 2 + (c >> 5), rr = r & 15, cc = c & 31, ob = rr * 64 + cc * 2; return st * 1024 + (ob ^ (((ob >> 9) & 1) << 5)); }
__host__ __device__ __forceinline__ void stage_rc(int b, int& R, int& C) { const int st = b / 1024, sb = b % 1024, swz = sb ^ (((sb >> 9) & 1) << 5); R = (st >> 1) * 16 + swz / 64; C = (st & 1) * 32 + (swz % 64) / 2; }
__host__ __device__ __forceinline__ int perm32(int rho) { const int n = rho >> 4, i = rho & 15; return 8 * (i >> 2) + 4 * n + (i & 3); }
struct Unit { int pm, pn; int rt, ct, br; };
struct Gemm { const bf16_t* A; const bf16_t* Bt; int M, N, K; };
template <class Epi, class Sched, bool STAMP = false>
__device__ __forceinline__ void gemm_phase(PG8_LAS unsigned char* lds, const Gemm g, const Sched& S, const Epi& E, unsigned long long* stamps) {
    const int tid = threadIdx.x, wid = __builtin_amdgcn_readfirstlane(tid >> 6), lane = tid & 63, wr = wid >> 2, wc = wid & 3, fr = lane & 15, fq = lane >> 4;
    const int K = g.K, nt = K / BK;
    int ts_lo = 0, ts_hi = 0, nts = 0; const unsigned long long rt_entry = STAMP ? (unsigned long long)wall_clock64() : 0ull;
#define PG8_STAMP() do { if (STAMP && wid == 0 && nts < 64) { const unsigned long long _c = (unsigned long long)clock64(); \
        ts_lo = (lane == nts) ? (int)(unsigned)_c : ts_lo; ts_hi = (lane == nts) ? (int)(unsigned)(_c >> 32) : ts_hi; ++nts; } } while (0)
    PG8_STAMP();
    unsigned voffA[2], voffB[2];
#pragma unroll
    for (int i = 0; i < 2; ++i) { int R, C; stage_rc(tid * 16 + i * 8192, R, C); const int Rb = Epi::PERM ? ((R & ~31) + perm32(R & 31)) : R;
        voffA[i] = (unsigned)(R * K + C) * 2u; voffB[i] = (unsigned)(Rb * K + C) * 2u; }
    const size_t kstep = (size_t)(BK * 2);
    const size_t hstep = (size_t)HALF * K * 2;
    const size_t tstep = 2 * hstep;
    const unsigned ldsw = (unsigned)wid * 1024u;
    const int aoff = lds_byte(wr * 64 + fr, fq * 8), boff = lds_byte(wc * 32 + fr, fq * 8);
#define PG8_SA(b, h) (((b) * 2 + (h)) * HTB)
#define PG8_SB(b, h) ((4 + (b) * 2 + (h)) * HTB)
#define PG8_STAGE(bufoff, gbase, voff) do { _Pragma("unroll") for (int _i = 0; _i < 2; ++_i) \
        __builtin_amdgcn_global_load_lds((const unsigned*)((const char*)(gbase) + (voff)[_i]), (PG8_LAS unsigned*)(lds + (bufoff) + ldsw + _i * 8192), 16, 0, 0); } while (0)
#define PG8_LDA(dst, b, h) do { _Pragma("unroll") for (int m = 0; m < 4; ++m) _Pragma("unroll") for (int k = 0; k < 2; ++k) dst[m][k] = *(const PG8_LAS bf16x8*)(lds + PG8_SA(b, h) + aoff + m * 2048 + k * 1024); } while (0)
#define PG8_LDB(dst, b, h) do { _Pragma("unroll") for (int n = 0; n < 2; ++n) _Pragma("unroll") for (int k = 0; k < 2; ++k) dst[n][k] = *(const PG8_LAS bf16x8*)(lds + PG8_SB(b, h) + boff + n * 2048 + k * 1024); } while (0)
#define PG8_MMA(ai, bj, At, Bt) do { __builtin_amdgcn_s_setprio(1); _Pragma("unroll") for (int m = 0; m < 4; ++m) _Pragma("unroll") for (int n = 0; n < 2; ++n) _Pragma("unroll") for (int k = 0; k < 2; ++k) \
        acc[ai][bj][m][n] = __builtin_amdgcn_mfma_f32_16x16x32_bf16(Bt[n][k], At[m][k], acc[ai][bj][m][n], 0, 0, 0); __builtin_amdgcn_s_setprio(0); } while (0)
#define PG8_WAIT_V(n) asm volatile("s_waitcnt vmcnt(" #n ")" ::: "memory")
#define PG8_WAIT_L(n) asm volatile("s_waitcnt lgkmcnt(" #n ")" ::: "memory")
#define PG8_BAR __builtin_amdgcn_s_barrier()
#define PG8_SCHED __builtin_amdgcn_sched_barrier(0)
    Unit cur, nxt; int ui = 0;
    if (!S.next(0, cur)) return;
    f32x4 acc[2][2][4][2];
#pragma unroll
    for (int a = 0; a < 2; ++a)
#pragma unroll
        for (int b = 0; b < 2; ++b)
#pragma unroll
            for (int m = 0; m < 4; ++m)
#pragma unroll
                for (int n = 0; n < 2; ++n) acc[a][b][m][n] = (f32x4){0.f, 0.f, 0.f, 0.f};
    bf16x8 At[4][2], B0[2][2], B1[2][2];
    const char* cA = (const char*)g.A + (size_t)cur.pm * tstep; const char* cB = (const char*)g.Bt + (size_t)cur.pn * tstep;
    S.a_ready(cur);
    PG8_STAGE(PG8_SB(0, 0), cB, voffB); PG8_STAGE(PG8_SA(0, 0), cA, voffA); PG8_STAGE(PG8_SB(0, 1), cB + hstep, voffB); PG8_STAGE(PG8_SA(0, 1), cA + hstep, voffA);
    if (wr == 1) PG8_BAR;
    PG8_WAIT_V(4); PG8_BAR;
    PG8_STAGE(PG8_SB(1, 0), cB + kstep, voffB); PG8_STAGE(PG8_SA(1, 0), cA + kstep, voffA); PG8_STAGE(PG8_SB(1, 1), cB + hstep + kstep, voffB);
    PG8_WAIT_V(6); PG8_BAR;
    PG8_STAMP();
    for (;;) {
        const bool has_next = S.next(ui + 1, nxt);
        const char* nA = has_next ? (const char*)g.A + (size_t)nxt.pm * tstep : cA; const char* nB = has_next ? (const char*)g.Bt + (size_t)nxt.pn * tstep : cB;
        for (int t = 0; t < nt; t += 2) {
            const bool last = (t == nt - 2);
            const char* a1 = cA + (size_t)(t + 1) * kstep;
            const char* a2 = last ? nA : cA + (size_t)(t + 2) * kstep; const char* b2 = last ? nB : cB + (size_t)(t + 2) * kstep;
            const char* a3 = a2 + kstep; const char* b3 = b2 + kstep;
            if (last && has_next) S.a_ready(nxt);
            PG8_LDB(B0, 0, 0); PG8_SCHED; PG8_LDA(At, 0, 0); PG8_STAGE(PG8_SA(1, 1), a1 + hstep, voffA);
            PG8_WAIT_L(8); PG8_BAR; PG8_WAIT_L(0); PG8_MMA(0, 0, At, B0); PG8_BAR; PG8_SCHED;
            PG8_LDB(B1, 0, 1); PG8_STAGE(PG8_SB(0, 0), b2, voffB);
            PG8_BAR; PG8_WAIT_L(0); PG8_MMA(0, 1, At, B1); PG8_BAR;
            PG8_LDA(At, 0, 1); PG8_STAGE(PG8_SA(0, 0), a2, voffA);
            PG8_BAR; PG8_WAIT_L(0); PG8_MMA(1, 0, At, B0); PG8_BAR; PG8_SCHED;
            PG8_STAGE(PG8_SB(0, 1), b2 + hstep, voffB);
            PG8_WAIT_V(6); PG8_BAR; PG8_MMA(1, 1, At, B1); PG8_BAR;
            PG8_LDB(B0, 1, 0); PG8_SCHED; PG8_LDA(At, 1, 0); PG8_STAGE(PG8_SA(0, 1), a2 + hstep, voffA);
            PG8_WAIT_L(8); PG8_BAR; PG8_WAIT_L(0); PG8_MMA(0, 0, At, B0); PG8_BAR; PG8_SCHED;
            PG8_LDB(B1, 1, 1); PG8_STAGE(PG8_SB(1, 0), b3, voffB);
            PG8_BAR; PG8_WAIT_L(0); PG8_MMA(0, 1, At, B1); PG8_BAR;
            PG8_LDA(At, 1, 1); PG8_STAGE(PG8_SA(1, 0), a3, voffA);
            PG8_BAR; PG8_WAIT_L(0); PG8_MMA(1, 0, At, B0); PG8_BAR; PG8_SCHED;
            PG8_STAGE(PG8_SB(1, 1), b3 + hstep, voffB);
            PG8_WAIT_V(6); PG8_BAR; PG8_MMA(1, 1, At, B1); PG8_BAR;
        }
        PG8_STAMP();
        if constexpr (!Epi::AFTER_DRAIN) { E(acc, cur, wr, wc, fr, fq); S.done(cur); }
        PG8_STAMP();
        if (!has_next) break;
#pragma unroll
        for (int a = 0; a < 2; ++a)
#pragma unroll
            for (int b = 0; b < 2; ++b)
#pragma unroll
                for (int m = 0; m < 4; ++m)
#pragma unroll
                    for (int n = 0; n < 2; ++n) acc[a][b][m][n] = (f32x4){0.f, 0.f, 0.f, 0.f};
        cur = nxt; cA = nA; cB = nB; ++ui;
    }
    PG8_WAIT_V(0);
    if (wr == 0) PG8_BAR;
    PG8_BAR;
    if constexpr (Epi::AFTER_DRAIN) { E.fused(acc, cur, wr, wc, fr, fq, lds, wid, lane); S.done(cur); }
    PG8_STAMP();
    if (STAMP && wid == 0) { stamps[lane] = lane < nts ? (((unsigned long long)(unsigned)ts_hi << 32) | (unsigned)ts_lo) : 0ull;
        if (lane == 62) stamps[62] = rt_entry; if (lane == 63) stamps[63] = (unsigned long long)wall_clock64(); }
#undef PG8_STAMP
#undef PG8_SA
#undef PG8_SB
#undef PG8_STAGE
#undef PG8_LDA
#undef PG8_LDB
#undef PG8_MMA
#undef PG8_WAIT_V
#undef PG8_WAIT_L
#undef PG8_BAR
#undef PG8_SCHED
}
}
using pg8::Unit;

struct SchedPlain {
    int nM, nN, nwg, G, c;
    __device__ void init(int nM_, int nN_, int G_, int c_) { nM = nM_; nN = nN_; nwg = nM * nN; G = G_; c = c_; }
    __device__ bool next(int i, Unit& u) const {
        const long L = (long)i * G + c; if (L >= nwg) return false;
        int wgid = (int)L; { const int q = nwg / 8, r = nwg % 8, xcd = wgid % 8, off = wgid / 8; wgid = (xcd < r ? xcd * (q + 1) : r * (q + 1) + (xcd - r) * q) + off; }
        const int nig = 8 * nN, gid = wgid / nig, fm = gid * 8, gsz = (nM - fm) < 8 ? (nM - fm) : 8;
        u.pm = fm + ((wgid % nig) % gsz); u.pn = (wgid % nig) / gsz; u.rt = u.pm; u.ct = u.pn; u.br = 0; return true;
    }
    DI void a_ready(const Unit&) const {}
    DI void done(const Unit&) const {}
};
struct SchedMerge {
    int G, c, pmb1, pmb2;
    __device__ void init(int G_, int c_) { G = G_; c = c_; pmb1 = (int)((OFF_YB - OFF_YA) / YTILE); pmb2 = (int)((OFF_YC - OFF_YA) / YTILE); }
    __device__ bool next(int i, Unit& u) const {
        const int tile = (i / 3) * G + c, br = i % 3; if (tile >= 528) return false;
        u.rt = tile >> 2; u.ct = tile & 3; u.br = br;
        u.pm = u.rt + (br == 0 ? 0 : (br == 1 ? pmb1 : pmb2)); u.pn = br * 4 + u.ct; return true;
    }
    DI void a_ready(const Unit&) const {}
    DI void done(const Unit&) const {}
};
template <int NCT> struct SchedMoe {
    int G, c;
    __device__ void init(int G_, int c_) { G = G_; c = c_; }
    __device__ bool next(int i, Unit& u) const {
        const int L = i * G + c; if (L >= 16 * 17 * NCT) return false;
        const int e = L / (17 * NCT), rem = L % (17 * NCT); u.rt = rem / NCT; u.ct = rem % NCT; u.br = e;
        u.pm = e * 17 + u.rt; u.pn = e * NCT + u.ct; return true;
    }
    DI void a_ready(const Unit&) const {}
    DI void done(const Unit&) const {}
};

DI u32x4 pack8(const f32x4& a, const f32x4& b) { u32x4 w = {pk2(a[0], a[1]), pk2(a[2], a[3]), pk2(b[0], b[1]), pk2(b[2], b[3])}; return w; }

struct EpiInProj {
    static constexpr bool PERM = true, AFTER_DRAIN = false;
    unsigned char* ws;
    DI void operator()(const f32x4 (&acc)[2][2][4][2], const Unit& u, int wr, int wc, int fr, int fq) const {
        const int pn = u.pn; bf16_t* base; int ld, colt; bool sig = false;
        if (pn < 6) { base = (bf16_t*)(ws + OFF_PA); ld = 1536; colt = pn * 256; }
        else if (pn < 13) { base = (bf16_t*)(ws + OFF_PR); ld = 1792; colt = (pn - 6) * 256; }
        else if (pn < 19) { base = (bf16_t*)(ws + OFF_PC); ld = 1536; colt = (pn - 13) * 256; }
        else { base = (bf16_t*)(ws + OFF_PG); ld = 3072; colt = (pn - 19) * 256; sig = true; }
        const int row0 = u.pm * 256 + wr * 64 + fr, col0 = colt + wc * 32 + 8 * fq;
#pragma unroll
        for (int ai = 0; ai < 2; ++ai)
#pragma unroll
            for (int m = 0; m < 4; ++m) { bf16_t* rowp = base + (size_t)(row0 + ai * 128 + m * 16) * ld + col0;
#pragma unroll
                for (int bj = 0; bj < 2; ++bj) { f32x4 v0 = acc[ai][bj][m][0], v1 = acc[ai][bj][m][1];
                    if (sig) {
#pragma unroll
                        for (int i = 0; i < 4; ++i) { v0[i] = sigmoidf_(v0[i]); v1[i] = sigmoidf_(v1[i]); } }
                    *(u32x4*)(rowp + bj * 128) = pack8(v0, v1); } }
    }
};
struct EpiMerge {
    static constexpr bool PERM = true, AFTER_DRAIN = false;
    unsigned char* ws;
    DI void operator()(const f32x4 (&acc)[2][2][4][2], const Unit& u, int wr, int wc, int fr, int fq) const {
        const bf16_t* PG = (const bf16_t*)(ws + OFF_PG); bf16_t* M = (bf16_t*)(ws + OFF_M);
        const int row0 = u.rt * 256 + wr * 64 + fr, col0 = u.ct * 256 + wc * 32 + 8 * fq, br = u.br;
#pragma unroll
        for (int ai = 0; ai < 2; ++ai)
#pragma unroll
            for (int m = 0; m < 4; ++m) { const size_t r = (size_t)(row0 + ai * 128 + m * 16);
#pragma unroll
                for (int bj = 0; bj < 2; ++bj) { const int c = col0 + bj * 128;
                    const u32x4 g = *(const u32x4*)(PG + r * 3072 + br * 1024 + c);
                    u32x4 pv = {0u, 0u, 0u, 0u}; if (br != 0) pv = *(const u32x4*)(M + r * 1024 + c);
                    const f32x4 a0 = acc[ai][bj][m][0], a1 = acc[ai][bj][m][1];
                    f32x4 o0, o1;
                    o0[0] = bflo(pv[0]) + bflo(g[0]) * a0[0]; o0[1] = bfhi(pv[0]) + bfhi(g[0]) * a0[1]; o0[2] = bflo(pv[1]) + bflo(g[1]) * a0[2]; o0[3] = bfhi(pv[1]) + bfhi(g[1]) * a0[3];
                    o1[0] = bflo(pv[2]) + bflo(g[2]) * a1[0]; o1[1] = bfhi(pv[2]) + bfhi(g[2]) * a1[1]; o1[2] = bflo(pv[3]) + bflo(g[3]) * a1[2]; o1[3] = bfhi(pv[3]) + bfhi(g[3]) * a1[3];
                    *(u32x4*)(M + r * 1024 + c) = pack8(o0, o1); } }
    }
};
struct EpiOut {
    static constexpr bool PERM = false, AFTER_DRAIN = false;
    unsigned char* ws; int l;
    DI void operator()(const f32x4 (&acc)[2][2][4][2], const Unit& u, int wr, int wc, int fr, int fq) const {
        float* X = (float*)(ws + OFF_X); const float* MOD = (const float*)(ws + OFF_MOD) + (size_t)l * 5 * 6144;
        const int row0 = u.pm * 256 + wr * 64 + fr, col0 = u.pn * 256 + wc * 32 + 4 * fq;
#pragma unroll
        for (int ai = 0; ai < 2; ++ai)
#pragma unroll
            for (int m = 0; m < 4; ++m) { const int r = row0 + ai * 128 + m * 16; const int b = r / TT, s = r - b * TT; const int mi = s < NCTX ? 4 : b;
                const float* g1 = MOD + mi * 6144 + 2 * 1024; float* xr = X + (size_t)r * 1024;
#pragma unroll
                for (int bj = 0; bj < 2; ++bj)
#pragma unroll
                    for (int n = 0; n < 2; ++n) { const int c = col0 + bj * 128 + n * 16; const f32x4 gv = *(const f32x4*)(g1 + c); f32x4 xv = *(f32x4*)(xr + c);
                        xv += gv * acc[ai][bj][m][n]; *(f32x4*)(xr + c) = xv; } }
    }
};
struct EpiUp {
    static constexpr bool PERM = true, AFTER_DRAIN = false;
    unsigned char* ws;
    DI void operator()(const f32x4 (&acc)[2][2][4][2], const Unit& u, int wr, int wc, int fr, int fq) const {
        bf16_t* HID = (bf16_t*)(ws + OFF_HID);
        const int row0 = u.pm * 256 + wr * 64 + fr, hc0 = u.ct * 128 + wc * 16 + fq * 4;
#pragma unroll
        for (int ai = 0; ai < 2; ++ai)
#pragma unroll
            for (int m = 0; m < 4; ++m) { bf16_t* rowp = HID + (size_t)(row0 + ai * 128 + m * 16) * 1024 + hc0;
#pragma unroll
                for (int bj = 0; bj < 2; ++bj) { const f32x4 a = acc[ai][bj][m][0], b = acc[ai][bj][m][1]; f32x4 h;
#pragma unroll
                    for (int i = 0; i < 4; ++i) h[i] = a[i] * sigmoidf_(a[i]) * b[i];
                    u32x2 w = {pk2(h[0], h[1]), pk2(h[2], h[3])}; *(u32x2*)(rowp + bj * 64) = w; } }
    }
};
struct EpiDown {
    static constexpr bool PERM = true, AFTER_DRAIN = false;
    unsigned char* ws;
    DI void operator()(const f32x4 (&acc)[2][2][4][2], const Unit& u, int wr, int wc, int fr, int fq) const {
        bf16_t* O = (bf16_t*)(ws + OFF_OUT);
        const int row0 = u.pm * 256 + wr * 64 + fr, col0 = u.ct * 256 + wc * 32 + 8 * fq;
#pragma unroll
        for (int ai = 0; ai < 2; ++ai)
#pragma unroll
            for (int m = 0; m < 4; ++m) { bf16_t* rowp = O + (size_t)(row0 + ai * 128 + m * 16) * 1024 + col0;
#pragma unroll
                for (int bj = 0; bj < 2; ++bj) *(u32x4*)(rowp + bj * 128) = pack8(acc[ai][bj][m][0], acc[ai][bj][m][1]); }
    }
};
DI int row_mod(int r) { const int b = r / TT, s = r - b * TT; return s < NCTX ? 4 : b; }

__device__ void ph_prologue(const Params& p, LAS unsigned char* lds, int wg, int nwg) {
    const int tid = threadIdx.x;
    {   float4* X4 = (float4*)(p.ws + OFF_X);
        const size_t n4 = (size_t)RR * 256;
        for (size_t i = (size_t)wg * 512 + tid; i < n4; i += (size_t)nwg * 512) {
            const int row = (int)(i >> 8), c4 = (int)(i & 255); const int b = row / TT, s = row - b * TT;
            const float4* src = (s < NCTX) ? (const float4*)(p.ctx + ((size_t)(b * NCTX + s)) * DM) : (const float4*)(p.x + ((size_t)(b * SEQ + s - NCTX)) * DM);
            X4[i] = src[c4]; } }
    if (wg == 0 && tid < 16) {
        float* COS = (float*)(p.ws + OFF_ROPE); float* SIN = COS + 2048;
        const int k = tid; const int q4 = k & 3, dec = k >> 2;
        double th = (q4 == 0) ? 1.0 : (q4 == 1 ? 0.56234132519034908 : (q4 == 2 ? 0.31622776601683794 : 0.17782794100389228));
        for (int i = 0; i < dec; ++i) th *= 0.1;
        double ct = 1.0, st = th, term_c = 1.0, term_s = th; const double t2 = th * th;
        for (int n = 1; n <= 12; ++n) { term_c *= -t2 / (double)((2 * n - 1) * (2 * n)); term_s *= -t2 / (double)((2 * n) * (2 * n + 1)); ct += term_c; st += term_s; }
        double cp = 1.0, sp = 0.0;
        for (int pos = 0; pos < 128; ++pos) { COS[pos * 16 + k] = (float)cp; SIN[pos * 16 + k] = (float)sp; const double c2 = cp * ct - sp * st, s2 = sp * ct + cp * st; cp = c2; sp = s2; }
    }
    {
        LAS float* sc = (LAS float*)lds;
        LAS float* red = sc + 5 * 1024;
        float* MOD = (float*)(p.ws + OFF_MOD);
        for (int i = tid; i < 5 * 1024; i += 512) { const int m = i >> 10, k = i & 1023; const float v = (m < 4) ? p.c[m * 1024 + k] : p.c_ctx[k]; sc[i] = v * sigmoidf_(v); }
        __syncthreads();
        for (int u = wg; u < NL * 48; u += nwg) {
            const int l = u / 48, cb = u % 48; const int cl = tid & 127, col = cb * 128 + cl, kq = tid >> 7;
            const float* W = p.ada_w + (size_t)l * 1024 * 6144 + col;
            float a0 = 0, a1 = 0, a2 = 0, a3 = 0, a4 = 0;
            for (int k = kq * 256; k < kq * 256 + 256; ++k) { const float w = W[(size_t)k * 6144]; a0 += sc[k] * w; a1 += sc[1024 + k] * w; a2 += sc[2048 + k] * w; a3 += sc[3072 + k] * w; a4 += sc[4096 + k] * w; }
            red[(kq * 5 + 0) * 128 + cl] = a0; red[(kq * 5 + 1) * 128 + cl] = a1; red[(kq * 5 + 2) * 128 + cl] = a2; red[(kq * 5 + 3) * 128 + cl] = a3; red[(kq * 5 + 4) * 128 + cl] = a4;
            __syncthreads();
            if (tid < 128) { const float bb = p.ada_b[l * 6144 + col];
                for (int m = 0; m < 5; ++m) { const float s = red[(0 * 5 + m) * 128 + cl] + red[(1 * 5 + m) * 128 + cl] + red[(2 * 5 + m) * 128 + cl] + red[(3 * 5 + m) * 128 + cl];
                    MOD[((size_t)(l * 5 + m)) * 6144 + col] = s + bb; } }
            __syncthreads();
        }
    }
}

template <class RowMap> DI void tconv_tile(const float* src, int ldn, int k0, int n0, bf16_t* dst, int K, RowMap rm, LAS float* tile  , int tid) {
#pragma unroll
    for (int i = 0; i < 8; ++i) { const int k = (tid >> 6) + 8 * i, n = tid & 63; tile[k * 65 + n] = src[(size_t)(k0 + k) * ldn + n0 + n]; }
    __syncthreads();
    const int n = tid >> 3, k8 = (tid & 7) * 8; float v[8];
#pragma unroll
    for (int j = 0; j < 8; ++j) v[j] = tile[(k8 + j) * 65 + n];
    u32x4 w = {pk2(v[0], v[1]), pk2(v[2], v[3]), pk2(v[4], v[5]), pk2(v[6], v[7])};
    *(u32x4*)(dst + (size_t)rm(n0 + n) * K + k0 + k8) = w;
    __syncthreads();
}
struct RowId { DI int operator()(int n) const { return n; } };
struct RowW13 { int sel; DI int operator()(int j) const { return (j >> 7) * 256 + ((j & 127) >> 2) * 8 + sel * 4 + (j & 3); } };

__device__ void conv_mixer_weights(const Params& p, int l, LAS unsigned char* lds, int wg, int nwg) {
    LAS float* tile = (LAS float*)lds; const int tid = threadIdx.x;
    constexpr int U_IN = 16 * 124, U_BR = 3 * 8 * 16, U_OUT = 256;
    for (int u = wg; u < U_IN + U_BR + U_OUT; u += nwg) {
        if (u < U_IN) { const int kt = u / 124, nt = u % 124;
            tconv_tile(p.w_in + (size_t)l * 1024 * NIN, NIN, kt * 64, nt * 64, (bf16_t*)(p.ws + OFF_WIN), 1024, RowId(), tile, tid); }
        else if (u < U_IN + U_BR) { const int v = u - U_IN, i = v / 128, kt = (v % 128) / 16, nt = v % 16;
            tconv_tile(p.w_branch + ((size_t)(l * 3 + i)) * 512 * 1024, 1024, kt * 64, nt * 64, (bf16_t*)(p.ws + OFF_WBR) + (size_t)i * 1024 * 512, 512, RowId(), tile, tid); }
        else { const int v = u - U_IN - U_BR, kt = v / 16, nt = v % 16;
            tconv_tile(p.w_out + (size_t)l * 1024 * 1024, 1024, kt * 64, nt * 64, (bf16_t*)(p.ws + OFF_WOUT), 1024, RowId(), tile, tid); }
    }
}
__device__ void conv_expert_weights(const Params& p, int l, LAS unsigned char* lds, int wg, int nwg) {
    LAS float* tile = (LAS float*)lds; const int tid = threadIdx.x;
    for (int u = wg; u < 16 * 3 * 256; u += nwg) {
        const int e = u / 768, v = u % 768, which = v / 256, kt = (v % 256) / 16, nt = v % 16;
        const size_t eoff = ((size_t)(l * 16 + e)) * 1024 * 1024;
        if (which == 0) tconv_tile(p.exp_w1 + eoff, 1024, kt * 64, nt * 64, (bf16_t*)(p.ws + OFF_W13) + (size_t)e * 2048 * 1024, 1024, RowW13{0}, tile, tid);
        else if (which == 1) tconv_tile(p.exp_w3 + eoff, 1024, kt * 64, nt * 64, (bf16_t*)(p.ws + OFF_W13) + (size_t)e * 2048 * 1024, 1024, RowW13{1}, tile, tid);
        else tconv_tile(p.exp_w2 + eoff, 1024, kt * 64, nt * 64, (bf16_t*)(p.ws + OFF_W2) + (size_t)e * 1024 * 1024, 1024, RowId(), tile, tid);
    }
}

__device__ void norm1_rows(const Params& p, int l, int wg, int nwg) {
    const int tid = threadIdx.x, wave = tid >> 6, lane = tid & 63;
    const float* X = (const float*)(p.ws + OFF_X); bf16_t* H = (bf16_t*)(p.ws + OFF_H);
    const float* MOD = (const float*)(p.ws + OFF_MOD) + (size_t)l * 5 * 6144; const float* g = p.norm1_g + l * 1024;
    for (int r = wg * 8 + wave; r < RR; r += nwg * 8) {
        const float4* xr = (const float4*)(X + (size_t)r * 1024); float4 v[4]; float ss = 0.f;
#pragma unroll
        for (int i = 0; i < 4; ++i) { v[i] = xr[lane + 64 * i]; ss += v[i].x * v[i].x + v[i].y * v[i].y + v[i].z * v[i].z + v[i].w * v[i].w; }
        ss = wave_sum(ss);
        const float rinv = rsqrtf(ss * (1.f / 1024.f) + 1e-6f);
        const float* md = MOD + row_mod(r) * 6144;
#pragma unroll
        for (int i = 0; i < 4; ++i) { const int col = (lane + 64 * i) * 4;
            const float4 gg = *(const float4*)(g + col), sh = *(const float4*)(md + col), sc = *(const float4*)(md + 1024 + col);
            const float y0 = v[i].x * rinv * gg.x * (1.f + sc.x) + sh.x, y1 = v[i].y * rinv * gg.y * (1.f + sc.y) + sh.y, y2 = v[i].z * rinv * gg.z * (1.f + sc.z) + sh.z, y3 = v[i].w * rinv * gg.w * (1.f + sc.w) + sh.w;
            u32x2 w = {pk2(y0, y1), pk2(y2, y3)}; *(u32x2*)(H + (size_t)r * 1024 + col) = w; }
    }
}
DI void prep_rows_unit(const Params& p, int l, LAS unsigned char* lds, int ub) {
    const int tid = threadIdx.x;
    const int r0 = ub * 16; const int b = r0 / TT, s0 = r0 - b * TT;
    const bool isctx = s0 < NCTX; const int seg_lo = isctx ? 0 : NCTX, seg_hi = isctx ? NCTX : TT;
    const bool has_prev = s0 > seg_lo, has_next = (s0 + 16) < seg_hi;
    bf16_t* PA = (bf16_t*)(p.ws + OFF_PA); const bf16_t* PR = (const bf16_t*)(p.ws + OFF_PR); const bf16_t* PC = (const bf16_t*)(p.ws + OFF_PC);
    LAS float* TW = (LAS float*)lds; LAS float* AL = TW + 1024; LAS float* SG = TW + 2048;
#pragma unroll
    for (int i = 0; i < 8; ++i) { const int idx = tid + 512 * i; const int rr = idx >> 8, cc = idx & 255; const float v = bf2f(PR[(size_t)(r0 + rr) * 1792 + 1536 + cc]);
        if (cc < 64) TW[rr * 64 + cc] = tanhf(v); else if (cc < 128) AL[rr * 64 + cc - 64] = v; else SG[rr * 128 + cc - 128] = sigmoidf_(v); }
    float rc[16], kc[16], vc[16];
    {   const float* cw = p.rwkv_conv_w + (size_t)l * 3 * 1536;
#pragma unroll
        for (int g = 0; g < 3; ++g) {
            const int co = g * 512 + tid; const float w0 = cw[co], w1 = cw[1536 + co], w2 = cw[3072 + co];
            float x[18];
            x[0] = has_prev ? bf2f(PR[(size_t)(r0 - 1) * 1792 + co]) : 0.f;
#pragma unroll
            for (int i = 0; i < 16; ++i) x[i + 1] = bf2f(PR[(size_t)(r0 + i) * 1792 + co]);
            x[17] = has_next ? bf2f(PR[(size_t)(r0 + 16) * 1792 + co]) : 0.f;
#pragma unroll
            for (int i = 0; i < 16; ++i) { const float o = w0 * x[i] + w1 * x[i + 1] + w2 * x[i + 2]; if (g == 0) rc[i] = o; else if (g == 1) kc[i] = o; else vc[i] = o; }
        } }
    bf16_t* EW = (bf16_t*)(p.ws + OFF_EW); bf16_t* AA = (bf16_t*)(p.ws + OFF_AA);
    bf16_t* KK = (bf16_t*)(p.ws + OFF_KK); bf16_t* KC = (bf16_t*)(p.ws + OFF_KC); bf16_t* RC = (bf16_t*)(p.ws + OFF_RC); bf16_t* VC = (bf16_t*)(p.ws + OFF_VC);
    {   const float kkc = p.rwkv_k_k[l * 512 + tid];
#pragma unroll
        for (int i = 0; i < 16; ++i) { const float q = kc[i] * kkc; const float ss = wave_sum(q * q); const float kk = q / fmaxf(sqrtf(ss), 1e-12f);
            const size_t o = (size_t)(r0 + i) * 512 + tid; KK[o] = f2bf(kk); KC[o] = f2bf(kc[i]); RC[o] = f2bf(rc[i]); VC[o] = f2bf(vc[i]); } }
    __syncthreads();
    float bon[16];
#pragma unroll
    for (int i = 0; i < 16; ++i) bon[i] = 0.f;
    const float kac = p.rwkv_k_a[l * 512 + tid], rkc = p.rwkv_r_k[l * 512 + tid];
#pragma unroll 1
    for (int d = 0; d < 2; ++d) {
        float wa[16], aa[16];
#pragma unroll
        for (int i = 0; i < 16; ++i) { wa[i] = 0.f; aa[i] = 0.f; }
        const float* WU = p.rwkv_w_up + ((size_t)(l * 2 + d) * 64) * 512 + tid; const float* AU = p.rwkv_a_up + ((size_t)(l * 2 + d) * 64) * 512 + tid;
#pragma unroll 1
        for (int j = 0; j < 64; j += 4) {
            const float wu0 = WU[(j + 0) * 512], wu1 = WU[(j + 1) * 512], wu2 = WU[(j + 2) * 512], wu3 = WU[(j + 3) * 512];
            const float au0 = AU[(j + 0) * 512], au1 = AU[(j + 1) * 512], au2 = AU[(j + 2) * 512], au3 = AU[(j + 3) * 512];
#pragma unroll
            for (int i = 0; i < 16; ++i) { const f32x4 t = *(const LAS f32x4*)(TW + i * 64 + j); wa[i] += t[0] * wu0 + t[1] * wu1 + t[2] * wu2 + t[3] * wu3;
                const f32x4 a4 = *(const LAS f32x4*)(AL + i * 64 + j); aa[i] += a4[0] * au0 + a4[1] * au1 + a4[2] * au2 + a4[3] * au3; }
        }
        const float w0c = p.rwkv_w0[(l * 2 + d) * 512 + tid], a0c = p.rwkv_a0[(l * 2 + d) * 512 + tid];
#pragma unroll
        for (int i = 0; i < 16; ++i) {
            const float z = w0c + wa[i];
            const float sp = fmaxf(-z, 0.f) + log1pf(__expf(-fabsf(z)));
            const float e = __expf(-sp - 0.5f);
            const float a = sigmoidf_(a0c + aa[i]);
            const size_t o = (size_t)d * RR * 512 + (size_t)(r0 + i) * 512 + tid; EW[o] = f2bf(e); AA[o] = f2bf(a);
            const float kd = kc[i] * (1.f + (a - 1.f) * kac);
            bon[i] += wave_sum(rc[i] * kd * rkc);
        }
    }
    {   float ga[16];
#pragma unroll
        for (int i = 0; i < 16; ++i) ga[i] = 0.f;
        const float* GU = p.rwkv_g_up + (size_t)l * 128 * 512 + tid;
#pragma unroll 1
        for (int j = 0; j < 128; j += 4) {
            const float g0 = GU[(j + 0) * 512], g1 = GU[(j + 1) * 512], g2 = GU[(j + 2) * 512], g3 = GU[(j + 3) * 512];
#pragma unroll
            for (int i = 0; i < 16; ++i) { const f32x4 t = *(const LAS f32x4*)(SG + i * 128 + j); ga[i] += t[0] * g0 + t[1] * g1 + t[2] * g2 + t[3] * g3; }
        }
        bf16_t* G = (bf16_t*)(p.ws + OFF_G); bf16_t* YB0 = (bf16_t*)(p.ws + OFF_YB0); const float lnb2 = 2.f * p.rwkv_ln_b[l * 512 + tid];
#pragma unroll
        for (int i = 0; i < 16; ++i) { const size_t o = (size_t)(r0 + i) * 512 + tid; G[o] = f2bf(ga[i]); YB0[o] = f2bf(lnb2 + bon[i] * vc[i]); }
    }
    {   const float* cw = p.conv_w + (size_t)l * 3 * 512; const float c0 = cw[tid], c1 = cw[512 + tid], c2 = cw[1024 + tid];
        float uu[18];
        uu[0] = has_prev ? bf2f(PC[(size_t)(r0 - 1) * 1536 + 512 + tid]) * bf2f(PC[(size_t)(r0 - 1) * 1536 + 1024 + tid]) : 0.f;
#pragma unroll
        for (int i = 0; i < 16; ++i) uu[i + 1] = bf2f(PC[(size_t)(r0 + i) * 1536 + 512 + tid]) * bf2f(PC[(size_t)(r0 + i) * 1536 + 1024 + tid]);
        uu[17] = has_next ? bf2f(PC[(size_t)(r0 + 16) * 1536 + 512 + tid]) * bf2f(PC[(size_t)(r0 + 16) * 1536 + 1024 + tid]) : 0.f;
        bf16_t* YC = (bf16_t*)(p.ws + OFF_YC);
#pragma unroll
        for (int i = 0; i < 16; ++i) { const float bg = bf2f(PC[(size_t)(r0 + i) * 1536 + tid]); YC[(size_t)(r0 + i) * 512 + tid] = f2bf(bg * (c0 * uu[i] + c1 * uu[i + 1] + c2 * uu[i + 2])); }
    }
    {   const int rr = tid >> 5, g16 = (tid & 31) >> 1, hf = tid & 1; const int s = s0 + rr;
        bf16_t* base = PA + (size_t)(r0 + rr) * 1536 + g16 * 64 + 16 * hf;
        const u32x4 a0 = *(const u32x4*)base, a1 = *(const u32x4*)(base + 8), b0 = *(const u32x4*)(base + 32), b1 = *(const u32x4*)(base + 40);
        float x1[16], x2[16];
#pragma unroll
        for (int i = 0; i < 4; ++i) { x1[2 * i] = bflo(a0[i]); x1[2 * i + 1] = bfhi(a0[i]); x1[8 + 2 * i] = bflo(a1[i]); x1[9 + 2 * i] = bfhi(a1[i]);
            x2[2 * i] = bflo(b0[i]); x2[2 * i + 1] = bfhi(b0[i]); x2[8 + 2 * i] = bflo(b1[i]); x2[9 + 2 * i] = bfhi(b1[i]); }
        float ss = 0.f;
#pragma unroll
        for (int j = 0; j < 16; ++j) ss += x1[j] * x1[j] + x2[j] * x2[j];
        ss += __shfl_xor(ss, 1);
        const float rinv = rsqrtf(ss * (1.f / 64.f) + 1e-6f);
        const float* gg = (g16 < 8 ? p.q_norm_g : p.k_norm_g) + l * 64; const float qs = g16 < 8 ? 0.125f * 1.4426950408889634f : 1.f;
        const float* COS = (const float*)(p.ws + OFF_ROPE); const float* SIN = COS + 2048;
        const int tl = s - NCTX; const int pos = isctx ? 0 : (hf == 0 ? (tl >> 6) : (tl & 63));
#pragma unroll
        for (int j = 0; j < 16; ++j) { const float y1 = x1[j] * rinv * gg[16 * hf + j], y2 = x2[j] * rinv * gg[32 + 16 * hf + j];
            float o1 = y1, o2 = y2;
            if (!isctx) { const float c = COS[pos * 16 + j], sn = SIN[pos * 16 + j]; o1 = y1 * c - y2 * sn; o2 = y2 * c + y1 * sn; }
            x1[j] = o1 * qs; x2[j] = o2 * qs; }
        u32x4 w0, w1, w2, w3;
#pragma unroll
        for (int i = 0; i < 4; ++i) { w0[i] = pk2(x1[2 * i], x1[2 * i + 1]); w1[i] = pk2(x1[8 + 2 * i], x1[9 + 2 * i]); w2[i] = pk2(x2[2 * i], x2[2 * i + 1]); w3[i] = pk2(x2[8 + 2 * i], x2[9 + 2 * i]); }
        *(u32x4*)base = w0; *(u32x4*)(base + 8) = w1; *(u32x4*)(base + 32) = w2; *(u32x4*)(base + 40) = w3;
    }
    __syncthreads();
}
DI void prep_vt_unit(const Params& p, LAS unsigned char* lds, int uv) {
    const int tid = threadIdx.x; const int b = uv / 132, tb = uv % 132;
    const bf16_t* PA = (const bf16_t*)(p.ws + OFF_PA); bf16_t* VT = (bf16_t*)(p.ws + OFF_VT);
    LAS unsigned char* img = lds;
#pragma unroll
    for (int i = 0; i < 8; ++i) { const int id = tid + 512 * i, row = id >> 6, ch = id & 63;
        const u32x4 v = *(const u32x4*)(PA + (size_t)(b * TT + tb * 64 + row) * 1536 + 1024 + ch * 8); *(LAS u32x4*)(img + row * 1040 + ch * 16) = v; }
    __syncthreads();
    bf16_t* dst = VT + ((size_t)(b * 512 + tid)) * TT + tb * 64;
#pragma unroll
    for (int g = 0; g < 4; ++g) { unsigned w[8];
#pragma unroll
        for (int q = 0; q < 8; ++q) { const int p0 = 2 * q, p1 = 2 * q + 1;
            const int k0 = 16 * g + (p0 & 3) + 8 * ((p0 >> 2) & 1) + 4 * (p0 >> 3), k1 = 16 * g + (p1 & 3) + 8 * ((p1 >> 2) & 1) + 4 * (p1 >> 3);
            const unsigned lo = *(const LAS unsigned short*)(img + k0 * 1040 + tid * 2), hi = *(const LAS unsigned short*)(img + k1 * 1040 + tid * 2); w[q] = lo | (hi << 16); }
        u32x4 wa = {w[0], w[1], w[2], w[3]}, wb = {w[4], w[5], w[6], w[7]};
        *(u32x4*)(dst + 16 * g) = wa; *(u32x4*)(dst + 16 * g + 8) = wb; }
    __syncthreads();
}
__device__ void ph_prep(const Params& p, int l, LAS unsigned char* lds, int wg, int nwg) {
    for (int u = wg; u < 528; u += nwg) prep_vt_unit(p, lds, u);
    for (int u = wg; u < RR / 16; u += nwg) prep_rows_unit(p, l, lds, u);
}
#define MFMA32(a, b, c) __builtin_amdgcn_mfma_f32_32x32x16_bf16((a), (b), (c), 0, 0, 0)
DI bf16x8 pack_p(const f32x16& x, int s) {
    u32x4 w = {pk2(x[8 * s + 0], x[8 * s + 1]), pk2(x[8 * s + 2], x[8 * s + 3]), pk2(x[8 * s + 4], x[8 * s + 5]), pk2(x[8 * s + 6], x[8 * s + 7])};
    return __builtin_bit_cast(bf16x8, w);
}
DI void attn_unit(const Params& p, LAS unsigned char* lds, int b, int h, int m, int sq0, int nkt) {
    const int tid = threadIdx.x, wave = tid >> 6, lane = tid & 63, r32 = lane & 31, h2 = lane >> 5;
    const bf16_t* PA = (const bf16_t*)(p.ws + OFF_PA); const bf16_t* VT = (const bf16_t*)(p.ws + OFF_VT);
    bf16_t* O = (bf16_t*)(p.ws + OFF_OA) + (size_t)m * RR * 512;
    const size_t rowbase = (size_t)b * TT;
    bf16x8 qf[4];
    {   const bf16_t* qp = PA + (rowbase + sq0 + wave * 32 + r32) * 1536 + (h * 2 + m) * 64 + 8 * h2;
#pragma unroll
        for (int ks = 0; ks < 4; ++ks) qf[ks] = *(const bf16x8*)(qp + 16 * ks); }
    const int srow = tid >> 3, sch = (tid & 7) ^ ((srow >> 1) & 7);
    const bf16_t* kg = PA + (rowbase + srow) * 1536 + 512 + (h * 2 + m) * 64 + sch * 8;
    const bf16_t* vg0 = VT + ((size_t)((b * 4 + h) * 128 + srow)) * TT + sch * 8;
    const bf16_t* vg1 = vg0 + (size_t)64 * TT;
    LAS unsigned char* Kb = lds; LAS unsigned char* Vb = lds + 16384;
    const int swz = (r32 >> 1) & 7;
    int coff[4];
#pragma unroll
    for (int ks = 0; ks < 4; ++ks) coff[ks] = r32 * 128 + (((2 * ks + h2) ^ swz) << 4);
    f32x16 o[4];
#pragma unroll
    for (int i = 0; i < 4; ++i)
#pragma unroll
        for (int j = 0; j < 16; ++j) o[i][j] = 0.f;
    float m_run = -1e30f, l_run = 0.f;
    u32x4 kreg = *(const u32x4*)kg, vreg0 = *(const u32x4*)vg0, vreg1 = *(const u32x4*)vg1;
    *(LAS u32x4*)(Kb + tid * 16) = kreg; *(LAS u32x4*)(Vb + tid * 16) = vreg0; *(LAS u32x4*)(Vb + 8192 + tid * 16) = vreg1;
    __syncthreads();
    for (int kt = 0; kt < nkt; ++kt) {
        const int cur = kt & 1; const bool more = (kt + 1) < nkt;
        if (more) { kreg = *(const u32x4*)(kg + (size_t)(kt + 1) * 64 * 1536); vreg0 = *(const u32x4*)(vg0 + (kt + 1) * 64); vreg1 = *(const u32x4*)(vg1 + (kt + 1) * 64); }
        const LAS unsigned char* Kc = Kb + cur * 8192; const LAS unsigned char* Vc = Vb + cur * 16384;
        f32x16 s0, s1;
#pragma unroll
        for (int j = 0; j < 16; ++j) { s0[j] = 0.f; s1[j] = 0.f; }
#pragma unroll
        for (int ks = 0; ks < 4; ++ks) { const bf16x8 a0 = *(const LAS bf16x8*)(Kc + coff[ks]), a1 = *(const LAS bf16x8*)(Kc + 4096 + coff[ks]);
            s0 = MFMA32(a0, qf[ks], s0); s1 = MFMA32(a1, qf[ks], s1); }
        float tmax = s0[0];
#pragma unroll
        for (int j = 1; j < 16; ++j) tmax = fmaxf(tmax, s0[j]);
#pragma unroll
        for (int j = 0; j < 16; ++j) tmax = fmaxf(tmax, s1[j]);
        { auto rr = __builtin_amdgcn_permlane32_swap(__float_as_uint(tmax), __float_as_uint(tmax), false, false); tmax = fmaxf(__uint_as_float(rr[0]), __uint_as_float(rr[1])); }
        const float mn = fmaxf(m_run, tmax); const float alpha = __builtin_amdgcn_exp2f(m_run - mn); m_run = mn;
        float ps = 0.f;
#pragma unroll
        for (int j = 0; j < 16; ++j) { s0[j] = __builtin_amdgcn_exp2f(s0[j] - mn); s1[j] = __builtin_amdgcn_exp2f(s1[j] - mn); ps += s0[j] + s1[j]; }
        l_run = l_run * alpha + ps;
#pragma unroll
        for (int i = 0; i < 4; ++i)
#pragma unroll
            for (int j = 0; j < 16; ++j) o[i][j] *= alpha;
        bf16x8 pf[4]; pf[0] = pack_p(s0, 0); pf[1] = pack_p(s0, 1); pf[2] = pack_p(s1, 0); pf[3] = pack_p(s1, 1);
#pragma unroll
        for (int dvb = 0; dvb < 4; ++dvb)
#pragma unroll
            for (int st = 0; st < 4; ++st) { const bf16x8 a = *(const LAS bf16x8*)(Vc + dvb * 4096 + coff[st]); o[dvb] = MFMA32(a, pf[st], o[dvb]); }
        if (more) { LAS unsigned char* Kn = Kb + (cur ^ 1) * 8192; LAS unsigned char* Vn = Vb + (cur ^ 1) * 16384;
            *(LAS u32x4*)(Kn + tid * 16) = kreg; *(LAS u32x4*)(Vn + tid * 16) = vreg0; *(LAS u32x4*)(Vn + 8192 + tid * 16) = vreg1; }
        __syncthreads();
    }
    { auto rr = __builtin_amdgcn_permlane32_swap(__float_as_uint(l_run), __float_as_uint(l_run), false, false); l_run = __uint_as_float(rr[0]) + __uint_as_float(rr[1]); }
    const float inv = 1.f / l_run;
    bf16_t* orow = O + (rowbase + sq0 + wave * 32 + r32) * 512 + h * 128 + 4 * h2;
#pragma unroll
    for (int dvb = 0; dvb < 4; ++dvb)
#pragma unroll
        for (int g = 0; g < 4; ++g) { u32x2 w = {pk2(o[dvb][4 * g] * inv, o[dvb][4 * g + 1] * inv), pk2(o[dvb][4 * g + 2] * inv, o[dvb][4 * g + 3] * inv)};
            *(u32x2*)(orow + dvb * 32 + 8 * g) = w; }
}

constexpr int SC_STEPS = 32, SC_REC = 352  , SC_NCH = TT / SC_STEPS;
DI void scan_unit(const Params& p, int l, LAS unsigned char* lds, int u) {
    const int tid = threadIdx.x, wave = tid >> 6, lane = tid & 63;
    const int chain = u >> 1, half = u & 1; const int dir = chain & 1, bh = chain >> 1, b = bh >> 3, h = bh & 7;
    const int rl = wave * 4 + (lane >> 4), ks = lane & 15;
    const bf16_t* EW = (const bf16_t*)(p.ws + OFF_EW) + (size_t)dir * RR * 512; const bf16_t* AA = (const bf16_t*)(p.ws + OFF_AA) + (size_t)dir * RR * 512;
    const bf16_t* KK = (const bf16_t*)(p.ws + OFF_KK); const bf16_t* KC = (const bf16_t*)(p.ws + OFF_KC); const bf16_t* RC = (const bf16_t*)(p.ws + OFF_RC); const bf16_t* VC = (const bf16_t*)(p.ws + OFF_VC);
    bf16_t* OS = (bf16_t*)(p.ws + OFF_OS) + (size_t)dir * RR * 512;
    LAS float* buf = (LAS float*)lds;
    LAS float* obuf = buf + 2 * SC_STEPS * SC_REC;
    const int lj = tid >> 4, lq = tid & 15, lk = lq * 4;
    float ka[4];
#pragma unroll
    for (int i = 0; i < 4; ++i) ka[i] = p.rwkv_k_a[l * 512 + h * 64 + lk + i];
    u32x2 re, rk, ra, rkc, rr_; unsigned rv;
    auto tok = [&](int i) -> int { return dir == 0 ? i : (i < NCTX ? (NCTX - 1 - i) : (TT + NCTX - 1 - i)); };
    auto gload = [&](int c) { const size_t row = (size_t)b * TT + tok(c * SC_STEPS + lj); const size_t off = row * 512 + h * 64 + lk;
        re = *(const u32x2*)(EW + off); rk = *(const u32x2*)(KK + off); ra = *(const u32x2*)(AA + off); rkc = *(const u32x2*)(KC + off); rr_ = *(const u32x2*)(RC + off);
        rv = *(const unsigned*)(VC + row * 512 + h * 64 + half * 32 + lq * 2); };
    auto lstore = [&](int bi) { LAS float* d = buf + (bi * SC_STEPS + lj) * SC_REC;
        const float e[4] = {bflo(re[0]), bfhi(re[0]), bflo(re[1]), bfhi(re[1])}; const float kk[4] = {bflo(rk[0]), bfhi(rk[0]), bflo(rk[1]), bfhi(rk[1])};
        const float a[4] = {bflo(ra[0]), bfhi(ra[0]), bflo(ra[1]), bfhi(ra[1])}; const float kc[4] = {bflo(rkc[0]), bfhi(rkc[0]), bflo(rkc[1]), bfhi(rkc[1])};
        f32x4 dec, kkv, kka, kd, rv4;
#pragma unroll
        for (int i = 0; i < 4; ++i) { dec[i] = __expf(-e[i]); kkv[i] = kk[i]; kka[i] = kk[i] * a[i]; kd[i] = kc[i] * (1.f + (a[i] - 1.f) * ka[i]); }
        rv4[0] = bflo(rr_[0]); rv4[1] = bfhi(rr_[0]); rv4[2] = bflo(rr_[1]); rv4[3] = bfhi(rr_[1]);
        *(LAS f32x4*)(d + lk) = dec; *(LAS f32x4*)(d + 64 + lk) = kkv; *(LAS f32x4*)(d + 128 + lk) = kka; *(LAS f32x4*)(d + 192 + lk) = kd; *(LAS f32x4*)(d + 256 + lk) = rv4;
        d[320 + lq * 2] = bflo(rv); d[320 + lq * 2 + 1] = bfhi(rv); };
    float s0 = 0.f, s1 = 0.f, s2 = 0.f, s3 = 0.f;
    gload(0); lstore(0); __syncthreads();
#pragma unroll 1
    for (int c = 0; c < SC_NCH; ++c) {
        const int cur = c & 1; const bool more = (c + 1) < SC_NCH;
        if (more) gload(c + 1);
        const LAS float* d = buf + cur * SC_STEPS * SC_REC + ks * 4; LAS float* ob = obuf + cur * SC_STEPS * 32;
#pragma unroll 8
        for (int j = 0; j < SC_STEPS; ++j) {
            const LAS float* dj = d + j * SC_REC;
            const f32x4 w4 = *(const LAS f32x4*)dj, kk4 = *(const LAS f32x4*)(dj + 64), kka4 = *(const LAS f32x4*)(dj + 128), kd4 = *(const LAS f32x4*)(dj + 192), r4 = *(const LAS f32x4*)(dj + 256);
            const float v = buf[(cur * SC_STEPS + j) * SC_REC + 320 + rl];
            float sa = (s0 * kk4[0] + s1 * kk4[1]) + (s2 * kk4[2] + s3 * kk4[3]);
            sa = allsum16(sa);
            s0 = s0 * w4[0] + (v * kd4[0] - sa * kka4[0]); s1 = s1 * w4[1] + (v * kd4[1] - sa * kka4[1]);
            s2 = s2 * w4[2] + (v * kd4[2] - sa * kka4[2]); s3 = s3 * w4[3] + (v * kd4[3] - sa * kka4[3]);
            float y = (s0 * r4[0] + s1 * r4[1]) + (s2 * r4[2] + s3 * r4[3]);
            y = allsum16(y);
            if (ks == 0) ob[j * 32 + rl] = y;
        }
        if (more) lstore(cur ^ 1);
        __syncthreads();
        {   const size_t row = (size_t)b * TT + tok(c * SC_STEPS + lj);
            const float y0 = ob[lj * 32 + lq * 2], y1 = ob[lj * 32 + lq * 2 + 1];
            *(unsigned*)(OS + row * 512 + h * 64 + half * 32 + lq * 2) = pk2(y0, y1); }
    }
    __syncthreads();
}

__device__ void ph_mix(const Params& p, int l, LAS unsigned char* lds, LAS unsigned* bcast) {
    unsigned* ctr = (unsigned*)(p.ws + OFF_CTR) + l * 64;
    constexpr int N_SCAN = 128, N_LAT = 1024, N_CTX = 32;
    for (;;) {
        if (threadIdx.x == 0) *bcast = atomicAdd(ctr, 1u);
        __syncthreads();
        const int u = (int)*bcast;
        __syncthreads();
        if (u >= N_SCAN + N_LAT + N_CTX) break;
        if (u < N_SCAN) scan_unit(p, l, lds, u);
        else if (u < N_SCAN + N_LAT) { const int v = u - N_SCAN; const int qb = v & 31, m = (v >> 5) & 1, h = (v >> 6) & 3, b = v >> 8; attn_unit(p, lds, b, h, m, NCTX + qb * 256, TT / 64); }
        else { const int v = u - N_SCAN - N_LAT; const int m = v & 1, h = (v >> 1) & 3, b = v >> 3; attn_unit(p, lds, b, h, m, 0, NCTX / 64); }
    }
}
__device__ void ph_post(const Params& p, int l, int wg, int nwg) {
    const int tid = threadIdx.x, wave = tid >> 6, lane = tid & 63;
    const float lam_init = 0.8f - 0.6f * expf(-0.3f * (float)l);
    float lam;
    {   const float* lv = p.diff_lambda + l * 256; const float a = wave_sum(lv[lane] * lv[64 + lane]), c = wave_sum(lv[128 + lane] * lv[192 + lane]); lam = expf(a) - expf(c) + lam_init; }
    const bf16_t* OA0 = (const bf16_t*)(p.ws + OFF_OA); const bf16_t* OA1 = OA0 + (size_t)RR * 512;
    const bf16_t* OS0 = (const bf16_t*)(p.ws + OFF_OS); const bf16_t* OS1 = OS0 + (size_t)RR * 512;
    const bf16_t* YB0 = (const bf16_t*)(p.ws + OFF_YB0); const bf16_t* G = (const bf16_t*)(p.ws + OFF_G);
    bf16_t* YA = (bf16_t*)(p.ws + OFF_YA); bf16_t* YB = (bf16_t*)(p.ws + OFF_YB);
    float sg[8], lg[8];
#pragma unroll
    for (int i = 0; i < 8; ++i) { sg[i] = p.diff_subln_g[l * 128 + (lane & 15) * 8 + i] * (1.f - lam_init); lg[i] = p.rwkv_ln_g[l * 512 + lane * 8 + i]; }
    for (int r = wg * 8 + wave; r < RR; r += nwg * 8) {
        const size_t o = (size_t)r * 512 + lane * 8;
        {   const u32x4 a = *(const u32x4*)(OA0 + o), c = *(const u32x4*)(OA1 + o); float v[8]; float ss = 0.f;
#pragma unroll
            for (int i = 0; i < 4; ++i) { v[2 * i] = bflo(a[i]) - lam * bflo(c[i]); v[2 * i + 1] = bfhi(a[i]) - lam * bfhi(c[i]); ss += v[2 * i] * v[2 * i] + v[2 * i + 1] * v[2 * i + 1]; }
            ss = allsum16(ss);
            const float rinv = rsqrtf(ss * (1.f / 128.f) + 1e-6f);
            u32x4 w;
#pragma unroll
            for (int i = 0; i < 4; ++i) w[i] = pk2(v[2 * i] * rinv * sg[2 * i], v[2 * i + 1] * rinv * sg[2 * i + 1]);
            *(u32x4*)(YA + o) = w; }
        {   const u32x4 y0 = *(const u32x4*)(YB0 + o), gg = *(const u32x4*)(G + o); float y[8];
#pragma unroll
            for (int i = 0; i < 4; ++i) { y[2 * i] = bflo(y0[i]); y[2 * i + 1] = bfhi(y0[i]); }
#pragma unroll
            for (int d = 0; d < 2; ++d) { const u32x4 ov = *(const u32x4*)((d ? OS1 : OS0) + o); float v[8]; float sm = 0.f;
#pragma unroll
                for (int i = 0; i < 4; ++i) { v[2 * i] = bflo(ov[i]); v[2 * i + 1] = bfhi(ov[i]); sm += v[2 * i] + v[2 * i + 1]; }
                const float mu = allsum8(sm) * (1.f / 64.f); float sq = 0.f;
#pragma unroll
                for (int i = 0; i < 8; ++i) { v[i] -= mu; sq += v[i] * v[i]; }
                const float rinv = rsqrtf(allsum8(sq) * (1.f / 64.f) + 64e-5f);
#pragma unroll
                for (int i = 0; i < 8; ++i) y[i] += v[i] * rinv * lg[i]; }
            u32x4 w;
#pragma unroll
            for (int i = 0; i < 4; ++i) w[i] = pk2(y[2 * i] * bflo(gg[i]), y[2 * i + 1] * bfhi(gg[i]));
            *(u32x4*)(YB + o) = w; }
    }
}

constexpr int RW_QS = 4096 + 16;
__device__ void ph_norm2(const Params& p, int l, LAS unsigned char* lds, int wg, int nwg) {
    const int tid = threadIdx.x, wave = tid >> 6, lane = tid & 63;
    LAS float* RW = (LAS float*)lds;
    LAS float* hrow = RW + 4 * RW_QS + wave * 1024;
    {   const float* rw = p.router_w + (size_t)l * 1024 * 16;
        for (int i = tid; i < 16384; i += 512) { const int k = i >> 4, e = i & 15; RW[(k >> 8) * RW_QS + (k & 255) * 16 + e] = rw[i]; } }
    __syncthreads();
    const float* X = (const float*)(p.ws + OFF_X); bf16_t* H = (bf16_t*)(p.ws + OFF_H);
    const float* MOD = (const float*)(p.ws + OFF_MOD) + (size_t)l * 5 * 6144; const float* g = p.norm2_g + l * 1024;
    float* AFFL = (float*)(p.ws + OFF_AFFL); float* AFFC = (float*)(p.ws + OFF_AFFC); int* INV = (int*)(p.ws + OFF_INV);
    const int e = lane & 15, kq = lane >> 4;
    for (int r = wg * 8 + wave; r < RR; r += nwg * 8) {
        const float4* xr = (const float4*)(X + (size_t)r * 1024); float4 v[4]; float ss = 0.f;
#pragma unroll
        for (int i = 0; i < 4; ++i) { v[i] = xr[lane + 64 * i]; ss += v[i].x * v[i].x + v[i].y * v[i].y + v[i].z * v[i].z + v[i].w * v[i].w; }
        ss = wave_sum(ss);
        const float rinv = rsqrtf(ss * (1.f / 1024.f) + 1e-6f);
        const int b = r / TT, s = r - b * TT; const float* md = MOD + (s < NCTX ? 4 : b) * 6144;
#pragma unroll
        for (int i = 0; i < 4; ++i) { const int col = (lane + 64 * i) * 4;
            const float4 gg = *(const float4*)(g + col), sh = *(const float4*)(md + 3 * 1024 + col), sc = *(const float4*)(md + 4 * 1024 + col);
            f32x4 y; y[0] = v[i].x * rinv * gg.x * (1.f + sc.x) + sh.x; y[1] = v[i].y * rinv * gg.y * (1.f + sc.y) + sh.y; y[2] = v[i].z * rinv * gg.z * (1.f + sc.z) + sh.z; y[3] = v[i].w * rinv * gg.w * (1.f + sc.w) + sh.w;
            u32x2 w = {pk2(y[0], y[1]), pk2(y[2], y[3])}; *(u32x2*)(H + (size_t)r * 1024 + col) = w;
            *(LAS f32x4*)(hrow + col) = y; }
        float acc = 0.f; const LAS float* hq = hrow + kq * 256; const LAS float* wq = RW + kq * RW_QS + e;
#pragma unroll 8
        for (int k = 0; k < 256; ++k) acc += hq[k] * wq[k * 16];
        acc += __shfl_xor(acc, 16); acc += __shfl_xor(acc, 32);
        float mx = acc; mx = fmaxf(mx, __shfl_xor(mx, 1)); mx = fmaxf(mx, __shfl_xor(mx, 2)); mx = fmaxf(mx, __shfl_xor(mx, 4)); mx = fmaxf(mx, __shfl_xor(mx, 8));
        const float ex = expf(acc - mx); float sm = ex; sm += __shfl_xor(sm, 1); sm += __shfl_xor(sm, 2); sm += __shfl_xor(sm, 4); sm += __shfl_xor(sm, 8);
        const float aff = ex / sm;
        if (lane < 16) { if (s < NCTX) AFFC[((size_t)(b * 16 + e)) * NCTX + s] = aff; else AFFL[((size_t)(b * 16 + e)) * SEQ + (s - NCTX)] = aff;
            INV[(size_t)r * 16 + e] = -1; }
    }
    __syncthreads();
}

DI void topk_unit(const Params& p, LAS unsigned char* lds, int u) {
    const int tid = threadIdx.x, wave = tid >> 6, lane = tid & 63;
    const bool lat = u < 64; const int v_ = lat ? u : u - 64; const int b = v_ >> 4, e = v_ & 15;
    const int n = lat ? SEQ : NCTX, cap = lat ? CAPL : CAPC;
    const float* aff = lat ? (const float*)(p.ws + OFF_AFFL) + ((size_t)(b * 16 + e)) * SEQ : (const float*)(p.ws + OFF_AFFC) + ((size_t)(b * 16 + e)) * NCTX;
    LAS unsigned* hist = (LAS unsigned*)lds;
    LAS unsigned* sh = hist + 256;
    unsigned long long key[16];
#pragma unroll
    for (int i = 0; i < 16; ++i) { const int idx = tid + 512 * i; key[i] = (idx < n) ? (((unsigned long long)__float_as_uint(aff[idx]) << 13) | (unsigned long long)(8191 - idx)) : 0ull; }
    unsigned long long prefix = 0ull, mask = 0ull; unsigned need = (unsigned)cap;
#pragma unroll 1
    for (int shift = 40; shift >= 0; shift -= 8) {
        if (tid < 256) hist[tid] = 0u;
        if (tid == 0) sh[2] = 0u;
        __syncthreads();
#pragma unroll
        for (int i = 0; i < 16; ++i) if (tid + 512 * i < n && (key[i] & mask) == prefix) __hip_atomic_fetch_add(&hist[(unsigned)(key[i] >> shift) & 255u], 1u, __ATOMIC_RELAXED, __HIP_MEMORY_SCOPE_WORKGROUP);
        __syncthreads();
        if (wave == 0) {
            unsigned loc[4]; unsigned ls = 0;
#pragma unroll
            for (int j = 0; j < 4; ++j) { loc[j] = hist[255 - 4 * lane - j]; ls += loc[j]; }
            unsigned incl = ls;
#pragma unroll
            for (int o = 1; o < 64; o <<= 1) { const unsigned t = __shfl_up(incl, o); if (lane >= o) incl += t; }
            const unsigned long long bal = __ballot(incl >= need);
            const int first = __ffsll((long long)bal) - 1;
            if (lane == first) { unsigned run = incl - ls; int bin = 255 - 4 * lane; unsigned above = run;
#pragma unroll
                for (int j = 0; j < 4; ++j) { if (run + loc[j] >= need) { bin = 255 - 4 * lane - j; above = run; break; } run += loc[j]; }
                sh[0] = (unsigned)bin; sh[1] = above; }
        }
        __syncthreads();
        prefix |= ((unsigned long long)sh[0]) << shift; mask |= 255ull << shift; need -= sh[1];
        __syncthreads();
    }
    int* SROW = (int*)(p.ws + OFF_SROW); float* SGATE = (float*)(p.ws + OFF_SGATE); int* INV = (int*)(p.ws + OFF_INV);
    const int sb = lat ? b * CAPL : 4 * CAPL + b * CAPC;
#pragma unroll
    for (int i = 0; i < 16; ++i) { const int idx = tid + 512 * i;
        if (idx < n && key[i] >= prefix) { const unsigned pos = __hip_atomic_fetch_add(&sh[2], 1u, __ATOMIC_RELAXED, __HIP_MEMORY_SCOPE_WORKGROUP); const int slot = sb + (int)pos; const int row = b * TT + (lat ? NCTX + idx : idx);
            SROW[e * ESLOT + slot] = row; SGATE[e * ESLOT + slot] = __uint_as_float((unsigned)(key[i] >> 13)); INV[(size_t)row * 16 + e] = slot; } }
    if (lat && b == 0 && tid < 128) { SROW[e * ESLOT + 4 * CAPL + 4 * CAPC + tid] = -1; SGATE[e * ESLOT + 4 * CAPL + 4 * CAPC + tid] = 0.f; }
    __syncthreads();
}
__device__ void ph_topk(const Params& p, LAS unsigned char* lds, int wg, int nwg) { for (int u = wg; u < 128; u += nwg) topk_unit(p, lds, u); }

__device__ void ph_gather(const Params& p, int wg, int nwg) {
    const int tid = threadIdx.x, wave = tid >> 6, lane = tid & 63;
    const int* SROW = (const int*)(p.ws + OFF_SROW); const bf16_t* H = (const bf16_t*)(p.ws + OFF_H); bf16_t* XG = (bf16_t*)(p.ws + OFF_XG);
    for (int i = wg * 8 + wave; i < EROWS; i += nwg * 8) {
        const int row = SROW[i]; u32x4 a = {0u, 0u, 0u, 0u}, c = {0u, 0u, 0u, 0u};
        if (row >= 0) { const u32x4* src = (const u32x4*)(H + (size_t)row * 1024); a = src[lane]; c = src[64 + lane]; }
        u32x4* dst = (u32x4*)(XG + (size_t)i * 1024); dst[lane] = a; dst[64 + lane] = c;
    }
}

__device__ void ph_combine(const Params& p, int l, int wg, int nwg) {
    const int tid = threadIdx.x, wave = tid >> 6, lane = tid & 63;
    const int* INV = (const int*)(p.ws + OFF_INV); const float* SGATE = (const float*)(p.ws + OFF_SGATE); const bf16_t* OUT = (const bf16_t*)(p.ws + OFF_OUT);
    float* X = (float*)(p.ws + OFF_X); const float* MOD = (const float*)(p.ws + OFF_MOD) + (size_t)l * 5 * 6144;
    for (int r = wg * 8 + wave; r < RR; r += nwg * 8) {
        float acc[16];
#pragma unroll
        for (int i = 0; i < 16; ++i) acc[i] = 0.f;
        bool any = false;
        for (int e = 0; e < 16; ++e) { const int slot = INV[(size_t)r * 16 + e];
            if (slot >= 0) { any = true; const float gt = SGATE[e * ESLOT + slot]; const u32x4* src = (const u32x4*)(OUT + ((size_t)(e * ESLOT + slot)) * 1024);
                const u32x4 a = src[lane], c = src[64 + lane];
#pragma unroll
                for (int i = 0; i < 4; ++i) { acc[2 * i] += gt * bflo(a[i]); acc[2 * i + 1] += gt * bfhi(a[i]); acc[8 + 2 * i] += gt * bflo(c[i]); acc[9 + 2 * i] += gt * bfhi(c[i]); } } }
        if (any) { const float* g2 = MOD + row_mod(r) * 6144 + 5 * 1024; float* xr = X + (size_t)r * 1024;
#pragma unroll
            for (int hh = 0; hh < 2; ++hh) { const int col = hh * 512 + lane * 8;
#pragma unroll
                for (int q = 0; q < 2; ++q) { f32x4 xv = *(f32x4*)(xr + col + 4 * q); const f32x4 gv = *(const f32x4*)(g2 + col + 4 * q);
#pragma unroll
                    for (int i = 0; i < 4; ++i) xv[i] += gv[i] * acc[hh * 8 + q * 4 + i];
                    *(f32x4*)(xr + col + 4 * q) = xv; } } }
    }
}
__device__ void ph_output(const Params& p, int wg, int nwg) {
    const float4* X4 = (const float4*)(p.ws + OFF_X); float4* O4 = (float4*)p.out;
    const size_t n4 = (size_t)NB * SEQ * 256;
    for (size_t i = (size_t)wg * 512 + threadIdx.x; i < n4; i += (size_t)nwg * 512) { const size_t row = i >> 8; const size_t b = row / SEQ, t = row - b * SEQ; O4[i] = X4[(b * TT + NCTX + t) * 256 + (i & 255)]; }
}
constexpr int LDS_BYTES = 131072 + 256;
enum { PH_PROLOGUE = 0, PH_A, PH_B, PH_C, PH_D, PH_E, PH_F, PH_G, PH_H, PH_I, PH_J, PH_K, PH_L, PH_M, PH_OUT };

template <int PH> DI void run_phase(const Params& p, int l, LAS unsigned char* lds, int wg, int nwg) {
    if constexpr (PH == PH_PROLOGUE) ph_prologue(p, lds, wg, nwg);
    if constexpr (PH == PH_A) { conv_mixer_weights(p, l, lds, wg, nwg); norm1_rows(p, l, wg, nwg); }
    if constexpr (PH == PH_B) { pg8::Gemm g{(const bf16_t*)(p.ws + OFF_H), (const bf16_t*)(p.ws + OFF_WIN), RR, NIN, 1024}; SchedPlain S; S.init(RR / 256, NIN / 256, nwg, wg); EpiInProj E{p.ws};
        pg8::gemm_phase<EpiInProj, SchedPlain>(lds, g, S, E, nullptr); }
    if constexpr (PH == PH_C) ph_prep(p, l, lds, wg, nwg);
    if constexpr (PH == PH_D) ph_mix(p, l, lds, (LAS unsigned*)(lds + 131072 + 64));
    if constexpr (PH == PH_E) ph_post(p, l, wg, nwg);
    if constexpr (PH == PH_F) { pg8::Gemm g{(const bf16_t*)(p.ws + OFF_YA), (const bf16_t*)(p.ws + OFF_WBR), RR, 1024, 512}; SchedMerge S; S.init(nwg, wg); EpiMerge E{p.ws};
        pg8::gemm_phase<EpiMerge, SchedMerge>(lds, g, S, E, nullptr); }
    if constexpr (PH == PH_G) { pg8::Gemm g{(const bf16_t*)(p.ws + OFF_M), (const bf16_t*)(p.ws + OFF_WOUT), RR, 1024, 1024}; SchedPlain S; S.init(RR / 256, 4, nwg, wg); EpiOut E{p.ws, l};
        pg8::gemm_phase<EpiOut, SchedPlain>(lds, g, S, E, nullptr); }
    if constexpr (PH == PH_H) { conv_expert_weights(p, l, lds, wg, nwg); ph_norm2(p, l, lds, wg, nwg); }
    if constexpr (PH == PH_I) ph_topk(p, lds, wg, nwg);
    if constexpr (PH == PH_J) ph_gather(p, wg, nwg);
    if constexpr (PH == PH_K) { pg8::Gemm g{(const bf16_t*)(p.ws + OFF_XG), (const bf16_t*)(p.ws + OFF_W13), EROWS, 2048, 1024}; SchedMoe<8> S; S.init(nwg, wg); EpiUp E{p.ws};
        pg8::gemm_phase<EpiUp, SchedMoe<8>>(lds, g, S, E, nullptr); }
    if constexpr (PH == PH_L) { pg8::Gemm g{(const bf16_t*)(p.ws + OFF_HID), (const bf16_t*)(p.ws + OFF_W2), EROWS, 1024, 1024}; SchedMoe<4> S; S.init(nwg, wg); EpiDown E{p.ws};
        pg8::gemm_phase<EpiDown, SchedMoe<4>>(lds, g, S, E, nullptr); }
    if constexpr (PH == PH_M) ph_combine(p, l, wg, nwg);
    if constexpr (PH == PH_OUT) ph_output(p, wg, nwg);
}

#ifndef MEGA
#define MEGA 0
#endif
#if !MEGA
template <int PH> __global__ __launch_bounds__(512, 2) void k_phase(Params p, int l) {
    extern __shared__ __attribute__((aligned(16))) unsigned char shm[];
    run_phase<PH>(p, l, (LAS unsigned char*)shm, blockIdx.x, gridDim.x);
}
template <int PH> static void launch_phase(const Params& p, int l, int grid, hipStream_t st) {
    static bool attr = false;
    if (!attr) { (void)hipFuncSetAttribute((const void*)k_phase<PH>, hipFuncAttributeMaxDynamicSharedMemorySize, LDS_BYTES); attr = true; }
    hipLaunchKernelGGL(k_phase<PH>, dim3(grid), dim3(512), LDS_BYTES, st, p, l);
}
#else
__global__ __launch_bounds__(512, 2) void k_mega(Params p) {
    extern __shared__ __attribute__((aligned(16))) unsigned char shm[];
    LAS unsigned char* lds = (LAS unsigned char*)shm;
    LAS unsigned* xbw = (LAS unsigned*)(lds + 131072);
    if (threadIdx.x < 4) xbw[threadIdx.x] = 0u;
    __syncthreads();
    XcdBarrier bar = xcd_barrier_post((unsigned*)(p.ws + OFF_BAR), (volatile LAS unsigned*)xbw);
    const int wg = blockIdx.x, nwg = gridDim.x;
    run_phase<PH_PROLOGUE>(p, 0, lds, wg, nwg); xcd_barrier(bar);
#pragma unroll 1
    for (int l = 0; l < NL; ++l) {
        run_phase<PH_A>(p, l, lds, wg, nwg); xcd_barrier(bar);
        run_phase<PH_B>(p, l, lds, wg, nwg); xcd_barrier(bar);
        run_phase<PH_C>(p, l, lds, wg, nwg); xcd_barrier(bar);
        run_phase<PH_D>(p, l, lds, wg, nwg); xcd_barrier(bar);
        run_phase<PH_E>(p, l, lds, wg, nwg); xcd_barrier(bar);
        run_phase<PH_F>(p, l, lds, wg, nwg); xcd_barrier(bar);
        run_phase<PH_G>(p, l, lds, wg, nwg); xcd_barrier(bar);
        run_phase<PH_H>(p, l, lds, wg, nwg); xcd_barrier(bar);
        run_phase<PH_I>(p, l, lds, wg, nwg); xcd_barrier(bar);
        run_phase<PH_J>(p, l, lds, wg, nwg); xcd_barrier(bar);
        run_phase<PH_K>(p, l, lds, wg, nwg); xcd_barrier(bar);
        run_phase<PH_L>(p, l, lds, wg, nwg); xcd_barrier(bar);
        run_phase<PH_M>(p, l, lds, wg, nwg); xcd_barrier(bar);
    }
    run_phase<PH_OUT>(p, 0, lds, wg, nwg);
}
#endif

extern "C" void kernel_launch(void* const* d_in, const int* in_sizes, int n_in, void* d_out, int out_size, void* d_ws, size_t ws_size, hipStream_t stream) {
    if (n_in < 31 || ws_size < WS_NEEDED) return;
    Params p{};
    const float** f = (const float**)&p;
    for (int i = 0; i < 31; ++i) f[i] = (const float*)d_in[i];
    p.out = (float*)d_out; p.ws = (unsigned char*)d_ws;
    (void)hipMemsetAsync(d_ws, 0, 65536, stream);
#if !MEGA
    const int G = 256;
    launch_phase<PH_PROLOGUE>(p, 0, G, stream);
    for (int l = 0; l < NL; ++l) {
        launch_phase<PH_A>(p, l, G, stream); launch_phase<PH_B>(p, l, G, stream); launch_phase<PH_C>(p, l, G, stream); launch_phase<PH_D>(p, l, G, stream);
        launch_phase<PH_E>(p, l, G, stream); launch_phase<PH_F>(p, l, G, stream); launch_phase<PH_G>(p, l, G, stream); launch_phase<PH_H>(p, l, G, stream);
        launch_phase<PH_I>(p, l, G, stream); launch_phase<PH_J>(p, l, G, stream); launch_phase<PH_K>(p, l, G, stream); launch_phase<PH_L>(p, l, G, stream);
        launch_phase<PH_M>(p, l, G, stream);
    }
    launch_phase<PH_OUT>(p, 0, G, stream);
#else
    static int grid = 0;
    if (!grid) {
        (void)hipFuncSetAttribute((const void*)k_mega, hipFuncAttributeMaxDynamicSharedMemorySize, LDS_BYTES);
        int dev = 0, cus = 0, per_cu = 0; (void)hipGetDevice(&dev); (void)hipDeviceGetAttribute(&cus, hipDeviceAttributeMultiprocessorCount, dev);
        (void)hipOccupancyMaxActiveBlocksPerMultiprocessor(&per_cu, (const void*)k_mega, 512, LDS_BYTES);
        grid = cus * (per_cu < 1 ? per_cu : 1);
    }
    if (grid <= 0) return;
    hipLaunchKernelGGL(k_mega, dim3(grid), dim3(512), LDS_BYTES, stream, p);
#endif
}
```

```cpp
#include <hip/hip_runtime.h>
#include <stdint.h>

#define LAS __attribute__((address_space(3)))
typedef unsigned short bf16_t;
typedef short bf16x8 __attribute__((ext_vector_type(8)));
typedef float f32x4 __attribute__((ext_vector_type(4)));
typedef float f32x16 __attribute__((ext_vector_type(16)));
typedef float f32x2v __attribute__((ext_vector_type(2)));
typedef __bf16 bf16x2v __attribute__((ext_vector_type(2)));
typedef unsigned u32x4 __attribute__((ext_vector_type(4)));
typedef unsigned u32x2 __attribute__((ext_vector_type(2)));

#define DI __device__ __forceinline__
DI int otid() { int t = threadIdx.x; asm volatile("" : "+v"(t)); return t; }
DI float bf2f(bf16_t v) { return __uint_as_float(((unsigned)v) << 16); }
DI float bflo(unsigned w) { return __uint_as_float(w << 16); }
DI float bfhi(unsigned w) { return __uint_as_float(w & 0xffff0000u); }
DI unsigned pk2(float a, float b) { f32x2v v = {a, b}; return __builtin_bit_cast(unsigned, __builtin_convertvector(v, bf16x2v)); }
DI unsigned pk4_fp8(float a, float b, float c, float d) { unsigned w = 0; w = __builtin_amdgcn_cvt_pk_fp8_f32(a, b, w, false); w = __builtin_amdgcn_cvt_pk_fp8_f32(c, d, w, true); return w; }
DI unsigned pk4_i8(float a, float b, float c, float d) { const int ia = (int)rintf(a), ib = (int)rintf(b), ic = (int)rintf(c), id = (int)rintf(d); return (unsigned)(ia & 255) | ((unsigned)(ib & 255) << 8) | ((unsigned)(ic & 255) << 16) | ((unsigned)id << 24); }
DI unsigned pk4_u8(float a, float b, float c, float d) { unsigned w = 0; w = __builtin_amdgcn_cvt_pk_u8_f32(a, 0, w); w = __builtin_amdgcn_cvt_pk_u8_f32(b, 1, w); w = __builtin_amdgcn_cvt_pk_u8_f32(c, 2, w); w = __builtin_amdgcn_cvt_pk_u8_f32(d, 3, w); return w; }
DI bf16_t f2bf(float a) { return (bf16_t)(pk2(a, 0.f) & 0xffffu); }
DI float sigmoidf_(float x) { return __builtin_amdgcn_rcpf(1.f + __expf(-x)); }
template <int CTRL> DI float dppmov(float x) { return __builtin_bit_cast(float, __builtin_amdgcn_update_dpp(0, __builtin_bit_cast(int, x), CTRL, 0xf, 0xf, true)); }
DI float allsum16(float x) { x += dppmov<0xB1>(x); x += dppmov<0x4E>(x); x += dppmov<0x141>(x); x += dppmov<0x140>(x); return x; }
DI float allsum8(float x) { x += dppmov<0xB1>(x); x += dppmov<0x4E>(x); x += dppmov<0x141>(x); return x; }
DI float allmax16(float x) { x = fmaxf(x, dppmov<0xB1>(x)); x = fmaxf(x, dppmov<0x4E>(x)); x = fmaxf(x, dppmov<0x141>(x)); x = fmaxf(x, dppmov<0x140>(x)); return x; }
DI float sum_x16(float x) { auto r = __builtin_amdgcn_permlane16_swap(__float_as_uint(x), __float_as_uint(x), false, false); return __uint_as_float(r[0]) + __uint_as_float(r[1]); }
DI float sum_x32(float x) { auto r = __builtin_amdgcn_permlane32_swap(__float_as_uint(x), __float_as_uint(x), false, false); return __uint_as_float(r[0]) + __uint_as_float(r[1]); }
DI float wave_sum(float v) { return sum_x32(sum_x16(allsum16(v))); }
DI float wave_max(float v) { v = allmax16(v); { auto r = __builtin_amdgcn_permlane16_swap(__float_as_uint(v), __float_as_uint(v), false, false); v = fmaxf(__uint_as_float(r[0]), __uint_as_float(r[1])); }
    { auto r = __builtin_amdgcn_permlane32_swap(__float_as_uint(v), __float_as_uint(v), false, false); v = fmaxf(__uint_as_float(r[0]), __uint_as_float(r[1])); } return v; }
DI float bperm(float v, int byte_addr) { return __builtin_bit_cast(float, __builtin_amdgcn_ds_bpermute(byte_addr, __builtin_bit_cast(int, v))); }

constexpr int NB = 4, SEQ = 8192, NCTX = 256, TT = SEQ + NCTX, RR = NB * TT, DM = 1024, NIN = 7936, NL = 4;
constexpr int NE = 16, CAPL = 1024, CAPC = 32, ESLOT = 4352, EROWS = NE * ESLOT;
static_assert(RR == 33792 && RR % 256 == 0 && EROWS % 256 == 0, "shape");

constexpr size_t MB1 = 1u << 20;
constexpr size_t alignup(size_t x) { return (x + MB1 - 1) / MB1 * MB1; }
constexpr size_t SZ_T = (size_t)RR * 512 * 2;
constexpr size_t OFF_BAR = 0;
constexpr size_t OFF_CTR = 32768;
constexpr size_t OFF_MOD = 65536;
constexpr size_t OFF_ROPE = OFF_MOD + (size_t)NL * 5 * 6144 * 4;
constexpr size_t OFF_AFFL = MB1;
constexpr size_t OFF_AFFC = OFF_AFFL + (size_t)4 * 16 * 8192 * 4;
constexpr size_t OFF_SROW = OFF_AFFC + (size_t)4 * 16 * 256 * 4;
constexpr size_t OFF_SGATE = OFF_SROW + (size_t)EROWS * 4;
constexpr size_t OFF_INV = OFF_SGATE + (size_t)EROWS * 4;
constexpr size_t OFF_LRW = OFF_INV + (size_t)RR * 16 * 4;
constexpr size_t OFF_SW = OFF_LRW + (size_t)(4 * 512 * 64 + 512 * 128) * 2;
constexpr size_t OFF_SH = OFF_SW + (size_t)NIN * 4;
constexpr size_t OFF_X = alignup(OFF_SH + (size_t)RR * 4);
constexpr size_t OFF_H = alignup(OFF_X + (size_t)RR * 1024 * 4);
constexpr size_t OFF_VT = OFF_H;
constexpr size_t OFF_YB0 = OFF_H + SZ_T;
constexpr size_t OFF_M = OFF_H;
constexpr size_t OFF_WIN = alignup(OFF_H + 2 * SZ_T);
constexpr size_t OFF_WBR = alignup(OFF_WIN + (size_t)NIN * 1024 * 2);
constexpr size_t OFF_WOUT = alignup(OFF_WBR + (size_t)3 * 1024 * 512 * 2);
constexpr size_t OFF_PA = alignup(OFF_WOUT + (size_t)1024 * 1024 * 2);
constexpr size_t OFF_PR = alignup(OFF_PA + (size_t)RR * 1536 * 2);
constexpr size_t OFF_PC = alignup(OFF_PR + (size_t)RR * 1792 * 2);
constexpr size_t OFF_PG = alignup(OFF_PC + (size_t)RR * 1536 * 2);
constexpr size_t OFF_PEND = alignup(OFF_PG + (size_t)RR * 3072 * 2);
constexpr size_t OFF_OS = OFF_PR;
constexpr size_t OFF_OA = OFF_OS + 2 * SZ_T;
constexpr size_t OFF_YA = alignup(OFF_OA + 2 * SZ_T);
constexpr size_t OFF_YB = alignup(OFF_YA + SZ_T);
static_assert(OFF_YB + SZ_T <= OFF_PG, "overlay");
constexpr size_t OFF_XG = OFF_PR;
constexpr size_t OFF_HID = alignup(OFF_XG + (size_t)EROWS * 1024);
constexpr size_t OFF_OUT = alignup(OFF_HID + (size_t)EROWS * 1024);
static_assert(OFF_OUT + (size_t)EROWS * 1024 * 2 <= OFF_PEND, "overlay");
constexpr size_t OFF_EW = OFF_PEND;
constexpr size_t OFF_AA = OFF_EW + 2 * SZ_T;
constexpr size_t OFF_KK = OFF_AA + 2 * SZ_T;
constexpr size_t OFF_KC = OFF_KK + SZ_T;
constexpr size_t OFF_RC = OFF_KC + SZ_T;
constexpr size_t OFF_VC = OFF_RC + SZ_T;
constexpr size_t OFF_YC = alignup(OFF_VC + SZ_T);
constexpr size_t OFF_G = alignup(OFF_YC + SZ_T);
constexpr size_t OFF_W13 = alignup(OFF_G + SZ_T);
constexpr size_t OFF_W2 = OFF_W13 + (size_t)16 * 2048 * 1024;
constexpr size_t WS_NEEDED = alignup(OFF_W2 + (size_t)16 * 1024 * 1024);
constexpr int YTILE = 262144;
static_assert((OFF_YB - OFF_YA) % YTILE == 0 && (OFF_YC - OFF_YA) % YTILE == 0 && OFF_YC > OFF_YA, "merge A tiles");

struct Params {
    const float *x, *c, *ctx, *c_ctx, *norm1_g, *norm2_g, *ada_w, *ada_b, *w_in, *q_norm_g, *k_norm_g, *diff_lambda, *diff_subln_g,
        *rwkv_conv_w, *rwkv_w0, *rwkv_w_up, *rwkv_a0, *rwkv_a_up, *rwkv_g_up, *rwkv_k_k, *rwkv_k_a, *rwkv_r_k, *rwkv_ln_g, *rwkv_ln_b,
        *conv_w, *w_branch, *w_out, *router_w, *exp_w1, *exp_w3, *exp_w2;
    float* out;
    unsigned char* ws;
};
#define XB_TMO      128
#define XB_XCNT(j)  (256  + 64 * (j))
#define XB_XSUB(j)  (1280 + 64 * (j))
#define XB_XGEN(j)  (2304 + 64 * (j))
#define XB_TOP      3328
#define XB_TOPGEN   3392
#define XCD_BAR_WORDS 3456
#define XB_SPIN_CAP (1u << 18)

__device__ __forceinline__ unsigned xb_ld(unsigned* p)              { return __hip_atomic_load(p, __ATOMIC_RELAXED, __HIP_MEMORY_SCOPE_AGENT); }
__device__ __forceinline__ unsigned xb_add(unsigned* p, unsigned v) { return __hip_atomic_fetch_add(p, v, __ATOMIC_RELAXED, __HIP_MEMORY_SCOPE_AGENT); }
__device__ __forceinline__ unsigned xb_xcc_id() { return (unsigned)__builtin_amdgcn_s_getreg((3 << 11) | 20) & 0xFu; }
#define XB_SPIN(cond, bar) do { unsigned _sp = 0; while (cond) { __builtin_amdgcn_s_sleep(1); \
    if ((++_sp & 255u) == 0u) { if (xb_ld(&(bar)[XB_TMO])) break; if (_sp > XB_SPIN_CAP) { atomicAdd(&(bar)[XB_TMO], 1u); break; } } } } while (0)

struct XcdBarrier {
    unsigned* bar; unsigned x;
    volatile LAS unsigned* st;
};

__device__ __forceinline__ XcdBarrier xcd_barrier_post(unsigned* bar, volatile LAS unsigned* st) {
    XcdBarrier b; b.bar = bar; b.x = xb_xcc_id(); b.st = st;
    if (threadIdx.x == 0) (void)xb_add(&bar[XB_XCNT(b.x)], 1u);
    return b;
}
__device__ __forceinline__ void xcd_barrier_complete(unsigned* bar, unsigned x, unsigned& nloc, unsigned& nx) {
    const unsigned G = gridDim.x * gridDim.y * gridDim.z;
    unsigned sum, cnt, mine, sp = 0u;
    for (;;) {
        sum = 0u; cnt = 0u; mine = 0u;
#pragma unroll
        for (unsigned j = 0; j < 16; ++j) { const unsigned c = xb_ld(&bar[XB_XCNT(j)]); sum += c; cnt += (c > 0u) ? 1u : 0u; mine = (j == x) ? c : mine; }
        if (sum == G) break;
        __builtin_amdgcn_s_sleep(1);
        if ((++sp & 255u) == 0u) { if (xb_ld(&bar[XB_TMO])) break; if (sp > XB_SPIN_CAP) { atomicAdd(&bar[XB_TMO], 1u); break; } }
    }
    nloc = mine > 0u ? mine : 1u; nx = cnt > 0u ? cnt : 1u;
}

__device__ __forceinline__ void xcd_barrier(const XcdBarrier& b) {
    asm volatile("s_waitcnt vmcnt(0)" ::: "memory");
    __syncthreads();
    if (threadIdx.x == 0) {
        unsigned* bar = b.bar;
        __builtin_amdgcn_s_waitcnt(0);
        unsigned nloc = b.st[0], nx = b.st[1];
        if (nloc == 0u) { xcd_barrier_complete(bar, b.x, nloc, nx); b.st[0] = nloc; b.st[1] = nx; }
        const unsigned old = xb_add(&bar[XB_XSUB(b.x)], 1u);
        const unsigned gen = old / nloc;
        if (old + 1u == (gen + 1u) * nloc) {
            __builtin_amdgcn_fence(__ATOMIC_RELEASE, "agent");
            asm volatile("s_waitcnt vmcnt(0)" ::: "memory");
            const unsigned og = xb_add(&bar[XB_TOP], 1u);
            const unsigned tg = og / nx;
            if (og + 1u == (tg + 1u) * nx) xb_add(&bar[XB_TOPGEN], 1u);
            else XB_SPIN(xb_ld(&bar[XB_TOPGEN]) == tg, bar);
            __builtin_amdgcn_fence(__ATOMIC_ACQUIRE, "agent");
            xb_add(&bar[XB_XGEN(b.x)], 1u);
            asm volatile("s_waitcnt vmcnt(0)" ::: "memory");
        } else {
            XB_SPIN(xb_ld(&bar[XB_XGEN(b.x)]) == gen, bar);
            __builtin_amdgcn_fence(__ATOMIC_ACQUIRE, "agent");
            asm volatile("s_waitcnt vmcnt(0)" ::: "memory");
        }
    }
    __syncthreads();
}
namespace pg8 {
#define PG8_LAS __attribute__((address_space(3)))
constexpr int BM = 256, BK = 64, HALF = 128, HTB = HALF * BK * 2  , STAGE_BYTES = 8 * HTB, NXCD = 8, WGM = 8;
__host__ __device__ __forceinline__ int lds_byte(int r, int c) { const int st = (r >> 4) * 2 + (c >> 5), rr = r & 15, cc = c & 31, ob = rr * 64 + cc * 2; return st * 1024 + (ob ^ (((ob >> 9) & 1) << 5)); }
__host__ __device__ __forceinline__ void stage_rc(int b, int& R, int& C) { const int st = b / 1024, sb = b % 1024, swz = sb ^ (((sb >> 9) & 1) << 5); R = (st >> 1) * 16 + swz / 64; C = (st & 1) * 32 + (swz % 64) / 2; }
__host__ __device__ __forceinline__ int perm32(int rho) { const int n = rho >> 4, i = rho & 15; return 8 * (i >> 2) + 4 * n + (i & 3); }
typedef int v4i_t __attribute__((ext_vector_type(4)));
typedef int v8i_t __attribute__((ext_vector_type(8)));
struct Unit { int pm, pn; int rt, ct, br; };
struct Gemm { const bf16_t* A; const bf16_t* Bt; int M, N, K; };
template <class Epi, class Sched, bool STAMP = false, int QM = 0>
__device__ __forceinline__ void gemm_phase(PG8_LAS unsigned char* lds, const Gemm g, const Sched& S, const Epi& E, unsigned long long* stamps) {
    const int tid = otid(), wid = __builtin_amdgcn_readfirstlane(tid >> 6), lane = tid & 63, wr = wid >> 2, wc = wid & 3, fr = lane & 15, fq = lane >> 4;
    const int K = g.K, nt = K / BK;
    int ts_lo = 0, ts_hi = 0, nts = 0; const unsigned long long rt_entry = STAMP ? (unsigned long long)wall_clock64() : 0ull;
#define PG8_STAMP() do { if (STAMP && wid == 0 && nts < 64) { const unsigned long long _c = (unsigned long long)clock64(); \
        ts_lo = (lane == nts) ? (int)(unsigned)_c : ts_lo; ts_hi = (lane == nts) ? (int)(unsigned)(_c >> 32) : ts_hi; ++nts; } } while (0)
    PG8_STAMP();
    unsigned voffA[2], voffB[2];
#pragma unroll
    for (int i = 0; i < 2; ++i) { int R, C; stage_rc(tid * 16 + i * 8192, R, C); const int Rb = Epi::PERM ? ((R & ~31) + perm32(R & 31)) : R;
        voffA[i] = (unsigned)(R * K + C) * 2u; voffB[i] = (unsigned)(Rb * K + C) * 2u; }
    const size_t kstep = (size_t)(BK * 2);
    const size_t hstep = (size_t)HALF * K * 2;
    const size_t tstep = 2 * hstep;
    const unsigned ldsw = (unsigned)wid * 1024u;
    const int aoff = lds_byte(wr * 64 + fr, fq * 8), boff = lds_byte(wc * 32 + fr, fq * 8);
#define PG8_SA(b, h) (((b) * 2 + (h)) * HTB)
#define PG8_SB(b, h) ((4 + (b) * 2 + (h)) * HTB)
#define PG8_STAGE(bufoff, gbase, voff) do { _Pragma("unroll") for (int _i = 0; _i < 2; ++_i) \
        __builtin_amdgcn_global_load_lds((const unsigned*)((const char*)(gbase) + (voff)[_i]), (PG8_LAS unsigned*)(lds + (bufoff) + ldsw + _i * 8192), 16, 0, 0); } while (0)
#define PG8_LDA(dst, b, h) do { _Pragma("unroll") for (int m = 0; m < 4; ++m) dst[m] = __builtin_shufflevector(*(const PG8_LAS v4i_t*)(lds + PG8_SA(b, h) + aoff + m * 2048), *(const PG8_LAS v4i_t*)(lds + PG8_SA(b, h) + aoff + m * 2048 + 1024), 0, 1, 2, 3, 4, 5, 6, 7); } while (0)
#define PG8_LDB(dst, b, h) do { _Pragma("unroll") for (int n = 0; n < 2; ++n) dst[n] = __builtin_shufflevector(*(const PG8_LAS v4i_t*)(lds + PG8_SB(b, h) + boff + n * 2048), *(const PG8_LAS v4i_t*)(lds + PG8_SB(b, h) + boff + n * 2048 + 1024), 0, 1, 2, 3, 4, 5, 6, 7); } while (0)
#define PG8_MMA(ai, bj, At, Bt) do { __builtin_amdgcn_s_setprio(1); \
        if constexpr (QM == 1) { _Pragma("unroll") for (int m = 0; m < 4; ++m) _Pragma("unroll") for (int n = 0; n < 2; ++n) \
            asm volatile("v_mfma_scale_f32_16x16x128_f8f6f4 %0, %1, %2, %0, %3, %3 op_sel_hi:[0,0,0]" : "+v"(acc[ai][bj][m][n]) : "v"(Bt[n]), "v"(At[m]), "v"(one_scale)); } \
        else if constexpr (QM == 2) { _Pragma("unroll") for (int m = 0; m < 4; ++m) _Pragma("unroll") for (int n = 0; n < 2; ++n) { v4i_t c_ = __builtin_bit_cast(v4i_t, acc[ai][bj][m][n]); \
            c_ = __builtin_amdgcn_mfma_i32_16x16x64_i8(__builtin_shufflevector(Bt[n], Bt[n], 0, 1, 2, 3), __builtin_shufflevector(At[m], At[m], 0, 1, 2, 3), c_, 0, 0, 0); \
            c_ = __builtin_amdgcn_mfma_i32_16x16x64_i8(__builtin_shufflevector(Bt[n], Bt[n], 4, 5, 6, 7), __builtin_shufflevector(At[m], At[m], 4, 5, 6, 7), c_, 0, 0, 0); acc[ai][bj][m][n] = __builtin_bit_cast(f32x4, c_); } } \
        else { _Pragma("unroll") for (int m = 0; m < 4; ++m) _Pragma("unroll") for (int n = 0; n < 2; ++n) { \
            acc[ai][bj][m][n] = __builtin_amdgcn_mfma_f32_16x16x32_bf16(__builtin_bit_cast(bf16x8, __builtin_shufflevector(Bt[n], Bt[n], 0, 1, 2, 3)), __builtin_bit_cast(bf16x8, __builtin_shufflevector(At[m], At[m], 0, 1, 2, 3)), acc[ai][bj][m][n], 0, 0, 0); \
            acc[ai][bj][m][n] = __builtin_amdgcn_mfma_f32_16x16x32_bf16(__builtin_bit_cast(bf16x8, __builtin_shufflevector(Bt[n], Bt[n], 4, 5, 6, 7)), __builtin_bit_cast(bf16x8, __builtin_shufflevector(At[m], At[m], 4, 5, 6, 7)), acc[ai][bj][m][n], 0, 0, 0); } } \
        __builtin_amdgcn_s_setprio(0); } while (0)
#define PG8_WAIT_V(n) asm volatile("s_waitcnt vmcnt(" #n ")" ::: "memory")
#define PG8_WAIT_L(n) asm volatile("s_waitcnt lgkmcnt(" #n ")" ::: "memory")
#define PG8_BAR __builtin_amdgcn_s_barrier()
#define PG8_SCHED __builtin_amdgcn_sched_barrier(0)
    Unit cur, nxt; int ui = 0;
    if (!S.next(0, cur)) return;
    f32x4 acc[2][2][4][2];
#pragma unroll
    for (int a = 0; a < 2; ++a)
#pragma unroll
        for (int b = 0; b < 2; ++b)
#pragma unroll
            for (int m = 0; m < 4; ++m)
#pragma unroll
                for (int n = 0; n < 2; ++n) acc[a][b][m][n] = (f32x4){0.f, 0.f, 0.f, 0.f};
    const int one_scale = 0x7f7f7f7f;
    v8i_t At[4], B0[2], B1[2];
    const char* cA = (const char*)g.A + (size_t)cur.pm * tstep; const char* cB = (const char*)g.Bt + (size_t)cur.pn * tstep;
    S.a_ready(cur);
    PG8_STAGE(PG8_SB(0, 0), cB, voffB); PG8_STAGE(PG8_SA(0, 0), cA, voffA); PG8_STAGE(PG8_SB(0, 1), cB + hstep, voffB); PG8_STAGE(PG8_SA(0, 1), cA + hstep, voffA);
    if (wr == 1) PG8_BAR;
    PG8_WAIT_V(4); PG8_BAR;
    PG8_STAGE(PG8_SB(1, 0), cB + kstep, voffB); PG8_STAGE(PG8_SA(1, 0), cA + kstep, voffA); PG8_STAGE(PG8_SB(1, 1), cB + hstep + kstep, voffB);
    PG8_WAIT_V(6); PG8_BAR;
    PG8_STAMP();
    for (;;) {
        const bool has_next = S.next(ui + 1, nxt);
        const char* nA = has_next ? (const char*)g.A + (size_t)nxt.pm * tstep : cA; const char* nB = has_next ? (const char*)g.Bt + (size_t)nxt.pn * tstep : cB;
        for (int t = 0; t < nt; t += 2) {
            const bool last = (t == nt - 2);
            const char* a1 = cA + (size_t)(t + 1) * kstep;
            const char* a2 = last ? nA : cA + (size_t)(t + 2) * kstep; const char* b2 = last ? nB : cB + (size_t)(t + 2) * kstep;
            const char* a3 = a2 + kstep; const char* b3 = b2 + kstep;
            if (last && has_next) S.a_ready(nxt);
            PG8_LDB(B0, 0, 0); PG8_SCHED; PG8_LDA(At, 0, 0); PG8_STAGE(PG8_SA(1, 1), a1 + hstep, voffA);
            PG8_WAIT_L(8); PG8_BAR; PG8_WAIT_L(0); PG8_MMA(0, 0, At, B0); PG8_BAR; PG8_SCHED;
            PG8_LDB(B1, 0, 1); PG8_STAGE(PG8_SB(0, 0), b2, voffB);
            PG8_BAR; PG8_WAIT_L(0); PG8_MMA(0, 1, At, B1); PG8_BAR;
            PG8_LDA(At, 0, 1); PG8_STAGE(PG8_SA(0, 0), a2, voffA);
            PG8_BAR; PG8_WAIT_L(0); PG8_MMA(1, 0, At, B0); PG8_BAR; PG8_SCHED;
            PG8_STAGE(PG8_SB(0, 1), b2 + hstep, voffB);
            PG8_WAIT_V(6); PG8_BAR; PG8_MMA(1, 1, At, B1); PG8_BAR;
            PG8_LDB(B0, 1, 0); PG8_SCHED; PG8_LDA(At, 1, 0); PG8_STAGE(PG8_SA(0, 1), a2 + hstep, voffA);
            PG8_WAIT_L(8); PG8_BAR; PG8_WAIT_L(0); PG8_MMA(0, 0, At, B0); PG8_BAR; PG8_SCHED;
            PG8_LDB(B1, 1, 1); PG8_STAGE(PG8_SB(1, 0), b3, voffB);
            PG8_BAR; PG8_WAIT_L(0); PG8_MMA(0, 1, At, B1); PG8_BAR;
            PG8_LDA(At, 1, 1); PG8_STAGE(PG8_SA(1, 0), a3, voffA);
            PG8_BAR; PG8_WAIT_L(0); PG8_MMA(1, 0, At, B0); PG8_BAR; PG8_SCHED;
            PG8_STAGE(PG8_SB(1, 1), b3 + hstep, voffB);
            PG8_WAIT_V(6); PG8_BAR; PG8_MMA(1, 1, At, B1); PG8_BAR;
        }
        PG8_STAMP();
        if constexpr (QM == 1) { asm volatile("s_nop 15\n\ts_nop 15" ::: "memory"); }
        if constexpr (!Epi::AFTER_DRAIN) { E(acc, cur, wr, wc, fr, fq); S.done(cur); }
        PG8_STAMP();
        if (!has_next) break;
        if (!Epi::keep_acc(cur)) {
#pragma unroll
        for (int a = 0; a < 2; ++a)
#pragma unroll
            for (int b = 0; b < 2; ++b)
#pragma unroll
                for (int m = 0; m < 4; ++m)
#pragma unroll
                    for (int n = 0; n < 2; ++n) acc[a][b][m][n] = (f32x4){0.f, 0.f, 0.f, 0.f};
        }
        cur = nxt; cA = nA; cB = nB; ++ui;
    }
    PG8_WAIT_V(0);
    if (wr == 0) PG8_BAR;
    PG8_BAR;
    if constexpr (Epi::AFTER_DRAIN) { E.fused(acc, cur, wr, wc, fr, fq, lds, wid, lane); S.done(cur); }
    PG8_STAMP();
    if (STAMP && wid == 0) { stamps[lane] = lane < nts ? (((unsigned long long)(unsigned)ts_hi << 32) | (unsigned)ts_lo) : 0ull;
        if (lane == 62) stamps[62] = rt_entry; if (lane == 63) stamps[63] = (unsigned long long)wall_clock64(); }
#undef PG8_STAMP
#undef PG8_SA
#undef PG8_SB
#undef PG8_STAGE
#undef PG8_LDA
#undef PG8_LDB
#undef PG8_MMA
#undef PG8_WAIT_V
#undef PG8_WAIT_L
#undef PG8_BAR
#undef PG8_SCHED
}
}
using pg8::Unit;

struct SchedPlain {
    int nM, nN, nwg, G, c;
    __device__ void init(int nM_, int nN_, int G_, int c_) { nM = nM_; nN = nN_; nwg = nM * nN; G = G_; c = c_; }
    __device__ bool next(int i, Unit& u) const {
        const long L = (long)i * G + c; if (L >= nwg) return false;
        int wgid = (int)L; { const int q = nwg / 8, r = nwg % 8, xcd = wgid % 8, off = wgid / 8; wgid = (xcd < r ? xcd * (q + 1) : r * (q + 1) + (xcd - r) * q) + off; }
        const int nig = 8 * nN, gid = wgid / nig, fm = gid * 8, gsz = (nM - fm) < 8 ? (nM - fm) : 8;
        u.pm = __builtin_amdgcn_readfirstlane(fm + ((wgid % nig) % gsz)); u.pn = __builtin_amdgcn_readfirstlane((wgid % nig) / gsz); u.rt = u.pm; u.ct = u.pn; u.br = 0; return true;
    }
    DI void a_ready(const Unit&) const {}
    DI void done(const Unit&) const {}
};
struct SchedMerge {
    int G, c, pmb1, pmb2;
    __device__ void init(int G_, int c_) { G = G_; c = (G_ % 8 == 0) ? ((c_ % 8) * (G_ / 8) + c_ / 8) : c_;
        pmb1 = (int)((OFF_YB - OFF_YA) / YTILE); pmb2 = (int)((OFF_YC - OFF_YA) / YTILE); }
    __device__ bool next(int i, Unit& u) const {
        const int tile = (i / 3) * G + c, br = i % 3; if (tile >= 512) return false;
        const int lp = tile >> 2; u.rt = __builtin_amdgcn_readfirstlane(lp + (lp >> 5) + 1); u.ct = __builtin_amdgcn_readfirstlane(tile & 3); u.br = __builtin_amdgcn_readfirstlane(br);
        u.pm = u.rt + (u.br == 0 ? 0 : (u.br == 1 ? pmb1 : pmb2)); u.pn = u.br * 4 + u.ct; return true;
    }
    DI void a_ready(const Unit&) const {}
    DI void done(const Unit&) const {}
};
struct SchedLat {
    int G, c;
    __device__ void init(int G_, int c_) { G = G_; c = (G_ % 8 == 0) ? ((c_ % 8) * (G_ / 8) + c_ / 8) : c_; }
    __device__ bool next(int i, Unit& u) const {
        const int tile = i * G + c; if (tile >= 512) return false;
        const int lp = tile >> 2; u.pm = u.rt = __builtin_amdgcn_readfirstlane(lp + (lp >> 5) + 1); u.pn = u.ct = __builtin_amdgcn_readfirstlane(tile & 3); u.br = 0; return true;
    }
    DI void a_ready(const Unit&) const {}
    DI void done(const Unit&) const {}
};
template <int NCT> struct SchedMoe {
    int G, c;
    __device__ void init(int G_, int c_) { G = G_; c = c_; }
    __device__ bool next(int i, Unit& u) const {
        const int L = i * G + c; if (L >= 16 * 17 * NCT) return false;
        const int e = __builtin_amdgcn_readfirstlane(L / (17 * NCT)), rem = L - e * (17 * NCT); u.rt = __builtin_amdgcn_readfirstlane(rem / NCT); u.ct = rem - u.rt * NCT; u.br = e;
        u.pm = e * 17 + u.rt; u.pn = e * NCT + u.ct; return true;
    }
    DI void a_ready(const Unit&) const {}
    DI void done(const Unit&) const {}
};

DI u32x4 pack8(const f32x4& a, const f32x4& b) { u32x4 w = {pk2(a[0], a[1]), pk2(a[2], a[3]), pk2(b[0], b[1]), pk2(b[2], b[3])}; return w; }

typedef int v4i_q __attribute__((ext_vector_type(4)));
struct EpiInProj {
    static constexpr bool PERM = true, AFTER_DRAIN = false;
    static DI bool keep_acc(const Unit&) { return false; }
    unsigned char* ws; int nost;
    DI void operator()(const f32x4 (&acc)[2][2][4][2], const Unit& u, int wr, int wc, int fr, int fq) const {
        const int pn = u.pn; bf16_t* base; int ld, colt; bool sig = false;
        if (pn < 6) { base = (bf16_t*)(ws + OFF_PA); ld = 1536; colt = pn * 256; }
        else if (pn < 13) { base = (bf16_t*)(ws + OFF_PR); ld = 1792; colt = (pn - 6) * 256; }
        else if (pn < 19) { base = (bf16_t*)(ws + OFF_PC); ld = 1536; colt = (pn - 13) * 256; }
        else { base = (bf16_t*)(ws + OFF_PG); ld = 3072; colt = (pn - 19) * 256; sig = true; }
        const int row0 = u.pm * 256 + wr * 64 + fr, col0 = colt + wc * 32 + 8 * fq;
        const float* sW = (const float*)(ws + OFF_SW) + pn * 256 + wc * 32 + 8 * fq; const float* sH = (const float*)(ws + OFF_SH);
        f32x4 cs[2][2]; float rsv[2][4];
#pragma unroll
        for (int bj = 0; bj < 2; ++bj) { cs[bj][0] = *(const f32x4*)(sW + bj * 128); cs[bj][1] = *(const f32x4*)(sW + bj * 128 + 4); }
#pragma unroll
        for (int ai = 0; ai < 2; ++ai)
#pragma unroll
            for (int m = 0; m < 4; ++m) rsv[ai][m] = sH[row0 + ai * 128 + m * 16];
#pragma unroll
        for (int bj = 0; bj < 2; ++bj) { const f32x4 cs0 = cs[bj][0], cs1 = cs[bj][1];
#pragma unroll
            for (int ai = 0; ai < 2; ++ai)
#pragma unroll
                for (int m = 0; m < 4; ++m) { bf16_t* rowp = base + (size_t)(row0 + ai * 128 + m * 16) * ld + col0; const float rs = rsv[ai][m];
                    const v4i_q i0 = __builtin_bit_cast(v4i_q, acc[ai][bj][m][0]), i1 = __builtin_bit_cast(v4i_q, acc[ai][bj][m][1]); f32x4 v0, v1;
#pragma unroll
                    for (int i = 0; i < 4; ++i) { v0[i] = (float)i0[i] * rs * cs0[i]; v1[i] = (float)i1[i] * rs * cs1[i]; }
                    if (sig) {
#pragma unroll
                        for (int i = 0; i < 4; ++i) { v0[i] = fmaxf(rintf(255.f * sigmoidf_(v0[i])), 1.f); v1[i] = fmaxf(rintf(255.f * sigmoidf_(v1[i])), 1.f); }
                        const u32x2 pk = {pk4_u8(v0[0], v0[1], v0[2], v0[3]), pk4_u8(v1[0], v1[1], v1[2], v1[3])};
                        unsigned char* gp = ws + OFF_PG + (size_t)(row0 + ai * 128 + m * 16) * 3072 + col0 + bj * 128;
                        if (nost) asm volatile("" :: "v"(pk)); else *(u32x2*)gp = pk; }
                    else { const u32x4 pk = pack8(v0, v1); if (nost) asm volatile("" :: "v"(pk)); else *(u32x4*)(rowp + bj * 128) = pk; } } }
    }
};
struct EpiMerge {
    static constexpr bool PERM = true, AFTER_DRAIN = false;
    static DI bool keep_acc(const Unit& u) { return u.br < 2; }
    unsigned char* ws; int nog;
    DI void operator()(f32x4 (&acc)[2][2][4][2], const Unit& u, int wr, int wc, int fr, int fq) const {
        const unsigned char* PG = ws + OFF_PG; bf16_t* M = (bf16_t*)(ws + OFF_M);
        const int row0 = u.rt * 256 + wr * 64 + fr, col0 = u.ct * 256 + wc * 32 + 8 * fq, br = u.br;
#pragma unroll
        for (int ai = 0; ai < 2; ++ai) {
            u32x2 gq[4][2], gnx[4][2];
#pragma unroll
            for (int m = 0; m < 4; ++m)
#pragma unroll
                for (int bj = 0; bj < 2; ++bj) { const size_t r = (size_t)(row0 + ai * 128 + m * 16); const int c = col0 + bj * 128;
                    gq[m][bj] = (u32x2){0x80808080u, 0x80808080u}; gnx[m][bj] = gq[m][bj];
                    if (!nog) { gq[m][bj] = *(const u32x2*)(PG + r * 3072 + br * 1024 + c); if (br < 2) gnx[m][bj] = *(const u32x2*)(PG + r * 3072 + (br + 1) * 1024 + c); } }
#pragma unroll
            for (int m = 0; m < 4; ++m)
#pragma unroll
                for (int bj = 0; bj < 2; ++bj) { const size_t r = (size_t)(row0 + ai * 128 + m * 16); const int c = col0 + bj * 128;
                    const u32x2 g = gq[m][bj], gn = gnx[m][bj];
                    float f[8];
#pragma unroll
                    for (int i = 0; i < 8; ++i) f[i] = (float)((g[i >> 2] >> (8 * (i & 3))) & 255u);
                    if (br < 2) {
#pragma unroll
                        for (int i = 0; i < 8; ++i) f[i] *= __builtin_amdgcn_rcpf((float)((gn[i >> 2] >> (8 * (i & 3))) & 255u)); }
                    else {
#pragma unroll
                        for (int i = 0; i < 8; ++i) f[i] *= (1.f / 255.f); }
                    f32x4& a0 = acc[ai][bj][m][0]; f32x4& a1 = acc[ai][bj][m][1];
#pragma unroll
                    for (int i = 0; i < 4; ++i) { a0[i] *= f[i]; a1[i] *= f[4 + i]; }
                    if (br == 2) *(u32x4*)(M + r * 1024 + c) = pack8(a0, a1); } }
    }
};
struct EpiOut {
    static constexpr bool PERM = false, AFTER_DRAIN = false;
    static DI bool keep_acc(const Unit&) { return false; }
    unsigned char* ws; int l; float scale;
    DI void operator()(const f32x4 (&acc)[2][2][4][2], const Unit& u, int wr, int wc, int fr, int fq) const {
        float* X = (float*)(ws + OFF_X); const float* MOD = (const float*)(ws + OFF_MOD) + (size_t)l * 5 * 6144;
        const int row0 = u.pm * 256 + wr * 64 + fr, col0 = u.pn * 256 + wc * 32 + 4 * fq;
#pragma unroll
        for (int ai = 0; ai < 2; ++ai)
#pragma unroll
            for (int mh = 0; mh < 2; ++mh) {
                f32x4 xv[2][4], gv[2][4];
#pragma unroll
                for (int mm = 0; mm < 2; ++mm) { const int r = row0 + ai * 128 + (2 * mh + mm) * 16; const int b = r / TT, s_ = r - b * TT; const int mi = s_ < NCTX ? 4 : b;
                    const float* g1 = MOD + mi * 6144 + 2 * 1024; const float* xr = X + (size_t)r * 1024;
#pragma unroll
                    for (int j = 0; j < 4; ++j) { const int c = col0 + (j >> 1) * 128 + (j & 1) * 16; gv[mm][j] = *(const f32x4*)(g1 + c); xv[mm][j] = *(const f32x4*)(xr + c); } }
#pragma unroll
                for (int mm = 0; mm < 2; ++mm) { const int m = 2 * mh + mm; const int r = row0 + ai * 128 + m * 16; float* xr = X + (size_t)r * 1024;
#pragma unroll
                    for (int j = 0; j < 4; ++j) { const int c = col0 + (j >> 1) * 128 + (j & 1) * 16; *(f32x4*)(xr + c) = xv[mm][j] + gv[mm][j] * acc[ai][j >> 1][m][j & 1] * scale; } }
            }
    }
};
struct EpiUp {
    static constexpr bool PERM = true, AFTER_DRAIN = false;
    static DI bool keep_acc(const Unit&) { return false; }
    unsigned char* ws;
    DI void operator()(const f32x4 (&acc)[2][2][4][2], const Unit& u, int, int, int, int) const {
        const int t_ = otid(), wid_ = t_ >> 6, wr = wid_ >> 2, wc = wid_ & 3, fr = t_ & 15, fq = (t_ >> 4) & 3;
        unsigned char* HID = ws + OFF_HID;
        const int row0 = u.pm * 256 + wr * 64 + fr, hc0 = u.ct * 128 + wc * 16 + fq * 4;
#pragma unroll
        for (int ai = 0; ai < 2; ++ai)
#pragma unroll
            for (int m = 0; m < 4; ++m) { unsigned char* rowp = HID + (size_t)(row0 + ai * 128 + m * 16) * 1024 + hc0;
#pragma unroll
                for (int bj = 0; bj < 2; ++bj) { const f32x4 a = acc[ai][bj][m][0] * (1.f / 32.f), b = acc[ai][bj][m][1] * (1.f / 32.f); f32x4 h;
#pragma unroll
                    for (int i = 0; i < 4; ++i) h[i] = a[i] * sigmoidf_(a[i]) * b[i];
                    *(unsigned*)(rowp + bj * 64) = pk4_fp8(h[0], h[1], h[2], h[3]); } }
    }
};
struct EpiDown {
    static constexpr bool PERM = true, AFTER_DRAIN = false;
    static DI bool keep_acc(const Unit&) { return false; }
    unsigned char* ws;
    DI void operator()(const f32x4 (&acc)[2][2][4][2], const Unit& u, int, int, int, int) const {
        const int t_ = otid(), wid_ = t_ >> 6, wr = wid_ >> 2, wc = wid_ & 3, fr = t_ & 15, fq = (t_ >> 4) & 3;
        bf16_t* O = (bf16_t*)(ws + OFF_OUT);
        const int row0 = u.pm * 256 + wr * 64 + fr, col0 = u.ct * 256 + wc * 32 + 8 * fq;
#pragma unroll
        for (int ai = 0; ai < 2; ++ai)
#pragma unroll
            for (int m = 0; m < 4; ++m) { bf16_t* rowp = O + (size_t)(row0 + ai * 128 + m * 16) * 1024 + col0;
#pragma unroll
                for (int bj = 0; bj < 2; ++bj) *(u32x4*)(rowp + bj * 128) = pack8(acc[ai][bj][m][0] * (1.f / 32.f), acc[ai][bj][m][1] * (1.f / 32.f)); }
    }
};
DI int row_mod(int r) { const int b = r / TT, s = r - b * TT; return s < NCTX ? 4 : b; }

__device__ void ph_prologue(const Params& p, LAS unsigned char* lds, int wg, int nwg) {
    const int tid = otid();
    if (wg == 0 && tid < 16) {
        float* COS = (float*)(p.ws + OFF_ROPE); float* SIN = COS + 2048;
        const int k = tid; const int q4 = k & 3, dec = k >> 2;
        double th = (q4 == 0) ? 1.0 : (q4 == 1 ? 0.56234132519034908 : (q4 == 2 ? 0.31622776601683794 : 0.17782794100389228));
        for (int i = 0; i < dec; ++i) th *= 0.1;
        double ct = 1.0, st = th, term_c = 1.0, term_s = th; const double t2 = th * th;
        for (int n = 1; n <= 12; ++n) { term_c *= -t2 / (double)((2 * n - 1) * (2 * n)); term_s *= -t2 / (double)((2 * n) * (2 * n + 1)); ct += term_c; st += term_s; }
        double cp = 1.0, sp = 0.0;
        for (int pos = 0; pos < 128; ++pos) { COS[pos * 16 + k] = (float)cp; SIN[pos * 16 + k] = (float)sp; const double c2 = cp * ct - sp * st, s2 = sp * ct + cp * st; cp = c2; sp = s2; }
    }
    {
        LAS float* sc = (LAS float*)lds;
        LAS float* red = sc + 5 * 1024;
        float* MOD = (float*)(p.ws + OFF_MOD);
        for (int i = tid; i < 5 * 1024; i += 512) { const int m = i >> 10, k = i & 1023; const float v = (m < 4) ? p.c[m * 1024 + k] : p.c_ctx[k]; sc[i] = v * sigmoidf_(v); }
        __syncthreads();
        for (int u = wg; u < NL * 48; u += nwg) {
            const int l = u / 48, cb = u % 48; const int cl = tid & 127, col = cb * 128 + cl, kq = tid >> 7;
            const float* W = p.ada_w + (size_t)l * 1024 * 6144 + col;
            float a0 = 0, a1 = 0, a2 = 0, a3 = 0, a4 = 0;
#pragma unroll 1
            for (int k0 = kq * 256; k0 < kq * 256 + 256; k0 += 16) { float wv[16];
#pragma unroll
                for (int j = 0; j < 16; ++j) wv[j] = W[(size_t)(k0 + j) * 6144];
#pragma unroll
                for (int j = 0; j < 16; ++j) { const int k = k0 + j; const float w = wv[j]; a0 += sc[k] * w; a1 += sc[1024 + k] * w; a2 += sc[2048 + k] * w; a3 += sc[3072 + k] * w; a4 += sc[4096 + k] * w; } }
            red[(kq * 5 + 0) * 128 + cl] = a0; red[(kq * 5 + 1) * 128 + cl] = a1; red[(kq * 5 + 2) * 128 + cl] = a2; red[(kq * 5 + 3) * 128 + cl] = a3; red[(kq * 5 + 4) * 128 + cl] = a4;
            __syncthreads();
            if (tid < 128) { const float bb = p.ada_b[l * 6144 + col];
                for (int m = 0; m < 5; ++m) { const float s = red[(0 * 5 + m) * 128 + cl] + red[(1 * 5 + m) * 128 + cl] + red[(2 * 5 + m) * 128 + cl] + red[(3 * 5 + m) * 128 + cl];
                    MOD[((size_t)(l * 5 + m)) * 6144 + col] = s + bb; } }
            __syncthreads();
        }
    }
}

template <class RowMap> DI void tconv_tile(const float* src, int ldn, int k0, int n0, bf16_t* dst, int K, RowMap rm, LAS float* tile  , int tid) {
#pragma unroll
    for (int i = 0; i < 8; ++i) { const int k = (tid >> 6) + 8 * i, n = tid & 63; tile[k * 65 + n] = src[(size_t)(k0 + k) * ldn + n0 + n]; }
    __syncthreads();
    const int n = tid >> 3, k8 = (tid & 7) * 8; float v[8];
#pragma unroll
    for (int j = 0; j < 8; ++j) v[j] = tile[(k8 + j) * 65 + n];
    u32x4 w = {pk2(v[0], v[1]), pk2(v[2], v[3]), pk2(v[4], v[5]), pk2(v[6], v[7])};
    *(u32x4*)(dst + (size_t)rm(n0 + n) * K + k0 + k8) = w;
    __syncthreads();
}
template <class RowMap> DI void tconv_tile_f8(const float* src, int ldn, int k0, int n0, unsigned char* dst, int K, RowMap rm, float scale, LAS float* tile  , int tid) {
#pragma unroll
    for (int i = 0; i < 8; ++i) { const int k = (tid >> 6) + 8 * i, n = tid & 63; tile[k * 65 + n] = src[(size_t)(k0 + k) * ldn + n0 + n]; }
    __syncthreads();
    const int n = tid >> 3, k8 = (tid & 7) * 8; float v[8];
#pragma unroll
    for (int j = 0; j < 8; ++j) v[j] = tile[(k8 + j) * 65 + n] * scale;
    u32x2 w = {pk4_fp8(v[0], v[1], v[2], v[3]), pk4_fp8(v[4], v[5], v[6], v[7])};
    *(u32x2*)(dst + (size_t)rm(n0 + n) * K + k0 + k8) = w;
    __syncthreads();
}
struct RowId { DI int operator()(int n) const { return n; } };
struct RowW13 { int sel; DI int operator()(int j) const { return (j >> 7) * 256 + ((j & 127) >> 2) * 8 + sel * 4 + (j & 3); } };

DI void tblk_load(const float* src, int ldn, int k0, int n0, int tid, f32x4 (&v)[8]) {
    const float* s = src + (size_t)(k0 + 4 * (tid >> 5)) * ldn + n0 + 4 * (tid & 31);
#pragma unroll
    for (int i = 0; i < 2; ++i)
#pragma unroll
        for (int j = 0; j < 4; ++j) v[i * 4 + j] = *(const f32x4*)(s + (size_t)(64 * i + j) * ldn);
}
template <int OB> DI void tblk_to_lds(const f32x4 (&v)[8], float scale, LAS unsigned char* tile, int tid) {
    constexpr int S = 128 * OB + 8; const int c4 = tid & 31, r = tid >> 5;
#pragma unroll
    for (int i = 0; i < 2; ++i) {
        const f32x4 f0 = v[i * 4 + 0], f1 = v[i * 4 + 1], f2 = v[i * 4 + 2], f3 = v[i * 4 + 3];
#pragma unroll
        for (int jn = 0; jn < 4; ++jn) { LAS unsigned char* d = tile + (4 * c4 + jn) * S + (4 * r + 64 * i) * OB;
            if constexpr (OB == 1) *(LAS unsigned*)d = pk4_fp8(f0[jn] * scale, f1[jn] * scale, f2[jn] * scale, f3[jn] * scale);
            else *(LAS u32x2*)d = (u32x2){pk2(f0[jn], f1[jn]), pk2(f2[jn], f3[jn])}; }
    }
}
template <int OB, class RowMap> DI void tblk_from_lds(const LAS unsigned char* tile, unsigned char* dst, int Kb, int k0, int n0, RowMap rm, int tid) {
    constexpr int S = 128 * OB + 8; const int n = tid >> 2, q = tid & 3;
    const LAS unsigned char* t = tile + n * S + q * 32 * OB; unsigned char* d = dst + (size_t)rm(n0 + n) * Kb + k0 * OB + q * 32 * OB;
#pragma unroll
    for (int j = 0; j < 2 * OB; ++j) { const u32x2 a = *(const LAS u32x2*)(t + 16 * j), c = *(const LAS u32x2*)(t + 16 * j + 8); *(u32x4*)(d + 16 * j) = (u32x4){a[0], a[1], c[0], c[1]}; }
}
template <int OB, class RowMap> DI void tblk_unit(const float* src, int ldn, int k0, int n0, unsigned char* dst, int Kb, RowMap rm, float scale, LAS unsigned char* tile, int tid) {
    f32x4 v[8]; tblk_load(src, ldn, k0, n0, tid, v); tblk_to_lds<OB>(v, scale, tile, tid);
    __syncthreads();
    tblk_from_lds<OB>(tile, dst, Kb, k0, n0, rm, tid);
    __syncthreads();
}
DI float max_hi3(float v) {
    v = fmaxf(v, dppmov<0x128>(v));
    { auto r = __builtin_amdgcn_permlane16_swap(__float_as_uint(v), __float_as_uint(v), false, false); v = fmaxf(__uint_as_float(r[0]), __uint_as_float(r[1])); }
    { auto r = __builtin_amdgcn_permlane32_swap(__float_as_uint(v), __float_as_uint(v), false, false); v = fmaxf(__uint_as_float(r[0]), __uint_as_float(r[1])); } return v; }
DI void win_strip(const float* src, float* SW, unsigned char* dst, int n0, LAS unsigned char* tile, int tid) {
    constexpr int S = 1024 + 8; const int c4 = tid & 7, r = tid >> 3; LAS float* red = (LAS float*)(tile + 32 * S);
    f32x4 v[16]; const float* s = src + (size_t)(4 * r) * NIN + n0 + 4 * c4;
#pragma unroll
    for (int i = 0; i < 4; ++i)
#pragma unroll
        for (int j = 0; j < 4; ++j) v[i * 4 + j] = *(const f32x4*)(s + (size_t)(256 * i + j) * NIN);
    float am[4] = {0.f, 0.f, 0.f, 0.f};
#pragma unroll
    for (int i = 0; i < 16; ++i) { am[0] = fmaxf(am[0], fabsf(v[i][0])); am[1] = fmaxf(am[1], fabsf(v[i][1])); am[2] = fmaxf(am[2], fabsf(v[i][2])); am[3] = fmaxf(am[3], fabsf(v[i][3])); }
#pragma unroll
    for (int j = 0; j < 4; ++j) am[j] = max_hi3(am[j]);
    if ((tid & 63) < 8) *(LAS f32x4*)(red + (tid >> 6) * 32 + 4 * c4) = (f32x4){am[0], am[1], am[2], am[3]};
    __syncthreads();
    float inv[4];
#pragma unroll
    for (int j = 0; j < 4; ++j) { float m = red[4 * c4 + j];
#pragma unroll
        for (int w = 1; w < 8; ++w) m = fmaxf(m, red[w * 32 + 4 * c4 + j]);
        m = fmaxf(m, 1e-20f); inv[j] = 127.f / m; if (r == 0) SW[n0 + 4 * c4 + j] = m * (1.f / 127.f); }
#pragma unroll
    for (int i = 0; i < 4; ++i) {
        const f32x4 f0 = v[i * 4 + 0], f1 = v[i * 4 + 1], f2 = v[i * 4 + 2], f3 = v[i * 4 + 3];
#pragma unroll
        for (int jn = 0; jn < 4; ++jn) *(LAS unsigned*)(tile + (4 * c4 + jn) * S + 4 * r + 256 * i) = pk4_i8(f0[jn] * inv[jn], f1[jn] * inv[jn], f2[jn] * inv[jn], f3[jn] * inv[jn]);
    }
    __syncthreads();
    {   const int n = tid >> 4, q = tid & 15; const LAS unsigned char* t = tile + n * S + q * 64; unsigned char* d = dst + (size_t)(n0 + n) * 1024 + q * 64;
#pragma unroll
        for (int j = 0; j < 4; ++j) { const u32x2 a = *(const LAS u32x2*)(t + 16 * j), c = *(const LAS u32x2*)(t + 16 * j + 8); *(u32x4*)(d + 16 * j) = (u32x4){a[0], a[1], c[0], c[1]}; } }
    __syncthreads();
}

__device__ void conv_mixer_a(const Params& p, int l, LAS unsigned char* lds) {
    LAS float* tile = (LAS float*)lds; LAS unsigned* bc = (LAS unsigned*)(lds + 36864); const int tid = otid();
    unsigned* ctr = (unsigned*)(p.ws + OFF_CTR) + (48 + l) * 64;
    constexpr int U_IN = 248, U_LR = 48;
    for (;;) {
        if (tid == 0) *bc = atomicAdd(ctr, 1u);
        __syncthreads();
        const int u = (int)*bc;
        __syncthreads();
        if (u >= U_IN + U_LR) break;
        if (u < U_IN) win_strip(p.w_in + (size_t)l * 1024 * NIN, (float*)(p.ws + OFF_SW), p.ws + OFF_WIN, u * 32, lds, tid);
        else { const int v = u - U_IN; bf16_t* LRW = (bf16_t*)(p.ws + OFF_LRW);
            if (v < 32) { const int mi = v >> 3, nt = v & 7; const float* src = (mi < 2 ? p.rwkv_w_up : p.rwkv_a_up) + ((size_t)(l * 2 + (mi & 1)) * 64) * 512;
                tconv_tile(src, 512, 0, nt * 64, LRW + (size_t)mi * 512 * 64, 64, RowId(), tile, tid); }
            else { const int w = v - 32, kt = w >> 3, nt = w & 7;
                tconv_tile(p.rwkv_g_up + (size_t)l * 128 * 512, 512, kt * 64, nt * 64, LRW + (size_t)4 * 512 * 64, 128, RowId(), tile, tid); } }
    }
}
__device__ void conv_mixer_b(const Params& p, int l, LAS unsigned char* lds, int wg, int nwg) {
    const int tid = otid();
    constexpr int U_BR = 3 * 4 * 8, U_OUT = 64;
    for (int u = wg; u < U_BR + U_OUT; u += nwg) {
        if (u < U_BR) { const int i = u / 32, kt = (u % 32) / 8, nt = u % 8;
            tblk_unit<2>(p.w_branch + ((size_t)(l * 3 + i)) * 512 * 1024, 1024, kt * 128, nt * 128, p.ws + OFF_WBR + (size_t)i * 1024 * 512 * 2, 512 * 2, RowId(), 1.f, lds, tid); }
        else { const int v = u - U_BR, kt = v / 8, nt = v % 8;
            tblk_unit<2>(p.w_out + (size_t)l * 1024 * 1024, 1024, kt * 128, nt * 128, p.ws + OFF_WOUT, 1024 * 2, RowId(), 1.f, lds, tid); }
    }
}
__device__ void conv_expert_weights(const Params& p, int l, LAS unsigned char* lds, int qofs = 16) {
    LAS unsigned* bc = (LAS unsigned*)(lds + 128 * 136); const int tid = otid();
    unsigned* ctr = (unsigned*)(p.ws + OFF_CTR) + (qofs + l) * 64;
    constexpr int NU = 16 * 3 * 64;
    const float* w1 = p.exp_w1 + (size_t)l * 16 * 1024 * 1024; const float* w3 = p.exp_w3 + (size_t)l * 16 * 1024 * 1024; const float* w2 = p.exp_w2 + (size_t)l * 16 * 1024 * 1024;
#define EXP_SRC(u_) (((((u_) % 192) >> 6) == 0 ? w1 : ((((u_) % 192) >> 6) == 1 ? w3 : w2)) + (size_t)((u_) / 192) * 1024 * 1024)
#define EXP_K0(u_) (((((u_) % 192) >> 3) & 7) * 128)
#define EXP_N0(u_) ((((u_) % 192) & 7) * 128)
    if (tid == 0) *bc = atomicAdd(ctr, 1u);
    __syncthreads();
    int u = (int)*bc;
    __syncthreads();
    if (u >= NU) return;
    f32x4 v[8]; tblk_load(EXP_SRC(u), 1024, EXP_K0(u), EXP_N0(u), tid, v);
    for (;;) {
        if (tid == 0) *bc = atomicAdd(ctr, 1u);
        tblk_to_lds<1>(v, 32.f, lds, tid);
        __syncthreads();
        const int un = (int)*bc;
        if (un < NU) tblk_load(EXP_SRC(un), 1024, EXP_K0(un), EXP_N0(un), tid, v);
        {   const int e = u / 192, w = u % 192, which = w >> 6, k0 = ((w >> 3) & 7) * 128, n0 = (w & 7) * 128;
            if (which == 0) tblk_from_lds<1>(lds, p.ws + OFF_W13 + (size_t)e * 2048 * 1024, 1024, k0, n0, RowW13{0}, tid);
            else if (which == 1) tblk_from_lds<1>(lds, p.ws + OFF_W13 + (size_t)e * 2048 * 1024, 1024, k0, n0, RowW13{1}, tid);
            else tblk_from_lds<1>(lds, p.ws + OFF_W2 + (size_t)e * 1024 * 1024, 1024, k0, n0, RowId(), tid); }
        __syncthreads();
        if (un >= NU) break;
        u = un;
    }
#undef EXP_SRC
#undef EXP_K0
#undef EXP_N0
}

__device__ void norm1_rows(const Params& p, int l, int wg, int nwg) {
    const int tid = otid(), wave = tid >> 6, lane = tid & 63;
    float* X = (float*)(p.ws + OFF_X); bf16_t* H = (bf16_t*)(p.ws + OFF_H);
    const float* MOD = (const float*)(p.ws + OFF_MOD) + (size_t)l * 5 * 6144; const float* g = p.norm1_g + l * 1024;
    for (int r = wg * 8 + wave; r < RR; r += nwg * 8) {
        const int b_ = r / TT, s_ = r - b_ * TT;
        const float4* xr = (s_ < NCTX) ? (const float4*)(p.ctx + ((size_t)(b_ * NCTX + s_)) * DM) : (const float4*)(p.x + ((size_t)(b_ * SEQ + s_ - NCTX)) * DM); float4* xw = (float4*)(X + (size_t)r * 1024); float4 v[4]; float ss = 0.f;
#pragma unroll
        for (int i = 0; i < 4; ++i) v[i] = xr[lane + 64 * i];
#pragma unroll
        for (int i = 0; i < 4; ++i) { xw[lane + 64 * i] = v[i]; ss += v[i].x * v[i].x + v[i].y * v[i].y + v[i].z * v[i].z + v[i].w * v[i].w; }
        ss = wave_sum(ss);
        const float rinv = rsqrtf(ss * (1.f / 1024.f) + 1e-6f);
        const float* md = MOD + row_mod(r) * 6144;
        float y[16]; float am = 0.f;
#pragma unroll
        for (int i = 0; i < 4; ++i) { const int col = (lane + 64 * i) * 4;
            const float4 gg = *(const float4*)(g + col), sh = *(const float4*)(md + col), sc = *(const float4*)(md + 1024 + col);
            y[4 * i] = v[i].x * rinv * gg.x * (1.f + sc.x) + sh.x; y[4 * i + 1] = v[i].y * rinv * gg.y * (1.f + sc.y) + sh.y; y[4 * i + 2] = v[i].z * rinv * gg.z * (1.f + sc.z) + sh.z; y[4 * i + 3] = v[i].w * rinv * gg.w * (1.f + sc.w) + sh.w;
#pragma unroll
            for (int j = 0; j < 4; ++j) am = fmaxf(am, fabsf(y[4 * i + j])); }
        am = fmaxf(wave_max(am), 1e-20f); const float inv = 127.f / am;
        if (lane == 0) ((float*)(p.ws + OFF_SH))[r] = am * (1.f / 127.f);
#pragma unroll
        for (int i = 0; i < 4; ++i) *(unsigned*)((unsigned char*)H + (size_t)r * 1024 + (lane + 64 * i) * 4) = pk4_i8(y[4 * i] * inv, y[4 * i + 1] * inv, y[4 * i + 2] * inv, y[4 * i + 3] * inv);
    }
}
#define MFMA16(a, b, c) __builtin_amdgcn_mfma_f32_16x16x32_bf16((a), (b), (c), 0, 0, 0)
DI float tanh_fast(float x) { return 1.f - 2.f * __builtin_amdgcn_rcpf(1.f + __expf(2.f * x)); }
DI void unpack4(const u32x2 w, float (&o)[4]) { o[0] = bflo(w[0]); o[1] = bfhi(w[0]); o[2] = bflo(w[1]); o[3] = bfhi(w[1]); }
DI void prep_rows_unit(const Params& p, int l, LAS unsigned char* lds, int ub, int dup) {
    const int tid = otid(), wave = tid >> 6, lane = tid & 63, c16 = lane & 15, rq = lane >> 4;
    const int r0 = ub * 16; const int b = r0 / TT, s0 = r0 - b * TT;
    const bool isctx = s0 < NCTX; const int seg_lo = isctx ? 0 : NCTX, seg_hi = isctx ? NCTX : TT;
    const bool has_prev = s0 > seg_lo, has_next = (s0 + 16) < seg_hi;
    bf16_t* PA = (bf16_t*)(p.ws + OFF_PA); const bf16_t* PR = (const bf16_t*)(p.ws + OFF_PR); const bf16_t* PC = (const bf16_t*)(p.ws + OFF_PC);
    const int col0 = wave * 64 + c16 * 4, rb = r0 + 4 * rq;
    const bool pv = (rq > 0) || has_prev, nv = (rq < 3) || has_next;
    u32x2 rawc[3][6], rawu[2][6], rawbg[4]; u32x4 rawlr[8], rawqk[4];
#pragma unroll
    for (int g = 0; g < 3; ++g)
#pragma unroll
        for (int j = 0; j < 6; ++j) { const bool ok = (j == 0) ? pv : ((j == 5) ? nv : true); rawc[g][j] = (u32x2){0u, 0u}; if (ok) rawc[g][j] = *(const u32x2*)(PR + (size_t)(rb - 1 + j) * 1792 + g * 512 + col0); }
    {   const bf16_t* lr = PR + (size_t)(r0 + c16) * 1792 + 1536 + 8 * rq;
#pragma unroll
        for (int i = 0; i < 8; ++i) rawlr[i] = *(const u32x4*)(lr + 32 * i); }
#pragma unroll
    for (int j = 0; j < 6; ++j) { const bool ok = (j == 0) ? pv : ((j == 5) ? nv : true); rawu[0][j] = (u32x2){0u, 0u}; rawu[1][j] = (u32x2){0u, 0u};
        if (ok) { rawu[0][j] = *(const u32x2*)(PC + (size_t)(rb - 1 + j) * 1536 + 512 + col0); rawu[1][j] = *(const u32x2*)(PC + (size_t)(rb - 1 + j) * 1536 + 1024 + col0); } }
#pragma unroll
    for (int i = 0; i < 4; ++i) rawbg[i] = *(const u32x2*)(PC + (size_t)(rb + i) * 1536 + col0);
    bf16_t* qkbase = PA + (size_t)(r0 + (tid >> 5)) * 1536 + ((tid & 31) >> 1) * 64 + 16 * (tid & 1);
    if (!dup) { rawqk[0] = *(const u32x4*)qkbase; rawqk[1] = *(const u32x4*)(qkbase + 8); rawqk[2] = *(const u32x4*)(qkbase + 32); rawqk[3] = *(const u32x4*)(qkbase + 40); }
    __builtin_amdgcn_sched_barrier(0);
    float rc[4][4], kc[4][4], vc[4][4];
    {   const float* cw = p.rwkv_conv_w + (size_t)l * 3 * 1536;
#pragma unroll
        for (int g = 0; g < 3; ++g) {
            const int co = g * 512 + col0; const f32x4 w0 = *(const f32x4*)(cw + co), w1 = *(const f32x4*)(cw + 1536 + co), w2 = *(const f32x4*)(cw + 3072 + co);
            float x[6][4];
#pragma unroll
            for (int j = 0; j < 6; ++j) unpack4(rawc[g][j], x[j]);
#pragma unroll
            for (int i = 0; i < 4; ++i)
#pragma unroll
                for (int c = 0; c < 4; ++c) { const float o = w0[c] * x[i][c] + w1[c] * x[i + 1][c] + w2[c] * x[i + 2][c]; if (g == 0) rc[i][c] = o; else if (g == 1) kc[i][c] = o; else vc[i][c] = o; }
        } }
    bf16_t* EW = (bf16_t*)(p.ws + OFF_EW); bf16_t* AA = (bf16_t*)(p.ws + OFF_AA);
    bf16_t* KK = (bf16_t*)(p.ws + OFF_KK); bf16_t* KC = (bf16_t*)(p.ws + OFF_KC); bf16_t* RC = (bf16_t*)(p.ws + OFF_RC); bf16_t* VC = (bf16_t*)(p.ws + OFF_VC);
    {   const f32x4 kkc = *(const f32x4*)(p.rwkv_k_k + l * 512 + col0);
#pragma unroll
        for (int i = 0; i < 4; ++i) { float q[4]; float ss = 0.f;
#pragma unroll
            for (int c = 0; c < 4; ++c) { q[c] = kc[i][c] * kkc[c]; ss += q[c] * q[c]; }
            ss = allsum16(ss); const float rn = 1.f / fmaxf(sqrtf(ss), 1e-12f);
            const size_t o = (size_t)(rb + i) * 512 + col0;
            u32x2 w; w[0] = pk2(q[0] * rn, q[1] * rn); w[1] = pk2(q[2] * rn, q[3] * rn); *(u32x2*)(KK + o) = w;
            w[0] = pk2(kc[i][0], kc[i][1]); w[1] = pk2(kc[i][2], kc[i][3]); *(u32x2*)(KC + o) = w;
            w[0] = pk2(rc[i][0], rc[i][1]); w[1] = pk2(rc[i][2], rc[i][3]); *(u32x2*)(RC + o) = w;
            w[0] = pk2(vc[i][0], vc[i][1]); w[1] = pk2(vc[i][2], vc[i][3]); *(u32x2*)(VC + o) = w; } }
    bf16x8 twf[2], alf[2], sgf[4];
    {
#pragma unroll
        for (int ks = 0; ks < 2; ++ks) { const u32x4 v = rawlr[ks]; u32x4 t;
#pragma unroll
            for (int i = 0; i < 4; ++i) t[i] = pk2(tanh_fast(bflo(v[i])), tanh_fast(bfhi(v[i])));
            twf[ks] = __builtin_bit_cast(bf16x8, t); alf[ks] = __builtin_bit_cast(bf16x8, rawlr[2 + ks]); }
#pragma unroll
        for (int ks = 0; ks < 4; ++ks) { const u32x4 v = rawlr[4 + ks]; u32x4 t;
#pragma unroll
            for (int i = 0; i < 4; ++i) t[i] = pk2(sigmoidf_(bflo(v[i])), sigmoidf_(bfhi(v[i])));
            sgf[ks] = __builtin_bit_cast(bf16x8, t); } }
    const bf16_t* LRW = (const bf16_t*)(p.ws + OFF_LRW);
    float bon[4] = {0.f, 0.f, 0.f, 0.f};
    const f32x4 kac = *(const f32x4*)(p.rwkv_k_a + l * 512 + col0), rkc = *(const f32x4*)(p.rwkv_r_k + l * 512 + col0);
#pragma unroll 1
    for (int d = 0; d < 2; ++d) {
        f32x4 wa[4], aa[4];
#pragma unroll
        for (int cb = 0; cb < 4; ++cb) { wa[cb] = (f32x4){0.f, 0.f, 0.f, 0.f}; aa[cb] = (f32x4){0.f, 0.f, 0.f, 0.f};
            const bf16_t* bw = LRW + ((size_t)d * 512 + col0 + cb) * 64 + 8 * rq; const bf16_t* ba = bw + (size_t)2 * 512 * 64;
#pragma unroll
            for (int ks = 0; ks < 2; ++ks) { wa[cb] = MFMA16(twf[ks], *(const bf16x8*)(bw + 32 * ks), wa[cb]); aa[cb] = MFMA16(alf[ks], *(const bf16x8*)(ba + 32 * ks), aa[cb]); } }
        const f32x4 w0c = *(const f32x4*)(p.rwkv_w0 + (l * 2 + d) * 512 + col0), a0c = *(const f32x4*)(p.rwkv_a0 + (l * 2 + d) * 512 + col0);
#pragma unroll
        for (int i = 0; i < 4; ++i) { float e[4], a[4]; float bs = 0.f;
#pragma unroll
            for (int c = 0; c < 4; ++c) { const float z = w0c[c] + wa[c][i];
                const float sp = fmaxf(-z, 0.f) + __logf(1.f + __expf(-fabsf(z)));
                e[c] = __expf(-sp - 0.5f);
                a[c] = sigmoidf_(a0c[c] + aa[c][i]);
                const float kd = kc[i][c] * (1.f + (a[c] - 1.f) * kac[c]); bs += rc[i][c] * kd * rkc[c]; }
            bon[i] += allsum16(bs);
            const size_t o = (size_t)d * RR * 512 + (size_t)(rb + i) * 512 + col0;
            u32x2 w; w[0] = pk2(e[0], e[1]); w[1] = pk2(e[2], e[3]); *(u32x2*)(EW + o) = w;
            w[0] = pk2(a[0], a[1]); w[1] = pk2(a[2], a[3]); *(u32x2*)(AA + o) = w; }
    }
    {
        f32x4 ga[4];
#pragma unroll
        for (int cb = 0; cb < 4; ++cb) { ga[cb] = (f32x4){0.f, 0.f, 0.f, 0.f}; const bf16_t* bg = LRW + (size_t)4 * 512 * 64 + ((size_t)col0 + cb) * 128 + 8 * rq;
#pragma unroll
            for (int ks = 0; ks < 4; ++ks) ga[cb] = MFMA16(sgf[ks], *(const bf16x8*)(bg + 32 * ks), ga[cb]); }
        bf16_t* G = (bf16_t*)(p.ws + OFF_G); bf16_t* YB0 = (bf16_t*)(p.ws + OFF_YB0); const f32x4 lnb = *(const f32x4*)(p.rwkv_ln_b + l * 512 + col0);
#pragma unroll
        for (int i = 0; i < 4; ++i) { const size_t o = (size_t)(rb + i) * 512 + col0;
            u32x2 w; w[0] = pk2(ga[0][i], ga[1][i]); w[1] = pk2(ga[2][i], ga[3][i]); *(u32x2*)(G + o) = w;
            w[0] = pk2(2.f * lnb[0] + bon[i] * vc[i][0], 2.f * lnb[1] + bon[i] * vc[i][1]); w[1] = pk2(2.f * lnb[2] + bon[i] * vc[i][2], 2.f * lnb[3] + bon[i] * vc[i][3]); *(u32x2*)(YB0 + o) = w; }
    }
    {
        const float* cw = p.conv_w + (size_t)l * 3 * 512; const f32x4 c0 = *(const f32x4*)(cw + col0), c1 = *(const f32x4*)(cw + 512 + col0), c2 = *(const f32x4*)(cw + 1024 + col0);
        float uu[6][4];
#pragma unroll
        for (int j = 0; j < 6; ++j) { float fa[4], fc[4]; unpack4(rawu[0][j], fa); unpack4(rawu[1][j], fc);
#pragma unroll
            for (int q = 0; q < 4; ++q) uu[j][q] = fa[q] * fc[q]; }
        bf16_t* YC = (bf16_t*)(p.ws + OFF_YC);
#pragma unroll
        for (int i = 0; i < 4; ++i) { float bg[4]; unpack4(rawbg[i], bg); float o[4];
#pragma unroll
            for (int q = 0; q < 4; ++q) o[q] = bg[q] * (c0[q] * uu[i][q] + c1[q] * uu[i + 1][q] + c2[q] * uu[i + 2][q]);
            u32x2 w = {pk2(o[0], o[1]), pk2(o[2], o[3])}; *(u32x2*)(YC + (size_t)(rb + i) * 512 + col0) = w; }
    }
    if (!dup) {   const int rr = tid >> 5, g16 = (tid & 31) >> 1, hf = tid & 1; const int s = s0 + rr;
        bf16_t* base = qkbase;
        const u32x4 a0 = rawqk[0], a1 = rawqk[1], b0 = rawqk[2], b1 = rawqk[3];
        float x1[16], x2[16];
#pragma unroll
        for (int i = 0; i < 4; ++i) { x1[2 * i] = bflo(a0[i]); x1[2 * i + 1] = bfhi(a0[i]); x1[8 + 2 * i] = bflo(a1[i]); x1[9 + 2 * i] = bfhi(a1[i]);
            x2[2 * i] = bflo(b0[i]); x2[2 * i + 1] = bfhi(b0[i]); x2[8 + 2 * i] = bflo(b1[i]); x2[9 + 2 * i] = bfhi(b1[i]); }
        float ss = 0.f;
#pragma unroll
        for (int j = 0; j < 16; ++j) ss += x1[j] * x1[j] + x2[j] * x2[j];
        ss += dppmov<0xB1>(ss);
        const float rinv = rsqrtf(ss * (1.f / 64.f) + 1e-6f);
        const float* gg = (g16 < 8 ? p.q_norm_g : p.k_norm_g) + l * 64; const float qs = g16 < 8 ? 0.125f * 1.4426950408889634f : 1.f;
        const float* COS = (const float*)(p.ws + OFF_ROPE); const float* SIN = COS + 2048;
        const int tl = s - NCTX; const int pos = isctx ? 0 : (hf == 0 ? (tl >> 6) : (tl & 63));
#pragma unroll
        for (int j = 0; j < 16; ++j) { const float y1 = x1[j] * rinv * gg[16 * hf + j], y2 = x2[j] * rinv * gg[32 + 16 * hf + j];
            float o1 = y1, o2 = y2;
            if (!isctx) { const float c = COS[pos * 16 + j], sn = SIN[pos * 16 + j]; o1 = y1 * c - y2 * sn; o2 = y2 * c + y1 * sn; }
            x1[j] = o1 * qs; x2[j] = o2 * qs; }
        u32x4 w0, w1, w2, w3;
#pragma unroll
        for (int i = 0; i < 4; ++i) { w0[i] = pk2(x1[2 * i], x1[2 * i + 1]); w1[i] = pk2(x1[8 + 2 * i], x1[9 + 2 * i]); w2[i] = pk2(x2[2 * i], x2[2 * i + 1]); w3[i] = pk2(x2[8 + 2 * i], x2[9 + 2 * i]); }
        *(u32x4*)base = w0; *(u32x4*)(base + 8) = w1; *(u32x4*)(base + 32) = w2; *(u32x4*)(base + 40) = w3;
    }
}
DI void prep_vt_unit(const Params& p, LAS unsigned char* lds, int uv) {
    const int tid = otid(); const int b = uv / 132, tb = uv % 132;
    const bf16_t* PA = (const bf16_t*)(p.ws + OFF_PA); bf16_t* VT = (bf16_t*)(p.ws + OFF_VT);
    LAS unsigned char* img = lds;
#pragma unroll
    for (int i = 0; i < 8; ++i) { const int id = tid + 512 * i, row = id >> 6, ch = id & 63;
        const u32x4 v = *(const u32x4*)(PA + (size_t)(b * TT + tb * 64 + row) * 1536 + 1024 + ch * 8); *(LAS u32x4*)(img + row * 1040 + ch * 16) = v; }
    __syncthreads();
    bf16_t* dst = VT + ((size_t)(b * 512 + tid)) * TT + tb * 64;
#pragma unroll
    for (int g = 0; g < 4; ++g) { unsigned w[8];
#pragma unroll
        for (int q = 0; q < 8; ++q) { const int p0 = 2 * q, p1 = 2 * q + 1;
            const int k0 = 16 * g + (p0 & 3) + 8 * ((p0 >> 2) & 1) + 4 * (p0 >> 3), k1 = 16 * g + (p1 & 3) + 8 * ((p1 >> 2) & 1) + 4 * (p1 >> 3);
            const unsigned lo = *(const LAS unsigned short*)(img + k0 * 1040 + tid * 2), hi = *(const LAS unsigned short*)(img + k1 * 1040 + tid * 2); w[q] = lo | (hi << 16); }
        u32x4 wa = {w[0], w[1], w[2], w[3]}, wb = {w[4], w[5], w[6], w[7]};
        *(u32x4*)(dst + 16 * g) = wa; *(u32x4*)(dst + 16 * g + 8) = wb; }
    __syncthreads();
}
__device__ void ph_prep(const Params& p, int l, LAS unsigned char* lds, int wg, int nwg, int dup) {
    for (int u = wg; u < 528; u += nwg) prep_vt_unit(p, lds, u);
    for (int u = wg; u < RR / 16; u += nwg) prep_rows_unit(p, l, lds, u, dup);
}
#define MFMA32(a, b, c) __builtin_amdgcn_mfma_f32_32x32x16_bf16((a), (b), (c), 0, 0, 0)
DI bf16x8 pack_p(const f32x16& x, int s) {
    u32x4 w = {pk2(x[8 * s + 0], x[8 * s + 1]), pk2(x[8 * s + 2], x[8 * s + 3]), pk2(x[8 * s + 4], x[8 * s + 5]), pk2(x[8 * s + 6], x[8 * s + 7])};
    return __builtin_bit_cast(bf16x8, w);
}
#define SCHED_FENCE() __builtin_amdgcn_sched_barrier(0)
DI void lds_barrier() { asm volatile("s_waitcnt lgkmcnt(0)" ::: "memory"); __builtin_amdgcn_s_barrier(); asm volatile("" ::: "memory"); }
DI void attn_qk(const LAS unsigned char* Kc, const int (&coff)[4], const bf16x8 (&qf)[4], f32x16& s0, f32x16& s1) {
    bf16x8 kf[4], kg[4];
#pragma unroll
    for (int ks = 0; ks < 4; ++ks) kf[ks] = *(const LAS bf16x8*)(Kc + coff[ks]);
#pragma unroll
    for (int j = 0; j < 16; ++j) { s0[j] = 0.f; s1[j] = 0.f; }
#pragma unroll
    for (int ks = 0; ks < 4; ++ks) kg[ks] = *(const LAS bf16x8*)(Kc + 4096 + coff[ks]);
#pragma unroll
    for (int ks = 0; ks < 4; ++ks) s0 = MFMA32(kf[ks], qf[ks], s0);
#pragma unroll
    for (int ks = 0; ks < 4; ++ks) s1 = MFMA32(kg[ks], qf[ks], s1);
}
DI void attn_partial(f32x16& s0, f32x16& s1, float& m_run, float& alpha, bool& resc) {
    float tmax = fmaxf(s0[0], s1[0]);
#pragma unroll
    for (int j = 1; j < 16; ++j) tmax = fmaxf(fmaxf(tmax, s0[j]), s1[j]);
    { auto rr = __builtin_amdgcn_permlane32_swap(__float_as_uint(tmax), __float_as_uint(tmax), false, false); tmax = fmaxf(__uint_as_float(rr[0]), __uint_as_float(rr[1])); }
    resc = __any(tmax > m_run); alpha = 1.f;
    if (resc) { const float mn = fmaxf(m_run, tmax); alpha = __builtin_amdgcn_exp2f(m_run - mn); m_run = mn; }
    const f32x2v m2 = {m_run, m_run};
#pragma unroll
    for (int j = 0; j < 8; ++j) { f32x2v a = (f32x2v){s0[2 * j], s0[2 * j + 1]} - m2, c = (f32x2v){s1[2 * j], s1[2 * j + 1]} - m2;
        s0[2 * j] = __builtin_amdgcn_exp2f(a[0]); s0[2 * j + 1] = __builtin_amdgcn_exp2f(a[1]); s1[2 * j] = c[0]; s1[2 * j + 1] = c[1]; }
}
DI void attn_finish(f32x16& s0, f32x16& s1, float alpha, float& l_run, bf16x8 (&pf)[4]) {
    f32x2v ps = {0.f, 0.f};
#pragma unroll
    for (int j = 0; j < 8; ++j) { s1[2 * j] = __builtin_amdgcn_exp2f(s1[2 * j]); s1[2 * j + 1] = __builtin_amdgcn_exp2f(s1[2 * j + 1]);
        ps += (f32x2v){s0[2 * j], s0[2 * j + 1]}; ps += (f32x2v){s1[2 * j], s1[2 * j + 1]}; }
    l_run = l_run * alpha + (ps[0] + ps[1]);
    pf[0] = pack_p(s0, 0); pf[1] = pack_p(s0, 1); pf[2] = pack_p(s1, 0); pf[3] = pack_p(s1, 1);
}
DI void attn_partial_nm(f32x16& s0, f32x16& s1, float& ps) {
#pragma unroll
    for (int j = 0; j < 16; ++j) { s0[j] = __builtin_amdgcn_exp2f(s0[j]); s1[j] = __builtin_amdgcn_exp2f(s1[j]); }
    float a = s0[0];
#pragma unroll
    for (int j = 1; j < 16; ++j) a += s0[j];
    ps = a;
}
DI void attn_finish_nm(f32x16& s0, f32x16& s1, float ps, float& l_run, bf16x8 (&pf)[4]) {
    float a = ps;
#pragma unroll
    for (int j = 0; j < 16; ++j) a += s1[j];
    l_run += a;
    pf[0] = pack_p(s0, 0); pf[1] = pack_p(s0, 1); pf[2] = pack_p(s1, 0); pf[3] = pack_p(s1, 1);
}
DI void attn_step_nm(const LAS unsigned char* Kc, const LAS unsigned char* Vc, const int (&coff)[4], const bf16x8 (&qf)[4],
                     const f32x16& P0, const f32x16& P1, float psP, f32x16& N0, f32x16& N1, float& psN, float& l_run, f32x16 (&o)[4]) {
    bf16x8 kf[8], vf[16]; unsigned w[16];
#pragma unroll
    for (int i = 0; i < 8; ++i) { kf[i] = *(const LAS bf16x8*)(Kc + (i >> 2) * 4096 + coff[i & 3]); SCHED_FENCE(); }
    const f32x16 z = {0.f, 0.f, 0.f, 0.f, 0.f, 0.f, 0.f, 0.f, 0.f, 0.f, 0.f, 0.f, 0.f, 0.f, 0.f, 0.f};
    float a = psP;
#pragma unroll
    for (int g = 0; g < 8; ++g) {
        if (g < 4) N0 = MFMA32(kf[g], qf[g], g == 0 ? z : N0); else N1 = MFMA32(kf[g], qf[g - 4], g == 4 ? z : N1);
        a += P1[2 * g]; a += P1[2 * g + 1];
        if (g < 4) { w[2 * g] = pk2(P0[4 * g], P0[4 * g + 1]); w[2 * g + 1] = pk2(P0[4 * g + 2], P0[4 * g + 3]); }
        else { w[2 * g] = pk2(P1[4 * g - 16], P1[4 * g - 15]); w[2 * g + 1] = pk2(P1[4 * g - 14], P1[4 * g - 13]); }
        if (g >= 4) vf[g - 4] = *(const LAS bf16x8*)(Vc + coff[g - 4]);
        SCHED_FENCE();
    }
    l_run += a;
    bf16x8 pf[4];
#pragma unroll
    for (int k = 0; k < 4; ++k) { const u32x4 t = {w[4 * k], w[4 * k + 1], w[4 * k + 2], w[4 * k + 3]}; pf[k] = __builtin_bit_cast(bf16x8, t); }
    float bsum = 0.f;
#pragma unroll
    for (int g = 0; g < 16; ++g) {
        o[g >> 2] = MFMA32(vf[g], pf[g & 3], o[g >> 2]);
        if (g + 4 < 16) vf[g + 4] = *(const LAS bf16x8*)(Vc + ((g + 4) >> 2) * 4096 + coff[(g + 4) & 3]);
        if (g < 8) { N0[2 * g] = __builtin_amdgcn_exp2f(N0[2 * g]); N0[2 * g + 1] = __builtin_amdgcn_exp2f(N0[2 * g + 1]); bsum = (g == 0) ? N0[0] + N0[1] : (bsum + N0[2 * g]) + N0[2 * g + 1]; }
        else { N1[2 * g - 16] = __builtin_amdgcn_exp2f(N1[2 * g - 16]); N1[2 * g - 15] = __builtin_amdgcn_exp2f(N1[2 * g - 15]); }
        SCHED_FENCE();
    }
    psN = bsum;
}
DI void attn_pv(const LAS unsigned char* Vc, const int (&coff)[4], const bf16x8 (&pf)[4], f32x16 (&o)[4]) {
#pragma unroll
    for (int dvb = 0; dvb < 4; ++dvb) { bf16x8 va[4];
#pragma unroll
        for (int i = 0; i < 4; ++i) va[i] = *(const LAS bf16x8*)(Vc + dvb * 4096 + coff[i]);
#pragma unroll
        for (int i = 0; i < 4; ++i) o[dvb] = MFMA32(va[i], pf[i], o[dvb]); }
}
#ifndef PROBE_ATTN_ABL
#define PROBE_ATTN_ABL 0
#endif
template <int ABL, bool NM> DI void attn_unit(const Params& p, LAS unsigned char* lds, int b, int h, int m, int sq0, int nkt) {
    const int tid = otid(), wave = tid >> 6, lane = tid & 63, r32 = lane & 31, h2 = lane >> 5;
    const bf16_t* PA = (const bf16_t*)(p.ws + OFF_PA); const bf16_t* VT = (const bf16_t*)(p.ws + OFF_VT);
    bf16_t* O = (bf16_t*)(p.ws + (ABL ? WS_NEEDED : OFF_OA)) + (size_t)m * RR * 512;
    const size_t rowbase = (size_t)b * TT;
    bf16x8 qf[4];
    {   const bf16_t* qp = PA + (rowbase + sq0 + wave * 32 + r32) * 1536 + (h * 2 + m) * 64 + 8 * h2;
#pragma unroll
        for (int ks = 0; ks < 4; ++ks) qf[ks] = *(const bf16x8*)(qp + 16 * ks); }
    const int srow = tid >> 3, sch = (tid & 7) ^ ((srow >> 1) & 7);
    const bf16_t* kgb = PA + rowbase * 1536 + 512 + (h * 2 + m) * 64;
    const bf16_t* vgb = VT + ((size_t)((b * 4 + h) * 128)) * TT;
    const int kofs = srow * 1536 + sch * 8, vofs = srow * TT + sch * 8;
    LAS unsigned char* Kb = lds; LAS unsigned char* Vb = lds + 24576;
    const int swz = (r32 >> 1) & 7;
    int coff[4];
#pragma unroll
    for (int ks = 0; ks < 4; ++ks) coff[ks] = r32 * 128 + (((2 * ks + h2) ^ swz) << 4);
    f32x16 o[4];
#pragma unroll
    for (int i = 0; i < 4; ++i)
#pragma unroll
        for (int j = 0; j < 16; ++j) o[i][j] = 0.f;
    float m_run = -1e30f, l_run = 0.f, alA = 1.f, alB = 1.f; bool rsA = false, rsB = false;
    f32x16 A0, A1, B0, B1; bf16x8 pf[4];
    int bprev = 2, bcur = 0, bnext = 1;
    const int wu = __builtin_amdgcn_readfirstlane(tid >> 6) * 1024;
#define AT_DMA1(gp, la) asm volatile("s_mov_b32 m0, %0\n\ts_nop 0\n\tglobal_load_lds_dwordx4 %1, off" :: "s"((unsigned)(unsigned long long)(la)), "v"(gp) : "m0", "memory")
#define AT_DMA(t, bi) do { if (ABL & 4) break; \
        AT_DMA1(kgb + (kofs + (t) * 64 * 1536), Kb + (bi) * 8192 + wu); \
        AT_DMA1(vgb + (vofs + (t) * 64), Vb + (bi) * 16384 + wu); \
        AT_DMA1(vgb + (vofs + 64 * TT + (t) * 64), Vb + (bi) * 16384 + 8192 + wu); } while (0)
#define AT_LANDED() do { if (!(ABL & 4)) asm volatile("s_waitcnt vmcnt(0)" ::: "memory"); } while (0)
#define AT_BAR() do { if (!(ABL & 4)) lds_barrier(); } while (0)
#define AT_QK(Kc, N0, N1) do { if (ABL & 2) { _Pragma("unroll") for (int j_ = 0; j_ < 16; ++j_) { asm volatile("" : "+v"(N0[j_])); asm volatile("" : "+v"(N1[j_])); } } else attn_qk(Kc, coff, qf, N0, N1); } while (0)
#define AT_PV(Vc) do { if (ABL & 2) { _Pragma("unroll") for (int i_ = 0; i_ < 4; ++i_) asm volatile("" :: "v"(pf[i_])); } else attn_pv(Vc, coff, pf, o); } while (0)
#define AT_PART(N0, N1, alN, rsN) do { if (ABL & 1) { alN = 1.f; rsN = false; } else if (NM) { rsN = false; attn_partial_nm(N0, N1, alN); } else attn_partial(N0, N1, m_run, alN, rsN); } while (0)
#define AT_FIN(P0, P1, alP) do { if (ABL & 1) { pf[0] = pack_p(P0, 0); pf[1] = pack_p(P0, 1); pf[2] = pack_p(P1, 0); pf[3] = pack_p(P1, 1); l_run = 1.f; } else if (NM) attn_finish_nm(P0, P1, alP, l_run, pf); else attn_finish(P0, P1, alP, l_run, pf); } while (0)
#define AT_ROT() do { const int t_ = bprev; bprev = bcur; bcur = bnext; bnext = t_; } while (0)
#define AT_RESC(al, rs) do { if (__builtin_expect(rs, 0)) { asm volatile("" ::: "memory"); _Pragma("unroll") for (int i_ = 0; i_ < 4; ++i_) _Pragma("unroll") for (int j_ = 0; j_ < 16; ++j_) o[i_][j_] *= (al); } } while (0)
#define AT_STEP(j, P0, P1, alP, N0, N1, alN, rsN) do { \
        if ((j) + 1 < nkt) AT_DMA((j) + 1, bnext); \
        SCHED_FENCE(); \
        if constexpr (NM && ABL == 0) { attn_step_nm(Kb + bcur * 8192, Vb + bprev * 16384, coff, qf, P0, P1, alP, N0, N1, alN, l_run, o); SCHED_FENCE(); AT_LANDED(); AT_BAR(); AT_ROT(); break; } \
        AT_QK(Kb + bcur * 8192, N0, N1); AT_FIN(P0, P1, alP); \
        __builtin_amdgcn_sched_group_barrier(0x100, 8, 0); \
        _Pragma("unroll") for (int g_ = 0; g_ < 8; ++g_) { __builtin_amdgcn_sched_group_barrier(0x8, 1, 0); __builtin_amdgcn_sched_group_barrier(0x402, NM ? 5 : 7, 0); } \
        SCHED_FENCE(); \
        AT_PV(Vb + bprev * 16384); AT_PART(N0, N1, alN, rsN); \
        __builtin_amdgcn_sched_group_barrier(0x100, 4, 0); \
        _Pragma("unroll") for (int g_ = 0; g_ < 16; ++g_) { __builtin_amdgcn_sched_group_barrier(0x8, 1, 0); __builtin_amdgcn_sched_group_barrier(0x100, 1, 0); __builtin_amdgcn_sched_group_barrier(0x402, NM ? 3 : 4, 0); } \
        SCHED_FENCE(); \
        AT_RESC(alN, rsN); \
        AT_LANDED(); AT_BAR(); AT_ROT(); } while (0)
    AT_DMA(0, 0); AT_LANDED(); AT_BAR();
    if (nkt > 1) AT_DMA(1, 1);
    AT_QK(Kb, A0, A1); AT_PART(A0, A1, alA, rsA);
    AT_LANDED(); AT_BAR(); AT_ROT();
    int j = 1;
    for (; j + 1 < nkt; j += 2) { AT_STEP(j, A0, A1, alA, B0, B1, alB, rsB); AT_STEP(j + 1, B0, B1, alB, A0, A1, alA, rsA); }
    if (j < nkt) {
        AT_STEP(j, A0, A1, alA, B0, B1, alB, rsB);
        AT_FIN(B0, B1, alB);
    } else AT_FIN(A0, A1, alA);
    AT_PV(Vb + bprev * 16384);
#undef AT_DMA
#undef AT_DMA1
#undef AT_LANDED
#undef AT_ROT
#undef AT_RESC
#undef AT_STEP
#undef AT_BAR
#undef AT_QK
#undef AT_PV
#undef AT_PART
#undef AT_FIN
    { auto rr = __builtin_amdgcn_permlane32_swap(__float_as_uint(l_run), __float_as_uint(l_run), false, false); l_run = __uint_as_float(rr[0]) + __uint_as_float(rr[1]); }
    const float inv = 1.f / l_run;
    const int tid2 = otid();
    bf16_t* orow = O + (rowbase + sq0 + (tid2 >> 6) * 32 + (tid2 & 31)) * 512 + h * 128 + 4 * ((tid2 >> 5) & 1);
#pragma unroll
    for (int dvb = 0; dvb < 4; ++dvb)
#pragma unroll
        for (int g = 0; g < 4; ++g) { u32x2 w = {pk2(o[dvb][4 * g] * inv, o[dvb][4 * g + 1] * inv), pk2(o[dvb][4 * g + 2] * inv, o[dvb][4 * g + 3] * inv)};
            *(u32x2*)(orow + dvb * 32 + 8 * g) = w; }
    lds_barrier();
}

constexpr int CS_TKK = 0, CS_TR = 2304, CS_TKD = 4608, CS_TKA = 6912, CS_TVN = 9216, CS_TDA = 11264, CS_TVS = 16384, CS_G15 = 21504, CS_TBM = 21760, CS_TCM = 23040, CS_TBC = 24064, CS_BUF = 25344;
constexpr int CS_E = 2 * CS_BUF, CS_YO = CS_E + 4096;
constexpr int CS_RS = 144, CS_RT = 80, CS_C = 16, CS_NCH = TT / CS_C;
static_assert(CS_NCH % 4 == 0 && CS_YO + 4096 <= 131072, "scan");
#ifndef PROBE_SCAN_ABL
#define PROBE_SCAN_ABL 0
#endif
DI void scan_unit(const Params& p, int l, LAS unsigned char* lds, int u, int dup = 0) {
    const int abl = dup ? PROBE_SCAN_ABL : 0;
    const int tid = otid(), wave = tid >> 6, lane = tid & 63, c16 = lane & 15, q = lane >> 4;
    const int chain = u; const int dir = chain & 1, bh = chain >> 1, b = bh >> 3, h = bh & 7;
    auto tok = [&](int i) -> int { return dir == 0 ? i : (i < NCTX ? (NCTX - 1 - i) : (TT + NCTX - 1 - i)); };
    for (int i = tid; i < 2 * 16 * 16; i += 512) { const int bf = i >> 8, r = (i >> 4) & 15, cidx = i & 15; *(LAS unsigned short*)(lds + bf * CS_BUF + CS_TBM + r * CS_RT + (16 + cidx) * 2) = 0; }
    for (int i = tid; i < 2 * 64 * 16; i += 512) { const int bf = i >> 10, r = (i >> 4) & 63, cidx = i & 15; *(LAS unsigned short*)(lds + bf * CS_BUF + CS_TVS + r * CS_RT + (16 + cidx) * 2) = 0; }
    lds_barrier();
    if (wave >= 4) {
        __builtin_amdgcn_s_setprio(1);
        const bf16_t* EW = (const bf16_t*)(p.ws + OFF_EW) + (size_t)dir * RR * 512; const bf16_t* AA = (const bf16_t*)(p.ws + OFF_AA) + (size_t)dir * RR * 512;
        const bf16_t* KK = (const bf16_t*)(p.ws + OFF_KK); const bf16_t* KC = (const bf16_t*)(p.ws + OFF_KC); const bf16_t* RC = (const bf16_t*)(p.ws + OFF_RC); const bf16_t* VC = (const bf16_t*)(p.ws + OFF_VC);
        bf16_t* OS = (bf16_t*)(p.ws + ((dup && PROBE_SCAN_ABL) ? WS_NEEDED : OFF_OS)) + (size_t)dir * RR * 512;
        const int pu = tid - 256, pw = wave - 4, lt = pu >> 4, k4 = (pu & 15) * 4;
        const int posk = 32 * (k4 >> 5) + 8 * (((k4 & 31) >> 2) & 3) + 4 * ((k4 & 31) >> 4);
        const f32x4 ka4 = *(const f32x4*)(p.rwkv_k_a + l * 512 + h * 64 + k4);
        struct Raw { u32x2 re, rk, ra, rkc, rr_, rv; };
        auto gload = [&](int c) -> Raw { const size_t off = ((size_t)b * TT + tok(c * CS_C + lt)) * 512 + h * 64 + k4; Raw w;
            w.re = *(const u32x2*)(EW + off); w.rk = *(const u32x2*)(KK + off); w.ra = *(const u32x2*)(AA + off); w.rkc = *(const u32x2*)(KC + off); w.rr_ = *(const u32x2*)(RC + off); w.rv = *(const u32x2*)(VC + off); return w; };
        auto stage1 = [&](const Raw& w) { float e[4]; unpack4(w.re, e); *(LAS f32x4*)(lds + CS_E + (lt * 64 + k4) * 4) = (f32x4){e[0], e[1], e[2], e[3]}; };
        auto stage2 = [&](const Raw& w, int par) {
            LAS unsigned char* B = lds + par * CS_BUF;
            f32x4 cs = (f32x4){0.f, 0.f, 0.f, 0.f};
#pragma unroll
            for (int i = 0; i < 16; ++i) { const f32x4 ev = *(const LAS f32x4*)(lds + CS_E + (i * 64 + k4) * 4); if (i <= lt) cs += ev; }
            float e[4], kk[4], a[4], kc[4], r[4]; unpack4(w.re, e); unpack4(w.rk, kk); unpack4(w.ra, a); unpack4(w.rkc, kc); unpack4(w.rr_, r);
            float tkk[4], tr[4], tkd[4], tka[4]; f32x4 g;
#pragma unroll
            for (int i = 0; i < 4; ++i) { g[i] = __expf(-cs[i]); const float gi = __expf(cs[i]), gp = __expf(e[i] - cs[i]);
                tkk[i] = kk[i] * gp; tr[i] = r[i] * g[i]; tkd[i] = kc[i] * (1.f + (a[i] - 1.f) * ka4[i]) * gi; tka[i] = kk[i] * a[i] * gi; }
            *(LAS u32x2*)(B + CS_TKK + lt * CS_RS + posk * 2) = (u32x2){pk2(tkk[0], tkk[1]), pk2(tkk[2], tkk[3])};
            *(LAS u32x2*)(B + CS_TR + lt * CS_RS + posk * 2) = (u32x2){pk2(tr[0], tr[1]), pk2(tr[2], tr[3])};
            *(LAS u32x2*)(B + CS_TKD + lt * CS_RS + posk * 2) = (u32x2){pk2(tkd[0], tkd[1]), pk2(tkd[2], tkd[3])};
            *(LAS u32x2*)(B + CS_TKA + lt * CS_RS + posk * 2) = (u32x2){pk2(tka[0], tka[1]), pk2(tka[2], tka[3])};
            *(LAS u32x2*)(B + CS_TVN + (lt * 64 + k4) * 2) = w.rv;
            if (lt == 15) *(LAS f32x4*)(B + CS_G15 + k4 * 4) = g;
        };
        auto stage3 = [&](int par) {
            LAS unsigned char* B = lds + par * CS_BUF;
            {   const LAS unsigned char* ta = B + ((pw & 1) ? CS_TKA : CS_TKD) + c16 * CS_RS + q * 16; const LAS unsigned char* tb = B + ((pw & 2) ? CS_TR : CS_TKK) + c16 * CS_RS + q * 16;
                f32x4 m = (f32x4){0.f, 0.f, 0.f, 0.f};
                m = MFMA16(*(const LAS bf16x8*)ta, *(const LAS bf16x8*)tb, m); m = MFMA16(*(const LAS bf16x8*)(ta + 64), *(const LAS bf16x8*)(tb + 64), m);
#pragma unroll
                for (int i = 0; i < 4; ++i) { const int j = 4 * q + i; const bool keep = (pw & 2) ? (j <= c16) : (j < c16); m[i] = keep ? m[i] : 0.f; }
                if (pw == 0) { u32x2 w = {pk2(m[0], m[1]), pk2(m[2], m[3])}; *(LAS u32x2*)(B + CS_TBM + c16 * CS_RT + 8 * q) = w; }
                else if (pw == 1) *(LAS f32x4*)(B + CS_TCM + (c16 * 16 + 4 * q) * 4) = m;
                else if (pw == 2) { u32x2 w = {pk2(m[0], m[1]), pk2(m[2], m[3])}; *(LAS u32x2*)(B + CS_TBC + c16 * CS_RT + 8 * q) = w; }
                else { u32x2 w = {pk2(-m[0], -m[1]), pk2(-m[2], -m[3])}; *(LAS u32x2*)(B + CS_TBC + c16 * CS_RT + 32 + 8 * q) = w; } }
            if (pu < 192) { const bool isv = pu >= 128; const int kk_ = isv ? (pu - 128) : (pu >> 1), half = isv ? 0 : (pu & 1);
                const int pk_ = 32 * (kk_ >> 5) + 8 * (((kk_ & 31) >> 2) & 3) + 4 * ((kk_ & 31) >> 4) + (kk_ & 3);
                const LAS unsigned char* src = isv ? (B + CS_TVN + kk_ * 2) : (B + (half ? CS_TKA : CS_TKD) + pk_ * 2); const int sstr = isv ? 128 : CS_RS;
                unsigned w[8];
#pragma unroll
                for (int t2 = 0; t2 < 8; ++t2) { const unsigned lo = *(const LAS unsigned short*)(src + (2 * t2) * sstr), hi = *(const LAS unsigned short*)(src + (2 * t2 + 1) * sstr); w[t2] = (lo | (hi << 16)) ^ (half ? 0x80008000u : 0u); }
                LAS unsigned char* dst = isv ? (B + CS_TVS + kk_ * CS_RT) : (B + CS_TDA + kk_ * CS_RT + half * 32);
                *(LAS u32x4*)dst = (u32x4){w[0], w[1], w[2], w[3]}; *(LAS u32x4*)(dst + 16) = (u32x4){w[4], w[5], w[6], w[7]}; }
        };
        Raw ring[4]; ring[0] = gload(0); ring[1] = gload(1); ring[2] = gload(2); ring[3] = gload(3);
        stage1(ring[0]); lds_barrier();
        stage2(ring[0], 0); ring[0] = gload(4); lds_barrier();
        stage3(0); stage1(ring[1]); lds_barrier();
#pragma unroll 1
        for (int c4 = 0; c4 < CS_NCH; c4 += 4) {
#pragma unroll
            for (int ci = 0; ci < 4; ++ci) { const int c = c4 + ci;
                if (c + 1 < CS_NCH) { if (!(abl & 2)) stage2(ring[(ci + 1) & 3], (c + 1) & 1); if (c + 5 < CS_NCH && !(abl & 8)) ring[(ci + 1) & 3] = gload(c + 5); }
                lds_barrier();
                if (c + 1 < CS_NCH && !(abl & 4)) stage3((c + 1) & 1);
                lds_barrier();
                if (!(abl & 16)) {   const f32x4 yy = *(const LAS f32x4*)(lds + CS_YO + (lt * 64 + k4) * 4);
                    *(u32x2*)(OS + ((size_t)b * TT + tok(c * CS_C + lt)) * 512 + h * 64 + k4) = (u32x2){pk2(yy[0], yy[1]), pk2(yy[2], yy[3])}; }
                if (c + 2 < CS_NCH) stage1(ring[(ci + 2) & 3]);
                lds_barrier();
            }
        }
        __builtin_amdgcn_s_setprio(0);
    } else {
        const int v = 16 * wave + c16;
        f32x4 sT[4];
#pragma unroll
        for (int i = 0; i < 4; ++i) sT[i] = (f32x4){0.f, 0.f, 0.f, 0.f};
        lds_barrier(); lds_barrier(); lds_barrier();
#pragma unroll 1
        for (int c = 0; c < CS_NCH; ++c) {
            if (abl & 1) { lds_barrier(); lds_barrier(); lds_barrier(); continue; }
            const LAS unsigned char* B = lds + (c & 1) * CS_BUF;
            const LAS unsigned char* tvs = B + CS_TVS + v * CS_RT + q * 16;
            const bf16x8 fkk0 = *(const LAS bf16x8*)(B + CS_TKK + c16 * CS_RS + q * 16), fkk1 = *(const LAS bf16x8*)(B + CS_TKK + c16 * CS_RS + 64 + q * 16);
            const bf16x8 fbm = *(const LAS bf16x8*)(B + CS_TBM + c16 * CS_RT + q * 16), fv0 = *(const LAS bf16x8*)tvs;
            f32x4 cc[4][4], cin[4];
#pragma unroll
            for (int i = 0; i < 4; ++i) { cin[i] = *(const LAS f32x4*)(B + CS_TCM + ((4 * q + i) * 16 + 4 * q) * 4);
#pragma unroll
                for (int jj = 0; jj < 4; ++jj) cc[i][jj] = *(const LAS f32x4*)(B + CS_TCM + ((4 * q + i) * 16 + 4 * jj) * 4); }
            const bf16x8 fr0 = *(const LAS bf16x8*)(B + CS_TR + c16 * CS_RS + q * 16), fr1 = *(const LAS bf16x8*)(B + CS_TR + c16 * CS_RS + 64 + q * 16);
            const bf16x8 fbc = *(const LAS bf16x8*)(B + CS_TBC + c16 * CS_RT + q * 16);
            bf16x8 fda[4]; f32x4 gg[4];
#pragma unroll
            for (int rb = 0; rb < 4; ++rb) { fda[rb] = *(const LAS bf16x8*)(B + CS_TDA + (16 * rb + c16) * CS_RT + q * 16); gg[rb] = *(const LAS f32x4*)(B + CS_G15 + (16 * rb + 4 * q) * 4); }
            bf16x8 sf[2];
#pragma unroll
            for (int s2 = 0; s2 < 2; ++s2) { u32x4 w = {pk2(sT[2 * s2][0], sT[2 * s2][1]), pk2(sT[2 * s2][2], sT[2 * s2][3]), pk2(sT[2 * s2 + 1][0], sT[2 * s2 + 1][1]), pk2(sT[2 * s2 + 1][2], sT[2 * s2 + 1][3])}; sf[s2] = __builtin_bit_cast(bf16x8, w); }
            f32x4 x = (f32x4){0.f, 0.f, 0.f, 0.f};
            x = MFMA16(fkk0, sf[0], x); x = MFMA16(fkk1, sf[1], x); x = MFMA16(fbm, fv0, x);
            f32x4 yv = (f32x4){0.f, 0.f, 0.f, 0.f};
            yv = MFMA16(fr0, sf[0], yv); yv = MFMA16(fr1, sf[1], yv);
            f32x4 sa = (f32x4){0.f, 0.f, 0.f, 0.f};
#pragma unroll
            for (int q0 = 0; q0 < 4; ++q0) {
                f32x4 y; y[0] = x[0]; y[1] = x[1] - y[0] * cin[1][0]; y[2] = x[2] - y[0] * cin[2][0] - y[1] * cin[2][1]; y[3] = x[3] - y[0] * cin[3][0] - y[1] * cin[3][1] - y[2] * cin[3][2];
                if (q == q0) sa = y;
                if (q0 < 3) { const int src = (c16 + 16 * q0) << 2; const float b0 = bperm(y[0], src), b1 = bperm(y[1], src), b2 = bperm(y[2], src), b3 = bperm(y[3], src);
#pragma unroll
                    for (int i = 0; i < 4; ++i) x[i] -= b0 * cc[i][q0][0] + b1 * cc[i][q0][1] + b2 * cc[i][q0][2] + b3 * cc[i][q0][3]; }
            }
            lds_barrier();
            { u32x2 w = {pk2(sa[0], sa[1]), pk2(sa[2], sa[3])}; *(LAS u32x2*)(lds + (c & 1) * CS_BUF + CS_TVS + v * CS_RT + 32 + q * 8) = w; }
            const bf16x8 bvs = *(const LAS bf16x8*)tvs;
            yv = MFMA16(fbc, bvs, yv);
#pragma unroll
            for (int rb = 0; rb < 4; ++rb) sT[rb] = MFMA16(fda[rb], bvs, sT[rb]);
#pragma unroll
            for (int i = 0; i < 4; ++i) *(LAS float*)(lds + CS_YO + ((4 * q + i) * 64 + v) * 4) = yv[i];
            lds_barrier();
#pragma unroll
            for (int rb = 0; rb < 4; ++rb) sT[rb] *= gg[rb];
            lds_barrier();
        }
    }
    lds_barrier();
}

__device__ void ph_mix(const Params& p, int l, LAS unsigned char* lds, LAS unsigned* bcast, int dup) {
    unsigned* ctr = (unsigned*)(p.ws + OFF_CTR) + l * 64 + (dup ? 32 : 0);
    constexpr int N_SCAN = 64, N_LAT = 1024, N_CTX = 32;
    bool nm; { const int lane = otid() & 63; const float mq = wave_max(fabsf(p.q_norm_g[l * 64 + lane])), mk = wave_max(fabsf(p.k_norm_g[l * 64 + lane]));
        nm = __builtin_amdgcn_readfirstlane((8.f * 1.4426950408889634f * mq * mk <= 64.f) ? 1 : 0) != 0; }
    for (;;) {
        if (otid() == 0) *bcast = atomicAdd(ctr, 1u);
        __syncthreads();
        const int u = (int)*bcast;
        __syncthreads();
        if (u >= N_SCAN + N_LAT + N_CTX) break;
#ifdef PROBE_DMODE
        if (dup && PROBE_DMODE == 2 && u >= N_SCAN) break;
        if (dup && PROBE_DMODE == 3 && u < N_SCAN) continue;
#endif
        if (u < N_SCAN) scan_unit(p, l, lds, u, dup);
        else if (u < N_SCAN + N_LAT) { const int v = u - N_SCAN; const int qb = v & 31, m = (v >> 5) & 1, h = (v >> 6) & 3, b = v >> 8;
            if (PROBE_ATTN_ABL != 0 && dup) attn_unit<PROBE_ATTN_ABL, false>(p, lds, b, h, m, NCTX + qb * 256, TT / 64);
            else if (nm) attn_unit<0, true>(p, lds, b, h, m, NCTX + qb * 256, TT / 64); else attn_unit<0, false>(p, lds, b, h, m, NCTX + qb * 256, TT / 64); }
        else { const int v = u - N_SCAN - N_LAT; const int m = v & 1, h = (v >> 1) & 3, b = v >> 3; attn_unit<0, false>(p, lds, b, h, m, 0, NCTX / 64); }
    }
    if (!dup) { conv_expert_weights(p, l, lds); if (l + 1 < NL) conv_mixer_a(p, l + 1, lds); }
}
__device__ void ph_post(const Params& p, int l, int wg, int nwg) {
    const int tid = otid(), wave = tid >> 6, lane = tid & 63;
    const float lam_init = 0.8f - 0.6f * expf(-0.3f * (float)l);
    float lam;
    {   const float* lv = p.diff_lambda + l * 256; const float a = wave_sum(lv[lane] * lv[64 + lane]), c = wave_sum(lv[128 + lane] * lv[192 + lane]); lam = expf(a) - expf(c) + lam_init; }
    const bf16_t* OA0 = (const bf16_t*)(p.ws + OFF_OA); const bf16_t* OA1 = OA0 + (size_t)RR * 512;
    const bf16_t* OS0 = (const bf16_t*)(p.ws + OFF_OS); const bf16_t* OS1 = OS0 + (size_t)RR * 512;
    const bf16_t* YB0 = (const bf16_t*)(p.ws + OFF_YB0); const bf16_t* G = (const bf16_t*)(p.ws + OFF_G);
    bf16_t* YA = (bf16_t*)(p.ws + OFF_YA); bf16_t* YB = (bf16_t*)(p.ws + OFF_YB);
    float sg[8], lg[8];
#pragma unroll
    for (int i = 0; i < 8; ++i) { sg[i] = p.diff_subln_g[l * 128 + (lane & 15) * 8 + i] * (1.f - lam_init); lg[i] = p.rwkv_ln_g[l * 512 + lane * 8 + i]; }
    const int rstep = nwg * 8; int r = wg * 8 + wave;
    u32x4 la, lc, ly0, lgg, lo0, lo1;
    auto ldrow = [&](int rr) { const size_t o = (size_t)rr * 512 + lane * 8; la = *(const u32x4*)(OA0 + o); lc = *(const u32x4*)(OA1 + o); ly0 = *(const u32x4*)(YB0 + o); lgg = *(const u32x4*)(G + o); lo0 = *(const u32x4*)(OS0 + o); lo1 = *(const u32x4*)(OS1 + o); };
    if (r < RR) ldrow(r);
    while (r < RR) {
        const size_t o = (size_t)r * 512 + lane * 8;
        const u32x4 a = la, c = lc, y0 = ly0, gg = lgg, ov0 = lo0, ov1 = lo1;
        if (r + rstep < RR) ldrow(r + rstep);
        {   float v[8]; float ss = 0.f;
#pragma unroll
            for (int i = 0; i < 4; ++i) { v[2 * i] = bflo(a[i]) - lam * bflo(c[i]); v[2 * i + 1] = bfhi(a[i]) - lam * bfhi(c[i]); ss += v[2 * i] * v[2 * i] + v[2 * i + 1] * v[2 * i + 1]; }
            ss = allsum16(ss);
            const float rinv = rsqrtf(ss * (1.f / 128.f) + 1e-6f);
            u32x4 w;
#pragma unroll
            for (int i = 0; i < 4; ++i) w[i] = pk2(v[2 * i] * rinv * sg[2 * i], v[2 * i + 1] * rinv * sg[2 * i + 1]);
            *(u32x4*)(YA + o) = w; }
        {   float y[8];
#pragma unroll
            for (int i = 0; i < 4; ++i) { y[2 * i] = bflo(y0[i]); y[2 * i + 1] = bfhi(y0[i]); }
#pragma unroll
            for (int d = 0; d < 2; ++d) { const u32x4 ov = d ? ov1 : ov0; float v[8]; float sm = 0.f;
#pragma unroll
                for (int i = 0; i < 4; ++i) { v[2 * i] = bflo(ov[i]); v[2 * i + 1] = bfhi(ov[i]); sm += v[2 * i] + v[2 * i + 1]; }
                const float mu = allsum8(sm) * (1.f / 64.f); float sq = 0.f;
#pragma unroll
                for (int i = 0; i < 8; ++i) { v[i] -= mu; sq += v[i] * v[i]; }
                const float rinv = rsqrtf(allsum8(sq) * (1.f / 64.f) + 64e-5f);
#pragma unroll
                for (int i = 0; i < 8; ++i) y[i] += v[i] * rinv * lg[i]; }
            u32x4 w;
#pragma unroll
            for (int i = 0; i < 4; ++i) w[i] = pk2(y[2 * i] * bflo(gg[i]), y[2 * i + 1] * bfhi(gg[i]));
            *(u32x4*)(YB + o) = w; }
        r += rstep;
    }
}

template <int KSTEPS> DI void rows16_mma2(const bf16_t* arow, const bf16_t* brow, int ldb, f32x4 (&acc)[2]) {
#pragma unroll 1
    for (int k0 = 0; k0 < KSTEPS; k0 += 8) { bf16x8 a[8], b0[8], b1[8];
#pragma unroll
        for (int k = 0; k < 8; ++k) { a[k] = *(const bf16x8*)(arow + 32 * (k0 + k)); b0[k] = *(const bf16x8*)(brow + 32 * (k0 + k)); b1[k] = *(const bf16x8*)(brow + ldb + 32 * (k0 + k)); }
#pragma unroll
        for (int k = 0; k < 8; ++k) { acc[0] = MFMA16(a[k], b0[k], acc[0]); acc[1] = MFMA16(a[k], b1[k], acc[1]); } }
}
__device__ void ctx_merge_units(const Params& p, int wg, int nwg) {
    const int tid = otid(), wave = tid >> 6, lane = tid & 63, c16 = lane & 15, q = lane >> 4;
    const unsigned char* PG = p.ws + OFF_PG; bf16_t* M = (bf16_t*)(p.ws + OFF_M); const bf16_t* WBR = (const bf16_t*)(p.ws + OFF_WBR);
    for (int u = wg; u < 256; u += nwg) {
        const int rbk = u >> 2; const int r0 = (rbk >> 4) * TT + (rbk & 15) * 16; const int colw = (u & 3) * 256 + wave * 32 + c16 * 2;
        f32x4 tot[2] = {(f32x4){0.f, 0.f, 0.f, 0.f}, (f32x4){0.f, 0.f, 0.f, 0.f}};
#pragma unroll 1
        for (int br = 0; br < 3; ++br) {
            const bf16_t* Y = (const bf16_t*)(p.ws + (br == 0 ? OFF_YA : (br == 1 ? OFF_YB : OFF_YC)));
            f32x4 acc[2] = {(f32x4){0.f, 0.f, 0.f, 0.f}, (f32x4){0.f, 0.f, 0.f, 0.f}};
            rows16_mma2<16>(Y + (size_t)(r0 + c16) * 512 + 8 * q, WBR + ((size_t)br * 1024 + colw) * 512 + 8 * q, 512, acc);
#pragma unroll
            for (int i = 0; i < 4; ++i) { const unsigned g = *(const unsigned short*)(PG + (size_t)(r0 + 4 * q + i) * 3072 + br * 1024 + colw);
                tot[0][i] += (float)(g & 255u) * (1.f / 255.f) * acc[0][i]; tot[1][i] += (float)(g >> 8) * (1.f / 255.f) * acc[1][i]; }
        }
#pragma unroll
        for (int i = 0; i < 4; ++i) *(unsigned*)(M + (size_t)(r0 + 4 * q + i) * 1024 + colw) = pk2(tot[0][i], tot[1][i]);
    }
}
__device__ void ctx_out_units(const Params& p, int l, int wg, int nwg, float scale) {
    const int tid = otid(), wave = tid >> 6, lane = tid & 63, c16 = lane & 15, q = lane >> 4;
    const bf16_t* M = (const bf16_t*)(p.ws + OFF_M); const bf16_t* WOUT = (const bf16_t*)(p.ws + OFF_WOUT); float* X = (float*)(p.ws + OFF_X);
    const float* g1 = (const float*)(p.ws + OFF_MOD) + ((size_t)l * 5 + 4) * 6144 + 2 * 1024;
    for (int u = wg; u < 256; u += nwg) {
        const int rbk = u >> 2; const int r0 = (rbk >> 4) * TT + (rbk & 15) * 16; const int colw = (u & 3) * 256 + wave * 32 + c16 * 2;
        f32x4 acc[2] = {(f32x4){0.f, 0.f, 0.f, 0.f}, (f32x4){0.f, 0.f, 0.f, 0.f}};
        rows16_mma2<32>(M + (size_t)(r0 + c16) * 1024 + 8 * q, WOUT + (size_t)colw * 1024 + 8 * q, 1024, acc);
        const f32x2v gv = *(const f32x2v*)(g1 + colw);
#pragma unroll
        for (int i = 0; i < 4; ++i) { float* xp = X + (size_t)(r0 + 4 * q + i) * 1024 + colw; f32x2v xv = *(f32x2v*)xp;
            xv[0] += gv[0] * acc[0][i] * scale; xv[1] += gv[1] * acc[1][i] * scale; *(f32x2v*)xp = xv; }
    }
}

constexpr int RW_ES = 260, RW_QS = 16 * RW_ES;
__device__ void ph_norm2(const Params& p, int l, LAS unsigned char* lds, int wg, int nwg) {
    const int tid = otid(), wave = tid >> 6, lane = tid & 63;
    LAS float* RW = (LAS float*)lds;
    LAS float* hrow = RW + 4 * RW_QS + wave * 1024;
    {   const float* rw = p.router_w + (size_t)l * 1024 * 16;
        for (int i = tid; i < 16384; i += 512) { const int k = i >> 4, e = i & 15; RW[(k >> 8) * RW_QS + e * RW_ES + (k & 255)] = rw[i]; } }
    __syncthreads();
    const float* X = (const float*)(p.ws + OFF_X); bf16_t* H = (bf16_t*)(p.ws + OFF_H);
    const float* MOD = (const float*)(p.ws + OFF_MOD) + (size_t)l * 5 * 6144; const float* g = p.norm2_g + l * 1024;
    float* AFFL = (float*)(p.ws + OFF_AFFL); float* AFFC = (float*)(p.ws + OFF_AFFC); int* INV = (int*)(p.ws + OFF_INV);
    const int e = lane & 15, kq = lane >> 4;
    const int rstep = nwg * 8; int r = wg * 8 + wave;
    float4 v[4];
    if (r < RR) { const float4* xr = (const float4*)(X + (size_t)r * 1024);
#pragma unroll
        for (int i = 0; i < 4; ++i) v[i] = xr[lane + 64 * i]; }
    while (r < RR) {
        float4 vn[4];
        if (r + rstep < RR) { const float4* xr = (const float4*)(X + (size_t)(r + rstep) * 1024);
#pragma unroll
            for (int i = 0; i < 4; ++i) vn[i] = xr[lane + 64 * i]; }
        float ss = 0.f;
#pragma unroll
        for (int i = 0; i < 4; ++i) ss += v[i].x * v[i].x + v[i].y * v[i].y + v[i].z * v[i].z + v[i].w * v[i].w;
        ss = wave_sum(ss);
        const float rinv = rsqrtf(ss * (1.f / 1024.f) + 1e-6f);
        const int b = r / TT, s_ = r - b * TT; const float* md = MOD + (s_ < NCTX ? 4 : b) * 6144;
        float4 ggv[4], shv[4], scv[4];
#pragma unroll
        for (int i = 0; i < 4; ++i) { const int col = (lane + 64 * i) * 4; ggv[i] = *(const float4*)(g + col); shv[i] = *(const float4*)(md + 3 * 1024 + col); scv[i] = *(const float4*)(md + 4 * 1024 + col); }
#pragma unroll
        for (int i = 0; i < 4; ++i) { const int col = (lane + 64 * i) * 4;
            const float4 gg = ggv[i], sh = shv[i], sc = scv[i];
            f32x4 y; y[0] = v[i].x * rinv * gg.x * (1.f + sc.x) + sh.x; y[1] = v[i].y * rinv * gg.y * (1.f + sc.y) + sh.y; y[2] = v[i].z * rinv * gg.z * (1.f + sc.z) + sh.z; y[3] = v[i].w * rinv * gg.w * (1.f + sc.w) + sh.w;
            u32x2 w = {pk2(y[0], y[1]), pk2(y[2], y[3])}; *(u32x2*)(H + (size_t)r * 1024 + col) = w;
            *(LAS f32x4*)(hrow + col) = y; }
        f32x4 acc4 = (f32x4){0.f, 0.f, 0.f, 0.f}; const LAS float* hq = hrow + kq * 256; const LAS float* wq = RW + kq * RW_QS + e * RW_ES;
#pragma unroll 8
        for (int k = 0; k < 256; k += 4) acc4 += *(const LAS f32x4*)(hq + k) * *(const LAS f32x4*)(wq + k);
        float acc = (acc4[0] + acc4[1]) + (acc4[2] + acc4[3]);
        acc = sum_x32(sum_x16(acc));
        const float mx = allmax16(acc);
        const float ex = expf(acc - mx); const float sm = allsum16(ex);
        const float aff = ex / sm;
        if (lane < 16) { if (s_ < NCTX) AFFC[((size_t)(b * 16 + e)) * NCTX + s_] = aff; else AFFL[((size_t)(b * 16 + e)) * SEQ + (s_ - NCTX)] = aff;
            INV[(size_t)r * 16 + e] = -1; }
#pragma unroll
        for (int i = 0; i < 4; ++i) v[i] = vn[i];
        r += rstep;
    }
    __syncthreads();
}

DI void topk_unit(const Params& p, LAS unsigned char* lds, int u) {
    const int tid = otid(), wave = tid >> 6, lane = tid & 63;
    const bool lat = u < 64; const int v_ = lat ? u : u - 64; const int b = v_ >> 4, e = v_ & 15;
    const int n = lat ? SEQ : NCTX, cap = lat ? CAPL : CAPC;
    const float* aff = lat ? (const float*)(p.ws + OFF_AFFL) + ((size_t)(b * 16 + e)) * SEQ : (const float*)(p.ws + OFF_AFFC) + ((size_t)(b * 16 + e)) * NCTX;
    LAS unsigned* hist = (LAS unsigned*)lds;
    LAS unsigned* sh = hist + 256;
    unsigned long long key[16];
#pragma unroll
    for (int i = 0; i < 16; ++i) { const int idx = tid + 512 * i; key[i] = (idx < n) ? (((unsigned long long)__float_as_uint(aff[idx]) << 13) | (unsigned long long)(8191 - idx)) : 0ull; }
    unsigned long long prefix = 0ull, mask = 0ull; unsigned need = (unsigned)cap;
#pragma unroll 1
    for (int shift = 40; shift >= 0; shift -= 8) {
        if (tid < 256) hist[tid] = 0u;
        if (tid == 0) sh[2] = 0u;
        __syncthreads();
#pragma unroll
        for (int i = 0; i < 16; ++i) if (tid + 512 * i < n && (key[i] & mask) == prefix) __hip_atomic_fetch_add(&hist[(unsigned)(key[i] >> shift) & 255u], 1u, __ATOMIC_RELAXED, __HIP_MEMORY_SCOPE_WORKGROUP);
        __syncthreads();
        if (wave == 0) {
            unsigned loc[4]; unsigned ls = 0;
#pragma unroll
            for (int j = 0; j < 4; ++j) { loc[j] = hist[255 - 4 * lane - j]; ls += loc[j]; }
            unsigned incl = ls;
#pragma unroll
            for (int o = 1; o < 64; o <<= 1) { const unsigned t = (unsigned)__builtin_amdgcn_ds_bpermute((lane - o) << 2, (int)incl); if (lane >= o) incl += t; }
            const unsigned long long bal = __ballot(incl >= need);
            const int first = __ffsll((long long)bal) - 1;
            if (lane == first) { unsigned run = incl - ls; int bin = 255 - 4 * lane; unsigned above = run;
#pragma unroll
                for (int j = 0; j < 4; ++j) { if (run + loc[j] >= need) { bin = 255 - 4 * lane - j; above = run; break; } run += loc[j]; }
                sh[0] = (unsigned)bin; sh[1] = above; }
        }
        __syncthreads();
        prefix |= ((unsigned long long)sh[0]) << shift; mask |= 255ull << shift; need -= sh[1];
        __syncthreads();
    }
    int* SROW = (int*)(p.ws + OFF_SROW); float* SGATE = (float*)(p.ws + OFF_SGATE); int* INV = (int*)(p.ws + OFF_INV);
    const int sb = lat ? b * CAPL : 4 * CAPL + b * CAPC;
#pragma unroll
    for (int i = 0; i < 16; ++i) { const int idx = tid + 512 * i;
        if (idx < n && key[i] >= prefix) { const unsigned pos = __hip_atomic_fetch_add(&sh[2], 1u, __ATOMIC_RELAXED, __HIP_MEMORY_SCOPE_WORKGROUP); const int slot = sb + (int)pos; const int row = b * TT + (lat ? NCTX + idx : idx);
            SROW[e * ESLOT + slot] = row; SGATE[e * ESLOT + slot] = __uint_as_float((unsigned)(key[i] >> 13)); INV[(size_t)row * 16 + e] = slot; } }
    if (lat && b == 0 && tid < 128) { SROW[e * ESLOT + 4 * CAPL + 4 * CAPC + tid] = -1; SGATE[e * ESLOT + 4 * CAPL + 4 * CAPC + tid] = 0.f; }
    __syncthreads();
}
__device__ void ph_topk(const Params& p, LAS unsigned char* lds, int wg, int nwg) { for (int u = wg; u < 128; u += nwg) topk_unit(p, lds, u); }

__device__ void ph_gather(const Params& p, int wg, int nwg) {
    const int tid = otid(), wave = tid >> 6, lane = tid & 63;
    const int* SROW = (const int*)(p.ws + OFF_SROW); const bf16_t* H = (const bf16_t*)(p.ws + OFF_H); unsigned char* XG = p.ws + OFF_XG;
    const int step = nwg * 8; int i = wg * 8 + wave;
    u32x4 a = {0u, 0u, 0u, 0u}, c = {0u, 0u, 0u, 0u};
    auto ld = [&](int ii) { const int row = SROW[ii]; a = (u32x4){0u, 0u, 0u, 0u}; c = a; if (row >= 0) { const u32x4* src = (const u32x4*)(H + (size_t)row * 1024); a = src[2 * lane]; c = src[2 * lane + 1]; } };
    if (i < EROWS) ld(i);
    while (i < EROWS) {
        const u32x4 ca = a, cc = c;
        if (i + step < EROWS) ld(i + step);
        u32x4 w;
#pragma unroll
        for (int j = 0; j < 2; ++j) { w[j] = pk4_fp8(bflo(ca[2 * j]), bfhi(ca[2 * j]), bflo(ca[2 * j + 1]), bfhi(ca[2 * j + 1])); w[2 + j] = pk4_fp8(bflo(cc[2 * j]), bfhi(cc[2 * j]), bflo(cc[2 * j + 1]), bfhi(cc[2 * j + 1])); }
        *(u32x4*)(XG + (size_t)i * 1024 + lane * 16) = w;
        i += step;
    }
}

__device__ void ph_combine(const Params& p, int l, int wg, int nwg, float scale) {
    const int tid = otid(), wave = tid >> 6, lane = tid & 63;
    const int* INV = (const int*)(p.ws + OFF_INV); const float* SGATE = (const float*)(p.ws + OFF_SGATE); const bf16_t* OUT = (const bf16_t*)(p.ws + OFF_OUT);
    float* X = (float*)(p.ws + OFF_X); const float* MOD = (const float*)(p.ws + OFF_MOD) + (size_t)l * 5 * 6144; bf16_t* H = (bf16_t*)(p.ws + OFF_H);
    const bool nxt = (l + 1 < NL) && (scale != 0.f), last = (l + 1 == NL) && (scale != 0.f); const float* g1n = p.norm1_g + (nxt ? (l + 1) : l) * 1024; const float* MODN = MOD + (nxt ? 5 * 6144 : 0);
    for (int r = wg * 8 + wave; r < RR; r += nwg * 8) {
        const u32x4* iv = (const u32x4*)(INV + (size_t)r * 16); const u32x4 sl0 = iv[0], sl1 = iv[1], sl2 = iv[2], sl3 = iv[3];
        const int mi = row_mod(r); const float* g2 = MOD + mi * 6144 + 5 * 1024; float* xr = X + (size_t)r * 1024; const float* md = MODN + mi * 6144;
        f32x4 xv[4], gv[4], ggv[4], shv[4], scv[4];
#pragma unroll
        for (int j = 0; j < 4; ++j) { const int col = (j >> 1) * 512 + lane * 8 + 4 * (j & 1); xv[j] = *(const f32x4*)(xr + col); gv[j] = *(const f32x4*)(g2 + col);
            if (nxt) { ggv[j] = *(const f32x4*)(g1n + col); shv[j] = *(const f32x4*)(md + col); scv[j] = *(const f32x4*)(md + 1024 + col); } }
        float acc[16];
#pragma unroll
        for (int i = 0; i < 16; ++i) acc[i] = 0.f;
#pragma unroll
        for (int e = 0; e < 16; ++e) { const int slot = (int)(e < 4 ? sl0[e & 3] : (e < 8 ? sl1[e & 3] : (e < 12 ? sl2[e & 3] : sl3[e & 3])));
            if (slot >= 0) { const float gt = SGATE[e * ESLOT + slot]; const u32x4* src = (const u32x4*)(OUT + ((size_t)(e * ESLOT + slot)) * 1024);
                const u32x4 a = src[lane], c = src[64 + lane];
#pragma unroll
                for (int i = 0; i < 4; ++i) { acc[2 * i] += gt * bflo(a[i]); acc[2 * i + 1] += gt * bfhi(a[i]); acc[8 + 2 * i] += gt * bflo(c[i]); acc[9 + 2 * i] += gt * bfhi(c[i]); } } }
        float* orow = p.out + ((size_t)(mi & 3) * SEQ + (size_t)(r - (r / TT) * TT - NCTX)) * 1024;
        float ss = 0.f;
#pragma unroll
        for (int j = 0; j < 4; ++j)
#pragma unroll
            for (int i = 0; i < 4; ++i) { xv[j][i] += gv[j][i] * acc[(j >> 1) * 8 + (j & 1) * 4 + i] * scale; ss += xv[j][i] * xv[j][i]; }
        float y[16]; float inv = 0.f, am = 0.f;
        if (nxt) { ss = wave_sum(ss); const float rinv = rsqrtf(ss * (1.f / 1024.f) + 1e-6f);
#pragma unroll
            for (int j = 0; j < 4; ++j)
#pragma unroll
                for (int i = 0; i < 4; ++i) { const float t = xv[j][i] * rinv * ggv[j][i] * (1.f + scv[j][i]) + shv[j][i]; y[j * 4 + i] = t; am = fmaxf(am, fabsf(t)); }
            am = fmaxf(wave_max(am), 1e-20f); inv = 127.f / am; }
#pragma unroll
        for (int j = 0; j < 4; ++j) { const int col = (j >> 1) * 512 + lane * 8 + 4 * (j & 1);
            if (last) { if (mi < 4) *(f32x4*)(orow + col) = xv[j]; } else *(f32x4*)(xr + col) = xv[j]; }
        if (nxt) { if (lane == 0) ((float*)(p.ws + OFF_SH))[r] = am * (1.f / 127.f);
#pragma unroll
            for (int hh = 0; hh < 2; ++hh) { u32x2 w = {pk4_i8(y[hh * 8] * inv, y[hh * 8 + 1] * inv, y[hh * 8 + 2] * inv, y[hh * 8 + 3] * inv), pk4_i8(y[hh * 8 + 4] * inv, y[hh * 8 + 5] * inv, y[hh * 8 + 6] * inv, y[hh * 8 + 7] * inv)};
                *(u32x2*)((unsigned char*)H + (size_t)r * 1024 + hh * 512 + lane * 8) = w; } }
    }
}
__device__ void ph_output(const Params& p, int wg, int nwg) {
    const float4* X4 = (const float4*)(p.ws + OFF_X); float4* O4 = (float4*)p.out;
    const size_t n4 = (size_t)NB * SEQ * 256;
    for (size_t i = (size_t)wg * 512 + otid(); i < n4; i += (size_t)nwg * 512) { const size_t row = i >> 8; const size_t b = row / SEQ, t = row - b * SEQ; O4[i] = X4[(b * TT + NCTX + t) * 256 + (i & 255)]; }
}
constexpr int LDS_BYTES = 131072 + 256;
enum { PH_PROLOGUE = 0, PH_A, PH_B, PH_C, PH_D, PH_E, PH_F, PH_G, PH_H, PH_I, PH_J, PH_K, PH_L, PH_M, PH_OUT };

#ifndef PROBE_NOST
#define PROBE_NOST 0
#endif
template <int PH> DI void run_phase(const Params& pin, int l, LAS unsigned char* lds, int wg_in, int nwg, int dup = 0) {
    int wg = wg_in; asm volatile("" : "+s"(wg));
    Params p = pin; { unsigned long long w = (unsigned long long)pin.ws; asm volatile("" : "+s"(w)); p.ws = (unsigned char*)(__attribute__((address_space(1))) unsigned char*)w; }
    if constexpr (PH == PH_PROLOGUE) { ph_prologue(p, lds, wg, nwg); conv_mixer_b(p, 0, lds, wg, nwg); conv_mixer_a(p, 0, lds); }
    if constexpr (PH == PH_A) { norm1_rows(p, l, wg, nwg); }
    if constexpr (PH == PH_B) { int kq = 512; asm volatile("" : "+s"(kq));
        pg8::Gemm g{(const bf16_t*)(p.ws + OFF_H), (const bf16_t*)(p.ws + OFF_WIN), RR, NIN, kq}; SchedPlain S; S.init(RR / 256, NIN / 256, nwg, wg); EpiInProj E{p.ws, (PROBE_NOST && dup) ? 1 : 0};
        pg8::gemm_phase<EpiInProj, SchedPlain, false, 2>(lds, g, S, E, nullptr); }
    if constexpr (PH == PH_C) ph_prep(p, l, lds, wg, nwg, dup);
    if constexpr (PH == PH_D) ph_mix(p, l, lds, (LAS unsigned*)(lds + 131072 + 64), dup);
    if constexpr (PH == PH_E) ph_post(p, l, wg, nwg);
    if constexpr (PH == PH_F) { pg8::Gemm g{(const bf16_t*)(p.ws + OFF_YA), (const bf16_t*)(p.ws + OFF_WBR), RR, 1024, 512}; SchedMerge S; S.init(nwg, wg); EpiMerge E{p.ws, (PROBE_NOST == 3 && dup) ? 1 : 0};
        pg8::gemm_phase<EpiMerge, SchedMerge>(lds, g, S, E, nullptr); ctx_merge_units(p, wg, nwg); }
    if constexpr (PH == PH_G) { pg8::Gemm g{(const bf16_t*)(p.ws + OFF_M), (const bf16_t*)(p.ws + OFF_WOUT), RR, 1024, 1024}; SchedLat S; S.init(nwg, wg); EpiOut E{p.ws, l, dup ? 0.f : 1.f};
        pg8::gemm_phase<EpiOut, SchedLat>(lds, g, S, E, nullptr); ctx_out_units(p, l, wg, nwg, dup ? 0.f : 1.f); }
    if constexpr (PH == PH_H) { if (!dup) { conv_expert_weights(p, l, lds); if (l + 1 < NL) { conv_mixer_b(p, l + 1, lds, wg, nwg); conv_mixer_a(p, l + 1, lds); } } ph_norm2(p, l, lds, wg, nwg); }
    if constexpr (PH == PH_I) ph_topk(p, lds, wg, nwg);
    if constexpr (PH == PH_J) ph_gather(p, wg, nwg);
    if constexpr (PH == PH_K) { int kq = 512; asm volatile("" : "+s"(kq));
        pg8::Gemm g{(const bf16_t*)(p.ws + OFF_XG), (const bf16_t*)(p.ws + OFF_W13), EROWS, 2048, kq}; SchedMoe<8> S; S.init(nwg, wg); EpiUp E{p.ws};
        pg8::gemm_phase<EpiUp, SchedMoe<8>, false, 1>(lds, g, S, E, nullptr); }
    if constexpr (PH == PH_L) { int kq = 512; asm volatile("" : "+s"(kq));
        pg8::Gemm g{(const bf16_t*)(p.ws + OFF_HID), (const bf16_t*)(p.ws + OFF_W2), EROWS, 1024, kq}; SchedMoe<4> S; S.init(nwg, wg); EpiDown E{p.ws};
        pg8::gemm_phase<EpiDown, SchedMoe<4>, false, 1>(lds, g, S, E, nullptr); }
    if constexpr (PH == PH_M) ph_combine(p, l, wg, nwg, dup ? 0.f : 1.f);
    if constexpr (PH == PH_OUT) { conv_expert_weights(p, l, lds, 32); if (l + 1 < NL) conv_mixer_b(p, l + 1, lds, wg, nwg); }
}

DI void grid_barrier(const Params& p, LAS unsigned* xbw) {
    unsigned long long w = (unsigned long long)p.ws; asm volatile("" : "+s"(w));
    XcdBarrier b; b.bar = (unsigned*)(__attribute__((address_space(1))) unsigned*)(w + OFF_BAR); b.x = xb_xcc_id(); b.st = (volatile LAS unsigned*)xbw; xcd_barrier(b);
}
#ifndef PROBE_MASK
#define PROBE_MASK 0u
#endif
#ifndef MEGA
#define MEGA 1
#endif
#if !MEGA
template <int PH> __global__ __launch_bounds__(512, 2) void k_phase(Params p, int l) {
    extern __shared__ __attribute__((aligned(16))) unsigned char shm[];
    run_phase<PH>(p, l, (LAS unsigned char*)shm, blockIdx.x, gridDim.x);
}
template <int PH> static void launch_phase(const Params& p, int l, int grid, hipStream_t st) {
    static bool attr = false;
    if (!attr) { (void)hipFuncSetAttribute((const void*)k_phase<PH>, hipFuncAttributeMaxDynamicSharedMemorySize, LDS_BYTES); attr = true; }
    hipLaunchKernelGGL(k_phase<PH>, dim3(grid), dim3(512), LDS_BYTES, st, p, l);
}
#else
__global__ __launch_bounds__(512, 2) void k_mega(Params p) {
    extern __shared__ __attribute__((aligned(16))) unsigned char shm[];
    LAS unsigned char* lds = (LAS unsigned char*)shm;
    LAS unsigned* xbw = (LAS unsigned*)(lds + 131072);
    if (threadIdx.x < 4) xbw[threadIdx.x] = 0u;
    __syncthreads();
    (void)xcd_barrier_post((unsigned*)(p.ws + OFF_BAR), (volatile LAS unsigned*)xbw);
    const int wg = blockIdx.x, nwg = gridDim.x;
    run_phase<PH_PROLOGUE>(p, 0, lds, wg, nwg); grid_barrier(p, xbw);
    if (PROBE_MASK & (1u << PH_PROLOGUE)) { run_phase<PH_PROLOGUE>(p, 0, lds, wg, nwg); grid_barrier(p, xbw); }
#pragma unroll 1
    for (int l = 0; l < NL; ++l) {
        if (l == 0) { run_phase<PH_A>(p, l, lds, wg, nwg); grid_barrier(p, xbw); }
        if (l == 0 && (PROBE_MASK & (1u << PH_A))) { run_phase<PH_A>(p, l, lds, wg, nwg); grid_barrier(p, xbw); }
        run_phase<PH_B>(p, l, lds, wg, nwg); grid_barrier(p, xbw);
        if (PROBE_MASK & (1u << PH_B)) { run_phase<PH_B>(p, l, lds, wg, nwg, 1); grid_barrier(p, xbw); }
        run_phase<PH_C>(p, l, lds, wg, nwg); grid_barrier(p, xbw);
        if (PROBE_MASK & (1u << PH_C)) { run_phase<PH_C>(p, l, lds, wg, nwg, 1); grid_barrier(p, xbw); }
        run_phase<PH_D>(p, l, lds, wg, nwg); grid_barrier(p, xbw);
        if (PROBE_MASK & (1u << PH_D)) { run_phase<PH_D>(p, l, lds, wg, nwg, 1); grid_barrier(p, xbw); }
        run_phase<PH_E>(p, l, lds, wg, nwg); grid_barrier(p, xbw);
        if (PROBE_MASK & (1u << PH_E)) { run_phase<PH_E>(p, l, lds, wg, nwg, 1); grid_barrier(p, xbw); }
        run_phase<PH_F>(p, l, lds, wg, nwg); grid_barrier(p, xbw);
        if (PROBE_MASK & (1u << PH_F)) { run_phase<PH_F>(p, l, lds, wg, nwg, 1); grid_barrier(p, xbw); }
        run_phase<PH_G>(p, l, lds, wg, nwg); grid_barrier(p, xbw);
        if (PROBE_MASK & (1u << PH_G)) { run_phase<PH_G>(p, l, lds, wg, nwg, 1); grid_barrier(p, xbw); }
        run_phase<PH_H>(p, l, lds, wg, nwg); grid_barrier(p, xbw);
        if (PROBE_MASK & (1u << PH_H)) { run_phase<PH_H>(p, l, lds, wg, nwg, 1); grid_barrier(p, xbw); }
        if (PROBE_MASK & (1u << PH_OUT)) { run_phase<PH_OUT>(p, l, lds, wg, nwg, 1); grid_barrier(p, xbw); }
        run_phase<PH_I>(p, l, lds, wg, nwg); grid_barrier(p, xbw);
        if (PROBE_MASK & (1u << PH_I)) { run_phase<PH_I>(p, l, lds, wg, nwg, 1); grid_barrier(p, xbw); }
        run_phase<PH_J>(p, l, lds, wg, nwg); grid_barrier(p, xbw);
        if (PROBE_MASK & (1u << PH_J)) { run_phase<PH_J>(p, l, lds, wg, nwg, 1); grid_barrier(p, xbw); }
        run_phase<PH_K>(p, l, lds, wg, nwg); grid_barrier(p, xbw);
        if (PROBE_MASK & (1u << PH_K)) { run_phase<PH_K>(p, l, lds, wg, nwg, 1); grid_barrier(p, xbw); }
        run_phase<PH_L>(p, l, lds, wg, nwg); grid_barrier(p, xbw);
        if (PROBE_MASK & (1u << PH_L)) { run_phase<PH_L>(p, l, lds, wg, nwg, 1); grid_barrier(p, xbw); }
        run_phase<PH_M>(p, l, lds, wg, nwg); grid_barrier(p, xbw);
        if (PROBE_MASK & (1u << PH_M)) { run_phase<PH_M>(p, l, lds, wg, nwg, 1); grid_barrier(p, xbw); }
    }
}
#endif

extern "C" void kernel_launch(void* const* d_in, const int* in_sizes, int n_in, void* d_out, int out_size, void* d_ws, size_t ws_size, hipStream_t stream) {
    if (n_in < 31 || ws_size < WS_NEEDED) return;
    Params p{};
    const float** f = (const float**)&p;
    for (int i = 0; i < 31; ++i) f[i] = (const float*)d_in[i];
    p.out = (float*)d_out; p.ws = (unsigned char*)d_ws;
    (void)hipMemsetAsync(d_ws, 0, 65536, stream);
#if !MEGA
    const int G = 256;
    launch_phase<PH_PROLOGUE>(p, 0, G, stream);
    for (int l = 0; l < NL; ++l) {
        launch_phase<PH_A>(p, l, G, stream); launch_phase<PH_B>(p, l, G, stream); launch_phase<PH_C>(p, l, G, stream); launch_phase<PH_D>(p, l, G, stream);
        launch_phase<PH_E>(p, l, G, stream); launch_phase<PH_F>(p, l, G, stream); launch_phase<PH_G>(p, l, G, stream); launch_phase<PH_H>(p, l, G, stream);
        launch_phase<PH_I>(p, l, G, stream); launch_phase<PH_J>(p, l, G, stream); launch_phase<PH_K>(p, l, G, stream); launch_phase<PH_L>(p, l, G, stream);
        launch_phase<PH_M>(p, l, G, stream);
    }
    launch_phase<PH_OUT>(p, 0, G, stream);
#else
    static int grid = 0;
    if (!grid) {
        (void)hipFuncSetAttribute((const void*)k_mega, hipFuncAttributeMaxDynamicSharedMemorySize, LDS_BYTES);
        int dev = 0, cus = 0, per_cu = 0; (void)hipGetDevice(&dev); (void)hipDeviceGetAttribute(&cus, hipDeviceAttributeMultiprocessorCount, dev);
        (void)hipOccupancyMaxActiveBlocksPerMultiprocessor(&per_cu, (const void*)k_mega, 512, LDS_BYTES);
        grid = cus * (per_cu < 1 ? per_cu : 1);
    }
    if (grid <= 0) return;
    hipLaunchKernelGGL(k_mega, dim3(grid), dim3(512), LDS_BYTES, stream, p);
#endif
}
```

```cpp
#include <hip/hip_runtime.h>
#include <stdint.h>

#define LAS __attribute__((address_space(3)))
typedef unsigned short bf16_t;
typedef short bf16x8 __attribute__((ext_vector_type(8)));
typedef float f32x4 __attribute__((ext_vector_type(4)));
typedef float f32x16 __attribute__((ext_vector_type(16)));
typedef float f32x2v __attribute__((ext_vector_type(2)));
typedef __bf16 bf16x2v __attribute__((ext_vector_type(2)));
typedef unsigned u32x4 __attribute__((ext_vector_type(4)));
typedef unsigned u32x2 __attribute__((ext_vector_type(2)));

#define DI __device__ __forceinline__
DI int otid() { int t = threadIdx.x; asm volatile("" : "+v"(t)); return t; }
DI float bf2f(bf16_t v) { return __uint_as_float(((unsigned)v) << 16); }
DI float bflo(unsigned w) { return __uint_as_float(w << 16); }
DI float bfhi(unsigned w) { return __uint_as_float(w & 0xffff0000u); }
DI unsigned pk2(float a, float b) { f32x2v v = {a, b}; return __builtin_bit_cast(unsigned, __builtin_convertvector(v, bf16x2v)); }
DI unsigned pk4_fp8(float a, float b, float c, float d) { unsigned w = 0; w = __builtin_amdgcn_cvt_pk_fp8_f32(a, b, w, false); w = __builtin_amdgcn_cvt_pk_fp8_f32(c, d, w, true); return w; }
DI unsigned pk4_i8(float a, float b, float c, float d) { const int ia = (int)rintf(a), ib = (int)rintf(b), ic = (int)rintf(c), id = (int)rintf(d); return (unsigned)(ia & 255) | ((unsigned)(ib & 255) << 8) | ((unsigned)(ic & 255) << 16) | ((unsigned)id << 24); }
DI unsigned pk4_u8(float a, float b, float c, float d) { unsigned w = 0; w = __builtin_amdgcn_cvt_pk_u8_f32(a, 0, w); w = __builtin_amdgcn_cvt_pk_u8_f32(b, 1, w); w = __builtin_amdgcn_cvt_pk_u8_f32(c, 2, w); w = __builtin_amdgcn_cvt_pk_u8_f32(d, 3, w); return w; }
DI bf16_t f2bf(float a) { return (bf16_t)(pk2(a, 0.f) & 0xffffu); }
DI float sigmoidf_(float x) { return __builtin_amdgcn_rcpf(1.f + __expf(-x)); }
template <int CTRL> DI float dppmov(float x) { return __builtin_bit_cast(float, __builtin_amdgcn_update_dpp(0, __builtin_bit_cast(int, x), CTRL, 0xf, 0xf, true)); }
DI float allsum16(float x) { x += dppmov<0xB1>(x); x += dppmov<0x4E>(x); x += dppmov<0x141>(x); x += dppmov<0x140>(x); return x; }
DI float allsum8(float x) { x += dppmov<0xB1>(x); x += dppmov<0x4E>(x); x += dppmov<0x141>(x); return x; }
DI float allmax16(float x) { x = fmaxf(x, dppmov<0xB1>(x)); x = fmaxf(x, dppmov<0x4E>(x)); x = fmaxf(x, dppmov<0x141>(x)); x = fmaxf(x, dppmov<0x140>(x)); return x; }
DI float sum_x16(float x) { auto r = __builtin_amdgcn_permlane16_swap(__float_as_uint(x), __float_as_uint(x), false, false); return __uint_as_float(r[0]) + __uint_as_float(r[1]); }
DI float sum_x32(float x) { auto r = __builtin_amdgcn_permlane32_swap(__float_as_uint(x), __float_as_uint(x), false, false); return __uint_as_float(r[0]) + __uint_as_float(r[1]); }
DI float wave_sum(float v) { return sum_x32(sum_x16(allsum16(v))); }
DI float wave_max(float v) { v = allmax16(v); { auto r = __builtin_amdgcn_permlane16_swap(__float_as_uint(v), __float_as_uint(v), false, false); v = fmaxf(__uint_as_float(r[0]), __uint_as_float(r[1])); }
    { auto r = __builtin_amdgcn_permlane32_swap(__float_as_uint(v), __float_as_uint(v), false, false); v = fmaxf(__uint_as_float(r[0]), __uint_as_float(r[1])); } return v; }
DI float bperm(float v, int byte_addr) { return __builtin_bit_cast(float, __builtin_amdgcn_ds_bpermute(byte_addr, __builtin_bit_cast(int, v))); }

constexpr int NB = 4, SEQ = 8192, NCTX = 256, TT = SEQ + NCTX, RR = NB * TT, DM = 1024, NIN = 7936, NL = 4;
constexpr int NE = 16, CAPL = 1024, CAPC = 32, ESLOT = 4352, EROWS = NE * ESLOT;
static_assert(RR == 33792 && RR % 256 == 0 && EROWS % 256 == 0, "shape");

constexpr size_t MB1 = 1u << 20;
constexpr size_t alignup(size_t x) { return (x + MB1 - 1) / MB1 * MB1; }
constexpr size_t SZ_T = (size_t)RR * 512 * 2;
constexpr size_t OFF_BAR = 0;
constexpr size_t OFF_CTR = 32768;
constexpr size_t OFF_MOD = 65536;
constexpr size_t OFF_ROPE = OFF_MOD + (size_t)NL * 5 * 6144 * 4;
constexpr size_t OFF_AFFL = MB1;
constexpr size_t OFF_AFFC = OFF_AFFL + (size_t)4 * 16 * 8192 * 4;
constexpr size_t OFF_SROW = OFF_AFFC + (size_t)4 * 16 * 256 * 4;
constexpr size_t OFF_SGATE = OFF_SROW + (size_t)EROWS * 4;
constexpr size_t OFF_INV = OFF_SGATE + (size_t)EROWS * 4;
constexpr size_t OFF_LRW = OFF_INV + (size_t)RR * 16 * 4;
constexpr size_t OFF_SW = OFF_LRW + (size_t)(4 * 512 * 64 + 512 * 128) * 2;
constexpr size_t OFF_SH = OFF_SW + (size_t)NIN * 4;
constexpr size_t OFF_X = alignup(OFF_SH + (size_t)RR * 4);
constexpr size_t OFF_H = alignup(OFF_X + (size_t)RR * 1024 * 4);
constexpr size_t OFF_VT = OFF_H;
constexpr size_t OFF_YB0 = OFF_H + SZ_T;
constexpr size_t OFF_M = OFF_H;
constexpr size_t OFF_WIN = alignup(OFF_H + 2 * SZ_T);
constexpr size_t OFF_WBR = alignup(OFF_WIN + (size_t)NIN * 1024 * 2);
constexpr size_t OFF_WOUT = alignup(OFF_WBR + (size_t)3 * 1024 * 512 * 2);
constexpr size_t OFF_PA = alignup(OFF_WOUT + (size_t)1024 * 1024 * 2);
constexpr size_t OFF_PR = alignup(OFF_PA + (size_t)RR * 1536 * 2);
constexpr size_t OFF_PC = alignup(OFF_PR + (size_t)RR * 1792 * 2);
constexpr size_t OFF_PG = alignup(OFF_PC + (size_t)RR * 1536 * 2);
constexpr size_t OFF_PEND = alignup(OFF_PG + (size_t)RR * 3072 * 2);
constexpr size_t OFF_OS = OFF_PR;
constexpr size_t OFF_OA = OFF_OS + 2 * SZ_T;
constexpr size_t OFF_YA = alignup(OFF_OA + 2 * SZ_T);
constexpr size_t OFF_YB = alignup(OFF_YA + SZ_T);
static_assert(OFF_YB + SZ_T <= OFF_PG, "overlay");
constexpr size_t OFF_XG = OFF_PR;
constexpr size_t OFF_HID = alignup(OFF_XG + (size_t)EROWS * 1024);
constexpr size_t OFF_OUT = alignup(OFF_HID + (size_t)EROWS * 1024);
static_assert(OFF_OUT + (size_t)EROWS * 1024 * 2 <= OFF_PEND, "overlay");
constexpr size_t OFF_EW = OFF_PEND;
constexpr size_t OFF_AA = OFF_EW + 2 * SZ_T;
constexpr size_t OFF_KK = OFF_AA + 2 * SZ_T;
constexpr size_t OFF_KC = OFF_KK + SZ_T;
constexpr size_t OFF_RC = OFF_KC + SZ_T;
constexpr size_t OFF_VC = OFF_RC + SZ_T;
constexpr size_t OFF_YC = alignup(OFF_VC + SZ_T);
constexpr size_t OFF_G = alignup(OFF_YC + SZ_T);
constexpr size_t OFF_W13 = alignup(OFF_G + SZ_T);
constexpr size_t OFF_W2 = OFF_W13 + (size_t)16 * 2048 * 1024;
constexpr size_t WS_NEEDED = alignup(OFF_W2 + (size_t)16 * 1024 * 1024);
constexpr int YTILE = 262144;
static_assert((OFF_YB - OFF_YA) % YTILE == 0 && (OFF_YC - OFF_YA) % YTILE == 0 && OFF_YC > OFF_YA, "merge A tiles");

struct Params {
    const float *x, *c, *ctx, *c_ctx, *norm1_g, *norm2_g, *ada_w, *ada_b, *w_in, *q_norm_g, *k_norm_g, *diff_lambda, *diff_subln_g,
        *rwkv_conv_w, *rwkv_w0, *rwkv_w_up, *rwkv_a0, *rwkv_a_up, *rwkv_g_up, *rwkv_k_k, *rwkv_k_a, *rwkv_r_k, *rwkv_ln_g, *rwkv_ln_b,
        *conv_w, *w_branch, *w_out, *router_w, *exp_w1, *exp_w3, *exp_w2;
    float* out;
    unsigned char* ws;
};
#define XB_TMO      128
#define XB_XCNT(j)  (256  + 64 * (j))
#define XB_XSUB(j)  (1280 + 64 * (j))
#define XB_XGEN(j)  (2304 + 64 * (j))
#define XB_TOP      3328
#define XB_TOPGEN   3392
#define XCD_BAR_WORDS 3456
#define XB_SPIN_CAP (1u << 18)

__device__ __forceinline__ unsigned xb_ld(unsigned* p)              { return __hip_atomic_load(p, __ATOMIC_RELAXED, __HIP_MEMORY_SCOPE_AGENT); }
__device__ __forceinline__ unsigned xb_add(unsigned* p, unsigned v) { return __hip_atomic_fetch_add(p, v, __ATOMIC_RELAXED, __HIP_MEMORY_SCOPE_AGENT); }
__device__ __forceinline__ unsigned xb_xcc_id() { return (unsigned)__builtin_amdgcn_s_getreg((3 << 11) | 20) & 0xFu; }
#define XB_SPIN(cond, bar) do { unsigned _sp = 0; while (cond) { __builtin_amdgcn_s_sleep(1); \
    if ((++_sp & 255u) == 0u) { if (xb_ld(&(bar)[XB_TMO])) break; if (_sp > XB_SPIN_CAP) { atomicAdd(&(bar)[XB_TMO], 1u); break; } } } } while (0)

struct XcdBarrier {
    unsigned* bar; unsigned x;
    volatile LAS unsigned* st;
};

__device__ __forceinline__ XcdBarrier xcd_barrier_post(unsigned* bar, volatile LAS unsigned* st) {
    XcdBarrier b; b.bar = bar; b.x = xb_xcc_id(); b.st = st;
    if (threadIdx.x == 0) (void)xb_add(&bar[XB_XCNT(b.x)], 1u);
    return b;
}
__device__ __forceinline__ void xcd_barrier_complete(unsigned* bar, unsigned x, unsigned& nloc, unsigned& nx) {
    const unsigned G = gridDim.x * gridDim.y * gridDim.z;
    unsigned sum, cnt, mine, sp = 0u;
    for (;;) {
        sum = 0u; cnt = 0u; mine = 0u;
#pragma unroll
        for (unsigned j = 0; j < 16; ++j) { const unsigned c = xb_ld(&bar[XB_XCNT(j)]); sum += c; cnt += (c > 0u) ? 1u : 0u; mine = (j == x) ? c : mine; }
        if (sum == G) break;
        __builtin_amdgcn_s_sleep(1);
        if ((++sp & 255u) == 0u) { if (xb_ld(&bar[XB_TMO])) break; if (sp > XB_SPIN_CAP) { atomicAdd(&bar[XB_TMO], 1u); break; } }
    }
    nloc = mine > 0u ? mine : 1u; nx = cnt > 0u ? cnt : 1u;
}

__device__ __forceinline__ void xcd_barrier(const XcdBarrier& b) {
    asm volatile("s_waitcnt vmcnt(0)" ::: "memory");
    __syncthreads();
    if (threadIdx.x == 0) {
        unsigned* bar = b.bar;
        __builtin_amdgcn_s_waitcnt(0);
        unsigned nloc = b.st[0], nx = b.st[1];
        if (nloc == 0u) { xcd_barrier_complete(bar, b.x, nloc, nx); b.st[0] = nloc; b.st[1] = nx; }
        const unsigned old = xb_add(&bar[XB_XSUB(b.x)], 1u);
        const unsigned gen = old / nloc;
        if (old + 1u == (gen + 1u) * nloc) {
            __builtin_amdgcn_fence(__ATOMIC_RELEASE, "agent");
            asm volatile("s_waitcnt vmcnt(0)" ::: "memory");
            const unsigned og = xb_add(&bar[XB_TOP], 1u);
            const unsigned tg = og / nx;
            if (og + 1u == (tg + 1u) * nx) xb_add(&bar[XB_TOPGEN], 1u);
            else XB_SPIN(xb_ld(&bar[XB_TOPGEN]) == tg, bar);
            __builtin_amdgcn_fence(__ATOMIC_ACQUIRE, "agent");
            xb_add(&bar[XB_XGEN(b.x)], 1u);
            asm volatile("s_waitcnt vmcnt(0)" ::: "memory");
        } else {
            XB_SPIN(xb_ld(&bar[XB_XGEN(b.x)]) == gen, bar);
            __builtin_amdgcn_fence(__ATOMIC_ACQUIRE, "agent");
            asm volatile("s_waitcnt vmcnt(0)" ::: "memory");
        }
    }
    __syncthreads();
}
namespace pg8 {
#define PG8_LAS __attribute__((address_space(3)))
constexpr int BM = 256, BK = 64, HALF = 128, HTB = HALF * BK * 2  , STAGE_BYTES = 8 * HTB, NXCD = 8, WGM = 8;
__host__ __device__ __forceinline__ int lds_byte(int r, int c) { const int st = (r >> 4) * 2 + (c >> 5), rr = r & 15, cc = c & 31, ob = rr * 64 + cc * 2; return st * 1024 + (ob ^ (((ob >> 9) & 1) << 5)); }
__host__ __device__ __forceinline__ void stage_rc(int b, int& R, int& C) { const int st = b / 1024, sb = b % 1024, swz = sb ^ (((sb >> 9) & 1) << 5); R = (st >> 1) * 16 + swz / 64; C = (st & 1) * 32 + (swz % 64) / 2; }
__host__ __device__ __forceinline__ int perm32(int rho) { const int n = rho >> 4, i = rho & 15; return 8 * (i >> 2) + 4 * n + (i & 3); }
typedef int v4i_t __attribute__((ext_vector_type(4)));
typedef int v8i_t __attribute__((ext_vector_type(8)));
struct Unit { int pm, pn; int rt, ct, br; };
struct Gemm { const bf16_t* A; const bf16_t* Bt; int M, N, K; };
template <class Epi, class Sched, bool STAMP = false, int QM = 0>
__device__ __forceinline__ void gemm_phase(PG8_LAS unsigned char* lds, const Gemm g, const Sched& S, const Epi& E, unsigned long long* stamps) {
    const int tid = otid(), wid = __builtin_amdgcn_readfirstlane(tid >> 6), lane = tid & 63, wr = wid >> 2, wc = wid & 3, fr = lane & 15, fq = lane >> 4;
    const int K = g.K, nt = K / BK;
    int ts_lo = 0, ts_hi = 0, nts = 0; const unsigned long long rt_entry = STAMP ? (unsigned long long)wall_clock64() : 0ull;
#define PG8_STAMP() do { if (STAMP && wid == 0 && nts < 64) { const unsigned long long _c = (unsigned long long)clock64(); \
        ts_lo = (lane == nts) ? (int)(unsigned)_c : ts_lo; ts_hi = (lane == nts) ? (int)(unsigned)(_c >> 32) : ts_hi; ++nts; } } while (0)
    PG8_STAMP();
    unsigned voffA[2], voffB[2];
#pragma unroll
    for (int i = 0; i < 2; ++i) { int R, C; stage_rc(tid * 16 + i * 8192, R, C); const int Rb = Epi::PERM ? ((R & ~31) + perm32(R & 31)) : R;
        voffA[i] = (unsigned)(R * K + C) * 2u; voffB[i] = (unsigned)(Rb * K + C) * 2u; }
    const size_t kstep = (size_t)(BK * 2);
    const size_t hstep = (size_t)HALF * K * 2;
    const size_t tstep = 2 * hstep;
    const unsigned ldsw = (unsigned)wid * 1024u;
    const int aoff = lds_byte(wr * 64 + fr, fq * 8), boff = lds_byte(wc * 32 + fr, fq * 8);
#define PG8_SA(b, h) (((b) * 2 + (h)) * HTB)
#define PG8_SB(b, h) ((4 + (b) * 2 + (h)) * HTB)
#define PG8_STAGE(bufoff, gbase, voff) do { _Pragma("unroll") for (int _i = 0; _i < 2; ++_i) \
        __builtin_amdgcn_global_load_lds((const unsigned*)((const char*)(gbase) + (voff)[_i]), (PG8_LAS unsigned*)(lds + (bufoff) + ldsw + _i * 8192), 16, 0, 0); } while (0)
#define PG8_LDA(dst, b, h) do { _Pragma("unroll") for (int m = 0; m < 4; ++m) dst[m] = __builtin_shufflevector(*(const PG8_LAS v4i_t*)(lds + PG8_SA(b, h) + aoff + m * 2048), *(const PG8_LAS v4i_t*)(lds + PG8_SA(b, h) + aoff + m * 2048 + 1024), 0, 1, 2, 3, 4, 5, 6, 7); } while (0)
#define PG8_LDB(dst, b, h) do { _Pragma("unroll") for (int n = 0; n < 2; ++n) dst[n] = __builtin_shufflevector(*(const PG8_LAS v4i_t*)(lds + PG8_SB(b, h) + boff + n * 2048), *(const PG8_LAS v4i_t*)(lds + PG8_SB(b, h) + boff + n * 2048 + 1024), 0, 1, 2, 3, 4, 5, 6, 7); } while (0)
#define PG8_MMA(ai, bj, At, Bt) do { __builtin_amdgcn_s_setprio(1); \
        if constexpr (QM == 1) { _Pragma("unroll") for (int m = 0; m < 4; ++m) _Pragma("unroll") for (int n = 0; n < 2; ++n) \
            asm volatile("v_mfma_scale_f32_16x16x128_f8f6f4 %0, %1, %2, %0, %3, %3 op_sel_hi:[0,0,0]" : "+v"(acc[ai][bj][m][n]) : "v"(Bt[n]), "v"(At[m]), "v"(one_scale)); } \
        else if constexpr (QM == 2) { _Pragma("unroll") for (int m = 0; m < 4; ++m) _Pragma("unroll") for (int n = 0; n < 2; ++n) { v4i_t c_ = __builtin_bit_cast(v4i_t, acc[ai][bj][m][n]); \
            c_ = __builtin_amdgcn_mfma_i32_16x16x64_i8(__builtin_shufflevector(Bt[n], Bt[n], 0, 1, 2, 3), __builtin_shufflevector(At[m], At[m], 0, 1, 2, 3), c_, 0, 0, 0); \
            c_ = __builtin_amdgcn_mfma_i32_16x16x64_i8(__builtin_shufflevector(Bt[n], Bt[n], 4, 5, 6, 7), __builtin_shufflevector(At[m], At[m], 4, 5, 6, 7), c_, 0, 0, 0); acc[ai][bj][m][n] = __builtin_bit_cast(f32x4, c_); } } \
        else { _Pragma("unroll") for (int m = 0; m < 4; ++m) _Pragma("unroll") for (int n = 0; n < 2; ++n) { \
            acc[ai][bj][m][n] = __builtin_amdgcn_mfma_f32_16x16x32_bf16(__builtin_bit_cast(bf16x8, __builtin_shufflevector(Bt[n], Bt[n], 0, 1, 2, 3)), __builtin_bit_cast(bf16x8, __builtin_shufflevector(At[m], At[m], 0, 1, 2, 3)), acc[ai][bj][m][n], 0, 0, 0); \
            acc[ai][bj][m][n] = __builtin_amdgcn_mfma_f32_16x16x32_bf16(__builtin_bit_cast(bf16x8, __builtin_shufflevector(Bt[n], Bt[n], 4, 5, 6, 7)), __builtin_bit_cast(bf16x8, __builtin_shufflevector(At[m], At[m], 4, 5, 6, 7)), acc[ai][bj][m][n], 0, 0, 0); } } \
        __builtin_amdgcn_s_setprio(0); } while (0)
#define PG8_WAIT_V(n) asm volatile("s_waitcnt vmcnt(" #n ")" ::: "memory")
#define PG8_WAIT_L(n) asm volatile("s_waitcnt lgkmcnt(" #n ")" ::: "memory")
#define PG8_BAR __builtin_amdgcn_s_barrier()
#define PG8_SCHED __builtin_amdgcn_sched_barrier(0)
    Unit cur, nxt; int ui = 0;
    if (!S.next(0, cur)) return;
    f32x4 acc[2][2][4][2];
#pragma unroll
    for (int a = 0; a < 2; ++a)
#pragma unroll
        for (int b = 0; b < 2; ++b)
#pragma unroll
            for (int m = 0; m < 4; ++m)
#pragma unroll
                for (int n = 0; n < 2; ++n) acc[a][b][m][n] = (f32x4){0.f, 0.f, 0.f, 0.f};
    const int one_scale = 0x7f7f7f7f;
    v8i_t At[4], B0[2], B1[2];
    const char* cA = (const char*)g.A + (size_t)cur.pm * tstep; const char* cB = (const char*)g.Bt + (size_t)cur.pn * tstep;
    S.a_ready(cur);
    PG8_STAGE(PG8_SB(0, 0), cB, voffB); PG8_STAGE(PG8_SA(0, 0), cA, voffA); PG8_STAGE(PG8_SB(0, 1), cB + hstep, voffB); PG8_STAGE(PG8_SA(0, 1), cA + hstep, voffA);
    if (wr == 1) PG8_BAR;
    PG8_WAIT_V(4); PG8_BAR;
    PG8_STAGE(PG8_SB(1, 0), cB + kstep, voffB); PG8_STAGE(PG8_SA(1, 0), cA + kstep, voffA); PG8_STAGE(PG8_SB(1, 1), cB + hstep + kstep, voffB);
    PG8_WAIT_V(6); PG8_BAR;
    PG8_STAMP();
    for (;;) {
        const bool has_next = S.next(ui + 1, nxt);
        const char* nA = has_next ? (const char*)g.A + (size_t)nxt.pm * tstep : cA; const char* nB = has_next ? (const char*)g.Bt + (size_t)nxt.pn * tstep : cB;
        for (int t = 0; t < nt; t += 2) {
            const bool last = (t == nt - 2);
            const char* a1 = cA + (size_t)(t + 1) * kstep;
            const char* a2 = last ? nA : cA + (size_t)(t + 2) * kstep; const char* b2 = last ? nB : cB + (size_t)(t + 2) * kstep;
            const char* a3 = a2 + kstep; const char* b3 = b2 + kstep;
            if (last && has_next) S.a_ready(nxt);
            PG8_LDB(B0, 0, 0); PG8_SCHED; PG8_LDA(At, 0, 0); PG8_STAGE(PG8_SA(1, 1), a1 + hstep, voffA);
            PG8_WAIT_L(8); PG8_BAR; PG8_WAIT_L(0); PG8_MMA(0, 0, At, B0); PG8_BAR; PG8_SCHED;
            PG8_LDB(B1, 0, 1); PG8_STAGE(PG8_SB(0, 0), b2, voffB);
            PG8_BAR; PG8_WAIT_L(0); PG8_MMA(0, 1, At, B1); PG8_BAR;
            PG8_LDA(At, 0, 1); PG8_STAGE(PG8_SA(0, 0), a2, voffA);
            PG8_BAR; PG8_WAIT_L(0); PG8_MMA(1, 0, At, B0); PG8_BAR; PG8_SCHED;
            PG8_STAGE(PG8_SB(0, 1), b2 + hstep, voffB);
            PG8_WAIT_V(6); PG8_BAR; PG8_MMA(1, 1, At, B1); PG8_BAR;
            PG8_LDB(B0, 1, 0); PG8_SCHED; PG8_LDA(At, 1, 0); PG8_STAGE(PG8_SA(0, 1), a2 + hstep, voffA);
            PG8_WAIT_L(8); PG8_BAR; PG8_WAIT_L(0); PG8_MMA(0, 0, At, B0); PG8_BAR; PG8_SCHED;
            PG8_LDB(B1, 1, 1); PG8_STAGE(PG8_SB(1, 0), b3, voffB);
            PG8_BAR; PG8_WAIT_L(0); PG8_MMA(0, 1, At, B1); PG8_BAR;
            PG8_LDA(At, 1, 1); PG8_STAGE(PG8_SA(1, 0), a3, voffA);
            PG8_BAR; PG8_WAIT_L(0); PG8_MMA(1, 0, At, B0); PG8_BAR; PG8_SCHED;
            PG8_STAGE(PG8_SB(1, 1), b3 + hstep, voffB);
            PG8_WAIT_V(6); PG8_BAR; PG8_MMA(1, 1, At, B1); PG8_BAR;
        }
        PG8_STAMP();
        if constexpr (QM == 1) { asm volatile("s_nop 15\n\ts_nop 15" ::: "memory"); }
        if constexpr (!Epi::AFTER_DRAIN) { E(acc, cur, wr, wc, fr, fq); S.done(cur); }
        PG8_STAMP();
        if (!has_next) break;
        if (!Epi::keep_acc(cur)) {
#pragma unroll
        for (int a = 0; a < 2; ++a)
#pragma unroll
            for (int b = 0; b < 2; ++b)
#pragma unroll
                for (int m = 0; m < 4; ++m)
#pragma unroll
                    for (int n = 0; n < 2; ++n) acc[a][b][m][n] = (f32x4){0.f, 0.f, 0.f, 0.f};
        }
        cur = nxt; cA = nA; cB = nB; ++ui;
    }
    PG8_WAIT_V(0);
    if (wr == 0) PG8_BAR;
    PG8_BAR;
    if constexpr (Epi::AFTER_DRAIN) { E.fused(acc, cur, wr, wc, fr, fq, lds, wid, lane); S.done(cur); }
    PG8_STAMP();
    if (STAMP && wid == 0) { stamps[lane] = lane < nts ? (((unsigned long long)(unsigned)ts_hi << 32) | (unsigned)ts_lo) : 0ull;
        if (lane == 62) stamps[62] = rt_entry; if (lane == 63) stamps[63] = (unsigned long long)wall_clock64(); }
#undef PG8_STAMP
#undef PG8_SA
#undef PG8_SB
#undef PG8_STAGE
#undef PG8_LDA
#undef PG8_LDB
#undef PG8_MMA
#undef PG8_WAIT_V
#undef PG8_WAIT_L
#undef PG8_BAR
#undef PG8_SCHED
}
}
using pg8::Unit;

struct SchedPlain {
    int nM, nN, nwg, G, c;
    __device__ void init(int nM_, int nN_, int G_, int c_) { nM = nM_; nN = nN_; nwg = nM * nN; G = G_; c = c_; }
    __device__ bool next(int i, Unit& u) const {
        const long L = (long)i * G + c; if (L >= nwg) return false;
        int wgid = (int)L; { const int q = nwg / 8, r = nwg % 8, xcd = wgid % 8, off = wgid / 8; wgid = (xcd < r ? xcd * (q + 1) : r * (q + 1) + (xcd - r) * q) + off; }
        const int nig = 8 * nN, gid = wgid / nig, fm = gid * 8, gsz = (nM - fm) < 8 ? (nM - fm) : 8;
        u.pm = __builtin_amdgcn_readfirstlane(fm + ((wgid % nig) % gsz)); u.pn = __builtin_amdgcn_readfirstlane((wgid % nig) / gsz); u.rt = u.pm; u.ct = u.pn; u.br = 0; return true;
    }
    DI void a_ready(const Unit&) const {}
    DI void done(const Unit&) const {}
};
struct SchedMerge {
    int G, c, pmb1, pmb2;
    __device__ void init(int G_, int c_) { G = G_; c = (G_ % 8 == 0) ? ((c_ % 8) * (G_ / 8) + c_ / 8) : c_;
        pmb1 = (int)((OFF_YB - OFF_YA) / YTILE); pmb2 = (int)((OFF_YC - OFF_YA) / YTILE); }
    __device__ bool next(int i, Unit& u) const {
        const int tile = (i / 3) * G + c, br = i % 3; if (tile >= 512) return false;
        const int lp = tile >> 2; u.rt = __builtin_amdgcn_readfirstlane(lp + (lp >> 5) + 1); u.ct = __builtin_amdgcn_readfirstlane(tile & 3); u.br = __builtin_amdgcn_readfirstlane(br);
        u.pm = u.rt + (u.br == 0 ? 0 : (u.br == 1 ? pmb1 : pmb2)); u.pn = u.br * 4 + u.ct; return true;
    }
    DI void a_ready(const Unit&) const {}
    DI void done(const Unit&) const {}
};
struct SchedLat {
    int G, c;
    __device__ void init(int G_, int c_) { G = G_; c = (G_ % 8 == 0) ? ((c_ % 8) * (G_ / 8) + c_ / 8) : c_; }
    __device__ bool next(int i, Unit& u) const {
        const int tile = i * G + c; if (tile >= 512) return false;
        const int lp = tile >> 2; u.pm = u.rt = __builtin_amdgcn_readfirstlane(lp + (lp >> 5) + 1); u.pn = u.ct = __builtin_amdgcn_readfirstlane(tile & 3); u.br = 0; return true;
    }
    DI void a_ready(const Unit&) const {}
    DI void done(const Unit&) const {}
};
template <int NCT> struct SchedMoe {
    int G, c;
    __device__ void init(int G_, int c_) { G = G_; c = c_; }
    __device__ bool next(int i, Unit& u) const {
        const int L = i * G + c; if (L >= 16 * 17 * NCT) return false;
        const int e = __builtin_amdgcn_readfirstlane(L / (17 * NCT)), rem = L - e * (17 * NCT); u.rt = __builtin_amdgcn_readfirstlane(rem / NCT); u.ct = rem - u.rt * NCT; u.br = e;
        u.pm = e * 17 + u.rt; u.pn = e * NCT + u.ct; return true;
    }
    DI void a_ready(const Unit&) const {}
    DI void done(const Unit&) const {}
};

DI u32x4 pack8(const f32x4& a, const f32x4& b) { u32x4 w = {pk2(a[0], a[1]), pk2(a[2], a[3]), pk2(b[0], b[1]), pk2(b[2], b[3])}; return w; }

typedef int v4i_q __attribute__((ext_vector_type(4)));
struct EpiInProj {
    static constexpr bool PERM = true, AFTER_DRAIN = false;
    static DI bool keep_acc(const Unit&) { return false; }
    unsigned char* ws; int nost;
    DI void operator()(const f32x4 (&acc)[2][2][4][2], const Unit& u, int wr, int wc, int fr, int fq) const {
        const int pn = u.pn; bf16_t* base; int ld, colt; bool sig = false;
        if (pn < 6) { base = (bf16_t*)(ws + OFF_PA); ld = 1536; colt = pn * 256; }
        else if (pn < 13) { base = (bf16_t*)(ws + OFF_PR); ld = 1792; colt = (pn - 6) * 256; }
        else if (pn < 19) { base = (bf16_t*)(ws + OFF_PC); ld = 1536; colt = (pn - 13) * 256; }
        else { base = (bf16_t*)(ws + OFF_PG); ld = 3072; colt = (pn - 19) * 256; sig = true; }
        const int row0 = u.pm * 256 + wr * 64 + fr, col0 = colt + wc * 32 + 8 * fq;
        const float* sW = (const float*)(ws + OFF_SW) + pn * 256 + wc * 32 + 8 * fq; const float* sH = (const float*)(ws + OFF_SH);
        f32x4 cs[2][2]; float rsv[2][4];
#pragma unroll
        for (int bj = 0; bj < 2; ++bj) { cs[bj][0] = *(const f32x4*)(sW + bj * 128); cs[bj][1] = *(const f32x4*)(sW + bj * 128 + 4); }
#pragma unroll
        for (int ai = 0; ai < 2; ++ai)
#pragma unroll
            for (int m = 0; m < 4; ++m) rsv[ai][m] = sH[row0 + ai * 128 + m * 16];
#pragma unroll
        for (int bj = 0; bj < 2; ++bj) { const f32x4 cs0 = cs[bj][0], cs1 = cs[bj][1];
#pragma unroll
            for (int ai = 0; ai < 2; ++ai)
#pragma unroll
                for (int m = 0; m < 4; ++m) { bf16_t* rowp = base + (size_t)(row0 + ai * 128 + m * 16) * ld + col0; const float rs = rsv[ai][m];
                    const v4i_q i0 = __builtin_bit_cast(v4i_q, acc[ai][bj][m][0]), i1 = __builtin_bit_cast(v4i_q, acc[ai][bj][m][1]); f32x4 v0, v1;
#pragma unroll
                    for (int i = 0; i < 4; ++i) { v0[i] = (float)i0[i] * rs * cs0[i]; v1[i] = (float)i1[i] * rs * cs1[i]; }
                    if (sig) {
#pragma unroll
                        for (int i = 0; i < 4; ++i) { v0[i] = fmaxf(rintf(255.f * sigmoidf_(v0[i])), 1.f); v1[i] = fmaxf(rintf(255.f * sigmoidf_(v1[i])), 1.f); }
                        const u32x2 pk = {pk4_u8(v0[0], v0[1], v0[2], v0[3]), pk4_u8(v1[0], v1[1], v1[2], v1[3])};
                        unsigned char* gp = ws + OFF_PG + (size_t)(row0 + ai * 128 + m * 16) * 3072 + col0 + bj * 128;
                        if (nost) asm volatile("" :: "v"(pk)); else *(u32x2*)gp = pk; }
                    else { const u32x4 pk = pack8(v0, v1); if (nost) asm volatile("" :: "v"(pk)); else *(u32x4*)(rowp + bj * 128) = pk; } } }
    }
};
struct EpiMerge {
    static constexpr bool PERM = true, AFTER_DRAIN = false;
    static DI bool keep_acc(const Unit& u) { return u.br < 2; }
    unsigned char* ws; int nog;
    DI void operator()(f32x4 (&acc)[2][2][4][2], const Unit& u, int wr, int wc, int fr, int fq) const {
        const unsigned char* PG = ws + OFF_PG; bf16_t* M = (bf16_t*)(ws + OFF_M);
        const int row0 = u.rt * 256 + wr * 64 + fr, col0 = u.ct * 256 + wc * 32 + 8 * fq, br = u.br;
#pragma unroll
        for (int ai = 0; ai < 2; ++ai) {
            u32x2 gq[4][2], gnx[4][2];
#pragma unroll
            for (int m = 0; m < 4; ++m)
#pragma unroll
                for (int bj = 0; bj < 2; ++bj) { const size_t r = (size_t)(row0 + ai * 128 + m * 16); const int c = col0 + bj * 128;
                    gq[m][bj] = (u32x2){0x80808080u, 0x80808080u}; gnx[m][bj] = gq[m][bj];
                    if (!nog) { gq[m][bj] = *(const u32x2*)(PG + r * 3072 + br * 1024 + c); if (br < 2) gnx[m][bj] = *(const u32x2*)(PG + r * 3072 + (br + 1) * 1024 + c); } }
#pragma unroll
            for (int m = 0; m < 4; ++m)
#pragma unroll
                for (int bj = 0; bj < 2; ++bj) { const size_t r = (size_t)(row0 + ai * 128 + m * 16); const int c = col0 + bj * 128;
                    const u32x2 g = gq[m][bj], gn = gnx[m][bj];
                    float f[8];
#pragma unroll
                    for (int i = 0; i < 8; ++i) f[i] = (float)((g[i >> 2] >> (8 * (i & 3))) & 255u);
                    if (br < 2) {
#pragma unroll
                        for (int i = 0; i < 8; ++i) f[i] *= __builtin_amdgcn_rcpf((float)((gn[i >> 2] >> (8 * (i & 3))) & 255u)); }
                    else {
#pragma unroll
                        for (int i = 0; i < 8; ++i) f[i] *= (1.f / 255.f); }
                    f32x4& a0 = acc[ai][bj][m][0]; f32x4& a1 = acc[ai][bj][m][1];
#pragma unroll
                    for (int i = 0; i < 4; ++i) { a0[i] *= f[i]; a1[i] *= f[4 + i]; }
                    if (br == 2) *(u32x4*)(M + r * 1024 + c) = pack8(a0, a1); } }
    }
};
struct EpiOut {
    static constexpr bool PERM = false, AFTER_DRAIN = false;
    static DI bool keep_acc(const Unit&) { return false; }
    unsigned char* ws; int l; float scale;
    DI void operator()(const f32x4 (&acc)[2][2][4][2], const Unit& u, int wr, int wc, int fr, int fq) const {
        float* X = (float*)(ws + OFF_X); const float* MOD = (const float*)(ws + OFF_MOD) + (size_t)l * 5 * 6144;
        const int row0 = u.pm * 256 + wr * 64 + fr, col0 = u.pn * 256 + wc * 32 + 4 * fq;
#pragma unroll
        for (int ai = 0; ai < 2; ++ai)
#pragma unroll
            for (int mh = 0; mh < 2; ++mh) {
                f32x4 xv[2][4], gv[2][4];
#pragma unroll
                for (int mm = 0; mm < 2; ++mm) { const int r = row0 + ai * 128 + (2 * mh + mm) * 16; const int b = r / TT, s_ = r - b * TT; const int mi = s_ < NCTX ? 4 : b;
                    const float* g1 = MOD + mi * 6144 + 2 * 1024; const float* xr = X + (size_t)r * 1024;
#pragma unroll
                    for (int j = 0; j < 4; ++j) { const int c = col0 + (j >> 1) * 128 + (j & 1) * 16; gv[mm][j] = *(const f32x4*)(g1 + c); xv[mm][j] = *(const f32x4*)(xr + c); } }
#pragma unroll
                for (int mm = 0; mm < 2; ++mm) { const int m = 2 * mh + mm; const int r = row0 + ai * 128 + m * 16; float* xr = X + (size_t)r * 1024;
#pragma unroll
                    for (int j = 0; j < 4; ++j) { const int c = col0 + (j >> 1) * 128 + (j & 1) * 16; *(f32x4*)(xr + c) = xv[mm][j] + gv[mm][j] * acc[ai][j >> 1][m][j & 1] * scale; } }
            }
    }
};
struct EpiUp {
    static constexpr bool PERM = true, AFTER_DRAIN = false;
    static DI bool keep_acc(const Unit&) { return false; }
    unsigned char* ws;
    DI void operator()(const f32x4 (&acc)[2][2][4][2], const Unit& u, int, int, int, int) const {
        const int t_ = otid(), wid_ = t_ >> 6, wr = wid_ >> 2, wc = wid_ & 3, fr = t_ & 15, fq = (t_ >> 4) & 3;
        unsigned char* HID = ws + OFF_HID;
        const int row0 = u.pm * 256 + wr * 64 + fr, hc0 = u.ct * 128 + wc * 16 + fq * 4;
#pragma unroll
        for (int ai = 0; ai < 2; ++ai)
#pragma unroll
            for (int m = 0; m < 4; ++m) { unsigned char* rowp = HID + (size_t)(row0 + ai * 128 + m * 16) * 1024 + hc0;
#pragma unroll
                for (int bj = 0; bj < 2; ++bj) { const f32x4 a = acc[ai][bj][m][0] * (1.f / 32.f), b = acc[ai][bj][m][1] * (1.f / 32.f); f32x4 h;
#pragma unroll
                    for (int i = 0; i < 4; ++i) h[i] = a[i] * sigmoidf_(a[i]) * b[i];
                    *(unsigned*)(rowp + bj * 64) = pk4_fp8(h[0], h[1], h[2], h[3]); } }
    }
};
struct EpiDown {
    static constexpr bool PERM = true, AFTER_DRAIN = false;
    static DI bool keep_acc(const Unit&) { return false; }
    unsigned char* ws;
    DI void operator()(const f32x4 (&acc)[2][2][4][2], const Unit& u, int, int, int, int) const {
        const int t_ = otid(), wid_ = t_ >> 6, wr = wid_ >> 2, wc = wid_ & 3, fr = t_ & 15, fq = (t_ >> 4) & 3;
        bf16_t* O = (bf16_t*)(ws + OFF_OUT);
        const int row0 = u.pm * 256 + wr * 64 + fr, col0 = u.ct * 256 + wc * 32 + 8 * fq;
#pragma unroll
        for (int ai = 0; ai < 2; ++ai)
#pragma unroll
            for (int m = 0; m < 4; ++m) { bf16_t* rowp = O + (size_t)(row0 + ai * 128 + m * 16) * 1024 + col0;
#pragma unroll
                for (int bj = 0; bj < 2; ++bj) *(u32x4*)(rowp + bj * 128) = pack8(acc[ai][bj][m][0] * (1.f / 32.f), acc[ai][bj][m][1] * (1.f / 32.f)); }
    }
};
DI int row_mod(int r) { const int b = r / TT, s = r - b * TT; return s < NCTX ? 4 : b; }

__device__ void ph_prologue(const Params& p, LAS unsigned char* lds, int wg, int nwg) {
    const int tid = otid();
    if (wg == 0 && tid < 16) {
        float* COS = (float*)(p.ws + OFF_ROPE); float* SIN = COS + 2048;
        const int k = tid; const int q4 = k & 3, dec = k >> 2;
        double th = (q4 == 0) ? 1.0 : (q4 == 1 ? 0.56234132519034908 : (q4 == 2 ? 0.31622776601683794 : 0.17782794100389228));
        for (int i = 0; i < dec; ++i) th *= 0.1;
        double ct = 1.0, st = th, term_c = 1.0, term_s = th; const double t2 = th * th;
        for (int n = 1; n <= 12; ++n) { term_c *= -t2 / (double)((2 * n - 1) * (2 * n)); term_s *= -t2 / (double)((2 * n) * (2 * n + 1)); ct += term_c; st += term_s; }
        double cp = 1.0, sp = 0.0;
        for (int pos = 0; pos < 128; ++pos) { COS[pos * 16 + k] = (float)cp; SIN[pos * 16 + k] = (float)sp; const double c2 = cp * ct - sp * st, s2 = sp * ct + cp * st; cp = c2; sp = s2; }
    }
    {
        LAS float* sc = (LAS float*)lds;
        LAS float* red = sc + 5 * 1024;
        float* MOD = (float*)(p.ws + OFF_MOD);
        for (int i = tid; i < 5 * 1024; i += 512) { const int m = i >> 10, k = i & 1023; const float v = (m < 4) ? p.c[m * 1024 + k] : p.c_ctx[k]; sc[i] = v * sigmoidf_(v); }
        __syncthreads();
        for (int u = wg; u < NL * 48; u += nwg) {
            const int l = u / 48, cb = u % 48; const int cl = tid & 127, col = cb * 128 + cl, kq = tid >> 7;
            const float* W = p.ada_w + (size_t)l * 1024 * 6144 + col;
            float a0 = 0, a1 = 0, a2 = 0, a3 = 0, a4 = 0;
#pragma unroll 1
            for (int k0 = kq * 256; k0 < kq * 256 + 256; k0 += 16) { float wv[16];
#pragma unroll
                for (int j = 0; j < 16; ++j) wv[j] = W[(size_t)(k0 + j) * 6144];
#pragma unroll
                for (int j = 0; j < 16; ++j) { const int k = k0 + j; const float w = wv[j]; a0 += sc[k] * w; a1 += sc[1024 + k] * w; a2 += sc[2048 + k] * w; a3 += sc[3072 + k] * w; a4 += sc[4096 + k] * w; } }
            red[(kq * 5 + 0) * 128 + cl] = a0; red[(kq * 5 + 1) * 128 + cl] = a1; red[(kq * 5 + 2) * 128 + cl] = a2; red[(kq * 5 + 3) * 128 + cl] = a3; red[(kq * 5 + 4) * 128 + cl] = a4;
            __syncthreads();
            if (tid < 128) { const float bb = p.ada_b[l * 6144 + col];
                for (int m = 0; m < 5; ++m) { const float s = red[(0 * 5 + m) * 128 + cl] + red[(1 * 5 + m) * 128 + cl] + red[(2 * 5 + m) * 128 + cl] + red[(3 * 5 + m) * 128 + cl];
                    MOD[((size_t)(l * 5 + m)) * 6144 + col] = s + bb; } }
            __syncthreads();
        }
    }
}

template <class RowMap> DI void tconv_tile(const float* src, int ldn, int k0, int n0, bf16_t* dst, int K, RowMap rm, LAS float* tile  , int tid) {
#pragma unroll
    for (int i = 0; i < 8; ++i) { const int k = (tid >> 6) + 8 * i, n = tid & 63; tile[k * 65 + n] = src[(size_t)(k0 + k) * ldn + n0 + n]; }
    __syncthreads();
    const int n = tid >> 3, k8 = (tid & 7) * 8; float v[8];
#pragma unroll
    for (int j = 0; j < 8; ++j) v[j] = tile[(k8 + j) * 65 + n];
    u32x4 w = {pk2(v[0], v[1]), pk2(v[2], v[3]), pk2(v[4], v[5]), pk2(v[6], v[7])};
    *(u32x4*)(dst + (size_t)rm(n0 + n) * K + k0 + k8) = w;
    __syncthreads();
}
template <class RowMap> DI void tconv_tile_f8(const float* src, int ldn, int k0, int n0, unsigned char* dst, int K, RowMap rm, float scale, LAS float* tile  , int tid) {
#pragma unroll
    for (int i = 0; i < 8; ++i) { const int k = (tid >> 6) + 8 * i, n = tid & 63; tile[k * 65 + n] = src[(size_t)(k0 + k) * ldn + n0 + n]; }
    __syncthreads();
    const int n = tid >> 3, k8 = (tid & 7) * 8; float v[8];
#pragma unroll
    for (int j = 0; j < 8; ++j) v[j] = tile[(k8 + j) * 65 + n] * scale;
    u32x2 w = {pk4_fp8(v[0], v[1], v[2], v[3]), pk4_fp8(v[4], v[5], v[6], v[7])};
    *(u32x2*)(dst + (size_t)rm(n0 + n) * K + k0 + k8) = w;
    __syncthreads();
}
struct RowId { DI int operator()(int n) const { return n; } };
struct RowW13 { int sel; DI int operator()(int j) const { return (j >> 7) * 256 + ((j & 127) >> 2) * 8 + sel * 4 + (j & 3); } };

DI void tblk_load(const float* src, int ldn, int k0, int n0, int tid, f32x4 (&v)[8]) {
    const float* s = src + (size_t)(k0 + 4 * (tid >> 5)) * ldn + n0 + 4 * (tid & 31);
#pragma unroll
    for (int i = 0; i < 2; ++i)
#pragma unroll
        for (int j = 0; j < 4; ++j) v[i * 4 + j] = *(const f32x4*)(s + (size_t)(64 * i + j) * ldn);
}
template <int OB> DI void tblk_to_lds(const f32x4 (&v)[8], float scale, LAS unsigned char* tile, int tid) {
    constexpr int S = 128 * OB + 8; const int c4 = tid & 31, r = tid >> 5;
#pragma unroll
    for (int i = 0; i < 2; ++i) {
        const f32x4 f0 = v[i * 4 + 0], f1 = v[i * 4 + 1], f2 = v[i * 4 + 2], f3 = v[i * 4 + 3];
#pragma unroll
        for (int jn = 0; jn < 4; ++jn) { LAS unsigned char* d = tile + (4 * c4 + jn) * S + (4 * r + 64 * i) * OB;
            if constexpr (OB == 1) *(LAS unsigned*)d = pk4_fp8(f0[jn] * scale, f1[jn] * scale, f2[jn] * scale, f3[jn] * scale);
            else *(LAS u32x2*)d = (u32x2){pk2(f0[jn], f1[jn]), pk2(f2[jn], f3[jn])}; }
    }
}
template <int OB, class RowMap> DI void tblk_from_lds(const LAS unsigned char* tile, unsigned char* dst, int Kb, int k0, int n0, RowMap rm, int tid) {
    constexpr int S = 128 * OB + 8; const int n = tid >> 2, q = tid & 3;
    const LAS unsigned char* t = tile + n * S + q * 32 * OB; unsigned char* d = dst + (size_t)rm(n0 + n) * Kb + k0 * OB + q * 32 * OB;
#pragma unroll
    for (int j = 0; j < 2 * OB; ++j) { const u32x2 a = *(const LAS u32x2*)(t + 16 * j), c = *(const LAS u32x2*)(t + 16 * j + 8); *(u32x4*)(d + 16 * j) = (u32x4){a[0], a[1], c[0], c[1]}; }
}
template <int OB, class RowMap> DI void tblk_unit(const float* src, int ldn, int k0, int n0, unsigned char* dst, int Kb, RowMap rm, float scale, LAS unsigned char* tile, int tid) {
    f32x4 v[8]; tblk_load(src, ldn, k0, n0, tid, v); tblk_to_lds<OB>(v, scale, tile, tid);
    __syncthreads();
    tblk_from_lds<OB>(tile, dst, Kb, k0, n0, rm, tid);
    __syncthreads();
}
DI float max_hi3(float v) {
    v = fmaxf(v, dppmov<0x128>(v));
    { auto r = __builtin_amdgcn_permlane16_swap(__float_as_uint(v), __float_as_uint(v), false, false); v = fmaxf(__uint_as_float(r[0]), __uint_as_float(r[1])); }
    { auto r = __builtin_amdgcn_permlane32_swap(__float_as_uint(v), __float_as_uint(v), false, false); v = fmaxf(__uint_as_float(r[0]), __uint_as_float(r[1])); } return v; }
DI void win_strip(const float* src, float* SW, unsigned char* dst, int n0, LAS unsigned char* tile, int tid) {
    constexpr int S = 1024 + 8; const int c4 = tid & 7, r = tid >> 3; LAS float* red = (LAS float*)(tile + 32 * S);
    f32x4 v[16]; const float* s = src + (size_t)(4 * r) * NIN + n0 + 4 * c4;
#pragma unroll
    for (int i = 0; i < 4; ++i)
#pragma unroll
        for (int j = 0; j < 4; ++j) v[i * 4 + j] = *(const f32x4*)(s + (size_t)(256 * i + j) * NIN);
    float am[4] = {0.f, 0.f, 0.f, 0.f};
#pragma unroll
    for (int i = 0; i < 16; ++i) { am[0] = fmaxf(am[0], fabsf(v[i][0])); am[1] = fmaxf(am[1], fabsf(v[i][1])); am[2] = fmaxf(am[2], fabsf(v[i][2])); am[3] = fmaxf(am[3], fabsf(v[i][3])); }
#pragma unroll
    for (int j = 0; j < 4; ++j) am[j] = max_hi3(am[j]);
    if ((tid & 63) < 8) *(LAS f32x4*)(red + (tid >> 6) * 32 + 4 * c4) = (f32x4){am[0], am[1], am[2], am[3]};
    __syncthreads();
    float inv[4];
#pragma unroll
    for (int j = 0; j < 4; ++j) { float m = red[4 * c4 + j];
#pragma unroll
        for (int w = 1; w < 8; ++w) m = fmaxf(m, red[w * 32 + 4 * c4 + j]);
        m = fmaxf(m, 1e-20f); inv[j] = 127.f / m; if (r == 0) SW[n0 + 4 * c4 + j] = m * (1.f / 127.f); }
#pragma unroll
    for (int i = 0; i < 4; ++i) {
        const f32x4 f0 = v[i * 4 + 0], f1 = v[i * 4 + 1], f2 = v[i * 4 + 2], f3 = v[i * 4 + 3];
#pragma unroll
        for (int jn = 0; jn < 4; ++jn) *(LAS unsigned*)(tile + (4 * c4 + jn) * S + 4 * r + 256 * i) = pk4_i8(f0[jn] * inv[jn], f1[jn] * inv[jn], f2[jn] * inv[jn], f3[jn] * inv[jn]);
    }
    __syncthreads();
    {   const int n = tid >> 4, q = tid & 15; const LAS unsigned char* t = tile + n * S + q * 64; unsigned char* d = dst + (size_t)(n0 + n) * 1024 + q * 64;
#pragma unroll
        for (int j = 0; j < 4; ++j) { const u32x2 a = *(const LAS u32x2*)(t + 16 * j), c = *(const LAS u32x2*)(t + 16 * j + 8); *(u32x4*)(d + 16 * j) = (u32x4){a[0], a[1], c[0], c[1]}; } }
    __syncthreads();
}

__device__ void conv_mixer_a(const Params& p, int l, LAS unsigned char* lds) {
    LAS float* tile = (LAS float*)lds; LAS unsigned* bc = (LAS unsigned*)(lds + 36864); const int tid = otid();
    unsigned* ctr = (unsigned*)(p.ws + OFF_CTR) + (48 + l) * 64;
    constexpr int U_IN = 248, U_LR = 48;
    for (;;) {
        if (tid == 0) *bc = atomicAdd(ctr, 1u);
        __syncthreads();
        const int u = (int)*bc;
        __syncthreads();
        if (u >= U_IN + U_LR) break;
        if (u < U_IN) win_strip(p.w_in + (size_t)l * 1024 * NIN, (float*)(p.ws + OFF_SW), p.ws + OFF_WIN, u * 32, lds, tid);
        else { const int v = u - U_IN; bf16_t* LRW = (bf16_t*)(p.ws + OFF_LRW);
            if (v < 32) { const int mi = v >> 3, nt = v & 7; const float* src = (mi < 2 ? p.rwkv_w_up : p.rwkv_a_up) + ((size_t)(l * 2 + (mi & 1)) * 64) * 512;
                tconv_tile(src, 512, 0, nt * 64, LRW + (size_t)mi * 512 * 64, 64, RowId(), tile, tid); }
            else { const int w = v - 32, kt = w >> 3, nt = w & 7;
                tconv_tile(p.rwkv_g_up + (size_t)l * 128 * 512, 512, kt * 64, nt * 64, LRW + (size_t)4 * 512 * 64, 128, RowId(), tile, tid); } }
    }
}
__device__ void conv_mixer_b(const Params& p, int l, LAS unsigned char* lds, int wg, int nwg) {
    const int tid = otid();
    constexpr int U_BR = 3 * 4 * 8, U_OUT = 64;
    for (int u = wg; u < U_BR + U_OUT; u += nwg) {
        if (u < U_BR) { const int i = u / 32, kt = (u % 32) / 8, nt = u % 8;
            tblk_unit<2>(p.w_branch + ((size_t)(l * 3 + i)) * 512 * 1024, 1024, kt * 128, nt * 128, p.ws + OFF_WBR + (size_t)i * 1024 * 512 * 2, 512 * 2, RowId(), 1.f, lds, tid); }
        else { const int v = u - U_BR, kt = v / 8, nt = v % 8;
            tblk_unit<2>(p.w_out + (size_t)l * 1024 * 1024, 1024, kt * 128, nt * 128, p.ws + OFF_WOUT, 1024 * 2, RowId(), 1.f, lds, tid); }
    }
}
__device__ void conv_expert_weights(const Params& p, int l, LAS unsigned char* lds, int qofs = 16) {
    LAS unsigned* bc = (LAS unsigned*)(lds + 128 * 136); const int tid = otid();
    unsigned* ctr = (unsigned*)(p.ws + OFF_CTR) + (qofs + l) * 64;
    constexpr int NU = 16 * 3 * 64;
    const float* w1 = p.exp_w1 + (size_t)l * 16 * 1024 * 1024; const float* w3 = p.exp_w3 + (size_t)l * 16 * 1024 * 1024; const float* w2 = p.exp_w2 + (size_t)l * 16 * 1024 * 1024;
#define EXP_SRC(u_) (((((u_) % 192) >> 6) == 0 ? w1 : ((((u_) % 192) >> 6) == 1 ? w3 : w2)) + (size_t)((u_) / 192) * 1024 * 1024)
#define EXP_K0(u_) (((((u_) % 192) >> 3) & 7) * 128)
#define EXP_N0(u_) ((((u_) % 192) & 7) * 128)
    if (tid == 0) *bc = atomicAdd(ctr, 1u);
    __syncthreads();
    int u = (int)*bc;
    __syncthreads();
    if (u >= NU) return;
    f32x4 v[8]; tblk_load(EXP_SRC(u), 1024, EXP_K0(u), EXP_N0(u), tid, v);
    for (;;) {
        if (tid == 0) *bc = atomicAdd(ctr, 1u);
        tblk_to_lds<1>(v, 32.f, lds, tid);
        __syncthreads();
        const int un = (int)*bc;
        if (un < NU) tblk_load(EXP_SRC(un), 1024, EXP_K0(un), EXP_N0(un), tid, v);
        {   const int e = u / 192, w = u % 192, which = w >> 6, k0 = ((w >> 3) & 7) * 128, n0 = (w & 7) * 128;
            if (which == 0) tblk_from_lds<1>(lds, p.ws + OFF_W13 + (size_t)e * 2048 * 1024, 1024, k0, n0, RowW13{0}, tid);
            else if (which == 1) tblk_from_lds<1>(lds, p.ws + OFF_W13 + (size_t)e * 2048 * 1024, 1024, k0, n0, RowW13{1}, tid);
            else tblk_from_lds<1>(lds, p.ws + OFF_W2 + (size_t)e * 1024 * 1024, 1024, k0, n0, RowId(), tid); }
        __syncthreads();
        if (un >= NU) break;
        u = un;
    }
#undef EXP_SRC
#undef EXP_K0
#undef EXP_N0
}

__device__ void norm1_rows(const Params& p, int l, int wg, int nwg) {
    const int tid = otid(), wave = tid >> 6, lane = tid & 63;
    float* X = (float*)(p.ws + OFF_X); bf16_t* H = (bf16_t*)(p.ws + OFF_H);
    const float* MOD = (const float*)(p.ws + OFF_MOD) + (size_t)l * 5 * 6144; const float* g = p.norm1_g + l * 1024;
    for (int r = wg * 8 + wave; r < RR; r += nwg * 8) {
        const int b_ = r / TT, s_ = r - b_ * TT;
        const float4* xr = (s_ < NCTX) ? (const float4*)(p.ctx + ((size_t)(b_ * NCTX + s_)) * DM) : (const float4*)(p.x + ((size_t)(b_ * SEQ + s_ - NCTX)) * DM); float4* xw = (float4*)(X + (size_t)r * 1024); float4 v[4]; float ss = 0.f;
#pragma unroll
        for (int i = 0; i < 4; ++i) v[i] = xr[lane + 64 * i];
#pragma unroll
        for (int i = 0; i < 4; ++i) { xw[lane + 64 * i] = v[i]; ss += v[i].x * v[i].x + v[i].y * v[i].y + v[i].z * v[i].z + v[i].w * v[i].w; }
        ss = wave_sum(ss);
        const float rinv = rsqrtf(ss * (1.f / 1024.f) + 1e-6f);
        const float* md = MOD + row_mod(r) * 6144;
        float y[16]; float am = 0.f;
#pragma unroll
        for (int i = 0; i < 4; ++i) { const int col = (lane + 64 * i) * 4;
            const float4 gg = *(const float4*)(g + col), sh = *(const float4*)(md + col), sc = *(const float4*)(md + 1024 + col);
            y[4 * i] = v[i].x * rinv * gg.x * (1.f + sc.x) + sh.x; y[4 * i + 1] = v[i].y * rinv * gg.y * (1.f + sc.y) + sh.y; y[4 * i + 2] = v[i].z * rinv * gg.z * (1.f + sc.z) + sh.z; y[4 * i + 3] = v[i].w * rinv * gg.w * (1.f + sc.w) + sh.w;
#pragma unroll
            for (int j = 0; j < 4; ++j) am = fmaxf(am, fabsf(y[4 * i + j])); }
        am = fmaxf(wave_max(am), 1e-20f); const float inv = 127.f / am;
        if (lane == 0) ((float*)(p.ws + OFF_SH))[r] = am * (1.f / 127.f);
#pragma unroll
        for (int i = 0; i < 4; ++i) *(unsigned*)((unsigned char*)H + (size_t)r * 1024 + (lane + 64 * i) * 4) = pk4_i8(y[4 * i] * inv, y[4 * i + 1] * inv, y[4 * i + 2] * inv, y[4 * i + 3] * inv);
    }
}
#define MFMA16(a, b, c) __builtin_amdgcn_mfma_f32_16x16x32_bf16((a), (b), (c), 0, 0, 0)
DI float tanh_fast(float x) { return 1.f - 2.f * __builtin_amdgcn_rcpf(1.f + __expf(2.f * x)); }
DI void unpack4(const u32x2 w, float (&o)[4]) { o[0] = bflo(w[0]); o[1] = bfhi(w[0]); o[2] = bflo(w[1]); o[3] = bfhi(w[1]); }
DI void prep_rows_unit(const Params& p, int l, LAS unsigned char* lds, int ub, int dup) {
    const int tid = otid(), wave = tid >> 6, lane = tid & 63, c16 = lane & 15, rq = lane >> 4;
    const int r0 = ub * 16; const int b = r0 / TT, s0 = r0 - b * TT;
    const bool isctx = s0 < NCTX; const int seg_lo = isctx ? 0 : NCTX, seg_hi = isctx ? NCTX : TT;
    const bool has_prev = s0 > seg_lo, has_next = (s0 + 16) < seg_hi;
    bf16_t* PA = (bf16_t*)(p.ws + OFF_PA); const bf16_t* PR = (const bf16_t*)(p.ws + OFF_PR); const bf16_t* PC = (const bf16_t*)(p.ws + OFF_PC);
    const int col0 = wave * 64 + c16 * 4, rb = r0 + 4 * rq;
    const bool pv = (rq > 0) || has_prev, nv = (rq < 3) || has_next;
    u32x2 rawc[3][6], rawu[2][6], rawbg[4]; u32x4 rawlr[8], rawqk[4];
#pragma unroll
    for (int g = 0; g < 3; ++g)
#pragma unroll
        for (int j = 0; j < 6; ++j) { const bool ok = (j == 0) ? pv : ((j == 5) ? nv : true); rawc[g][j] = (u32x2){0u, 0u}; if (ok) rawc[g][j] = *(const u32x2*)(PR + (size_t)(rb - 1 + j) * 1792 + g * 512 + col0); }
    {   const bf16_t* lr = PR + (size_t)(r0 + c16) * 1792 + 1536 + 8 * rq;
#pragma unroll
        for (int i = 0; i < 8; ++i) rawlr[i] = *(const u32x4*)(lr + 32 * i); }
#pragma unroll
    for (int j = 0; j < 6; ++j) { const bool ok = (j == 0) ? pv : ((j == 5) ? nv : true); rawu[0][j] = (u32x2){0u, 0u}; rawu[1][j] = (u32x2){0u, 0u};
        if (ok) { rawu[0][j] = *(const u32x2*)(PC + (size_t)(rb - 1 + j) * 1536 + 512 + col0); rawu[1][j] = *(const u32x2*)(PC + (size_t)(rb - 1 + j) * 1536 + 1024 + col0); } }
#pragma unroll
    for (int i = 0; i < 4; ++i) rawbg[i] = *(const u32x2*)(PC + (size_t)(rb + i) * 1536 + col0);
    bf16_t* qkbase = PA + (size_t)(r0 + (tid >> 5)) * 1536 + ((tid & 31) >> 1) * 64 + 16 * (tid & 1);
    if (!dup) { rawqk[0] = *(const u32x4*)qkbase; rawqk[1] = *(const u32x4*)(qkbase + 8); rawqk[2] = *(const u32x4*)(qkbase + 32); rawqk[3] = *(const u32x4*)(qkbase + 40); }
    __builtin_amdgcn_sched_barrier(0);
    float rc[4][4], kc[4][4], vc[4][4];
    {   const float* cw = p.rwkv_conv_w + (size_t)l * 3 * 1536;
#pragma unroll
        for (int g = 0; g < 3; ++g) {
            const int co = g * 512 + col0; const f32x4 w0 = *(const f32x4*)(cw + co), w1 = *(const f32x4*)(cw + 1536 + co), w2 = *(const f32x4*)(cw + 3072 + co);
            float x[6][4];
#pragma unroll
            for (int j = 0; j < 6; ++j) unpack4(rawc[g][j], x[j]);
#pragma unroll
            for (int i = 0; i < 4; ++i)
#pragma unroll
                for (int c = 0; c < 4; ++c) { const float o = w0[c] * x[i][c] + w1[c] * x[i + 1][c] + w2[c] * x[i + 2][c]; if (g == 0) rc[i][c] = o; else if (g == 1) kc[i][c] = o; else vc[i][c] = o; }
        } }
    bf16_t* EW = (bf16_t*)(p.ws + OFF_EW); bf16_t* AA = (bf16_t*)(p.ws + OFF_AA);
    bf16_t* KK = (bf16_t*)(p.ws + OFF_KK); bf16_t* KC = (bf16_t*)(p.ws + OFF_KC); bf16_t* RC = (bf16_t*)(p.ws + OFF_RC); bf16_t* VC = (bf16_t*)(p.ws + OFF_VC);
    {   const f32x4 kkc = *(const f32x4*)(p.rwkv_k_k + l * 512 + col0);
#pragma unroll
        for (int i = 0; i < 4; ++i) { float q[4]; float ss = 0.f;
#pragma unroll
            for (int c = 0; c < 4; ++c) { q[c] = kc[i][c] * kkc[c]; ss += q[c] * q[c]; }
            ss = allsum16(ss); const float rn = 1.f / fmaxf(sqrtf(ss), 1e-12f);
            const size_t o = (size_t)(rb + i) * 512 + col0;
            u32x2 w; w[0] = pk2(q[0] * rn, q[1] * rn); w[1] = pk2(q[2] * rn, q[3] * rn); *(u32x2*)(KK + o) = w;
            w[0] = pk2(kc[i][0], kc[i][1]); w[1] = pk2(kc[i][2], kc[i][3]); *(u32x2*)(KC + o) = w;
            w[0] = pk2(rc[i][0], rc[i][1]); w[1] = pk2(rc[i][2], rc[i][3]); *(u32x2*)(RC + o) = w;
            w[0] = pk2(vc[i][0], vc[i][1]); w[1] = pk2(vc[i][2], vc[i][3]); *(u32x2*)(VC + o) = w; } }
    bf16x8 twf[2], alf[2], sgf[4];
    {
#pragma unroll
        for (int ks = 0; ks < 2; ++ks) { const u32x4 v = rawlr[ks]; u32x4 t;
#pragma unroll
            for (int i = 0; i < 4; ++i) t[i] = pk2(tanh_fast(bflo(v[i])), tanh_fast(bfhi(v[i])));
            twf[ks] = __builtin_bit_cast(bf16x8, t); alf[ks] = __builtin_bit_cast(bf16x8, rawlr[2 + ks]); }
#pragma unroll
        for (int ks = 0; ks < 4; ++ks) { const u32x4 v = rawlr[4 + ks]; u32x4 t;
#pragma unroll
            for (int i = 0; i < 4; ++i) t[i] = pk2(sigmoidf_(bflo(v[i])), sigmoidf_(bfhi(v[i])));
            sgf[ks] = __builtin_bit_cast(bf16x8, t); } }
    const bf16_t* LRW = (const bf16_t*)(p.ws + OFF_LRW);
    float bon[4] = {0.f, 0.f, 0.f, 0.f};
    const f32x4 kac = *(const f32x4*)(p.rwkv_k_a + l * 512 + col0), rkc = *(const f32x4*)(p.rwkv_r_k + l * 512 + col0);
#pragma unroll 1
    for (int d = 0; d < 2; ++d) {
        f32x4 wa[4], aa[4];
#pragma unroll
        for (int cb = 0; cb < 4; ++cb) { wa[cb] = (f32x4){0.f, 0.f, 0.f, 0.f}; aa[cb] = (f32x4){0.f, 0.f, 0.f, 0.f};
            const bf16_t* bw = LRW + ((size_t)d * 512 + col0 + cb) * 64 + 8 * rq; const bf16_t* ba = bw + (size_t)2 * 512 * 64;
#pragma unroll
            for (int ks = 0; ks < 2; ++ks) { wa[cb] = MFMA16(twf[ks], *(const bf16x8*)(bw + 32 * ks), wa[cb]); aa[cb] = MFMA16(alf[ks], *(const bf16x8*)(ba + 32 * ks), aa[cb]); } }
        const f32x4 w0c = *(const f32x4*)(p.rwkv_w0 + (l * 2 + d) * 512 + col0), a0c = *(const f32x4*)(p.rwkv_a0 + (l * 2 + d) * 512 + col0);
#pragma unroll
        for (int i = 0; i < 4; ++i) { float e[4], a[4]; float bs = 0.f;
#pragma unroll
            for (int c = 0; c < 4; ++c) { const float z = w0c[c] + wa[c][i];
                const float sp = fmaxf(-z, 0.f) + __logf(1.f + __expf(-fabsf(z)));
                e[c] = __expf(-sp - 0.5f);
                a[c] = sigmoidf_(a0c[c] + aa[c][i]);
                const float kd = kc[i][c] * (1.f + (a[c] - 1.f) * kac[c]); bs += rc[i][c] * kd * rkc[c]; }
            bon[i] += allsum16(bs);
            const size_t o = (size_t)d * RR * 512 + (size_t)(rb + i) * 512 + col0;
            u32x2 w; w[0] = pk2(e[0], e[1]); w[1] = pk2(e[2], e[3]); *(u32x2*)(EW + o) = w;
            w[0] = pk2(a[0], a[1]); w[1] = pk2(a[2], a[3]); *(u32x2*)(AA + o) = w; }
    }
    {
        f32x4 ga[4];
#pragma unroll
        for (int cb = 0; cb < 4; ++cb) { ga[cb] = (f32x4){0.f, 0.f, 0.f, 0.f}; const bf16_t* bg = LRW + (size_t)4 * 512 * 64 + ((size_t)col0 + cb) * 128 + 8 * rq;
#pragma unroll
            for (int ks = 0; ks < 4; ++ks) ga[cb] = MFMA16(sgf[ks], *(const bf16x8*)(bg + 32 * ks), ga[cb]); }
        bf16_t* G = (bf16_t*)(p.ws + OFF_G); bf16_t* YB0 = (bf16_t*)(p.ws + OFF_YB0); const f32x4 lnb = *(const f32x4*)(p.rwkv_ln_b + l * 512 + col0);
#pragma unroll
        for (int i = 0; i < 4; ++i) { const size_t o = (size_t)(rb + i) * 512 + col0;
            u32x2 w; w[0] = pk2(ga[0][i], ga[1][i]); w[1] = pk2(ga[2][i], ga[3][i]); *(u32x2*)(G + o) = w;
            w[0] = pk2(2.f * lnb[0] + bon[i] * vc[i][0], 2.f * lnb[1] + bon[i] * vc[i][1]); w[1] = pk2(2.f * lnb[2] + bon[i] * vc[i][2], 2.f * lnb[3] + bon[i] * vc[i][3]); *(u32x2*)(YB0 + o) = w; }
    }
    {
        const float* cw = p.conv_w + (size_t)l * 3 * 512; const f32x4 c0 = *(const f32x4*)(cw + col0), c1 = *(const f32x4*)(cw + 512 + col0), c2 = *(const f32x4*)(cw + 1024 + col0);
        float uu[6][4];
#pragma unroll
        for (int j = 0; j < 6; ++j) { float fa[4], fc[4]; unpack4(rawu[0][j], fa); unpack4(rawu[1][j], fc);
#pragma unroll
            for (int q = 0; q < 4; ++q) uu[j][q] = fa[q] * fc[q]; }
        bf16_t* YC = (bf16_t*)(p.ws + OFF_YC);
#pragma unroll
        for (int i = 0; i < 4; ++i) { float bg[4]; unpack4(rawbg[i], bg); float o[4];
#pragma unroll
            for (int q = 0; q < 4; ++q) o[q] = bg[q] * (c0[q] * uu[i][q] + c1[q] * uu[i + 1][q] + c2[q] * uu[i + 2][q]);
            u32x2 w = {pk2(o[0], o[1]), pk2(o[2], o[3])}; *(u32x2*)(YC + (size_t)(rb + i) * 512 + col0) = w; }
    }
    if (!dup) {   const int rr = tid >> 5, g16 = (tid & 31) >> 1, hf = tid & 1; const int s = s0 + rr;
        bf16_t* base = qkbase;
        const u32x4 a0 = rawqk[0], a1 = rawqk[1], b0 = rawqk[2], b1 = rawqk[3];
        float x1[16], x2[16];
#pragma unroll
        for (int i = 0; i < 4; ++i) { x1[2 * i] = bflo(a0[i]); x1[2 * i + 1] = bfhi(a0[i]); x1[8 + 2 * i] = bflo(a1[i]); x1[9 + 2 * i] = bfhi(a1[i]);
            x2[2 * i] = bflo(b0[i]); x2[2 * i + 1] = bfhi(b0[i]); x2[8 + 2 * i] = bflo(b1[i]); x2[9 + 2 * i] = bfhi(b1[i]); }
        float ss = 0.f;
#pragma unroll
        for (int j = 0; j < 16; ++j) ss += x1[j] * x1[j] + x2[j] * x2[j];
        ss += dppmov<0xB1>(ss);
        const float rinv = rsqrtf(ss * (1.f / 64.f) + 1e-6f);
        const float* gg = (g16 < 8 ? p.q_norm_g : p.k_norm_g) + l * 64; const float qs = g16 < 8 ? 0.125f * 1.4426950408889634f : 1.f;
        const float* COS = (const float*)(p.ws + OFF_ROPE); const float* SIN = COS + 2048;
        const int tl = s - NCTX; const int pos = isctx ? 0 : (hf == 0 ? (tl >> 6) : (tl & 63));
#pragma unroll
        for (int j = 0; j < 16; ++j) { const float y1 = x1[j] * rinv * gg[16 * hf + j], y2 = x2[j] * rinv * gg[32 + 16 * hf + j];
            float o1 = y1, o2 = y2;
            if (!isctx) { const float c = COS[pos * 16 + j], sn = SIN[pos * 16 + j]; o1 = y1 * c - y2 * sn; o2 = y2 * c + y1 * sn; }
            x1[j] = o1 * qs; x2[j] = o2 * qs; }
        u32x4 w0, w1, w2, w3;
#pragma unroll
        for (int i = 0; i < 4; ++i) { w0[i] = pk2(x1[2 * i], x1[2 * i + 1]); w1[i] = pk2(x1[8 + 2 * i], x1[9 + 2 * i]); w2[i] = pk2(x2[2 * i], x2[2 * i + 1]); w3[i] = pk2(x2[8 + 2 * i], x2[9 + 2 * i]); }
        *(u32x4*)base = w0; *(u32x4*)(base + 8) = w1; *(u32x4*)(base + 32) = w2; *(u32x4*)(base + 40) = w3;
    }
}
DI void prep_vt_unit(const Params& p, LAS unsigned char* lds, int uv) {
    const int tid = otid(); const int b = uv / 132, tb = uv % 132;
    const bf16_t* PA = (const bf16_t*)(p.ws + OFF_PA); bf16_t* VT = (bf16_t*)(p.ws + OFF_VT);
    LAS unsigned char* img = lds;
#pragma unroll
    for (int i = 0; i < 8; ++i) { const int id = tid + 512 * i, row = id >> 6, ch = id & 63;
        const u32x4 v = *(const u32x4*)(PA + (size_t)(b * TT + tb * 64 + row) * 1536 + 1024 + ch * 8); *(LAS u32x4*)(img + row * 1040 + ch * 16) = v; }
    __syncthreads();
    bf16_t* dst = VT + ((size_t)(b * 512 + tid)) * TT + tb * 64;
#pragma unroll
    for (int g = 0; g < 4; ++g) { unsigned w[8];
#pragma unroll
        for (int q = 0; q < 8; ++q) { const int p0 = 2 * q, p1 = 2 * q + 1;
            const int k0 = 16 * g + (p0 & 3) + 8 * ((p0 >> 2) & 1) + 4 * (p0 >> 3), k1 = 16 * g + (p1 & 3) + 8 * ((p1 >> 2) & 1) + 4 * (p1 >> 3);
            const unsigned lo = *(const LAS unsigned short*)(img + k0 * 1040 + tid * 2), hi = *(const LAS unsigned short*)(img + k1 * 1040 + tid * 2); w[q] = lo | (hi << 16); }
        u32x4 wa = {w[0], w[1], w[2], w[3]}, wb = {w[4], w[5], w[6], w[7]};
        *(u32x4*)(dst + 16 * g) = wa; *(u32x4*)(dst + 16 * g + 8) = wb; }
    __syncthreads();
}
__device__ void ph_prep(const Params& p, int l, LAS unsigned char* lds, int wg, int nwg, int dup) {
    for (int u = wg; u < 528; u += nwg) prep_vt_unit(p, lds, u);
    for (int u = wg; u < RR / 16; u += nwg) prep_rows_unit(p, l, lds, u, dup);
}
#define MFMA32(a, b, c) __builtin_amdgcn_mfma_f32_32x32x16_bf16((a), (b), (c), 0, 0, 0)
DI bf16x8 pack_p(const f32x16& x, int s) {
    u32x4 w = {pk2(x[8 * s + 0], x[8 * s + 1]), pk2(x[8 * s + 2], x[8 * s + 3]), pk2(x[8 * s + 4], x[8 * s + 5]), pk2(x[8 * s + 6], x[8 * s + 7])};
    return __builtin_bit_cast(bf16x8, w);
}
#define SCHED_FENCE() __builtin_amdgcn_sched_barrier(0)
DI void lds_barrier() { asm volatile("s_waitcnt lgkmcnt(0)" ::: "memory"); __builtin_amdgcn_s_barrier(); asm volatile("" ::: "memory"); }
DI void attn_qk(const LAS unsigned char* Kc, const int (&coff)[4], const bf16x8 (&qf)[4], f32x16& s0, f32x16& s1) {
    bf16x8 kf[4], kg[4];
#pragma unroll
    for (int ks = 0; ks < 4; ++ks) kf[ks] = *(const LAS bf16x8*)(Kc + coff[ks]);
#pragma unroll
    for (int j = 0; j < 16; ++j) { s0[j] = 0.f; s1[j] = 0.f; }
#pragma unroll
    for (int ks = 0; ks < 4; ++ks) kg[ks] = *(const LAS bf16x8*)(Kc + 4096 + coff[ks]);
#pragma unroll
    for (int ks = 0; ks < 4; ++ks) s0 = MFMA32(kf[ks], qf[ks], s0);
#pragma unroll
    for (int ks = 0; ks < 4; ++ks) s1 = MFMA32(kg[ks], qf[ks], s1);
}
DI void attn_partial(f32x16& s0, f32x16& s1, float& m_run, float& alpha, bool& resc) {
    float tmax = fmaxf(s0[0], s1[0]);
#pragma unroll
    for (int j = 1; j < 16; ++j) tmax = fmaxf(fmaxf(tmax, s0[j]), s1[j]);
    { auto rr = __builtin_amdgcn_permlane32_swap(__float_as_uint(tmax), __float_as_uint(tmax), false, false); tmax = fmaxf(__uint_as_float(rr[0]), __uint_as_float(rr[1])); }
    resc = __any(tmax > m_run); alpha = 1.f;
    if (resc) { const float mn = fmaxf(m_run, tmax); alpha = __builtin_amdgcn_exp2f(m_run - mn); m_run = mn; }
    const f32x2v m2 = {m_run, m_run};
#pragma unroll
    for (int j = 0; j < 8; ++j) { f32x2v a = (f32x2v){s0[2 * j], s0[2 * j + 1]} - m2, c = (f32x2v){s1[2 * j], s1[2 * j + 1]} - m2;
        s0[2 * j] = __builtin_amdgcn_exp2f(a[0]); s0[2 * j + 1] = __builtin_amdgcn_exp2f(a[1]); s1[2 * j] = c[0]; s1[2 * j + 1] = c[1]; }
}
DI void attn_finish(f32x16& s0, f32x16& s1, float alpha, float& l_run, bf16x8 (&pf)[4]) {
    f32x2v ps = {0.f, 0.f};
#pragma unroll
    for (int j = 0; j < 8; ++j) { s1[2 * j] = __builtin_amdgcn_exp2f(s1[2 * j]); s1[2 * j + 1] = __builtin_amdgcn_exp2f(s1[2 * j + 1]);
        ps += (f32x2v){s0[2 * j], s0[2 * j + 1]}; ps += (f32x2v){s1[2 * j], s1[2 * j + 1]}; }
    l_run = l_run * alpha + (ps[0] + ps[1]);
    pf[0] = pack_p(s0, 0); pf[1] = pack_p(s0, 1); pf[2] = pack_p(s1, 0); pf[3] = pack_p(s1, 1);
}
DI void attn_partial_nm(f32x16& s0, f32x16& s1, float& ps) {
#pragma unroll
    for (int j = 0; j < 16; ++j) { s0[j] = __builtin_amdgcn_exp2f(s0[j]); s1[j] = __builtin_amdgcn_exp2f(s1[j]); }
    float a = s0[0];
#pragma unroll
    for (int j = 1; j < 16; ++j) a += s0[j];
    ps = a;
}
DI void attn_finish_nm(f32x16& s0, f32x16& s1, float ps, float& l_run, bf16x8 (&pf)[4]) {
    float a = ps;
#pragma unroll
    for (int j = 0; j < 16; ++j) a += s1[j];
    l_run += a;
    pf[0] = pack_p(s0, 0); pf[1] = pack_p(s0, 1); pf[2] = pack_p(s1, 0); pf[3] = pack_p(s1, 1);
}
DI void attn_step_nm(const LAS unsigned char* Kc, const LAS unsigned char* Vc, const int (&coff)[4], const bf16x8 (&qf)[4],
                     const f32x16& P0, const f32x16& P1, float psP, f32x16& N0, f32x16& N1, float& psN, float& l_run, f32x16 (&o)[4]) {
    bf16x8 kf[8], vf[16]; unsigned w[16];
#pragma unroll
    for (int i = 0; i < 8; ++i) { kf[i] = *(const LAS bf16x8*)(Kc + (i >> 2) * 4096 + coff[i & 3]); SCHED_FENCE(); }
    const f32x16 z = {0.f, 0.f, 0.f, 0.f, 0.f, 0.f, 0.f, 0.f, 0.f, 0.f, 0.f, 0.f, 0.f, 0.f, 0.f, 0.f};
    float a = psP;
#pragma unroll
    for (int g = 0; g < 8; ++g) {
        if (g < 4) N0 = MFMA32(kf[g], qf[g], g == 0 ? z : N0); else N1 = MFMA32(kf[g], qf[g - 4], g == 4 ? z : N1);
        a += P1[2 * g]; a += P1[2 * g + 1];
        if (g < 4) { w[2 * g] = pk2(P0[4 * g], P0[4 * g + 1]); w[2 * g + 1] = pk2(P0[4 * g + 2], P0[4 * g + 3]); }
        else { w[2 * g] = pk2(P1[4 * g - 16], P1[4 * g - 15]); w[2 * g + 1] = pk2(P1[4 * g - 14], P1[4 * g - 13]); }
        if (g >= 4) vf[g - 4] = *(const LAS bf16x8*)(Vc + coff[g - 4]);
        SCHED_FENCE();
    }
    l_run += a;
    bf16x8 pf[4];
#pragma unroll
    for (int k = 0; k < 4; ++k) { const u32x4 t = {w[4 * k], w[4 * k + 1], w[4 * k + 2], w[4 * k + 3]}; pf[k] = __builtin_bit_cast(bf16x8, t); }
    float bsum = 0.f;
#pragma unroll
    for (int g = 0; g < 16; ++g) {
        o[g >> 2] = MFMA32(vf[g], pf[g & 3], o[g >> 2]);
        if (g + 4 < 16) vf[g + 4] = *(const LAS bf16x8*)(Vc + ((g + 4) >> 2) * 4096 + coff[(g + 4) & 3]);
        if (g < 8) { N0[2 * g] = __builtin_amdgcn_exp2f(N0[2 * g]); N0[2 * g + 1] = __builtin_amdgcn_exp2f(N0[2 * g + 1]); bsum = (g == 0) ? N0[0] + N0[1] : (bsum + N0[2 * g]) + N0[2 * g + 1]; }
        else { N1[2 * g - 16] = __builtin_amdgcn_exp2f(N1[2 * g - 16]); N1[2 * g - 15] = __builtin_amdgcn_exp2f(N1[2 * g - 15]); }
        SCHED_FENCE();
    }
    psN = bsum;
}
DI void attn_pv(const LAS unsigned char* Vc, const int (&coff)[4], const bf16x8 (&pf)[4], f32x16 (&o)[4]) {
#pragma unroll
    for (int dvb = 0; dvb < 4; ++dvb) { bf16x8 va[4];
#pragma unroll
        for (int i = 0; i < 4; ++i) va[i] = *(const LAS bf16x8*)(Vc + dvb * 4096 + coff[i]);
#pragma unroll
        for (int i = 0; i < 4; ++i) o[dvb] = MFMA32(va[i], pf[i], o[dvb]); }
}
#ifndef PROBE_ATTN_ABL
#define PROBE_ATTN_ABL 0
#endif
template <int ABL, bool NM> DI void attn_unit(const Params& p, LAS unsigned char* lds, int b, int h, int m, int sq0, int nkt) {
    const int tid = otid(), wave = tid >> 6, lane = tid & 63, r32 = lane & 31, h2 = lane >> 5;
    const bf16_t* PA = (const bf16_t*)(p.ws + OFF_PA); const bf16_t* VT = (const bf16_t*)(p.ws + OFF_VT);
    bf16_t* O = (bf16_t*)(p.ws + (ABL ? WS_NEEDED : OFF_OA)) + (size_t)m * RR * 512;
    const size_t rowbase = (size_t)b * TT;
    bf16x8 qf[4];
    {   const bf16_t* qp = PA + (rowbase + sq0 + wave * 32 + r32) * 1536 + (h * 2 + m) * 64 + 8 * h2;
#pragma unroll
        for (int ks = 0; ks < 4; ++ks) qf[ks] = *(const bf16x8*)(qp + 16 * ks); }
    const int srow = tid >> 3, sch = (tid & 7) ^ ((srow >> 1) & 7);
    const bf16_t* kgb = PA + rowbase * 1536 + 512 + (h * 2 + m) * 64;
    const bf16_t* vgb = VT + ((size_t)((b * 4 + h) * 128)) * TT;
    const int kofs = srow * 1536 + sch * 8, vofs = srow * TT + sch * 8;
    LAS unsigned char* Kb = lds; LAS unsigned char* Vb = lds + 24576;
    const int swz = (r32 >> 1) & 7;
    int coff[4];
#pragma unroll
    for (int ks = 0; ks < 4; ++ks) coff[ks] = r32 * 128 + (((2 * ks + h2) ^ swz) << 4);
    f32x16 o[4];
#pragma unroll
    for (int i = 0; i < 4; ++i)
#pragma unroll
        for (int j = 0; j < 16; ++j) o[i][j] = 0.f;
    float m_run = -1e30f, l_run = 0.f, alA = 1.f, alB = 1.f; bool rsA = false, rsB = false;
    f32x16 A0, A1, B0, B1; bf16x8 pf[4];
    int bprev = 2, bcur = 0, bnext = 1;
    const int wu = __builtin_amdgcn_readfirstlane(tid >> 6) * 1024;
#define AT_DMA1(gp, la) asm volatile("s_mov_b32 m0, %0\n\ts_nop 0\n\tglobal_load_lds_dwordx4 %1, off" :: "s"((unsigned)(unsigned long long)(la)), "v"(gp) : "m0", "memory")
#define AT_DMA(t, bi) do { if (ABL & 4) break; \
        AT_DMA1(kgb + (kofs + (t) * 64 * 1536), Kb + (bi) * 8192 + wu); \
        AT_DMA1(vgb + (vofs + (t) * 64), Vb + (bi) * 16384 + wu); \
        AT_DMA1(vgb + (vofs + 64 * TT + (t) * 64), Vb + (bi) * 16384 + 8192 + wu); } while (0)
#define AT_LANDED() do { if (!(ABL & 4)) asm volatile("s_waitcnt vmcnt(0)" ::: "memory"); } while (0)
#define AT_BAR() do { if (!(ABL & 4)) lds_barrier(); } while (0)
#define AT_QK(Kc, N0, N1) do { if (ABL & 2) { _Pragma("unroll") for (int j_ = 0; j_ < 16; ++j_) { asm volatile("" : "+v"(N0[j_])); asm volatile("" : "+v"(N1[j_])); } } else attn_qk(Kc, coff, qf, N0, N1); } while (0)
#define AT_PV(Vc) do { if (ABL & 2) { _Pragma("unroll") for (int i_ = 0; i_ < 4; ++i_) asm volatile("" :: "v"(pf[i_])); } else attn_pv(Vc, coff, pf, o); } while (0)
#define AT_PART(N0, N1, alN, rsN) do { if (ABL & 1) { alN = 1.f; rsN = false; } else if (NM) { rsN = false; attn_partial_nm(N0, N1, alN); } else attn_partial(N0, N1, m_run, alN, rsN); } while (0)
#define AT_FIN(P0, P1, alP) do { if (ABL & 1) { pf[0] = pack_p(P0, 0); pf[1] = pack_p(P0, 1); pf[2] = pack_p(P1, 0); pf[3] = pack_p(P1, 1); l_run = 1.f; } else if (NM) attn_finish_nm(P0, P1, alP, l_run, pf); else attn_finish(P0, P1, alP, l_run, pf); } while (0)
#define AT_ROT() do { const int t_ = bprev; bprev = bcur; bcur = bnext; bnext = t_; } while (0)
#define AT_RESC(al, rs) do { if (__builtin_expect(rs, 0)) { asm volatile("" ::: "memory"); _Pragma("unroll") for (int i_ = 0; i_ < 4; ++i_) _Pragma("unroll") for (int j_ = 0; j_ < 16; ++j_) o[i_][j_] *= (al); } } while (0)
#define AT_STEP(j, P0, P1, alP, N0, N1, alN, rsN) do { \
        if ((j) + 1 < nkt) AT_DMA((j) + 1, bnext); \
        SCHED_FENCE(); \
        if constexpr (NM && ABL == 0) { attn_step_nm(Kb + bcur * 8192, Vb + bprev * 16384, coff, qf, P0, P1, alP, N0, N1, alN, l_run, o); SCHED_FENCE(); AT_LANDED(); AT_BAR(); AT_ROT(); break; } \
        AT_QK(Kb + bcur * 8192, N0, N1); AT_FIN(P0, P1, alP); \
        __builtin_amdgcn_sched_group_barrier(0x100, 8, 0); \
        _Pragma("unroll") for (int g_ = 0; g_ < 8; ++g_) { __builtin_amdgcn_sched_group_barrier(0x8, 1, 0); __builtin_amdgcn_sched_group_barrier(0x402, NM ? 5 : 7, 0); } \
        SCHED_FENCE(); \
        AT_PV(Vb + bprev * 16384); AT_PART(N0, N1, alN, rsN); \
        __builtin_amdgcn_sched_group_barrier(0x100, 4, 0); \
        _Pragma("unroll") for (int g_ = 0; g_ < 16; ++g_) { __builtin_amdgcn_sched_group_barrier(0x8, 1, 0); __builtin_amdgcn_sched_group_barrier(0x100, 1, 0); __builtin_amdgcn_sched_group_barrier(0x402, NM ? 3 : 4, 0); } \
        SCHED_FENCE(); \
        AT_RESC(alN, rsN); \
        AT_LANDED(); AT_BAR(); AT_ROT(); } while (0)
    AT_DMA(0, 0); AT_LANDED(); AT_BAR();
    if (nkt > 1) AT_DMA(1, 1);
    AT_QK(Kb, A0, A1); AT_PART(A0, A1, alA, rsA);
    AT_LANDED(); AT_BAR(); AT_ROT();
    int j = 1;
    for (; j + 1 < nkt; j += 2) { AT_STEP(j, A0, A1, alA, B0, B1, alB, rsB); AT_STEP(j + 1, B0, B1, alB, A0, A1, alA, rsA); }
    if (j < nkt) {
        AT_STEP(j, A0, A1, alA, B0, B1, alB, rsB);
        AT_FIN(B0, B1, alB);
    } else AT_FIN(A0, A1, alA);
    AT_PV(Vb + bprev * 16384);
#undef AT_DMA
#undef AT_DMA1
#undef AT_LANDED
#undef AT_ROT
#undef AT_RESC
#undef AT_STEP
#undef AT_BAR
#undef AT_QK
#undef AT_PV
#undef AT_PART
#undef AT_FIN
    { auto rr = __builtin_amdgcn_permlane32_swap(__float_as_uint(l_run), __float_as_uint(l_run), false, false); l_run = __uint_as_float(rr[0]) + __uint_as_float(rr[1]); }
    const float inv = 1.f / l_run;
    const int tid2 = otid();
    bf16_t* orow = O + (rowbase + sq0 + (tid2 >> 6) * 32 + (tid2 & 31)) * 512 + h * 128 + 4 * ((tid2 >> 5) & 1);
#pragma unroll
    for (int dvb = 0; dvb < 4; ++dvb)
#pragma unroll
        for (int g = 0; g < 4; ++g) { u32x2 w = {pk2(o[dvb][4 * g] * inv, o[dvb][4 * g + 1] * inv), pk2(o[dvb][4 * g + 2] * inv, o[dvb][4 * g + 3] * inv)};
            *(u32x2*)(orow + dvb * 32 + 8 * g) = w; }
    lds_barrier();
}

constexpr int CS_TKK = 0, CS_TR = 2304, CS_TKD = 4608, CS_TKA = 6912, CS_TVN = 9216, CS_TDA = 11264, CS_TVS = 16384, CS_G15 = 21504, CS_TBM = 21760, CS_TCM = 23040, CS_TBC = 24064, CS_BUF = 25344;
constexpr int CS_E = 2 * CS_BUF, CS_YO = CS_E + 4096;
constexpr int CS_RS = 144, CS_RT = 80, CS_C = 16, CS_NCH = TT / CS_C;
static_assert(CS_NCH % 4 == 0 && CS_YO + 4096 <= 131072, "scan");
#ifndef PROBE_SCAN_ABL
#define PROBE_SCAN_ABL 0
#endif
DI void scan_unit(const Params& p, int l, LAS unsigned char* lds, int u, int dup = 0) {
    const int abl = dup ? PROBE_SCAN_ABL : 0;
    const int tid = otid(), wave = tid >> 6, lane = tid & 63, c16 = lane & 15, q = lane >> 4;
    const int chain = u; const int dir = chain & 1, bh = chain >> 1, b = bh >> 3, h = bh & 7;
    auto tok = [&](int i) -> int { return dir == 0 ? i : (i < NCTX ? (NCTX - 1 - i) : (TT + NCTX - 1 - i)); };
    for (int i = tid; i < 2 * 16 * 16; i += 512) { const int bf = i >> 8, r = (i >> 4) & 15, cidx = i & 15; *(LAS unsigned short*)(lds + bf * CS_BUF + CS_TBM + r * CS_RT + (16 + cidx) * 2) = 0; }
    for (int i = tid; i < 2 * 64 * 16; i += 512) { const int bf = i >> 10, r = (i >> 4) & 63, cidx = i & 15; *(LAS unsigned short*)(lds + bf * CS_BUF + CS_TVS + r * CS_RT + (16 + cidx) * 2) = 0; }
    lds_barrier();
    if (wave >= 4) {
        __builtin_amdgcn_s_setprio(1);
        const bf16_t* EW = (const bf16_t*)(p.ws + OFF_EW) + (size_t)dir * RR * 512; const bf16_t* AA = (const bf16_t*)(p.ws + OFF_AA) + (size_t)dir * RR * 512;
        const bf16_t* KK = (const bf16_t*)(p.ws + OFF_KK); const bf16_t* KC = (const bf16_t*)(p.ws + OFF_KC); const bf16_t* RC = (const bf16_t*)(p.ws + OFF_RC); const bf16_t* VC = (const bf16_t*)(p.ws + OFF_VC);
        bf16_t* OS = (bf16_t*)(p.ws + ((dup && PROBE_SCAN_ABL) ? WS_NEEDED : OFF_OS)) + (size_t)dir * RR * 512;
        const int pu = tid - 256, pw = wave - 4, lt = pu >> 4, k4 = (pu & 15) * 4;
        const int posk = 32 * (k4 >> 5) + 8 * (((k4 & 31) >> 2) & 3) + 4 * ((k4 & 31) >> 4);
        const f32x4 ka4 = *(const f32x4*)(p.rwkv_k_a + l * 512 + h * 64 + k4);
        struct Raw { u32x2 re, rk, ra, rkc, rr_, rv; };
        auto gload = [&](int c) -> Raw { const size_t off = ((size_t)b * TT + tok(c * CS_C + lt)) * 512 + h * 64 + k4; Raw w;
            w.re = *(const u32x2*)(EW + off); w.rk = *(const u32x2*)(KK + off); w.ra = *(const u32x2*)(AA + off); w.rkc = *(const u32x2*)(KC + off); w.rr_ = *(const u32x2*)(RC + off); w.rv = *(const u32x2*)(VC + off); return w; };
        float cmask[16];
#pragma unroll
        for (int i = 0; i < 16; ++i) { cmask[i] = (i <= lt) ? 1.f : 0.f; asm volatile("" : "+v"(cmask[i])); }
        auto stage1 = [&](const Raw& w) { float e[4]; unpack4(w.re, e); *(LAS f32x4*)(lds + CS_E + (lt * 64 + k4) * 4) = (f32x4){e[0], e[1], e[2], e[3]}; };
        auto stage2 = [&](const Raw& w, int par) {
            LAS unsigned char* B = lds + par * CS_BUF;
            f32x4 cs = (f32x4){0.f, 0.f, 0.f, 0.f};
#pragma unroll
            for (int i = 0; i < 16; ++i) { const f32x4 ev = *(const LAS f32x4*)(lds + CS_E + (i * 64 + k4) * 4); const float mk = cmask[i]; cs[0] = fmaf(mk, ev[0], cs[0]); cs[1] = fmaf(mk, ev[1], cs[1]); cs[2] = fmaf(mk, ev[2], cs[2]); cs[3] = fmaf(mk, ev[3], cs[3]); }
            float e[4], kk[4], a[4], kc[4], r[4]; unpack4(w.re, e); unpack4(w.rk, kk); unpack4(w.ra, a); unpack4(w.rkc, kc); unpack4(w.rr_, r);
            float tkk[4], tr[4], tkd[4], tka[4]; f32x4 g;
#pragma unroll
            for (int i = 0; i < 4; ++i) { g[i] = __expf(-cs[i]); const float gi = __expf(cs[i]), gp = __expf(e[i] - cs[i]);
                tkk[i] = kk[i] * gp; tr[i] = r[i] * g[i]; tkd[i] = kc[i] * (1.f + (a[i] - 1.f) * ka4[i]) * gi; tka[i] = kk[i] * a[i] * gi; }
            *(LAS u32x2*)(B + CS_TKK + lt * CS_RS + posk * 2) = (u32x2){pk2(tkk[0], tkk[1]), pk2(tkk[2], tkk[3])};
            *(LAS u32x2*)(B + CS_TR + lt * CS_RS + posk * 2) = (u32x2){pk2(tr[0], tr[1]), pk2(tr[2], tr[3])};
            *(LAS u32x2*)(B + CS_TKD + lt * CS_RS + posk * 2) = (u32x2){pk2(tkd[0], tkd[1]), pk2(tkd[2], tkd[3])};
            *(LAS u32x2*)(B + CS_TKA + lt * CS_RS + posk * 2) = (u32x2){pk2(tka[0], tka[1]), pk2(tka[2], tka[3])};
            *(LAS u32x2*)(B + CS_TVN + (lt * 64 + k4) * 2) = w.rv;
            if (lt == 15) *(LAS f32x4*)(B + CS_G15 + k4 * 4) = g;
        };
        auto stage3 = [&](int par) {
            LAS unsigned char* B = lds + par * CS_BUF;
            {   const LAS unsigned char* ta = B + ((pw & 1) ? CS_TKA : CS_TKD) + c16 * CS_RS + q * 16; const LAS unsigned char* tb = B + ((pw & 2) ? CS_TR : CS_TKK) + c16 * CS_RS + q * 16;
                f32x4 m = (f32x4){0.f, 0.f, 0.f, 0.f};
                m = MFMA16(*(const LAS bf16x8*)ta, *(const LAS bf16x8*)tb, m); m = MFMA16(*(const LAS bf16x8*)(ta + 64), *(const LAS bf16x8*)(tb + 64), m);
#pragma unroll
                for (int i = 0; i < 4; ++i) { const int j = 4 * q + i; const bool keep = (pw & 2) ? (j <= c16) : (j < c16); m[i] = keep ? m[i] : 0.f; }
                if (pw == 0) { u32x2 w = {pk2(m[0], m[1]), pk2(m[2], m[3])}; *(LAS u32x2*)(B + CS_TBM + c16 * CS_RT + 8 * q) = w; }
                else if (pw == 1) *(LAS f32x4*)(B + CS_TCM + (c16 * 16 + 4 * q) * 4) = m;
                else if (pw == 2) { u32x2 w = {pk2(m[0], m[1]), pk2(m[2], m[3])}; *(LAS u32x2*)(B + CS_TBC + c16 * CS_RT + 8 * q) = w; }
                else { u32x2 w = {pk2(-m[0], -m[1]), pk2(-m[2], -m[3])}; *(LAS u32x2*)(B + CS_TBC + c16 * CS_RT + 32 + 8 * q) = w; } }
            if (pu < 192) { const bool isv = pu >= 128; const int kk_ = isv ? (pu - 128) : (pu >> 1), half = isv ? 0 : (pu & 1);
                const int pk_ = 32 * (kk_ >> 5) + 8 * (((kk_ & 31) >> 2) & 3) + 4 * ((kk_ & 31) >> 4) + (kk_ & 3);
                const LAS unsigned char* src = isv ? (B + CS_TVN + kk_ * 2) : (B + (half ? CS_TKA : CS_TKD) + pk_ * 2); const int sstr = isv ? 128 : CS_RS;
                unsigned w[8];
#pragma unroll
                for (int t2 = 0; t2 < 8; ++t2) { const unsigned lo = *(const LAS unsigned short*)(src + (2 * t2) * sstr), hi = *(const LAS unsigned short*)(src + (2 * t2 + 1) * sstr); w[t2] = (lo | (hi << 16)) ^ (half ? 0x80008000u : 0u); }
                LAS unsigned char* dst = isv ? (B + CS_TVS + kk_ * CS_RT) : (B + CS_TDA + kk_ * CS_RT + half * 32);
                *(LAS u32x4*)dst = (u32x4){w[0], w[1], w[2], w[3]}; *(LAS u32x4*)(dst + 16) = (u32x4){w[4], w[5], w[6], w[7]}; }
        };
        Raw ring[4]; ring[0] = gload(0); ring[1] = gload(1); ring[2] = gload(2); ring[3] = gload(3);
        stage1(ring[0]); lds_barrier();
        stage2(ring[0], 0); ring[0] = gload(4); lds_barrier();
        stage3(0); stage1(ring[1]); lds_barrier();
#pragma unroll 1
        for (int c4 = 0; c4 < CS_NCH; c4 += 4) {
#pragma unroll
            for (int ci = 0; ci < 4; ++ci) { const int c = c4 + ci;
                if (c + 1 < CS_NCH) { if (!(abl & 2)) stage2(ring[(ci + 1) & 3], (c + 1) & 1); if (c + 5 < CS_NCH && !(abl & 8)) ring[(ci + 1) & 3] = gload(c + 5); }
                lds_barrier();
                if (c + 1 < CS_NCH && !(abl & 4)) stage3((c + 1) & 1);
                lds_barrier();
                if (!(abl & 16)) {   const f32x4 yy = *(const LAS f32x4*)(lds + CS_YO + (lt * 64 + k4) * 4);
                    *(u32x2*)(OS + ((size_t)b * TT + tok(c * CS_C + lt)) * 512 + h * 64 + k4) = (u32x2){pk2(yy[0], yy[1]), pk2(yy[2], yy[3])}; }
                if (c + 2 < CS_NCH) stage1(ring[(ci + 2) & 3]);
                lds_barrier();
            }
        }
        __builtin_amdgcn_s_setprio(0);
    } else {
        const int v = 16 * wave + c16;
        f32x4 sT[4];
#pragma unroll
        for (int i = 0; i < 4; ++i) sT[i] = (f32x4){0.f, 0.f, 0.f, 0.f};
        lds_barrier(); lds_barrier(); lds_barrier();
#pragma unroll 1
        for (int c = 0; c < CS_NCH; ++c) {
            if (abl & 1) { lds_barrier(); lds_barrier(); lds_barrier(); continue; }
            const LAS unsigned char* B = lds + (c & 1) * CS_BUF;
            const LAS unsigned char* tvs = B + CS_TVS + v * CS_RT + q * 16;
            const bf16x8 fkk0 = *(const LAS bf16x8*)(B + CS_TKK + c16 * CS_RS + q * 16), fkk1 = *(const LAS bf16x8*)(B + CS_TKK + c16 * CS_RS + 64 + q * 16);
            const bf16x8 fbm = *(const LAS bf16x8*)(B + CS_TBM + c16 * CS_RT + q * 16), fv0 = *(const LAS bf16x8*)tvs;
            f32x4 cc[4][4], cin[4];
#pragma unroll
            for (int i = 0; i < 4; ++i) { cin[i] = *(const LAS f32x4*)(B + CS_TCM + ((4 * q + i) * 16 + 4 * q) * 4);
#pragma unroll
                for (int jj = 0; jj < 4; ++jj) cc[i][jj] = *(const LAS f32x4*)(B + CS_TCM + ((4 * q + i) * 16 + 4 * jj) * 4); }
            const bf16x8 fr0 = *(const LAS bf16x8*)(B + CS_TR + c16 * CS_RS + q * 16), fr1 = *(const LAS bf16x8*)(B + CS_TR + c16 * CS_RS + 64 + q * 16);
            const bf16x8 fbc = *(const LAS bf16x8*)(B + CS_TBC + c16 * CS_RT + q * 16);
            bf16x8 fda[4]; f32x4 gg[4];
#pragma unroll
            for (int rb = 0; rb < 4; ++rb) { fda[rb] = *(const LAS bf16x8*)(B + CS_TDA + (16 * rb + c16) * CS_RT + q * 16); gg[rb] = *(const LAS f32x4*)(B + CS_G15 + (16 * rb + 4 * q) * 4); }
            bf16x8 sf[2];
#pragma unroll
            for (int s2 = 0; s2 < 2; ++s2) { u32x4 w = {pk2(sT[2 * s2][0], sT[2 * s2][1]), pk2(sT[2 * s2][2], sT[2 * s2][3]), pk2(sT[2 * s2 + 1][0], sT[2 * s2 + 1][1]), pk2(sT[2 * s2 + 1][2], sT[2 * s2 + 1][3])}; sf[s2] = __builtin_bit_cast(bf16x8, w); }
            f32x4 x = (f32x4){0.f, 0.f, 0.f, 0.f};
            x = MFMA16(fkk0, sf[0], x); x = MFMA16(fkk1, sf[1], x); x = MFMA16(fbm, fv0, x);
            f32x4 yv = (f32x4){0.f, 0.f, 0.f, 0.f};
            yv = MFMA16(fr0, sf[0], yv); yv = MFMA16(fr1, sf[1], yv);
            f32x4 sa = (f32x4){0.f, 0.f, 0.f, 0.f};
#pragma unroll
            for (int q0 = 0; q0 < 4; ++q0) {
                f32x4 y; y[0] = x[0]; y[1] = x[1] - y[0] * cin[1][0]; y[2] = x[2] - y[0] * cin[2][0] - y[1] * cin[2][1]; y[3] = x[3] - y[0] * cin[3][0] - y[1] * cin[3][1] - y[2] * cin[3][2];
                if (q == q0) sa = y;
                if (q0 < 3) { const int src = (c16 + 16 * q0) << 2; const float b0 = bperm(y[0], src), b1 = bperm(y[1], src), b2 = bperm(y[2], src), b3 = bperm(y[3], src);
#pragma unroll
                    for (int i = 0; i < 4; ++i) x[i] -= b0 * cc[i][q0][0] + b1 * cc[i][q0][1] + b2 * cc[i][q0][2] + b3 * cc[i][q0][3]; }
            }
            lds_barrier();
            { u32x2 w = {pk2(sa[0], sa[1]), pk2(sa[2], sa[3])}; *(LAS u32x2*)(lds + (c & 1) * CS_BUF + CS_TVS + v * CS_RT + 32 + q * 8) = w; }
            const bf16x8 bvs = *(const LAS bf16x8*)tvs;
            yv = MFMA16(fbc, bvs, yv);
#pragma unroll
            for (int rb = 0; rb < 4; ++rb) sT[rb] = MFMA16(fda[rb], bvs, sT[rb]);
#pragma unroll
            for (int i = 0; i < 4; ++i) *(LAS float*)(lds + CS_YO + ((4 * q + i) * 64 + v) * 4) = yv[i];
            lds_barrier();
#pragma unroll
            for (int rb = 0; rb < 4; ++rb) sT[rb] *= gg[rb];
            lds_barrier();
        }
    }
    lds_barrier();
}

__device__ void ph_mix(const Params& p, int l, LAS unsigned char* lds, LAS unsigned* bcast, int dup) {
    unsigned* ctr = (unsigned*)(p.ws + OFF_CTR) + l * 64 + (dup ? 32 : 0);
    constexpr int N_SCAN = 64, N_LAT = 1024, N_CTX = 32;
    bool nm; { const int lane = otid() & 63; const float mq = wave_max(fabsf(p.q_norm_g[l * 64 + lane])), mk = wave_max(fabsf(p.k_norm_g[l * 64 + lane]));
        nm = __builtin_amdgcn_readfirstlane((8.f * 1.4426950408889634f * mq * mk <= 64.f) ? 1 : 0) != 0; }
    for (;;) {
        if (otid() == 0) *bcast = atomicAdd(ctr, 1u);
        __syncthreads();
        const int u = (int)*bcast;
        __syncthreads();
        if (u >= N_SCAN + N_LAT + N_CTX) break;
#ifdef PROBE_DMODE
        if (dup && PROBE_DMODE == 2 && u >= N_SCAN) break;
        if (dup && PROBE_DMODE == 3 && u < N_SCAN) continue;
#endif
        if (u < N_SCAN) scan_unit(p, l, lds, u, dup);
        else if (u < N_SCAN + N_LAT) { const int v = u - N_SCAN; const int qb = v & 31, m = (v >> 5) & 1, h = (v >> 6) & 3, b = v >> 8;
            if (PROBE_ATTN_ABL != 0 && dup) attn_unit<PROBE_ATTN_ABL, false>(p, lds, b, h, m, NCTX + qb * 256, TT / 64);
            else if (nm) attn_unit<0, true>(p, lds, b, h, m, NCTX + qb * 256, TT / 64); else attn_unit<0, false>(p, lds, b, h, m, NCTX + qb * 256, TT / 64); }
        else { const int v = u - N_SCAN - N_LAT; const int m = v & 1, h = (v >> 1) & 3, b = v >> 3; attn_unit<0, false>(p, lds, b, h, m, 0, NCTX / 64); }
    }
    if (!dup) { conv_expert_weights(p, l, lds); if (l + 1 < NL) conv_mixer_a(p, l + 1, lds); }
}
__device__ void ph_post(const Params& p, int l, int wg, int nwg) {
    const int tid = otid(), wave = tid >> 6, lane = tid & 63;
    const float lam_init = 0.8f - 0.6f * expf(-0.3f * (float)l);
    float lam;
    {   const float* lv = p.diff_lambda + l * 256; const float a = wave_sum(lv[lane] * lv[64 + lane]), c = wave_sum(lv[128 + lane] * lv[192 + lane]); lam = expf(a) - expf(c) + lam_init; }
    const bf16_t* OA0 = (const bf16_t*)(p.ws + OFF_OA); const bf16_t* OA1 = OA0 + (size_t)RR * 512;
    const bf16_t* OS0 = (const bf16_t*)(p.ws + OFF_OS); const bf16_t* OS1 = OS0 + (size_t)RR * 512;
    const bf16_t* YB0 = (const bf16_t*)(p.ws + OFF_YB0); const bf16_t* G = (const bf16_t*)(p.ws + OFF_G);
    bf16_t* YA = (bf16_t*)(p.ws + OFF_YA); bf16_t* YB = (bf16_t*)(p.ws + OFF_YB);
    float sg[8], lg[8];
#pragma unroll
    for (int i = 0; i < 8; ++i) { sg[i] = p.diff_subln_g[l * 128 + (lane & 15) * 8 + i] * (1.f - lam_init); lg[i] = p.rwkv_ln_g[l * 512 + lane * 8 + i]; }
    const int rstep = nwg * 8; int r = wg * 8 + wave;
    u32x4 la, lc, ly0, lgg, lo0, lo1;
    auto ldrow = [&](int rr) { const size_t o = (size_t)rr * 512 + lane * 8; la = *(const u32x4*)(OA0 + o); lc = *(const u32x4*)(OA1 + o); ly0 = *(const u32x4*)(YB0 + o); lgg = *(const u32x4*)(G + o); lo0 = *(const u32x4*)(OS0 + o); lo1 = *(const u32x4*)(OS1 + o); };
    if (r < RR) ldrow(r);
    while (r < RR) {
        const size_t o = (size_t)r * 512 + lane * 8;
        const u32x4 a = la, c = lc, y0 = ly0, gg = lgg, ov0 = lo0, ov1 = lo1;
        if (r + rstep < RR) ldrow(r + rstep);
        {   float v[8]; float ss = 0.f;
#pragma unroll
            for (int i = 0; i < 4; ++i) { v[2 * i] = bflo(a[i]) - lam * bflo(c[i]); v[2 * i + 1] = bfhi(a[i]) - lam * bfhi(c[i]); ss += v[2 * i] * v[2 * i] + v[2 * i + 1] * v[2 * i + 1]; }
            ss = allsum16(ss);
            const float rinv = rsqrtf(ss * (1.f / 128.f) + 1e-6f);
            u32x4 w;
#pragma unroll
            for (int i = 0; i < 4; ++i) w[i] = pk2(v[2 * i] * rinv * sg[2 * i], v[2 * i + 1] * rinv * sg[2 * i + 1]);
            *(u32x4*)(YA + o) = w; }
        {   float y[8];
#pragma unroll
            for (int i = 0; i < 4; ++i) { y[2 * i] = bflo(y0[i]); y[2 * i + 1] = bfhi(y0[i]); }
#pragma unroll
            for (int d = 0; d < 2; ++d) { const u32x4 ov = d ? ov1 : ov0; float v[8]; float sm = 0.f;
#pragma unroll
                for (int i = 0; i < 4; ++i) { v[2 * i] = bflo(ov[i]); v[2 * i + 1] = bfhi(ov[i]); sm += v[2 * i] + v[2 * i + 1]; }
                const float mu = allsum8(sm) * (1.f / 64.f); float sq = 0.f;
#pragma unroll
                for (int i = 0; i < 8; ++i) { v[i] -= mu; sq += v[i] * v[i]; }
                const float rinv = rsqrtf(allsum8(sq) * (1.f / 64.f) + 64e-5f);
#pragma unroll
                for (int i = 0; i < 8; ++i) y[i] += v[i] * rinv * lg[i]; }
            u32x4 w;
#pragma unroll
            for (int i = 0; i < 4; ++i) w[i] = pk2(y[2 * i] * bflo(gg[i]), y[2 * i + 1] * bfhi(gg[i]));
            *(u32x4*)(YB + o) = w; }
        r += rstep;
    }
}

template <int KSTEPS> DI void rows16_mma2(const bf16_t* arow, const bf16_t* brow, int ldb, f32x4 (&acc)[2]) {
#pragma unroll 1
    for (int k0 = 0; k0 < KSTEPS; k0 += 8) { bf16x8 a[8], b0[8], b1[8];
#pragma unroll
        for (int k = 0; k < 8; ++k) { a[k] = *(const bf16x8*)(arow + 32 * (k0 + k)); b0[k] = *(const bf16x8*)(brow + 32 * (k0 + k)); b1[k] = *(const bf16x8*)(brow + ldb + 32 * (k0 + k)); }
#pragma unroll
        for (int k = 0; k < 8; ++k) { acc[0] = MFMA16(a[k], b0[k], acc[0]); acc[1] = MFMA16(a[k], b1[k], acc[1]); } }
}
__device__ void ctx_merge_units(const Params& p, int wg, int nwg) {
    const int tid = otid(), wave = tid >> 6, lane = tid & 63, c16 = lane & 15, q = lane >> 4;
    const unsigned char* PG = p.ws + OFF_PG; bf16_t* M = (bf16_t*)(p.ws + OFF_M); const bf16_t* WBR = (const bf16_t*)(p.ws + OFF_WBR);
    for (int u = wg; u < 256; u += nwg) {
        const int rbk = u >> 2; const int r0 = (rbk >> 4) * TT + (rbk & 15) * 16; const int colw = (u & 3) * 256 + wave * 32 + c16 * 2;
        f32x4 tot[2] = {(f32x4){0.f, 0.f, 0.f, 0.f}, (f32x4){0.f, 0.f, 0.f, 0.f}};
#pragma unroll 1
        for (int br = 0; br < 3; ++br) {
            const bf16_t* Y = (const bf16_t*)(p.ws + (br == 0 ? OFF_YA : (br == 1 ? OFF_YB : OFF_YC)));
            f32x4 acc[2] = {(f32x4){0.f, 0.f, 0.f, 0.f}, (f32x4){0.f, 0.f, 0.f, 0.f}};
            rows16_mma2<16>(Y + (size_t)(r0 + c16) * 512 + 8 * q, WBR + ((size_t)br * 1024 + colw) * 512 + 8 * q, 512, acc);
#pragma unroll
            for (int i = 0; i < 4; ++i) { const unsigned g = *(const unsigned short*)(PG + (size_t)(r0 + 4 * q + i) * 3072 + br * 1024 + colw);
                tot[0][i] += (float)(g & 255u) * (1.f / 255.f) * acc[0][i]; tot[1][i] += (float)(g >> 8) * (1.f / 255.f) * acc[1][i]; }
        }
#pragma unroll
        for (int i = 0; i < 4; ++i) *(unsigned*)(M + (size_t)(r0 + 4 * q + i) * 1024 + colw) = pk2(tot[0][i], tot[1][i]);
    }
}
__device__ void ctx_out_units(const Params& p, int l, int wg, int nwg, float scale) {
    const int tid = otid(), wave = tid >> 6, lane = tid & 63, c16 = lane & 15, q = lane >> 4;
    const bf16_t* M = (const bf16_t*)(p.ws + OFF_M); const bf16_t* WOUT = (const bf16_t*)(p.ws + OFF_WOUT); float* X = (float*)(p.ws + OFF_X);
    const float* g1 = (const float*)(p.ws + OFF_MOD) + ((size_t)l * 5 + 4) * 6144 + 2 * 1024;
    for (int u = wg; u < 256; u += nwg) {
        const int rbk = u >> 2; const int r0 = (rbk >> 4) * TT + (rbk & 15) * 16; const int colw = (u & 3) * 256 + wave * 32 + c16 * 2;
        f32x4 acc[2] = {(f32x4){0.f, 0.f, 0.f, 0.f}, (f32x4){0.f, 0.f, 0.f, 0.f}};
        rows16_mma2<32>(M + (size_t)(r0 + c16) * 1024 + 8 * q, WOUT + (size_t)colw * 1024 + 8 * q, 1024, acc);
        const f32x2v gv = *(const f32x2v*)(g1 + colw);
#pragma unroll
        for (int i = 0; i < 4; ++i) { float* xp = X + (size_t)(r0 + 4 * q + i) * 1024 + colw; f32x2v xv = *(f32x2v*)xp;
            xv[0] += gv[0] * acc[0][i] * scale; xv[1] += gv[1] * acc[1][i] * scale; *(f32x2v*)xp = xv; }
    }
}

constexpr int RW_ES = 260, RW_QS = 16 * RW_ES;
__device__ void ph_norm2(const Params& p, int l, LAS unsigned char* lds, int wg, int nwg) {
    const int tid = otid(), wave = tid >> 6, lane = tid & 63;
    LAS float* RW = (LAS float*)lds;
    LAS float* hrow = RW + 4 * RW_QS + wave * 1024;
    {   const float* rw = p.router_w + (size_t)l * 1024 * 16;
        for (int i = tid; i < 16384; i += 512) { const int k = i >> 4, e = i & 15; RW[(k >> 8) * RW_QS + e * RW_ES + (k & 255)] = rw[i]; } }
    __syncthreads();
    const float* X = (const float*)(p.ws + OFF_X); bf16_t* H = (bf16_t*)(p.ws + OFF_H);
    const float* MOD = (const float*)(p.ws + OFF_MOD) + (size_t)l * 5 * 6144; const float* g = p.norm2_g + l * 1024;
    float* AFFL = (float*)(p.ws + OFF_AFFL); float* AFFC = (float*)(p.ws + OFF_AFFC); int* INV = (int*)(p.ws + OFF_INV);
    const int e = lane & 15, kq = lane >> 4;
    const int rstep = nwg * 8; int r = wg * 8 + wave;
    float4 v[4];
    if (r < RR) { const float4* xr = (const float4*)(X + (size_t)r * 1024);
#pragma unroll
        for (int i = 0; i < 4; ++i) v[i] = xr[lane + 64 * i]; }
    while (r < RR) {
        float4 vn[4];
        if (r + rstep < RR) { const float4* xr = (const float4*)(X + (size_t)(r + rstep) * 1024);
#pragma unroll
            for (int i = 0; i < 4; ++i) vn[i] = xr[lane + 64 * i]; }
        float ss = 0.f;
#pragma unroll
        for (int i = 0; i < 4; ++i) ss += v[i].x * v[i].x + v[i].y * v[i].y + v[i].z * v[i].z + v[i].w * v[i].w;
        ss = wave_sum(ss);
        const float rinv = rsqrtf(ss * (1.f / 1024.f) + 1e-6f);
        const int b = r / TT, s_ = r - b * TT; const float* md = MOD + (s_ < NCTX ? 4 : b) * 6144;
        float4 ggv[4], shv[4], scv[4];
#pragma unroll
        for (int i = 0; i < 4; ++i) { const int col = (lane + 64 * i) * 4; ggv[i] = *(const float4*)(g + col); shv[i] = *(const float4*)(md + 3 * 1024 + col); scv[i] = *(const float4*)(md + 4 * 1024 + col); }
#pragma unroll
        for (int i = 0; i < 4; ++i) { const int col = (lane + 64 * i) * 4;
            const float4 gg = ggv[i], sh = shv[i], sc = scv[i];
            f32x4 y; y[0] = v[i].x * rinv * gg.x * (1.f + sc.x) + sh.x; y[1] = v[i].y * rinv * gg.y * (1.f + sc.y) + sh.y; y[2] = v[i].z * rinv * gg.z * (1.f + sc.z) + sh.z; y[3] = v[i].w * rinv * gg.w * (1.f + sc.w) + sh.w;
            u32x2 w = {pk2(y[0], y[1]), pk2(y[2], y[3])}; *(u32x2*)(H + (size_t)r * 1024 + col) = w;
            *(LAS f32x4*)(hrow + col) = y; }
        f32x4 acc4 = (f32x4){0.f, 0.f, 0.f, 0.f}; const LAS float* hq = hrow + kq * 256; const LAS float* wq = RW + kq * RW_QS + e * RW_ES;
#pragma unroll 8
        for (int k = 0; k < 256; k += 4) acc4 += *(const LAS f32x4*)(hq + k) * *(const LAS f32x4*)(wq + k);
        float acc = (acc4[0] + acc4[1]) + (acc4[2] + acc4[3]);
        acc = sum_x32(sum_x16(acc));
        const float mx = allmax16(acc);
        const float ex = expf(acc - mx); const float sm = allsum16(ex);
        const float aff = ex / sm;
        if (lane < 16) { if (s_ < NCTX) AFFC[((size_t)(b * 16 + e)) * NCTX + s_] = aff; else AFFL[((size_t)(b * 16 + e)) * SEQ + (s_ - NCTX)] = aff;
            INV[(size_t)r * 16 + e] = -1; }
#pragma unroll
        for (int i = 0; i < 4; ++i) v[i] = vn[i];
        r += rstep;
    }
    __syncthreads();
}

DI void topk_unit(const Params& p, LAS unsigned char* lds, int u) {
    const int tid = otid(), wave = tid >> 6, lane = tid & 63;
    const bool lat = u < 64; const int v_ = lat ? u : u - 64; const int b = v_ >> 4, e = v_ & 15;
    const int n = lat ? SEQ : NCTX, cap = lat ? CAPL : CAPC;
    const float* aff = lat ? (const float*)(p.ws + OFF_AFFL) + ((size_t)(b * 16 + e)) * SEQ : (const float*)(p.ws + OFF_AFFC) + ((size_t)(b * 16 + e)) * NCTX;
    LAS unsigned* hist = (LAS unsigned*)lds;
    LAS unsigned* sh = hist + 256;
    unsigned long long key[16];
#pragma unroll
    for (int i = 0; i < 16; ++i) { const int idx = tid + 512 * i; key[i] = (idx < n) ? (((unsigned long long)__float_as_uint(aff[idx]) << 13) | (unsigned long long)(8191 - idx)) : 0ull; }
    unsigned long long prefix = 0ull, mask = 0ull; unsigned need = (unsigned)cap;
#pragma unroll 1
    for (int shift = 40; shift >= 0; shift -= 8) {
        if (tid < 256) hist[tid] = 0u;
        if (tid == 0) sh[2] = 0u;
        __syncthreads();
#pragma unroll
        for (int i = 0; i < 16; ++i) if (tid + 512 * i < n && (key[i] & mask) == prefix) __hip_atomic_fetch_add(&hist[(unsigned)(key[i] >> shift) & 255u], 1u, __ATOMIC_RELAXED, __HIP_MEMORY_SCOPE_WORKGROUP);
        __syncthreads();
        if (wave == 0) {
            unsigned loc[4]; unsigned ls = 0;
#pragma unroll
            for (int j = 0; j < 4; ++j) { loc[j] = hist[255 - 4 * lane - j]; ls += loc[j]; }
            unsigned incl = ls;
#pragma unroll
            for (int o = 1; o < 64; o <<= 1) { const unsigned t = (unsigned)__builtin_amdgcn_ds_bpermute((lane - o) << 2, (int)incl); if (lane >= o) incl += t; }
            const unsigned long long bal = __ballot(incl >= need);
            const int first = __ffsll((long long)bal) - 1;
            if (lane == first) { unsigned run = incl - ls; int bin = 255 - 4 * lane; unsigned above = run;
#pragma unroll
                for (int j = 0; j < 4; ++j) { if (run + loc[j] >= need) { bin = 255 - 4 * lane - j; above = run; break; } run += loc[j]; }
                sh[0] = (unsigned)bin; sh[1] = above; }
        }
        __syncthreads();
        prefix |= ((unsigned long long)sh[0]) << shift; mask |= 255ull << shift; need -= sh[1];
        __syncthreads();
    }
    int* SROW = (int*)(p.ws + OFF_SROW); float* SGATE = (float*)(p.ws + OFF_SGATE); int* INV = (int*)(p.ws + OFF_INV);
    const int sb = lat ? b * CAPL : 4 * CAPL + b * CAPC;
#pragma unroll
    for (int i = 0; i < 16; ++i) { const int idx = tid + 512 * i;
        if (idx < n && key[i] >= prefix) { const unsigned pos = __hip_atomic_fetch_add(&sh[2], 1u, __ATOMIC_RELAXED, __HIP_MEMORY_SCOPE_WORKGROUP); const int slot = sb + (int)pos; const int row = b * TT + (lat ? NCTX + idx : idx);
            SROW[e * ESLOT + slot] = row; SGATE[e * ESLOT + slot] = __uint_as_float((unsigned)(key[i] >> 13)); INV[(size_t)row * 16 + e] = slot; } }
    if (lat && b == 0 && tid < 128) { SROW[e * ESLOT + 4 * CAPL + 4 * CAPC + tid] = -1; SGATE[e * ESLOT + 4 * CAPL + 4 * CAPC + tid] = 0.f; }
    __syncthreads();
}
__device__ void ph_topk(const Params& p, LAS unsigned char* lds, int wg, int nwg) { for (int u = wg; u < 128; u += nwg) topk_unit(p, lds, u); }

__device__ void ph_gather(const Params& p, int wg, int nwg) {
    const int tid = otid(), wave = tid >> 6, lane = tid & 63;
    const int* SROW = (const int*)(p.ws + OFF_SROW); const bf16_t* H = (const bf16_t*)(p.ws + OFF_H); unsigned char* XG = p.ws + OFF_XG;
    const int step = nwg * 8; int i = wg * 8 + wave;
    u32x4 a = {0u, 0u, 0u, 0u}, c = {0u, 0u, 0u, 0u};
    auto ld = [&](int ii) { const int row = SROW[ii]; a = (u32x4){0u, 0u, 0u, 0u}; c = a; if (row >= 0) { const u32x4* src = (const u32x4*)(H + (size_t)row * 1024); a = src[2 * lane]; c = src[2 * lane + 1]; } };
    if (i < EROWS) ld(i);
    while (i < EROWS) {
        const u32x4 ca = a, cc = c;
        if (i + step < EROWS) ld(i + step);
        u32x4 w;
#pragma unroll
        for (int j = 0; j < 2; ++j) { w[j] = pk4_fp8(bflo(ca[2 * j]), bfhi(ca[2 * j]), bflo(ca[2 * j + 1]), bfhi(ca[2 * j + 1])); w[2 + j] = pk4_fp8(bflo(cc[2 * j]), bfhi(cc[2 * j]), bflo(cc[2 * j + 1]), bfhi(cc[2 * j + 1])); }
        *(u32x4*)(XG + (size_t)i * 1024 + lane * 16) = w;
        i += step;
    }
}

__device__ void ph_combine(const Params& p, int l, int wg, int nwg, float scale) {
    const int tid = otid(), wave = tid >> 6, lane = tid & 63;
    const int* INV = (const int*)(p.ws + OFF_INV); const float* SGATE = (const float*)(p.ws + OFF_SGATE); const bf16_t* OUT = (const bf16_t*)(p.ws + OFF_OUT);
    float* X = (float*)(p.ws + OFF_X); const float* MOD = (const float*)(p.ws + OFF_MOD) + (size_t)l * 5 * 6144; bf16_t* H = (bf16_t*)(p.ws + OFF_H);
    const bool nxt = (l + 1 < NL) && (scale != 0.f), last = (l + 1 == NL) && (scale != 0.f); const float* g1n = p.norm1_g + (nxt ? (l + 1) : l) * 1024; const float* MODN = MOD + (nxt ? 5 * 6144 : 0);
    for (int r = wg * 8 + wave; r < RR; r += nwg * 8) {
        const u32x4* iv = (const u32x4*)(INV + (size_t)r * 16); const u32x4 sl0 = iv[0], sl1 = iv[1], sl2 = iv[2], sl3 = iv[3];
        const int mi = row_mod(r); const float* g2 = MOD + mi * 6144 + 5 * 1024; float* xr = X + (size_t)r * 1024; const float* md = MODN + mi * 6144;
        f32x4 xv[4], gv[4], ggv[4], shv[4], scv[4];
#pragma unroll
        for (int j = 0; j < 4; ++j) { const int col = (j >> 1) * 512 + lane * 8 + 4 * (j & 1); xv[j] = *(const f32x4*)(xr + col); gv[j] = *(const f32x4*)(g2 + col);
            if (nxt) { ggv[j] = *(const f32x4*)(g1n + col); shv[j] = *(const f32x4*)(md + col); scv[j] = *(const f32x4*)(md + 1024 + col); } }
        float acc[16];
#pragma unroll
        for (int i = 0; i < 16; ++i) acc[i] = 0.f;
#pragma unroll
        for (int e = 0; e < 16; ++e) { const int slot = (int)(e < 4 ? sl0[e & 3] : (e < 8 ? sl1[e & 3] : (e < 12 ? sl2[e & 3] : sl3[e & 3])));
            if (slot >= 0) { const float gt = SGATE[e * ESLOT + slot]; const u32x4* src = (const u32x4*)(OUT + ((size_t)(e * ESLOT + slot)) * 1024);
                const u32x4 a = src[lane], c = src[64 + lane];
#pragma unroll
                for (int i = 0; i < 4; ++i) { acc[2 * i] += gt * bflo(a[i]); acc[2 * i + 1] += gt * bfhi(a[i]); acc[8 + 2 * i] += gt * bflo(c[i]); acc[9 + 2 * i] += gt * bfhi(c[i]); } } }
        float* orow = p.out + ((size_t)(mi & 3) * SEQ + (size_t)(r - (r / TT) * TT - NCTX)) * 1024;
        float ss = 0.f;
#pragma unroll
        for (int j = 0; j < 4; ++j)
#pragma unroll
            for (int i = 0; i < 4; ++i) { xv[j][i] += gv[j][i] * acc[(j >> 1) * 8 + (j & 1) * 4 + i] * scale; ss += xv[j][i] * xv[j][i]; }
        float y[16]; float inv = 0.f, am = 0.f;
        if (nxt) { ss = wave_sum(ss); const float rinv = rsqrtf(ss * (1.f / 1024.f) + 1e-6f);
#pragma unroll
            for (int j = 0; j < 4; ++j)
#pragma unroll
                for (int i = 0; i < 4; ++i) { const float t = xv[j][i] * rinv * ggv[j][i] * (1.f + scv[j][i]) + shv[j][i]; y[j * 4 + i] = t; am = fmaxf(am, fabsf(t)); }
            am = fmaxf(wave_max(am), 1e-20f); inv = 127.f / am; }
#pragma unroll
        for (int j = 0; j < 4; ++j) { const int col = (j >> 1) * 512 + lane * 8 + 4 * (j & 1);
            if (last) { if (mi < 4) *(f32x4*)(orow + col) = xv[j]; } else *(f32x4*)(xr + col) = xv[j]; }
        if (nxt) { if (lane == 0) ((float*)(p.ws + OFF_SH))[r] = am * (1.f / 127.f);
#pragma unroll
            for (int hh = 0; hh < 2; ++hh) { u32x2 w = {pk4_i8(y[hh * 8] * inv, y[hh * 8 + 1] * inv, y[hh * 8 + 2] * inv, y[hh * 8 + 3] * inv), pk4_i8(y[hh * 8 + 4] * inv, y[hh * 8 + 5] * inv, y[hh * 8 + 6] * inv, y[hh * 8 + 7] * inv)};
                *(u32x2*)((unsigned char*)H + (size_t)r * 1024 + hh * 512 + lane * 8) = w; } }
    }
}
__device__ void ph_output(const Params& p, int wg, int nwg) {
    const float4* X4 = (const float4*)(p.ws + OFF_X); float4* O4 = (float4*)p.out;
    const size_t n4 = (size_t)NB * SEQ * 256;
    for (size_t i = (size_t)wg * 512 + otid(); i < n4; i += (size_t)nwg * 512) { const size_t row = i >> 8; const size_t b = row / SEQ, t = row - b * SEQ; O4[i] = X4[(b * TT + NCTX + t) * 256 + (i & 255)]; }
}
constexpr int LDS_BYTES = 131072 + 256;
enum { PH_PROLOGUE = 0, PH_A, PH_B, PH_C, PH_D, PH_E, PH_F, PH_G, PH_H, PH_I, PH_J, PH_K, PH_L, PH_M, PH_OUT };

#ifndef PROBE_NOST
#define PROBE_NOST 0
#endif
template <int PH> DI void run_phase(const Params& pin, int l, LAS unsigned char* lds, int wg_in, int nwg, int dup = 0) {
    int wg = wg_in; asm volatile("" : "+s"(wg));
    Params p = pin; { unsigned long long w = (unsigned long long)pin.ws; asm volatile("" : "+s"(w)); p.ws = (unsigned char*)(__attribute__((address_space(1))) unsigned char*)w; }
    if constexpr (PH == PH_PROLOGUE) { ph_prologue(p, lds, wg, nwg); conv_mixer_b(p, 0, lds, wg, nwg); conv_mixer_a(p, 0, lds); }
    if constexpr (PH == PH_A) { norm1_rows(p, l, wg, nwg); }
    if constexpr (PH == PH_B) { int kq = 512; asm volatile("" : "+s"(kq));
        pg8::Gemm g{(const bf16_t*)(p.ws + OFF_H), (const bf16_t*)(p.ws + OFF_WIN), RR, NIN, kq}; SchedPlain S; S.init(RR / 256, NIN / 256, nwg, wg); EpiInProj E{p.ws, (PROBE_NOST && dup) ? 1 : 0};
        pg8::gemm_phase<EpiInProj, SchedPlain, false, 2>(lds, g, S, E, nullptr); }
    if constexpr (PH == PH_C) ph_prep(p, l, lds, wg, nwg, dup);
    if constexpr (PH == PH_D) ph_mix(p, l, lds, (LAS unsigned*)(lds + 131072 + 64), dup);
    if constexpr (PH == PH_E) ph_post(p, l, wg, nwg);
    if constexpr (PH == PH_F) { pg8::Gemm g{(const bf16_t*)(p.ws + OFF_YA), (const bf16_t*)(p.ws + OFF_WBR), RR, 1024, 512}; SchedMerge S; S.init(nwg, wg); EpiMerge E{p.ws, (PROBE_NOST == 3 && dup) ? 1 : 0};
        pg8::gemm_phase<EpiMerge, SchedMerge>(lds, g, S, E, nullptr); ctx_merge_units(p, wg, nwg); }
    if constexpr (PH == PH_G) { pg8::Gemm g{(const bf16_t*)(p.ws + OFF_M), (const bf16_t*)(p.ws + OFF_WOUT), RR, 1024, 1024}; SchedLat S; S.init(nwg, wg); EpiOut E{p.ws, l, dup ? 0.f : 1.f};
        pg8::gemm_phase<EpiOut, SchedLat>(lds, g, S, E, nullptr); ctx_out_units(p, l, wg, nwg, dup ? 0.f : 1.f); }
    if constexpr (PH == PH_H) { if (!dup) { conv_expert_weights(p, l, lds); if (l + 1 < NL) { conv_mixer_b(p, l + 1, lds, wg, nwg); conv_mixer_a(p, l + 1, lds); } } ph_norm2(p, l, lds, wg, nwg); }
    if constexpr (PH == PH_I) ph_topk(p, lds, wg, nwg);
    if constexpr (PH == PH_J) ph_gather(p, wg, nwg);
    if constexpr (PH == PH_K) { int kq = 512; asm volatile("" : "+s"(kq));
        pg8::Gemm g{(const bf16_t*)(p.ws + OFF_XG), (const bf16_t*)(p.ws + OFF_W13), EROWS, 2048, kq}; SchedMoe<8> S; S.init(nwg, wg); EpiUp E{p.ws};
        pg8::gemm_phase<EpiUp, SchedMoe<8>, false, 1>(lds, g, S, E, nullptr); }
    if constexpr (PH == PH_L) { int kq = 512; asm volatile("" : "+s"(kq));
        pg8::Gemm g{(const bf16_t*)(p.ws + OFF_HID), (const bf16_t*)(p.ws + OFF_W2), EROWS, 1024, kq}; SchedMoe<4> S; S.init(nwg, wg); EpiDown E{p.ws};
        pg8::gemm_phase<EpiDown, SchedMoe<4>, false, 1>(lds, g, S, E, nullptr); }
    if constexpr (PH == PH_M) ph_combine(p, l, wg, nwg, dup ? 0.f : 1.f);
    if constexpr (PH == PH_OUT) { conv_expert_weights(p, l, lds, 32); if (l + 1 < NL) conv_mixer_b(p, l + 1, lds, wg, nwg); }
}

DI void grid_barrier(const Params& p, LAS unsigned* xbw) {
    unsigned long long w = (unsigned long long)p.ws; asm volatile("" : "+s"(w));
    XcdBarrier b; b.bar = (unsigned*)(__attribute__((address_space(1))) unsigned*)(w + OFF_BAR); b.x = xb_xcc_id(); b.st = (volatile LAS unsigned*)xbw; xcd_barrier(b);
}
#ifndef PROBE_MASK
#define PROBE_MASK 0u
#endif
#ifndef MEGA
#define MEGA 1
#endif
#if !MEGA
template <int PH> __global__ __launch_bounds__(512, 2) void k_phase(Params p, int l) {
    extern __shared__ __attribute__((aligned(16))) unsigned char shm[];
    run_phase<PH>(p, l, (LAS unsigned char*)shm, blockIdx.x, gridDim.x);
}
template <int PH> static void launch_phase(const Params& p, int l, int grid, hipStream_t st) {
    static bool attr = false;
    if (!attr) { (void)hipFuncSetAttribute((const void*)k_phase<PH>, hipFuncAttributeMaxDynamicSharedMemorySize, LDS_BYTES); attr = true; }
    hipLaunchKernelGGL(k_phase<PH>, dim3(grid), dim3(512), LDS_BYTES, st, p, l);
}
#else
__global__ __launch_bounds__(512, 2) void k_mega(Params p) {
    extern __shared__ __attribute__((aligned(16))) unsigned char shm[];
    LAS unsigned char* lds = (LAS unsigned char*)shm;
    LAS unsigned* xbw = (LAS unsigned*)(lds + 131072);
    if (threadIdx.x < 4) xbw[threadIdx.x] = 0u;
    __syncthreads();
    (void)xcd_barrier_post((unsigned*)(p.ws + OFF_BAR), (volatile LAS unsigned*)xbw);
    const int wg = blockIdx.x, nwg = gridDim.x;
    run_phase<PH_PROLOGUE>(p, 0, lds, wg, nwg); grid_barrier(p, xbw);
    if (PROBE_MASK & (1u << PH_PROLOGUE)) { run_phase<PH_PROLOGUE>(p, 0, lds, wg, nwg); grid_barrier(p, xbw); }
#pragma unroll 1
    for (int l = 0; l < NL; ++l) {
        if (l == 0) { run_phase<PH_A>(p, l, lds, wg, nwg); grid_barrier(p, xbw); }
        if (l == 0 && (PROBE_MASK & (1u << PH_A))) { run_phase<PH_A>(p, l, lds, wg, nwg); grid_barrier(p, xbw); }
        run_phase<PH_B>(p, l, lds, wg, nwg); grid_barrier(p, xbw);
        if (PROBE_MASK & (1u << PH_B)) { run_phase<PH_B>(p, l, lds, wg, nwg, 1); grid_barrier(p, xbw); }
        run_phase<PH_C>(p, l, lds, wg, nwg); grid_barrier(p, xbw);
        if (PROBE_MASK & (1u << PH_C)) { run_phase<PH_C>(p, l, lds, wg, nwg, 1); grid_barrier(p, xbw); }
        run_phase<PH_D>(p, l, lds, wg, nwg); grid_barrier(p, xbw);
        if (PROBE_MASK & (1u << PH_D)) { run_phase<PH_D>(p, l, lds, wg, nwg, 1); grid_barrier(p, xbw); }
        run_phase<PH_E>(p, l, lds, wg, nwg); grid_barrier(p, xbw);
        if (PROBE_MASK & (1u << PH_E)) { run_phase<PH_E>(p, l, lds, wg, nwg, 1); grid_barrier(p, xbw); }
        run_phase<PH_F>(p, l, lds, wg, nwg); grid_barrier(p, xbw);
        if (PROBE_MASK & (1u << PH_F)) { run_phase<PH_F>(p, l, lds, wg, nwg, 1); grid_barrier(p, xbw); }
        run_phase<PH_G>(p, l, lds, wg, nwg); grid_barrier(p, xbw);
        if (PROBE_MASK & (1u << PH_G)) { run_phase<PH_G>(p, l, lds, wg, nwg, 1); grid_barrier(p, xbw); }
        run_phase<PH_H>(p, l, lds, wg, nwg); grid_barrier(p, xbw);
        if (PROBE_MASK & (1u << PH_H)) { run_phase<PH_H>(p, l, lds, wg, nwg, 1); grid_barrier(p, xbw); }
        if (PROBE_MASK & (1u << PH_OUT)) { run_phase<PH_OUT>(p, l, lds, wg, nwg, 1); grid_barrier(p, xbw); }
        run_phase<PH_I>(p, l, lds, wg, nwg); grid_barrier(p, xbw);
        if (PROBE_MASK & (1u << PH_I)) { run_phase<PH_I>(p, l, lds, wg, nwg, 1); grid_barrier(p, xbw); }
        run_phase<PH_J>(p, l, lds, wg, nwg); grid_barrier(p, xbw);
        if (PROBE_MASK & (1u << PH_J)) { run_phase<PH_J>(p, l, lds, wg, nwg, 1); grid_barrier(p, xbw); }
        run_phase<PH_K>(p, l, lds, wg, nwg); grid_barrier(p, xbw);
        if (PROBE_MASK & (1u << PH_K)) { run_phase<PH_K>(p, l, lds, wg, nwg, 1); grid_barrier(p, xbw); }
        run_phase<PH_L>(p, l, lds, wg, nwg); grid_barrier(p, xbw);
        if (PROBE_MASK & (1u << PH_L)) { run_phase<PH_L>(p, l, lds, wg, nwg, 1); grid_barrier(p, xbw); }
        run_phase<PH_M>(p, l, lds, wg, nwg); grid_barrier(p, xbw);
        if (PROBE_MASK & (1u << PH_M)) { run_phase<PH_M>(p, l, lds, wg, nwg, 1); grid_barrier(p, xbw); }
    }
}
#endif

extern "C" void kernel_launch(void* const* d_in, const int* in_sizes, int n_in, void* d_out, int out_size, void* d_ws, size_t ws_size, hipStream_t stream) {
    if (n_in < 31 || ws_size < WS_NEEDED) return;
    Params p{};
    const float** f = (const float**)&p;
    for (int i = 0; i < 31; ++i) f[i] = (const float*)d_in[i];
    p.out = (float*)d_out; p.ws = (unsigned char*)d_ws;
    (void)hipMemsetAsync(d_ws, 0, 65536, stream);
#if !MEGA
    const int G = 256;
    launch_phase<PH_PROLOGUE>(p, 0, G, stream);
    for (int l = 0; l < NL; ++l) {
        launch_phase<PH_A>(p, l, G, stream); launch_phase<PH_B>(p, l, G, stream); launch_phase<PH_C>(p, l, G, stream); launch_phase<PH_D>(p, l, G, stream);
        launch_phase<PH_E>(p, l, G, stream); launch_phase<PH_F>(p, l, G, stream); launch_phase<PH_G>(p, l, G, stream); launch_phase<PH_H>(p, l, G, stream);
        launch_phase<PH_I>(p, l, G, stream); launch_phase<PH_J>(p, l, G, stream); launch_phase<PH_K>(p, l, G, stream); launch_phase<PH_L>(p, l, G, stream);
        launch_phase<PH_M>(p, l, G, stream);
    }
    launch_phase<PH_OUT>(p, 0, G, stream);
#else
    static int grid = 0;
    if (!grid) {
        (void)hipFuncSetAttribute((const void*)k_mega, hipFuncAttributeMaxDynamicSharedMemorySize, LDS_BYTES);
        int dev = 0, cus = 0, per_cu = 0; (void)hipGetDevice(&dev); (void)hipDeviceGetAttribute(&cus, hipDeviceAttributeMultiprocessorCount, dev);
        (void)hipOccupancyMaxActiveBlocksPerMultiprocessor(&per_cu, (const void*)k_mega, 512, LDS_BYTES);
        grid = cus * (per_cu < 1 ? per_cu : 1);
    }
    if (grid <= 0) return;
    hipLaunchKernelGGL(k_mega, dim3(grid), dim3(512), LDS_BYTES, stream, p);
#endif
}
```

```cpp
#include <hip/hip_runtime.h>
#include <stdint.h>

#define LAS __attribute__((address_space(3)))
typedef unsigned short bf16_t;
typedef short bf16x8 __attribute__((ext_vector_type(8)));
typedef float f32x4 __attribute__((ext_vector_type(4)));
typedef float f32x16 __attribute__((ext_vector_type(16)));
typedef float f32x2v __attribute__((ext_vector_type(2)));
typedef __bf16 bf16x2v __attribute__((ext_vector_type(2)));
typedef unsigned u32x4 __attribute__((ext_vector_type(4)));
typedef unsigned u32x2 __attribute__((ext_vector_type(2)));

#define DI __device__ __forceinline__
DI int otid() { int t = threadIdx.x; asm volatile("" : "+v"(t)); return t; }
DI float bf2f(bf16_t v) { return __uint_as_float(((unsigned)v) << 16); }
DI float bflo(unsigned w) { return __uint_as_float(w << 16); }
DI float bfhi(unsigned w) { return __uint_as_float(w & 0xffff0000u); }
DI unsigned pk2(float a, float b) { f32x2v v = {a, b}; return __builtin_bit_cast(unsigned, __builtin_convertvector(v, bf16x2v)); }
DI unsigned pk4_fp8(float a, float b, float c, float d) { unsigned w = 0; w = __builtin_amdgcn_cvt_pk_fp8_f32(a, b, w, false); w = __builtin_amdgcn_cvt_pk_fp8_f32(c, d, w, true); return w; }
DI unsigned pk4_i8(float a, float b, float c, float d) { const int ia = (int)rintf(a), ib = (int)rintf(b), ic = (int)rintf(c), id = (int)rintf(d); return (unsigned)(ia & 255) | ((unsigned)(ib & 255) << 8) | ((unsigned)(ic & 255) << 16) | ((unsigned)id << 24); }
DI unsigned pk4_u8(float a, float b, float c, float d) { unsigned w = 0; w = __builtin_amdgcn_cvt_pk_u8_f32(a, 0, w); w = __builtin_amdgcn_cvt_pk_u8_f32(b, 1, w); w = __builtin_amdgcn_cvt_pk_u8_f32(c, 2, w); w = __builtin_amdgcn_cvt_pk_u8_f32(d, 3, w); return w; }
DI bf16_t f2bf(float a) { return (bf16_t)(pk2(a, 0.f) & 0xffffu); }
DI float sigmoidf_(float x) { return __builtin_amdgcn_rcpf(1.f + __expf(-x)); }
template <int CTRL> DI float dppmov(float x) { return __builtin_bit_cast(float, __builtin_amdgcn_update_dpp(0, __builtin_bit_cast(int, x), CTRL, 0xf, 0xf, true)); }
DI float allsum16(float x) { x += dppmov<0xB1>(x); x += dppmov<0x4E>(x); x += dppmov<0x141>(x); x += dppmov<0x140>(x); return x; }
DI float allsum8(float x) { x += dppmov<0xB1>(x); x += dppmov<0x4E>(x); x += dppmov<0x141>(x); return x; }
DI float allmax16(float x) { x = fmaxf(x, dppmov<0xB1>(x)); x = fmaxf(x, dppmov<0x4E>(x)); x = fmaxf(x, dppmov<0x141>(x)); x = fmaxf(x, dppmov<0x140>(x)); return x; }
DI float sum_x16(float x) { auto r = __builtin_amdgcn_permlane16_swap(__float_as_uint(x), __float_as_uint(x), false, false); return __uint_as_float(r[0]) + __uint_as_float(r[1]); }
DI float sum_x32(float x) { auto r = __builtin_amdgcn_permlane32_swap(__float_as_uint(x), __float_as_uint(x), false, false); return __uint_as_float(r[0]) + __uint_as_float(r[1]); }
DI float wave_sum(float v) { return sum_x32(sum_x16(allsum16(v))); }
DI float wave_max(float v) { v = allmax16(v); { auto r = __builtin_amdgcn_permlane16_swap(__float_as_uint(v), __float_as_uint(v), false, false); v = fmaxf(__uint_as_float(r[0]), __uint_as_float(r[1])); }
    { auto r = __builtin_amdgcn_permlane32_swap(__float_as_uint(v), __float_as_uint(v), false, false); v = fmaxf(__uint_as_float(r[0]), __uint_as_float(r[1])); } return v; }
DI float bperm(float v, int byte_addr) { return __builtin_bit_cast(float, __builtin_amdgcn_ds_bpermute(byte_addr, __builtin_bit_cast(int, v))); }

constexpr int NB = 4, SEQ = 8192, NCTX = 256, TT = SEQ + NCTX, RR = NB * TT, DM = 1024, NIN = 7936, NL = 4;
constexpr int NE = 16, CAPL = 1024, CAPC = 32, ESLOT = 4352, EROWS = NE * ESLOT;
static_assert(RR == 33792 && RR % 256 == 0 && EROWS % 256 == 0, "shape");

constexpr size_t MB1 = 1u << 20;
constexpr size_t alignup(size_t x) { return (x + MB1 - 1) / MB1 * MB1; }
constexpr size_t SZ_T = (size_t)RR * 512 * 2;
constexpr size_t OFF_BAR = 0;
constexpr size_t OFF_CTR = 32768;
constexpr size_t OFF_MOD = 65536;
constexpr size_t OFF_ROPE = OFF_MOD + (size_t)NL * 5 * 6144 * 4;
constexpr size_t OFF_AFFL = MB1;
constexpr size_t OFF_AFFC = OFF_AFFL + (size_t)4 * 16 * 8192 * 4;
constexpr size_t OFF_SROW = OFF_AFFC + (size_t)4 * 16 * 256 * 4;
constexpr size_t OFF_SGATE = OFF_SROW + (size_t)EROWS * 4;
constexpr size_t OFF_INV = OFF_SGATE + (size_t)EROWS * 4;
constexpr size_t OFF_LRW = OFF_INV + (size_t)RR * 16 * 4;
constexpr size_t OFF_SW = OFF_LRW + (size_t)(4 * 512 * 64 + 512 * 128) * 2;
constexpr size_t OFF_SH = OFF_SW + (size_t)NIN * 4;
constexpr size_t OFF_X = alignup(OFF_SH + (size_t)RR * 4);
constexpr size_t OFF_H = alignup(OFF_X + (size_t)RR * 1024 * 4);
constexpr size_t OFF_VT = OFF_H;
constexpr size_t OFF_YB0 = OFF_H + SZ_T;
constexpr size_t OFF_M = OFF_H;
constexpr size_t OFF_WIN = alignup(OFF_H + 2 * SZ_T);
constexpr size_t OFF_WBR = alignup(OFF_WIN + (size_t)NIN * 1024 * 2);
constexpr size_t OFF_WOUT = alignup(OFF_WBR + (size_t)3 * 1024 * 512 * 2);
constexpr size_t OFF_PA = alignup(OFF_WOUT + (size_t)1024 * 1024 * 2);
constexpr size_t OFF_PR = alignup(OFF_PA + (size_t)RR * 1536 * 2);
constexpr size_t OFF_PC = alignup(OFF_PR + (size_t)RR * 1792 * 2);
constexpr size_t OFF_PG = alignup(OFF_PC + (size_t)RR * 1536 * 2);
constexpr size_t OFF_PEND = alignup(OFF_PG + (size_t)RR * 3072 * 2);
constexpr size_t OFF_OS = OFF_PR;
constexpr size_t OFF_OA = OFF_OS + 2 * SZ_T;
constexpr size_t OFF_YA = alignup(OFF_OA + 2 * SZ_T);
constexpr size_t OFF_YB = alignup(OFF_YA + SZ_T);
static_assert(OFF_YB + SZ_T <= OFF_PG, "overlay");
constexpr size_t OFF_XG = OFF_PR;
constexpr size_t OFF_HID = alignup(OFF_XG + (size_t)EROWS * 1024);
constexpr size_t OFF_OUT = alignup(OFF_HID + (size_t)EROWS * 1024);
static_assert(OFF_OUT + (size_t)EROWS * 1024 * 2 <= OFF_PEND, "overlay");
constexpr size_t OFF_EW = OFF_PEND;
constexpr size_t OFF_AA = OFF_EW + 2 * SZ_T;
constexpr size_t OFF_KK = OFF_AA + 2 * SZ_T;
constexpr size_t OFF_KC = OFF_KK + SZ_T;
constexpr size_t OFF_RC = OFF_KC + SZ_T;
constexpr size_t OFF_VC = OFF_RC + SZ_T;
constexpr size_t OFF_YC = alignup(OFF_VC + SZ_T);
constexpr size_t OFF_G = alignup(OFF_YC + SZ_T);
constexpr size_t OFF_W13 = alignup(OFF_G + SZ_T);
constexpr size_t OFF_W2 = OFF_W13 + (size_t)16 * 2048 * 1024;
constexpr size_t WS_NEEDED = alignup(OFF_W2 + (size_t)16 * 1024 * 1024);
constexpr int YTILE = 262144;
static_assert((OFF_YB - OFF_YA) % YTILE == 0 && (OFF_YC - OFF_YA) % YTILE == 0 && OFF_YC > OFF_YA, "merge A tiles");

struct Params {
    const float *x, *c, *ctx, *c_ctx, *norm1_g, *norm2_g, *ada_w, *ada_b, *w_in, *q_norm_g, *k_norm_g, *diff_lambda, *diff_subln_g,
        *rwkv_conv_w, *rwkv_w0, *rwkv_w_up, *rwkv_a0, *rwkv_a_up, *rwkv_g_up, *rwkv_k_k, *rwkv_k_a, *rwkv_r_k, *rwkv_ln_g, *rwkv_ln_b,
        *conv_w, *w_branch, *w_out, *router_w, *exp_w1, *exp_w3, *exp_w2;
    float* out;
    unsigned char* ws;
};
#define XB_TMO      128
#define XB_XCNT(j)  (256  + 64 * (j))
#define XB_XSUB(j)  (1280 + 64 * (j))
#define XB_XGEN(j)  (2304 + 64 * (j))
#define XB_TOP      3328
#define XB_TOPGEN   3392
#define XCD_BAR_WORDS 3456
#define XB_SPIN_CAP (1u << 18)

__device__ __forceinline__ unsigned xb_ld(unsigned* p)              { return __hip_atomic_load(p, __ATOMIC_RELAXED, __HIP_MEMORY_SCOPE_AGENT); }
__device__ __forceinline__ unsigned xb_add(unsigned* p, unsigned v) { return __hip_atomic_fetch_add(p, v, __ATOMIC_RELAXED, __HIP_MEMORY_SCOPE_AGENT); }
__device__ __forceinline__ unsigned xb_xcc_id() { return (unsigned)__builtin_amdgcn_s_getreg((3 << 11) | 20) & 0xFu; }
#define XB_SPIN(cond, bar) do { unsigned _sp = 0; while (cond) { __builtin_amdgcn_s_sleep(1); \
    if ((++_sp & 255u) == 0u) { if (xb_ld(&(bar)[XB_TMO])) break; if (_sp > XB_SPIN_CAP) { atomicAdd(&(bar)[XB_TMO], 1u); break; } } } } while (0)

struct XcdBarrier {
    unsigned* bar; unsigned x;
    volatile LAS unsigned* st;
};

__device__ __forceinline__ XcdBarrier xcd_barrier_post(unsigned* bar, volatile LAS unsigned* st) {
    XcdBarrier b; b.bar = bar; b.x = xb_xcc_id(); b.st = st;
    if (threadIdx.x == 0) (void)xb_add(&bar[XB_XCNT(b.x)], 1u);
    return b;
}
__device__ __forceinline__ void xcd_barrier_complete(unsigned* bar, unsigned x, unsigned& nloc, unsigned& nx) {
    const unsigned G = gridDim.x * gridDim.y * gridDim.z;
    unsigned sum, cnt, mine, sp = 0u;
    for (;;) {
        sum = 0u; cnt = 0u; mine = 0u;
#pragma unroll
        for (unsigned j = 0; j < 16; ++j) { const unsigned c = xb_ld(&bar[XB_XCNT(j)]); sum += c; cnt += (c > 0u) ? 1u : 0u; mine = (j == x) ? c : mine; }
        if (sum == G) break;
        __builtin_amdgcn_s_sleep(1);
        if ((++sp & 255u) == 0u) { if (xb_ld(&bar[XB_TMO])) break; if (sp > XB_SPIN_CAP) { atomicAdd(&bar[XB_TMO], 1u); break; } }
    }
    nloc = mine > 0u ? mine : 1u; nx = cnt > 0u ? cnt : 1u;
}

__device__ __forceinline__ void xcd_barrier(const XcdBarrier& b) {
    asm volatile("s_waitcnt vmcnt(0)" ::: "memory");
    __syncthreads();
    if (threadIdx.x == 0) {
        unsigned* bar = b.bar;
        __builtin_amdgcn_s_waitcnt(0);
        unsigned nloc = b.st[0], nx = b.st[1];
        if (nloc == 0u) { xcd_barrier_complete(bar, b.x, nloc, nx); b.st[0] = nloc; b.st[1] = nx; }
        const unsigned old = xb_add(&bar[XB_XSUB(b.x)], 1u);
        const unsigned gen = old / nloc;
        if (old + 1u == (gen + 1u) * nloc) {
            __builtin_amdgcn_fence(__ATOMIC_RELEASE, "agent");
            asm volatile("s_waitcnt vmcnt(0)" ::: "memory");
            const unsigned og = xb_add(&bar[XB_TOP], 1u);
            const unsigned tg = og / nx;
            if (og + 1u == (tg + 1u) * nx) xb_add(&bar[XB_TOPGEN], 1u);
            else XB_SPIN(xb_ld(&bar[XB_TOPGEN]) == tg, bar);
            __builtin_amdgcn_fence(__ATOMIC_ACQUIRE, "agent");
            xb_add(&bar[XB_XGEN(b.x)], 1u);
            asm volatile("s_waitcnt vmcnt(0)" ::: "memory");
        } else {
            XB_SPIN(xb_ld(&bar[XB_XGEN(b.x)]) == gen, bar);
            __builtin_amdgcn_fence(__ATOMIC_ACQUIRE, "agent");
            asm volatile("s_waitcnt vmcnt(0)" ::: "memory");
        }
    }
    __syncthreads();
}
namespace pg8 {
#define PG8_LAS __attribute__((address_space(3)))
constexpr int BM = 256, BK = 64, HALF = 128, HTB = HALF * BK * 2  , STAGE_BYTES = 8 * HTB, NXCD = 8, WGM = 8;
__host__ __device__ __forceinline__ int lds_byte(int r, int c) { const int st = (r >> 4) * 2 + (c >> 5), rr = r & 15, cc = c & 31, ob = rr * 64 + cc * 2; return st * 1024 + (ob ^ (((ob >> 9) & 1) << 5)); }
__host__ __device__ __forceinline__ void stage_rc(int b, int& R, int& C) { const int st = b / 1024, sb = b % 1024, swz = sb ^ (((sb >> 9) & 1) << 5); R = (st >> 1) * 16 + swz / 64; C = (st & 1) * 32 + (swz % 64) / 2; }
__host__ __device__ __forceinline__ int perm32(int rho) { const int n = rho >> 4, i = rho & 15; return 8 * (i >> 2) + 4 * n + (i & 3); }
typedef int v4i_t __attribute__((ext_vector_type(4)));
typedef int v8i_t __attribute__((ext_vector_type(8)));
struct Unit { int pm, pn; int rt, ct, br; };
struct Gemm { const bf16_t* A; const bf16_t* Bt; int M, N, K; };
template <class Epi, class Sched, bool STAMP = false, int QM = 0>
__device__ __forceinline__ void gemm_phase(PG8_LAS unsigned char* lds, const Gemm g, const Sched& S, const Epi& E, unsigned long long* stamps) {
    const int tid = otid(), wid = __builtin_amdgcn_readfirstlane(tid >> 6), lane = tid & 63, wr = wid >> 2, wc = wid & 3, fr = lane & 15, fq = lane >> 4;
    const int K = g.K, nt = K / BK;
    int ts_lo = 0, ts_hi = 0, nts = 0; const unsigned long long rt_entry = STAMP ? (unsigned long long)wall_clock64() : 0ull;
#define PG8_STAMP() do { if (STAMP && wid == 0 && nts < 64) { const unsigned long long _c = (unsigned long long)clock64(); \
        ts_lo = (lane == nts) ? (int)(unsigned)_c : ts_lo; ts_hi = (lane == nts) ? (int)(unsigned)(_c >> 32) : ts_hi; ++nts; } } while (0)
    PG8_STAMP();
    unsigned voffA[2], voffB[2];
#pragma unroll
    for (int i = 0; i < 2; ++i) { int R, C; stage_rc(tid * 16 + i * 8192, R, C); const int Rb = Epi::PERM ? ((R & ~31) + perm32(R & 31)) : R;
        voffA[i] = (unsigned)(R * K + C) * 2u; voffB[i] = (unsigned)(Rb * K + C) * 2u; }
    const size_t kstep = (size_t)(BK * 2);
    const size_t hstep = (size_t)HALF * K * 2;
    const size_t tstep = 2 * hstep;
    const unsigned ldsw = (unsigned)wid * 1024u;
    const int aoff = lds_byte(wr * 64 + fr, fq * 8), boff = lds_byte(wc * 32 + fr, fq * 8);
#define PG8_SA(b, h) (((b) * 2 + (h)) * HTB)
#define PG8_SB(b, h) ((4 + (b) * 2 + (h)) * HTB)
#define PG8_STAGE(bufoff, gbase, voff) do { _Pragma("unroll") for (int _i = 0; _i < 2; ++_i) \
        __builtin_amdgcn_global_load_lds((const unsigned*)((const char*)(gbase) + (voff)[_i]), (PG8_LAS unsigned*)(lds + (bufoff) + ldsw + _i * 8192), 16, 0, 0); } while (0)
#define PG8_LDA(dst, b, h) do { _Pragma("unroll") for (int m = 0; m < 4; ++m) dst[m] = __builtin_shufflevector(*(const PG8_LAS v4i_t*)(lds + PG8_SA(b, h) + aoff + m * 2048), *(const PG8_LAS v4i_t*)(lds + PG8_SA(b, h) + aoff + m * 2048 + 1024), 0, 1, 2, 3, 4, 5, 6, 7); } while (0)
#define PG8_LDB(dst, b, h) do { _Pragma("unroll") for (int n = 0; n < 2; ++n) dst[n] = __builtin_shufflevector(*(const PG8_LAS v4i_t*)(lds + PG8_SB(b, h) + boff + n * 2048), *(const PG8_LAS v4i_t*)(lds + PG8_SB(b, h) + boff + n * 2048 + 1024), 0, 1, 2, 3, 4, 5, 6, 7); } while (0)
#define PG8_MMA(ai, bj, At, Bt) do { __builtin_amdgcn_s_setprio(1); \
        if constexpr (QM == 1) { _Pragma("unroll") for (int m = 0; m < 4; ++m) _Pragma("unroll") for (int n = 0; n < 2; ++n) \
            asm volatile("v_mfma_scale_f32_16x16x128_f8f6f4 %0, %1, %2, %0, %3, %3 op_sel_hi:[0,0,0]" : "+v"(acc[ai][bj][m][n]) : "v"(Bt[n]), "v"(At[m]), "v"(one_scale)); } \
        else if constexpr (QM == 2) { _Pragma("unroll") for (int m = 0; m < 4; ++m) _Pragma("unroll") for (int n = 0; n < 2; ++n) { v4i_t c_ = __builtin_bit_cast(v4i_t, acc[ai][bj][m][n]); \
            c_ = __builtin_amdgcn_mfma_i32_16x16x64_i8(__builtin_shufflevector(Bt[n], Bt[n], 0, 1, 2, 3), __builtin_shufflevector(At[m], At[m], 0, 1, 2, 3), c_, 0, 0, 0); \
            c_ = __builtin_amdgcn_mfma_i32_16x16x64_i8(__builtin_shufflevector(Bt[n], Bt[n], 4, 5, 6, 7), __builtin_shufflevector(At[m], At[m], 4, 5, 6, 7), c_, 0, 0, 0); acc[ai][bj][m][n] = __builtin_bit_cast(f32x4, c_); } } \
        else { _Pragma("unroll") for (int m = 0; m < 4; ++m) _Pragma("unroll") for (int n = 0; n < 2; ++n) { \
            acc[ai][bj][m][n] = __builtin_amdgcn_mfma_f32_16x16x32_bf16(__builtin_bit_cast(bf16x8, __builtin_shufflevector(Bt[n], Bt[n], 0, 1, 2, 3)), __builtin_bit_cast(bf16x8, __builtin_shufflevector(At[m], At[m], 0, 1, 2, 3)), acc[ai][bj][m][n], 0, 0, 0); \
            acc[ai][bj][m][n] = __builtin_amdgcn_mfma_f32_16x16x32_bf16(__builtin_bit_cast(bf16x8, __builtin_shufflevector(Bt[n], Bt[n], 4, 5, 6, 7)), __builtin_bit_cast(bf16x8, __builtin_shufflevector(At[m], At[m], 4, 5, 6, 7)), acc[ai][bj][m][n], 0, 0, 0); } } \
        __builtin_amdgcn_s_setprio(0); } while (0)
#define PG8_WAIT_V(n) asm volatile("s_waitcnt vmcnt(" #n ")" ::: "memory")
#define PG8_WAIT_L(n) asm volatile("s_waitcnt lgkmcnt(" #n ")" ::: "memory")
#define PG8_BAR __builtin_amdgcn_s_barrier()
#define PG8_SCHED __builtin_amdgcn_sched_barrier(0)
    Unit cur, nxt; int ui = 0;
    if (!S.next(0, cur)) return;
    f32x4 acc[2][2][4][2];
#pragma unroll
    for (int a = 0; a < 2; ++a)
#pragma unroll
        for (int b = 0; b < 2; ++b)
#pragma unroll
            for (int m = 0; m < 4; ++m)
#pragma unroll
                for (int n = 0; n < 2; ++n) acc[a][b][m][n] = (f32x4){0.f, 0.f, 0.f, 0.f};
    const int one_scale = 0x7f7f7f7f;
    v8i_t At[4], B0[2], B1[2];
    const char* cA = (const char*)g.A + (size_t)cur.pm * tstep; const char* cB = (const char*)g.Bt + (size_t)cur.pn * tstep;
    S.a_ready(cur);
    PG8_STAGE(PG8_SB(0, 0), cB, voffB); PG8_STAGE(PG8_SA(0, 0), cA, voffA); PG8_STAGE(PG8_SB(0, 1), cB + hstep, voffB); PG8_STAGE(PG8_SA(0, 1), cA + hstep, voffA);
    if (wr == 1) PG8_BAR;
    PG8_WAIT_V(4); PG8_BAR;
    PG8_STAGE(PG8_SB(1, 0), cB + kstep, voffB); PG8_STAGE(PG8_SA(1, 0), cA + kstep, voffA); PG8_STAGE(PG8_SB(1, 1), cB + hstep + kstep, voffB);
    PG8_WAIT_V(6); PG8_BAR;
    PG8_STAMP();
    for (;;) {
        const bool has_next = S.next(ui + 1, nxt);
        const char* nA = has_next ? (const char*)g.A + (size_t)nxt.pm * tstep : cA; const char* nB = has_next ? (const char*)g.Bt + (size_t)nxt.pn * tstep : cB;
        for (int t = 0; t < nt; t += 2) {
            const bool last = (t == nt - 2);
            const char* a1 = cA + (size_t)(t + 1) * kstep;
            const char* a2 = last ? nA : cA + (size_t)(t + 2) * kstep; const char* b2 = last ? nB : cB + (size_t)(t + 2) * kstep;
            const char* a3 = a2 + kstep; const char* b3 = b2 + kstep;
            if (last && has_next) S.a_ready(nxt);
            PG8_LDB(B0, 0, 0); PG8_SCHED; PG8_LDA(At, 0, 0); PG8_STAGE(PG8_SA(1, 1), a1 + hstep, voffA);
            PG8_WAIT_L(8); PG8_BAR; PG8_WAIT_L(0); PG8_MMA(0, 0, At, B0); PG8_BAR; PG8_SCHED;
            PG8_LDB(B1, 0, 1); PG8_STAGE(PG8_SB(0, 0), b2, voffB);
            PG8_BAR; PG8_WAIT_L(0); PG8_MMA(0, 1, At, B1); PG8_BAR;
            PG8_LDA(At, 0, 1); PG8_STAGE(PG8_SA(0, 0), a2, voffA);
            PG8_BAR; PG8_WAIT_L(0); PG8_MMA(1, 0, At, B0); PG8_BAR; PG8_SCHED;
            PG8_STAGE(PG8_SB(0, 1), b2 + hstep, voffB);
            PG8_WAIT_V(6); PG8_BAR; PG8_MMA(1, 1, At, B1); PG8_BAR;
            PG8_LDB(B0, 1, 0); PG8_SCHED; PG8_LDA(At, 1, 0); PG8_STAGE(PG8_SA(0, 1), a2 + hstep, voffA);
            PG8_WAIT_L(8); PG8_BAR; PG8_WAIT_L(0); PG8_MMA(0, 0, At, B0); PG8_BAR; PG8_SCHED;
            PG8_LDB(B1, 1, 1); PG8_STAGE(PG8_SB(1, 0), b3, voffB);
            PG8_BAR; PG8_WAIT_L(0); PG8_MMA(0, 1, At, B1); PG8_BAR;
            PG8_LDA(At, 1, 1); PG8_STAGE(PG8_SA(1, 0), a3, voffA);
            PG8_BAR; PG8_WAIT_L(0); PG8_MMA(1, 0, At, B0); PG8_BAR; PG8_SCHED;
            PG8_STAGE(PG8_SB(1, 1), b3 + hstep, voffB);
            PG8_WAIT_V(6); PG8_BAR; PG8_MMA(1, 1, At, B1); PG8_BAR;
        }
        PG8_STAMP();
        if constexpr (QM == 1) { asm volatile("s_nop 15\n\ts_nop 15" ::: "memory"); }
        if constexpr (!Epi::AFTER_DRAIN) { E(acc, cur, wr, wc, fr, fq); S.done(cur); }
        PG8_STAMP();
        if (!has_next) break;
        if (!Epi::keep_acc(cur)) {
#pragma unroll
        for (int a = 0; a < 2; ++a)
#pragma unroll
            for (int b = 0; b < 2; ++b)
#pragma unroll
                for (int m = 0; m < 4; ++m)
#pragma unroll
                    for (int n = 0; n < 2; ++n) acc[a][b][m][n] = (f32x4){0.f, 0.f, 0.f, 0.f};
        }
        cur = nxt; cA = nA; cB = nB; ++ui;
    }
    PG8_WAIT_V(0);
    if (wr == 0) PG8_BAR;
    PG8_BAR;
    if constexpr (Epi::AFTER_DRAIN) { E.fused(acc, cur, wr, wc, fr, fq, lds, wid, lane); S.done(cur); }
    PG8_STAMP();
    if (STAMP && wid == 0) { stamps[lane] = lane < nts ? (((unsigned long long)(unsigned)ts_hi << 32) | (unsigned)ts_lo) : 0ull;
        if (lane == 62) stamps[62] = rt_entry; if (lane == 63) stamps[63] = (unsigned long long)wall_clock64(); }
#undef PG8_STAMP
#undef PG8_SA
#undef PG8_SB
#undef PG8_STAGE
#undef PG8_LDA
#undef PG8_LDB
#undef PG8_MMA
#undef PG8_WAIT_V
#undef PG8_WAIT_L
#undef PG8_BAR
#undef PG8_SCHED
}
}
using pg8::Unit;

struct SchedPlain {
    int nM, nN, nwg, G, c;
    __device__ void init(int nM_, int nN_, int G_, int c_) { nM = nM_; nN = nN_; nwg = nM * nN; G = G_; c = c_; }
    __device__ bool next(int i, Unit& u) const {
        const long L = (long)i * G + c; if (L >= nwg) return false;
        int wgid = (int)L; { const int q = nwg / 8, r = nwg % 8, xcd = wgid % 8, off = wgid / 8; wgid = (xcd < r ? xcd * (q + 1) : r * (q + 1) + (xcd - r) * q) + off; }
        const int nig = 8 * nN, gid = wgid / nig, fm = gid * 8, gsz = (nM - fm) < 8 ? (nM - fm) : 8;
        u.pm = __builtin_amdgcn_readfirstlane(fm + ((wgid % nig) % gsz)); u.pn = __builtin_amdgcn_readfirstlane((wgid % nig) / gsz); u.rt = u.pm; u.ct = u.pn; u.br = 0; return true;
    }
    DI void a_ready(const Unit&) const {}
    DI void done(const Unit&) const {}
};
struct SchedMerge {
    int G, c, pmb1, pmb2;
    __device__ void init(int G_, int c_) { G = G_; c = (G_ % 8 == 0) ? ((c_ % 8) * (G_ / 8) + c_ / 8) : c_;
        pmb1 = (int)((OFF_YB - OFF_YA) / YTILE); pmb2 = (int)((OFF_YC - OFF_YA) / YTILE); }
    __device__ bool next(int i, Unit& u) const {
        const int tile = (i / 3) * G + c, br = i % 3; if (tile >= 512) return false;
        const int lp = tile >> 2; u.rt = __builtin_amdgcn_readfirstlane(lp + (lp >> 5) + 1); u.ct = __builtin_amdgcn_readfirstlane(tile & 3); u.br = __builtin_amdgcn_readfirstlane(br);
        u.pm = u.rt + (u.br == 0 ? 0 : (u.br == 1 ? pmb1 : pmb2)); u.pn = u.br * 4 + u.ct; return true;
    }
    DI void a_ready(const Unit&) const {}
    DI void done(const Unit&) const {}
};
struct SchedLat {
    int G, c;
    __device__ void init(int G_, int c_) { G = G_; c = (G_ % 8 == 0) ? ((c_ % 8) * (G_ / 8) + c_ / 8) : c_; }
    __device__ bool next(int i, Unit& u) const {
        const int tile = i * G + c; if (tile >= 512) return false;
        const int lp = tile >> 2; u.pm = u.rt = __builtin_amdgcn_readfirstlane(lp + (lp >> 5) + 1); u.pn = u.ct = __builtin_amdgcn_readfirstlane(tile & 3); u.br = 0; return true;
    }
    DI void a_ready(const Unit&) const {}
    DI void done(const Unit&) const {}
};
template <int NCT> struct SchedMoe {
    int G, c;
    __device__ void init(int G_, int c_) { G = G_; c = c_; }
    __device__ bool next(int i, Unit& u) const {
        const int L = i * G + c; if (L >= 16 * 17 * NCT) return false;
        const int e = __builtin_amdgcn_readfirstlane(L / (17 * NCT)), rem = L - e * (17 * NCT); u.rt = __builtin_amdgcn_readfirstlane(rem / NCT); u.ct = rem - u.rt * NCT; u.br = e;
        u.pm = e * 17 + u.rt; u.pn = e * NCT + u.ct; return true;
    }
    DI void a_ready(const Unit&) const {}
    DI void done(const Unit&) const {}
};

DI u32x4 pack8(const f32x4& a, const f32x4& b) { u32x4 w = {pk2(a[0], a[1]), pk2(a[2], a[3]), pk2(b[0], b[1]), pk2(b[2], b[3])}; return w; }

typedef int v4i_q __attribute__((ext_vector_type(4)));
struct EpiInProj {
    static constexpr bool PERM = true, AFTER_DRAIN = false;
    static DI bool keep_acc(const Unit&) { return false; }
    unsigned char* ws; int nost;
    DI void operator()(const f32x4 (&acc)[2][2][4][2], const Unit& u, int wr, int wc, int fr, int fq) const {
        const int pn = u.pn; bf16_t* base; int ld, colt; bool sig = false;
        if (pn < 6) { base = (bf16_t*)(ws + OFF_PA); ld = 1536; colt = pn * 256; }
        else if (pn < 13) { base = (bf16_t*)(ws + OFF_PR); ld = 1792; colt = (pn - 6) * 256; }
        else if (pn < 19) { base = (bf16_t*)(ws + OFF_PC); ld = 1536; colt = (pn - 13) * 256; }
        else { base = (bf16_t*)(ws + OFF_PG); ld = 3072; colt = (pn - 19) * 256; sig = true; }
        const int row0 = u.pm * 256 + wr * 64 + fr, col0 = colt + wc * 32 + 8 * fq;
        const float* sW = (const float*)(ws + OFF_SW) + pn * 256 + wc * 32 + 8 * fq; const float* sH = (const float*)(ws + OFF_SH);
        f32x4 cs[2][2]; float rsv[2][4];
#pragma unroll
        for (int bj = 0; bj < 2; ++bj) { cs[bj][0] = *(const f32x4*)(sW + bj * 128); cs[bj][1] = *(const f32x4*)(sW + bj * 128 + 4); }
#pragma unroll
        for (int ai = 0; ai < 2; ++ai)
#pragma unroll
            for (int m = 0; m < 4; ++m) rsv[ai][m] = sH[row0 + ai * 128 + m * 16];
#pragma unroll
        for (int bj = 0; bj < 2; ++bj) { const f32x4 cs0 = cs[bj][0], cs1 = cs[bj][1];
#pragma unroll
            for (int ai = 0; ai < 2; ++ai)
#pragma unroll
                for (int m = 0; m < 4; ++m) { bf16_t* rowp = base + (size_t)(row0 + ai * 128 + m * 16) * ld + col0; const float rs = rsv[ai][m];
                    const v4i_q i0 = __builtin_bit_cast(v4i_q, acc[ai][bj][m][0]), i1 = __builtin_bit_cast(v4i_q, acc[ai][bj][m][1]); f32x4 v0, v1;
#pragma unroll
                    for (int i = 0; i < 4; ++i) { v0[i] = (float)i0[i] * rs * cs0[i]; v1[i] = (float)i1[i] * rs * cs1[i]; }
                    if (sig) {
#pragma unroll
                        for (int i = 0; i < 4; ++i) { v0[i] = fmaxf(rintf(255.f * sigmoidf_(v0[i])), 1.f); v1[i] = fmaxf(rintf(255.f * sigmoidf_(v1[i])), 1.f); }
                        const u32x2 pk = {pk4_u8(v0[0], v0[1], v0[2], v0[3]), pk4_u8(v1[0], v1[1], v1[2], v1[3])};
                        unsigned char* gp = ws + OFF_PG + (size_t)(row0 + ai * 128 + m * 16) * 3072 + col0 + bj * 128;
                        if (nost) asm volatile("" :: "v"(pk)); else *(u32x2*)gp = pk; }
                    else { const u32x4 pk = pack8(v0, v1); if (nost) asm volatile("" :: "v"(pk)); else *(u32x4*)(rowp + bj * 128) = pk; } } }
    }
};
struct EpiMerge {
    static constexpr bool PERM = true, AFTER_DRAIN = false;
    static DI bool keep_acc(const Unit& u) { return u.br < 2; }
    unsigned char* ws; int nog;
    DI void operator()(f32x4 (&acc)[2][2][4][2], const Unit& u, int wr, int wc, int fr, int fq) const {
        const unsigned char* PG = ws + OFF_PG; bf16_t* M = (bf16_t*)(ws + OFF_M);
        const int row0 = u.rt * 256 + wr * 64 + fr, col0 = u.ct * 256 + wc * 32 + 8 * fq, br = u.br;
#pragma unroll
        for (int ai = 0; ai < 2; ++ai) {
            u32x2 gq[4][2], gnx[4][2];
#pragma unroll
            for (int m = 0; m < 4; ++m)
#pragma unroll
                for (int bj = 0; bj < 2; ++bj) { const size_t r = (size_t)(row0 + ai * 128 + m * 16); const int c = col0 + bj * 128;
                    gq[m][bj] = (u32x2){0x80808080u, 0x80808080u}; gnx[m][bj] = gq[m][bj];
                    if (!nog) { gq[m][bj] = *(const u32x2*)(PG + r * 3072 + br * 1024 + c); if (br < 2) gnx[m][bj] = *(const u32x2*)(PG + r * 3072 + (br + 1) * 1024 + c); } }
#pragma unroll
            for (int m = 0; m < 4; ++m)
#pragma unroll
                for (int bj = 0; bj < 2; ++bj) { const size_t r = (size_t)(row0 + ai * 128 + m * 16); const int c = col0 + bj * 128;
                    const u32x2 g = gq[m][bj], gn = gnx[m][bj];
                    float f[8];
#pragma unroll
                    for (int i = 0; i < 8; ++i) f[i] = (float)((g[i >> 2] >> (8 * (i & 3))) & 255u);
                    if (br < 2) {
#pragma unroll
                        for (int i = 0; i < 8; ++i) f[i] *= __builtin_amdgcn_rcpf((float)((gn[i >> 2] >> (8 * (i & 3))) & 255u)); }
                    else {
#pragma unroll
                        for (int i = 0; i < 8; ++i) f[i] *= (1.f / 255.f); }
                    f32x4& a0 = acc[ai][bj][m][0]; f32x4& a1 = acc[ai][bj][m][1];
#pragma unroll
                    for (int i = 0; i < 4; ++i) { a0[i] *= f[i]; a1[i] *= f[4 + i]; }
                    if (br == 2) *(u32x4*)(M + r * 1024 + c) = pack8(a0, a1); } }
    }
};
struct EpiOut {
    static constexpr bool PERM = false, AFTER_DRAIN = false;
    static DI bool keep_acc(const Unit&) { return false; }
    unsigned char* ws; int l; float scale;
    DI void operator()(const f32x4 (&acc)[2][2][4][2], const Unit& u, int wr, int wc, int fr, int fq) const {
        float* X = (float*)(ws + OFF_X); const float* MOD = (const float*)(ws + OFF_MOD) + (size_t)l * 5 * 6144;
        const int row0 = u.pm * 256 + wr * 64 + fr, col0 = u.pn * 256 + wc * 32 + 4 * fq;
#pragma unroll
        for (int ai = 0; ai < 2; ++ai)
#pragma unroll
            for (int mh = 0; mh < 2; ++mh) {
                f32x4 xv[2][4], gv[2][4];
#pragma unroll
                for (int mm = 0; mm < 2; ++mm) { const int r = row0 + ai * 128 + (2 * mh + mm) * 16; const int b = r / TT, s_ = r - b * TT; const int mi = s_ < NCTX ? 4 : b;
                    const float* g1 = MOD + mi * 6144 + 2 * 1024; const float* xr = X + (size_t)r * 1024;
#pragma unroll
                    for (int j = 0; j < 4; ++j) { const int c = col0 + (j >> 1) * 128 + (j & 1) * 16; gv[mm][j] = *(const f32x4*)(g1 + c); xv[mm][j] = *(const f32x4*)(xr + c); } }
#pragma unroll
                for (int mm = 0; mm < 2; ++mm) { const int m = 2 * mh + mm; const int r = row0 + ai * 128 + m * 16; float* xr = X + (size_t)r * 1024;
#pragma unroll
                    for (int j = 0; j < 4; ++j) { const int c = col0 + (j >> 1) * 128 + (j & 1) * 16; *(f32x4*)(xr + c) = xv[mm][j] + gv[mm][j] * acc[ai][j >> 1][m][j & 1] * scale; } }
            }
    }
};
struct EpiUp {
    static constexpr bool PERM = true, AFTER_DRAIN = false;
    static DI bool keep_acc(const Unit&) { return false; }
    unsigned char* ws;
    DI void operator()(const f32x4 (&acc)[2][2][4][2], const Unit& u, int, int, int, int) const {
        const int t_ = otid(), wid_ = t_ >> 6, wr = wid_ >> 2, wc = wid_ & 3, fr = t_ & 15, fq = (t_ >> 4) & 3;
        unsigned char* HID = ws + OFF_HID;
        const int row0 = u.pm * 256 + wr * 64 + fr, hc0 = u.ct * 128 + wc * 16 + fq * 4;
#pragma unroll
        for (int ai = 0; ai < 2; ++ai)
#pragma unroll
            for (int m = 0; m < 4; ++m) { unsigned char* rowp = HID + (size_t)(row0 + ai * 128 + m * 16) * 1024 + hc0;
#pragma unroll
                for (int bj = 0; bj < 2; ++bj) { const f32x4 a = acc[ai][bj][m][0] * (1.f / 32.f), b = acc[ai][bj][m][1] * (1.f / 32.f); f32x4 h;
#pragma unroll
                    for (int i = 0; i < 4; ++i) h[i] = a[i] * sigmoidf_(a[i]) * b[i];
                    *(unsigned*)(rowp + bj * 64) = pk4_fp8(h[0], h[1], h[2], h[3]); } }
    }
};
struct EpiDown {
    static constexpr bool PERM = true, AFTER_DRAIN = false;
    static DI bool keep_acc(const Unit&) { return false; }
    unsigned char* ws;
    DI void operator()(const f32x4 (&acc)[2][2][4][2], const Unit& u, int, int, int, int) const {
        const int t_ = otid(), wid_ = t_ >> 6, wr = wid_ >> 2, wc = wid_ & 3, fr = t_ & 15, fq = (t_ >> 4) & 3;
        bf16_t* O = (bf16_t*)(ws + OFF_OUT);
        const int row0 = u.pm * 256 + wr * 64 + fr, col0 = u.ct * 256 + wc * 32 + 8 * fq;
#pragma unroll
        for (int ai = 0; ai < 2; ++ai)
#pragma unroll
            for (int m = 0; m < 4; ++m) { bf16_t* rowp = O + (size_t)(row0 + ai * 128 + m * 16) * 1024 + col0;
#pragma unroll
                for (int bj = 0; bj < 2; ++bj) *(u32x4*)(rowp + bj * 128) = pack8(acc[ai][bj][m][0] * (1.f / 32.f), acc[ai][bj][m][1] * (1.f / 32.f)); }
    }
};
DI int row_mod(int r) { const int b = r / TT, s = r - b * TT; return s < NCTX ? 4 : b; }

__device__ void ph_prologue(const Params& p, LAS unsigned char* lds, int wg, int nwg) {
    const int tid = otid();
    if (wg == 0 && tid < 16) {
        float* COS = (float*)(p.ws + OFF_ROPE); float* SIN = COS + 2048;
        const int k = tid; const int q4 = k & 3, dec = k >> 2;
        double th = (q4 == 0) ? 1.0 : (q4 == 1 ? 0.56234132519034908 : (q4 == 2 ? 0.31622776601683794 : 0.17782794100389228));
        for (int i = 0; i < dec; ++i) th *= 0.1;
        double ct = 1.0, st = th, term_c = 1.0, term_s = th; const double t2 = th * th;
        for (int n = 1; n <= 12; ++n) { term_c *= -t2 / (double)((2 * n - 1) * (2 * n)); term_s *= -t2 / (double)((2 * n) * (2 * n + 1)); ct += term_c; st += term_s; }
        double cp = 1.0, sp = 0.0;
        for (int pos = 0; pos < 128; ++pos) { COS[pos * 16 + k] = (float)cp; SIN[pos * 16 + k] = (float)sp; const double c2 = cp * ct - sp * st, s2 = sp * ct + cp * st; cp = c2; sp = s2; }
    }
    {
        LAS float* sc = (LAS float*)lds;
        LAS float* red = sc + 5 * 1024;
        float* MOD = (float*)(p.ws + OFF_MOD);
        for (int i = tid; i < 5 * 1024; i += 512) { const int m = i >> 10, k = i & 1023; const float v = (m < 4) ? p.c[m * 1024 + k] : p.c_ctx[k]; sc[i] = v * sigmoidf_(v); }
        __syncthreads();
        for (int u = wg; u < NL * 48; u += nwg) {
            const int l = u / 48, cb = u % 48; const int cl = tid & 127, col = cb * 128 + cl, kq = tid >> 7;
            const float* W = p.ada_w + (size_t)l * 1024 * 6144 + col;
            float a0 = 0, a1 = 0, a2 = 0, a3 = 0, a4 = 0;
#pragma unroll 1
            for (int k0 = kq * 256; k0 < kq * 256 + 256; k0 += 16) { float wv[16];
#pragma unroll
                for (int j = 0; j < 16; ++j) wv[j] = W[(size_t)(k0 + j) * 6144];
#pragma unroll
                for (int j = 0; j < 16; ++j) { const int k = k0 + j; const float w = wv[j]; a0 += sc[k] * w; a1 += sc[1024 + k] * w; a2 += sc[2048 + k] * w; a3 += sc[3072 + k] * w; a4 += sc[4096 + k] * w; } }
            red[(kq * 5 + 0) * 128 + cl] = a0; red[(kq * 5 + 1) * 128 + cl] = a1; red[(kq * 5 + 2) * 128 + cl] = a2; red[(kq * 5 + 3) * 128 + cl] = a3; red[(kq * 5 + 4) * 128 + cl] = a4;
            __syncthreads();
            if (tid < 128) { const float bb = p.ada_b[l * 6144 + col];
                for (int m = 0; m < 5; ++m) { const float s = red[(0 * 5 + m) * 128 + cl] + red[(1 * 5 + m) * 128 + cl] + red[(2 * 5 + m) * 128 + cl] + red[(3 * 5 + m) * 128 + cl];
                    MOD[((size_t)(l * 5 + m)) * 6144 + col] = s + bb; } }
            __syncthreads();
        }
    }
}

template <class RowMap> DI void tconv_tile(const float* src, int ldn, int k0, int n0, bf16_t* dst, int K, RowMap rm, LAS float* tile  , int tid) {
#pragma unroll
    for (int i = 0; i < 8; ++i) { const int k = (tid >> 6) + 8 * i, n = tid & 63; tile[k * 65 + n] = src[(size_t)(k0 + k) * ldn + n0 + n]; }
    __syncthreads();
    const int n = tid >> 3, k8 = (tid & 7) * 8; float v[8];
#pragma unroll
    for (int j = 0; j < 8; ++j) v[j] = tile[(k8 + j) * 65 + n];
    u32x4 w = {pk2(v[0], v[1]), pk2(v[2], v[3]), pk2(v[4], v[5]), pk2(v[6], v[7])};
    *(u32x4*)(dst + (size_t)rm(n0 + n) * K + k0 + k8) = w;
    __syncthreads();
}
template <class RowMap> DI void tconv_tile_f8(const float* src, int ldn, int k0, int n0, unsigned char* dst, int K, RowMap rm, float scale, LAS float* tile  , int tid) {
#pragma unroll
    for (int i = 0; i < 8; ++i) { const int k = (tid >> 6) + 8 * i, n = tid & 63; tile[k * 65 + n] = src[(size_t)(k0 + k) * ldn + n0 + n]; }
    __syncthreads();
    const int n = tid >> 3, k8 = (tid & 7) * 8; float v[8];
#pragma unroll
    for (int j = 0; j < 8; ++j) v[j] = tile[(k8 + j) * 65 + n] * scale;
    u32x2 w = {pk4_fp8(v[0], v[1], v[2], v[3]), pk4_fp8(v[4], v[5], v[6], v[7])};
    *(u32x2*)(dst + (size_t)rm(n0 + n) * K + k0 + k8) = w;
    __syncthreads();
}
struct RowId { DI int operator()(int n) const { return n; } };
struct RowW13 { int sel; DI int operator()(int j) const { return (j >> 7) * 256 + ((j & 127) >> 2) * 8 + sel * 4 + (j & 3); } };

DI void tblk_load(const float* src, int ldn, int k0, int n0, int tid, f32x4 (&v)[8]) {
    const float* s = src + (size_t)(k0 + 4 * (tid >> 5)) * ldn + n0 + 4 * (tid & 31);
#pragma unroll
    for (int i = 0; i < 2; ++i)
#pragma unroll
        for (int j = 0; j < 4; ++j) v[i * 4 + j] = *(const f32x4*)(s + (size_t)(64 * i + j) * ldn);
}
template <int OB> DI void tblk_to_lds(const f32x4 (&v)[8], float scale, LAS unsigned char* tile, int tid) {
    constexpr int S = 128 * OB + 8; const int c4 = tid & 31, r = tid >> 5;
#pragma unroll
    for (int i = 0; i < 2; ++i) {
        const f32x4 f0 = v[i * 4 + 0], f1 = v[i * 4 + 1], f2 = v[i * 4 + 2], f3 = v[i * 4 + 3];
#pragma unroll
        for (int jn = 0; jn < 4; ++jn) { LAS unsigned char* d = tile + (4 * c4 + jn) * S + (4 * r + 64 * i) * OB;
            if constexpr (OB == 1) *(LAS unsigned*)d = pk4_fp8(f0[jn] * scale, f1[jn] * scale, f2[jn] * scale, f3[jn] * scale);
            else *(LAS u32x2*)d = (u32x2){pk2(f0[jn], f1[jn]), pk2(f2[jn], f3[jn])}; }
    }
}
template <int OB, class RowMap> DI void tblk_from_lds(const LAS unsigned char* tile, unsigned char* dst, int Kb, int k0, int n0, RowMap rm, int tid) {
    constexpr int S = 128 * OB + 8; const int n = tid >> 2, q = tid & 3;
    const LAS unsigned char* t = tile + n * S + q * 32 * OB; unsigned char* d = dst + (size_t)rm(n0 + n) * Kb + k0 * OB + q * 32 * OB;
#pragma unroll
    for (int j = 0; j < 2 * OB; ++j) { const u32x2 a = *(const LAS u32x2*)(t + 16 * j), c = *(const LAS u32x2*)(t + 16 * j + 8); *(u32x4*)(d + 16 * j) = (u32x4){a[0], a[1], c[0], c[1]}; }
}
template <int OB, class RowMap> DI void tblk_unit(const float* src, int ldn, int k0, int n0, unsigned char* dst, int Kb, RowMap rm, float scale, LAS unsigned char* tile, int tid) {
    f32x4 v[8]; tblk_load(src, ldn, k0, n0, tid, v); tblk_to_lds<OB>(v, scale, tile, tid);
    __syncthreads();
    tblk_from_lds<OB>(tile, dst, Kb, k0, n0, rm, tid);
    __syncthreads();
}
DI float max_hi3(float v) {
    v = fmaxf(v, dppmov<0x128>(v));
    { auto r = __builtin_amdgcn_permlane16_swap(__float_as_uint(v), __float_as_uint(v), false, false); v = fmaxf(__uint_as_float(r[0]), __uint_as_float(r[1])); }
    { auto r = __builtin_amdgcn_permlane32_swap(__float_as_uint(v), __float_as_uint(v), false, false); v = fmaxf(__uint_as_float(r[0]), __uint_as_float(r[1])); } return v; }
DI void win_strip(const float* src, float* SW, unsigned char* dst, int n0, LAS unsigned char* tile, int tid) {
    constexpr int S = 1024 + 8; const int c4 = tid & 7, r = tid >> 3; LAS float* red = (LAS float*)(tile + 32 * S);
    f32x4 v[16]; const float* s = src + (size_t)(4 * r) * NIN + n0 + 4 * c4;
#pragma unroll
    for (int i = 0; i < 4; ++i)
#pragma unroll
        for (int j = 0; j < 4; ++j) v[i * 4 + j] = *(const f32x4*)(s + (size_t)(256 * i + j) * NIN);
    float am[4] = {0.f, 0.f, 0.f, 0.f};
#pragma unroll
    for (int i = 0; i < 16; ++i) { am[0] = fmaxf(am[0], fabsf(v[i][0])); am[1] = fmaxf(am[1], fabsf(v[i][1])); am[2] = fmaxf(am[2], fabsf(v[i][2])); am[3] = fmaxf(am[3], fabsf(v[i][3])); }
#pragma unroll
    for (int j = 0; j < 4; ++j) am[j] = max_hi3(am[j]);
    if ((tid & 63) < 8) *(LAS f32x4*)(red + (tid >> 6) * 32 + 4 * c4) = (f32x4){am[0], am[1], am[2], am[3]};
    __syncthreads();
    float inv[4];
#pragma unroll
    for (int j = 0; j < 4; ++j) { float m = red[4 * c4 + j];
#pragma unroll
        for (int w = 1; w < 8; ++w) m = fmaxf(m, red[w * 32 + 4 * c4 + j]);
        m = fmaxf(m, 1e-20f); inv[j] = 127.f / m; if (r == 0) SW[n0 + 4 * c4 + j] = m * (1.f / 127.f); }
#pragma unroll
    for (int i = 0; i < 4; ++i) {
        const f32x4 f0 = v[i * 4 + 0], f1 = v[i * 4 + 1], f2 = v[i * 4 + 2], f3 = v[i * 4 + 3];
#pragma unroll
        for (int jn = 0; jn < 4; ++jn) *(LAS unsigned*)(tile + (4 * c4 + jn) * S + 4 * r + 256 * i) = pk4_i8(f0[jn] * inv[jn], f1[jn] * inv[jn], f2[jn] * inv[jn], f3[jn] * inv[jn]);
    }
    __syncthreads();
    {   const int n = tid >> 4, q = tid & 15; const LAS unsigned char* t = tile + n * S + q * 64; unsigned char* d = dst + (size_t)(n0 + n) * 1024 + q * 64;
#pragma unroll
        for (int j = 0; j < 4; ++j) { const u32x2 a = *(const LAS u32x2*)(t + 16 * j), c = *(const LAS u32x2*)(t + 16 * j + 8); *(u32x4*)(d + 16 * j) = (u32x4){a[0], a[1], c[0], c[1]}; } }
    __syncthreads();
}

__device__ void conv_mixer_a(const Params& p, int l, LAS unsigned char* lds) {
    LAS float* tile = (LAS float*)lds; LAS unsigned* bc = (LAS unsigned*)(lds + 36864); const int tid = otid();
    unsigned* ctr = (unsigned*)(p.ws + OFF_CTR) + (48 + l) * 64;
    constexpr int U_IN = 248, U_LR = 48;
    for (;;) {
        if (tid == 0) *bc = atomicAdd(ctr, 1u);
        __syncthreads();
        const int u = (int)*bc;
        __syncthreads();
        if (u >= U_IN + U_LR) break;
        if (u < U_IN) win_strip(p.w_in + (size_t)l * 1024 * NIN, (float*)(p.ws + OFF_SW), p.ws + OFF_WIN, u * 32, lds, tid);
        else { const int v = u - U_IN; bf16_t* LRW = (bf16_t*)(p.ws + OFF_LRW);
            if (v < 32) { const int mi = v >> 3, nt = v & 7; const float* src = (mi < 2 ? p.rwkv_w_up : p.rwkv_a_up) + ((size_t)(l * 2 + (mi & 1)) * 64) * 512;
                tconv_tile(src, 512, 0, nt * 64, LRW + (size_t)mi * 512 * 64, 64, RowId(), tile, tid); }
            else { const int w = v - 32, kt = w >> 3, nt = w & 7;
                tconv_tile(p.rwkv_g_up + (size_t)l * 128 * 512, 512, kt * 64, nt * 64, LRW + (size_t)4 * 512 * 64, 128, RowId(), tile, tid); } }
    }
}
__device__ void conv_mixer_b(const Params& p, int l, LAS unsigned char* lds, int wg, int nwg) {
    const int tid = otid();
    constexpr int U_BR = 3 * 4 * 8, U_OUT = 64;
    for (int u = wg; u < U_BR + U_OUT; u += nwg) {
        if (u < U_BR) { const int i = u / 32, kt = (u % 32) / 8, nt = u % 8;
            tblk_unit<2>(p.w_branch + ((size_t)(l * 3 + i)) * 512 * 1024, 1024, kt * 128, nt * 128, p.ws + OFF_WBR + (size_t)i * 1024 * 512 * 2, 512 * 2, RowId(), 1.f, lds, tid); }
        else { const int v = u - U_BR, kt = v / 8, nt = v % 8;
            tblk_unit<2>(p.w_out + (size_t)l * 1024 * 1024, 1024, kt * 128, nt * 128, p.ws + OFF_WOUT, 1024 * 2, RowId(), 1.f, lds, tid); }
    }
}
__device__ void conv_expert_weights(const Params& p, int l, LAS unsigned char* lds, int qofs = 16) {
    LAS unsigned* bc = (LAS unsigned*)(lds + 128 * 136); const int tid = otid();
    unsigned* ctr = (unsigned*)(p.ws + OFF_CTR) + (qofs + l) * 64;
    constexpr int NU = 16 * 3 * 64;
    const float* w1 = p.exp_w1 + (size_t)l * 16 * 1024 * 1024; const float* w3 = p.exp_w3 + (size_t)l * 16 * 1024 * 1024; const float* w2 = p.exp_w2 + (size_t)l * 16 * 1024 * 1024;
#define EXP_SRC(u_) (((((u_) % 192) >> 6) == 0 ? w1 : ((((u_) % 192) >> 6) == 1 ? w3 : w2)) + (size_t)((u_) / 192) * 1024 * 1024)
#define EXP_K0(u_) (((((u_) % 192) >> 3) & 7) * 128)
#define EXP_N0(u_) ((((u_) % 192) & 7) * 128)
    if (tid == 0) *bc = atomicAdd(ctr, 1u);
    __syncthreads();
    int u = (int)*bc;
    __syncthreads();
    if (u >= NU) return;
    f32x4 v[8]; tblk_load(EXP_SRC(u), 1024, EXP_K0(u), EXP_N0(u), tid, v);
    for (;;) {
        if (tid == 0) *bc = atomicAdd(ctr, 1u);
        tblk_to_lds<1>(v, 32.f, lds, tid);
        __syncthreads();
        const int un = (int)*bc;
        if (un < NU) tblk_load(EXP_SRC(un), 1024, EXP_K0(un), EXP_N0(un), tid, v);
        {   const int e = u / 192, w = u % 192, which = w >> 6, k0 = ((w >> 3) & 7) * 128, n0 = (w & 7) * 128;
            if (which == 0) tblk_from_lds<1>(lds, p.ws + OFF_W13 + (size_t)e * 2048 * 1024, 1024, k0, n0, RowW13{0}, tid);
            else if (which == 1) tblk_from_lds<1>(lds, p.ws + OFF_W13 + (size_t)e * 2048 * 1024, 1024, k0, n0, RowW13{1}, tid);
            else tblk_from_lds<1>(lds, p.ws + OFF_W2 + (size_t)e * 1024 * 1024, 1024, k0, n0, RowId(), tid); }
        __syncthreads();
        if (un >= NU) break;
        u = un;
    }
#undef EXP_SRC
#undef EXP_K0
#undef EXP_N0
}

__device__ void norm1_rows(const Params& p, int l, int wg, int nwg) {
    const int tid = otid(), wave = tid >> 6, lane = tid & 63;
    float* X = (float*)(p.ws + OFF_X); bf16_t* H = (bf16_t*)(p.ws + OFF_H);
    const float* MOD = (const float*)(p.ws + OFF_MOD) + (size_t)l * 5 * 6144; const float* g = p.norm1_g + l * 1024;
    for (int r = wg * 8 + wave; r < RR; r += nwg * 8) {
        const int b_ = r / TT, s_ = r - b_ * TT;
        const float4* xr = (s_ < NCTX) ? (const float4*)(p.ctx + ((size_t)(b_ * NCTX + s_)) * DM) : (const float4*)(p.x + ((size_t)(b_ * SEQ + s_ - NCTX)) * DM); float4* xw = (float4*)(X + (size_t)r * 1024); float4 v[4]; float ss = 0.f;
#pragma unroll
        for (int i = 0; i < 4; ++i) v[i] = xr[lane + 64 * i];
#pragma unroll
        for (int i = 0; i < 4; ++i) { xw[lane + 64 * i] = v[i]; ss += v[i].x * v[i].x + v[i].y * v[i].y + v[i].z * v[i].z + v[i].w * v[i].w; }
        ss = wave_sum(ss);
        const float rinv = rsqrtf(ss * (1.f / 1024.f) + 1e-6f);
        const float* md = MOD + row_mod(r) * 6144;
        float y[16]; float am = 0.f;
#pragma unroll
        for (int i = 0; i < 4; ++i) { const int col = (lane + 64 * i) * 4;
            const float4 gg = *(const float4*)(g + col), sh = *(const float4*)(md + col), sc = *(const float4*)(md + 1024 + col);
            y[4 * i] = v[i].x * rinv * gg.x * (1.f + sc.x) + sh.x; y[4 * i + 1] = v[i].y * rinv * gg.y * (1.f + sc.y) + sh.y; y[4 * i + 2] = v[i].z * rinv * gg.z * (1.f + sc.z) + sh.z; y[4 * i + 3] = v[i].w * rinv * gg.w * (1.f + sc.w) + sh.w;
#pragma unroll
            for (int j = 0; j < 4; ++j) am = fmaxf(am, fabsf(y[4 * i + j])); }
        am = fmaxf(wave_max(am), 1e-20f); const float inv = 127.f / am;
        if (lane == 0) ((float*)(p.ws + OFF_SH))[r] = am * (1.f / 127.f);
#pragma unroll
        for (int i = 0; i < 4; ++i) *(unsigned*)((unsigned char*)H + (size_t)r * 1024 + (lane + 64 * i) * 4) = pk4_i8(y[4 * i] * inv, y[4 * i + 1] * inv, y[4 * i + 2] * inv, y[4 * i + 3] * inv);
    }
}
#define MFMA16(a, b, c) __builtin_amdgcn_mfma_f32_16x16x32_bf16((a), (b), (c), 0, 0, 0)
DI float tanh_fast(float x) { return 1.f - 2.f * __builtin_amdgcn_rcpf(1.f + __expf(2.f * x)); }
DI void unpack4(const u32x2 w, float (&o)[4]) { o[0] = bflo(w[0]); o[1] = bfhi(w[0]); o[2] = bflo(w[1]); o[3] = bfhi(w[1]); }
DI void prep_rows_unit(const Params& p, int l, LAS unsigned char* lds, int ub, int dup) {
    const int tid = otid(), wave = tid >> 6, lane = tid & 63, c16 = lane & 15, rq = lane >> 4;
    const int r0 = ub * 16; const int b = r0 / TT, s0 = r0 - b * TT;
    const bool isctx = s0 < NCTX; const int seg_lo = isctx ? 0 : NCTX, seg_hi = isctx ? NCTX : TT;
    const bool has_prev = s0 > seg_lo, has_next = (s0 + 16) < seg_hi;
    bf16_t* PA = (bf16_t*)(p.ws + OFF_PA); const bf16_t* PR = (const bf16_t*)(p.ws + OFF_PR); const bf16_t* PC = (const bf16_t*)(p.ws + OFF_PC);
    const int col0 = wave * 64 + c16 * 4, rb = r0 + 4 * rq;
    const bool pv = (rq > 0) || has_prev, nv = (rq < 3) || has_next;
    u32x2 rawc[3][6], rawu[2][6], rawbg[4]; u32x4 rawlr[8], rawqk[4];
#pragma unroll
    for (int g = 0; g < 3; ++g)
#pragma unroll
        for (int j = 0; j < 6; ++j) { const bool ok = (j == 0) ? pv : ((j == 5) ? nv : true); rawc[g][j] = (u32x2){0u, 0u}; if (ok) rawc[g][j] = *(const u32x2*)(PR + (size_t)(rb - 1 + j) * 1792 + g * 512 + col0); }
    {   const bf16_t* lr = PR + (size_t)(r0 + c16) * 1792 + 1536 + 8 * rq;
#pragma unroll
        for (int i = 0; i < 8; ++i) rawlr[i] = *(const u32x4*)(lr + 32 * i); }
#pragma unroll
    for (int j = 0; j < 6; ++j) { const bool ok = (j == 0) ? pv : ((j == 5) ? nv : true); rawu[0][j] = (u32x2){0u, 0u}; rawu[1][j] = (u32x2){0u, 0u};
        if (ok) { rawu[0][j] = *(const u32x2*)(PC + (size_t)(rb - 1 + j) * 1536 + 512 + col0); rawu[1][j] = *(const u32x2*)(PC + (size_t)(rb - 1 + j) * 1536 + 1024 + col0); } }
#pragma unroll
    for (int i = 0; i < 4; ++i) rawbg[i] = *(const u32x2*)(PC + (size_t)(rb + i) * 1536 + col0);
    bf16_t* qkbase = PA + (size_t)(r0 + (tid >> 5)) * 1536 + ((tid & 31) >> 1) * 64 + 16 * (tid & 1);
    if (!dup) { rawqk[0] = *(const u32x4*)qkbase; rawqk[1] = *(const u32x4*)(qkbase + 8); rawqk[2] = *(const u32x4*)(qkbase + 32); rawqk[3] = *(const u32x4*)(qkbase + 40); }
    __builtin_amdgcn_sched_barrier(0);
    float rc[4][4], kc[4][4], vc[4][4];
    {   const float* cw = p.rwkv_conv_w + (size_t)l * 3 * 1536;
#pragma unroll
        for (int g = 0; g < 3; ++g) {
            const int co = g * 512 + col0; const f32x4 w0 = *(const f32x4*)(cw + co), w1 = *(const f32x4*)(cw + 1536 + co), w2 = *(const f32x4*)(cw + 3072 + co);
            float x[6][4];
#pragma unroll
            for (int j = 0; j < 6; ++j) unpack4(rawc[g][j], x[j]);
#pragma unroll
            for (int i = 0; i < 4; ++i)
#pragma unroll
                for (int c = 0; c < 4; ++c) { const float o = w0[c] * x[i][c] + w1[c] * x[i + 1][c] + w2[c] * x[i + 2][c]; if (g == 0) rc[i][c] = o; else if (g == 1) kc[i][c] = o; else vc[i][c] = o; }
        } }
    bf16_t* EW = (bf16_t*)(p.ws + OFF_EW); bf16_t* AA = (bf16_t*)(p.ws + OFF_AA);
    bf16_t* KK = (bf16_t*)(p.ws + OFF_KK); bf16_t* KC = (bf16_t*)(p.ws + OFF_KC); bf16_t* RC = (bf16_t*)(p.ws + OFF_RC); bf16_t* VC = (bf16_t*)(p.ws + OFF_VC);
    {   const f32x4 kkc = *(const f32x4*)(p.rwkv_k_k + l * 512 + col0);
#pragma unroll
        for (int i = 0; i < 4; ++i) { float q[4]; float ss = 0.f;
#pragma unroll
            for (int c = 0; c < 4; ++c) { q[c] = kc[i][c] * kkc[c]; ss += q[c] * q[c]; }
            ss = allsum16(ss); const float rn = 1.f / fmaxf(sqrtf(ss), 1e-12f);
            const size_t o = (size_t)(rb + i) * 512 + col0;
            u32x2 w; w[0] = pk2(q[0] * rn, q[1] * rn); w[1] = pk2(q[2] * rn, q[3] * rn); *(u32x2*)(KK + o) = w;
            w[0] = pk2(kc[i][0], kc[i][1]); w[1] = pk2(kc[i][2], kc[i][3]); *(u32x2*)(KC + o) = w;
            w[0] = pk2(rc[i][0], rc[i][1]); w[1] = pk2(rc[i][2], rc[i][3]); *(u32x2*)(RC + o) = w;
            w[0] = pk2(vc[i][0], vc[i][1]); w[1] = pk2(vc[i][2], vc[i][3]); *(u32x2*)(VC + o) = w; } }
    bf16x8 twf[2], alf[2], sgf[4];
    {
#pragma unroll
        for (int ks = 0; ks < 2; ++ks) { const u32x4 v = rawlr[ks]; u32x4 t;
#pragma unroll
            for (int i = 0; i < 4; ++i) t[i] = pk2(tanh_fast(bflo(v[i])), tanh_fast(bfhi(v[i])));
            twf[ks] = __builtin_bit_cast(bf16x8, t); alf[ks] = __builtin_bit_cast(bf16x8, rawlr[2 + ks]); }
#pragma unroll
        for (int ks = 0; ks < 4; ++ks) { const u32x4 v = rawlr[4 + ks]; u32x4 t;
#pragma unroll
            for (int i = 0; i < 4; ++i) t[i] = pk2(sigmoidf_(bflo(v[i])), sigmoidf_(bfhi(v[i])));
            sgf[ks] = __builtin_bit_cast(bf16x8, t); } }
    const bf16_t* LRW = (const bf16_t*)(p.ws + OFF_LRW);
    float bon[4] = {0.f, 0.f, 0.f, 0.f};
    const f32x4 kac = *(const f32x4*)(p.rwkv_k_a + l * 512 + col0), rkc = *(const f32x4*)(p.rwkv_r_k + l * 512 + col0);
#pragma unroll 1
    for (int d = 0; d < 2; ++d) {
        f32x4 wa[4], aa[4];
#pragma unroll
        for (int cb = 0; cb < 4; ++cb) { wa[cb] = (f32x4){0.f, 0.f, 0.f, 0.f}; aa[cb] = (f32x4){0.f, 0.f, 0.f, 0.f};
            const bf16_t* bw = LRW + ((size_t)d * 512 + col0 + cb) * 64 + 8 * rq; const bf16_t* ba = bw + (size_t)2 * 512 * 64;
#pragma unroll
            for (int ks = 0; ks < 2; ++ks) { wa[cb] = MFMA16(twf[ks], *(const bf16x8*)(bw + 32 * ks), wa[cb]); aa[cb] = MFMA16(alf[ks], *(const bf16x8*)(ba + 32 * ks), aa[cb]); } }
        const f32x4 w0c = *(const f32x4*)(p.rwkv_w0 + (l * 2 + d) * 512 + col0), a0c = *(const f32x4*)(p.rwkv_a0 + (l * 2 + d) * 512 + col0);
#pragma unroll
        for (int i = 0; i < 4; ++i) { float e[4], a[4]; float bs = 0.f;
#pragma unroll
            for (int c = 0; c < 4; ++c) { const float z = w0c[c] + wa[c][i];
                const float sp = fmaxf(-z, 0.f) + __logf(1.f + __expf(-fabsf(z)));
                e[c] = __expf(-sp - 0.5f) * 1.4426950408889634f;
                a[c] = sigmoidf_(a0c[c] + aa[c][i]);
                const float kd = kc[i][c] * (1.f + (a[c] - 1.f) * kac[c]); bs += rc[i][c] * kd * rkc[c]; }
            bon[i] += allsum16(bs);
            const size_t o = (size_t)d * RR * 512 + (size_t)(rb + i) * 512 + col0;
            u32x2 w; w[0] = pk2(e[0], e[1]); w[1] = pk2(e[2], e[3]); *(u32x2*)(EW + o) = w;
            w[0] = pk2(a[0], a[1]); w[1] = pk2(a[2], a[3]); *(u32x2*)(AA + o) = w; }
    }
    {
        f32x4 ga[4];
#pragma unroll
        for (int cb = 0; cb < 4; ++cb) { ga[cb] = (f32x4){0.f, 0.f, 0.f, 0.f}; const bf16_t* bg = LRW + (size_t)4 * 512 * 64 + ((size_t)col0 + cb) * 128 + 8 * rq;
#pragma unroll
            for (int ks = 0; ks < 4; ++ks) ga[cb] = MFMA16(sgf[ks], *(const bf16x8*)(bg + 32 * ks), ga[cb]); }
        bf16_t* G = (bf16_t*)(p.ws + OFF_G); bf16_t* YB0 = (bf16_t*)(p.ws + OFF_YB0); const f32x4 lnb = *(const f32x4*)(p.rwkv_ln_b + l * 512 + col0);
#pragma unroll
        for (int i = 0; i < 4; ++i) { const size_t o = (size_t)(rb + i) * 512 + col0;
            u32x2 w; w[0] = pk2(ga[0][i], ga[1][i]); w[1] = pk2(ga[2][i], ga[3][i]); *(u32x2*)(G + o) = w;
            w[0] = pk2(2.f * lnb[0] + bon[i] * vc[i][0], 2.f * lnb[1] + bon[i] * vc[i][1]); w[1] = pk2(2.f * lnb[2] + bon[i] * vc[i][2], 2.f * lnb[3] + bon[i] * vc[i][3]); *(u32x2*)(YB0 + o) = w; }
    }
    {
        const float* cw = p.conv_w + (size_t)l * 3 * 512; const f32x4 c0 = *(const f32x4*)(cw + col0), c1 = *(const f32x4*)(cw + 512 + col0), c2 = *(const f32x4*)(cw + 1024 + col0);
        float uu[6][4];
#pragma unroll
        for (int j = 0; j < 6; ++j) { float fa[4], fc[4]; unpack4(rawu[0][j], fa); unpack4(rawu[1][j], fc);
#pragma unroll
            for (int q = 0; q < 4; ++q) uu[j][q] = fa[q] * fc[q]; }
        bf16_t* YC = (bf16_t*)(p.ws + OFF_YC);
#pragma unroll
        for (int i = 0; i < 4; ++i) { float bg[4]; unpack4(rawbg[i], bg); float o[4];
#pragma unroll
            for (int q = 0; q < 4; ++q) o[q] = bg[q] * (c0[q] * uu[i][q] + c1[q] * uu[i + 1][q] + c2[q] * uu[i + 2][q]);
            u32x2 w = {pk2(o[0], o[1]), pk2(o[2], o[3])}; *(u32x2*)(YC + (size_t)(rb + i) * 512 + col0) = w; }
    }
    if (!dup) {   const int rr = tid >> 5, g16 = (tid & 31) >> 1, hf = tid & 1; const int s = s0 + rr;
        bf16_t* base = qkbase;
        const u32x4 a0 = rawqk[0], a1 = rawqk[1], b0 = rawqk[2], b1 = rawqk[3];
        float x1[16], x2[16];
#pragma unroll
        for (int i = 0; i < 4; ++i) { x1[2 * i] = bflo(a0[i]); x1[2 * i + 1] = bfhi(a0[i]); x1[8 + 2 * i] = bflo(a1[i]); x1[9 + 2 * i] = bfhi(a1[i]);
            x2[2 * i] = bflo(b0[i]); x2[2 * i + 1] = bfhi(b0[i]); x2[8 + 2 * i] = bflo(b1[i]); x2[9 + 2 * i] = bfhi(b1[i]); }
        float ss = 0.f;
#pragma unroll
        for (int j = 0; j < 16; ++j) ss += x1[j] * x1[j] + x2[j] * x2[j];
        ss += dppmov<0xB1>(ss);
        const float rinv = rsqrtf(ss * (1.f / 64.f) + 1e-6f);
        const float* gg = (g16 < 8 ? p.q_norm_g : p.k_norm_g) + l * 64; const float qs = g16 < 8 ? 0.125f * 1.4426950408889634f : 1.f;
        const float* COS = (const float*)(p.ws + OFF_ROPE); const float* SIN = COS + 2048;
        const int tl = s - NCTX; const int pos = isctx ? 0 : (hf == 0 ? (tl >> 6) : (tl & 63));
#pragma unroll
        for (int j = 0; j < 16; ++j) { const float y1 = x1[j] * rinv * gg[16 * hf + j], y2 = x2[j] * rinv * gg[32 + 16 * hf + j];
            float o1 = y1, o2 = y2;
            if (!isctx) { const float c = COS[pos * 16 + j], sn = SIN[pos * 16 + j]; o1 = y1 * c - y2 * sn; o2 = y2 * c + y1 * sn; }
            x1[j] = o1 * qs; x2[j] = o2 * qs; }
        u32x4 w0, w1, w2, w3;
#pragma unroll
        for (int i = 0; i < 4; ++i) { w0[i] = pk2(x1[2 * i], x1[2 * i + 1]); w1[i] = pk2(x1[8 + 2 * i], x1[9 + 2 * i]); w2[i] = pk2(x2[2 * i], x2[2 * i + 1]); w3[i] = pk2(x2[8 + 2 * i], x2[9 + 2 * i]); }
        *(u32x4*)base = w0; *(u32x4*)(base + 8) = w1; *(u32x4*)(base + 32) = w2; *(u32x4*)(base + 40) = w3;
    }
}
DI void prep_vt_unit(const Params& p, LAS unsigned char* lds, int uv) {
    const int tid = otid(); const int b = uv / 132, tb = uv % 132;
    const bf16_t* PA = (const bf16_t*)(p.ws + OFF_PA); bf16_t* VT = (bf16_t*)(p.ws + OFF_VT);
    LAS unsigned char* img = lds;
#pragma unroll
    for (int i = 0; i < 8; ++i) { const int id = tid + 512 * i, row = id >> 6, ch = id & 63;
        const u32x4 v = *(const u32x4*)(PA + (size_t)(b * TT + tb * 64 + row) * 1536 + 1024 + ch * 8); *(LAS u32x4*)(img + row * 1040 + ch * 16) = v; }
    __syncthreads();
    bf16_t* dst = VT + ((size_t)(b * 512 + tid)) * TT + tb * 64;
#pragma unroll
    for (int g = 0; g < 4; ++g) { unsigned w[8];
#pragma unroll
        for (int q = 0; q < 8; ++q) { const int p0 = 2 * q, p1 = 2 * q + 1;
            const int k0 = 16 * g + (p0 & 3) + 8 * ((p0 >> 2) & 1) + 4 * (p0 >> 3), k1 = 16 * g + (p1 & 3) + 8 * ((p1 >> 2) & 1) + 4 * (p1 >> 3);
            const unsigned lo = *(const LAS unsigned short*)(img + k0 * 1040 + tid * 2), hi = *(const LAS unsigned short*)(img + k1 * 1040 + tid * 2); w[q] = lo | (hi << 16); }
        u32x4 wa = {w[0], w[1], w[2], w[3]}, wb = {w[4], w[5], w[6], w[7]};
        *(u32x4*)(dst + 16 * g) = wa; *(u32x4*)(dst + 16 * g + 8) = wb; }
    __syncthreads();
}
__device__ void ph_prep(const Params& p, int l, LAS unsigned char* lds, int wg, int nwg, int dup) {
    for (int u = wg; u < 528 + RR / 16; u += nwg) { if (u < 528) prep_vt_unit(p, lds, u); else prep_rows_unit(p, l, lds, u - 528, dup); }
}
#define MFMA32(a, b, c) __builtin_amdgcn_mfma_f32_32x32x16_bf16((a), (b), (c), 0, 0, 0)
DI bf16x8 pack_p(const f32x16& x, int s) {
    u32x4 w = {pk2(x[8 * s + 0], x[8 * s + 1]), pk2(x[8 * s + 2], x[8 * s + 3]), pk2(x[8 * s + 4], x[8 * s + 5]), pk2(x[8 * s + 6], x[8 * s + 7])};
    return __builtin_bit_cast(bf16x8, w);
}
#define SCHED_FENCE() __builtin_amdgcn_sched_barrier(0)
DI void lds_barrier() { asm volatile("s_waitcnt lgkmcnt(0)" ::: "memory"); __builtin_amdgcn_s_barrier(); asm volatile("" ::: "memory"); }
DI void attn_qk(const LAS unsigned char* Kc, const int (&coff)[4], const bf16x8 (&qf)[4], f32x16& s0, f32x16& s1) {
    bf16x8 kf[4], kg[4];
#pragma unroll
    for (int ks = 0; ks < 4; ++ks) kf[ks] = *(const LAS bf16x8*)(Kc + coff[ks]);
#pragma unroll
    for (int j = 0; j < 16; ++j) { s0[j] = 0.f; s1[j] = 0.f; }
#pragma unroll
    for (int ks = 0; ks < 4; ++ks) kg[ks] = *(const LAS bf16x8*)(Kc + 4096 + coff[ks]);
#pragma unroll
    for (int ks = 0; ks < 4; ++ks) s0 = MFMA32(kf[ks], qf[ks], s0);
#pragma unroll
    for (int ks = 0; ks < 4; ++ks) s1 = MFMA32(kg[ks], qf[ks], s1);
}
DI void attn_partial(f32x16& s0, f32x16& s1, float& m_run, float& alpha, bool& resc) {
    float tmax = fmaxf(s0[0], s1[0]);
#pragma unroll
    for (int j = 1; j < 16; ++j) tmax = fmaxf(fmaxf(tmax, s0[j]), s1[j]);
    { auto rr = __builtin_amdgcn_permlane32_swap(__float_as_uint(tmax), __float_as_uint(tmax), false, false); tmax = fmaxf(__uint_as_float(rr[0]), __uint_as_float(rr[1])); }
    resc = __any(tmax > m_run); alpha = 1.f;
    if (resc) { const float mn = fmaxf(m_run, tmax); alpha = __builtin_amdgcn_exp2f(m_run - mn); m_run = mn; }
    const f32x2v m2 = {m_run, m_run};
#pragma unroll
    for (int j = 0; j < 8; ++j) { f32x2v a = (f32x2v){s0[2 * j], s0[2 * j + 1]} - m2, c = (f32x2v){s1[2 * j], s1[2 * j + 1]} - m2;
        s0[2 * j] = __builtin_amdgcn_exp2f(a[0]); s0[2 * j + 1] = __builtin_amdgcn_exp2f(a[1]); s1[2 * j] = c[0]; s1[2 * j + 1] = c[1]; }
}
DI void attn_finish(f32x16& s0, f32x16& s1, float alpha, float& l_run, bf16x8 (&pf)[4]) {
    f32x2v ps = {0.f, 0.f};
#pragma unroll
    for (int j = 0; j < 8; ++j) { s1[2 * j] = __builtin_amdgcn_exp2f(s1[2 * j]); s1[2 * j + 1] = __builtin_amdgcn_exp2f(s1[2 * j + 1]);
        ps += (f32x2v){s0[2 * j], s0[2 * j + 1]}; ps += (f32x2v){s1[2 * j], s1[2 * j + 1]}; }
    l_run = l_run * alpha + (ps[0] + ps[1]);
    pf[0] = pack_p(s0, 0); pf[1] = pack_p(s0, 1); pf[2] = pack_p(s1, 0); pf[3] = pack_p(s1, 1);
}
DI void attn_partial_nm(f32x16& s0, f32x16& s1, float& ps) {
#pragma unroll
    for (int j = 0; j < 16; ++j) { s0[j] = __builtin_amdgcn_exp2f(s0[j]); s1[j] = __builtin_amdgcn_exp2f(s1[j]); }
    float a = s0[0];
#pragma unroll
    for (int j = 1; j < 16; ++j) a += s0[j];
    ps = a;
}
DI void attn_finish_nm(f32x16& s0, f32x16& s1, float ps, float& l_run, bf16x8 (&pf)[4]) {
    float a = ps;
#pragma unroll
    for (int j = 0; j < 16; ++j) a += s1[j];
    l_run += a;
    pf[0] = pack_p(s0, 0); pf[1] = pack_p(s0, 1); pf[2] = pack_p(s1, 0); pf[3] = pack_p(s1, 1);
}
DI void attn_step_nm(const LAS unsigned char* Kc, const LAS unsigned char* Vc, const int (&coff)[4], const bf16x8 (&qf)[4],
                     const f32x16& P0, const f32x16& P1, float psP, f32x16& N0, f32x16& N1, float& psN, float& l_run, f32x16 (&o)[4]) {
    bf16x8 kf[8], vf[16]; unsigned w[16];
#pragma unroll
    for (int i = 0; i < 8; ++i) { kf[i] = *(const LAS bf16x8*)(Kc + (i >> 2) * 4096 + coff[i & 3]); SCHED_FENCE(); }
    const f32x16 z = {0.f, 0.f, 0.f, 0.f, 0.f, 0.f, 0.f, 0.f, 0.f, 0.f, 0.f, 0.f, 0.f, 0.f, 0.f, 0.f};
    float a = psP;
#pragma unroll
    for (int g = 0; g < 8; ++g) {
        if (g < 4) N0 = MFMA32(kf[g], qf[g], g == 0 ? z : N0); else N1 = MFMA32(kf[g], qf[g - 4], g == 4 ? z : N1);
        a += P1[2 * g]; a += P1[2 * g + 1];
        if (g < 4) { w[2 * g] = pk2(P0[4 * g], P0[4 * g + 1]); w[2 * g + 1] = pk2(P0[4 * g + 2], P0[4 * g + 3]); }
        else { w[2 * g] = pk2(P1[4 * g - 16], P1[4 * g - 15]); w[2 * g + 1] = pk2(P1[4 * g - 14], P1[4 * g - 13]); }
        if (g >= 4) vf[g - 4] = *(const LAS bf16x8*)(Vc + coff[g - 4]);
        SCHED_FENCE();
    }
    l_run += a;
    bf16x8 pf[4];
#pragma unroll
    for (int k = 0; k < 4; ++k) { const u32x4 t = {w[4 * k], w[4 * k + 1], w[4 * k + 2], w[4 * k + 3]}; pf[k] = __builtin_bit_cast(bf16x8, t); }
    float bsum = 0.f;
#pragma unroll
    for (int g = 0; g < 16; ++g) {
        o[g >> 2] = MFMA32(vf[g], pf[g & 3], o[g >> 2]);
        if (g + 4 < 16) vf[g + 4] = *(const LAS bf16x8*)(Vc + ((g + 4) >> 2) * 4096 + coff[(g + 4) & 3]);
        if (g < 8) { N0[2 * g] = __builtin_amdgcn_exp2f(N0[2 * g]); N0[2 * g + 1] = __builtin_amdgcn_exp2f(N0[2 * g + 1]); bsum = (g == 0) ? N0[0] + N0[1] : (bsum + N0[2 * g]) + N0[2 * g + 1]; }
        else { N1[2 * g - 16] = __builtin_amdgcn_exp2f(N1[2 * g - 16]); N1[2 * g - 15] = __builtin_amdgcn_exp2f(N1[2 * g - 15]); }
        SCHED_FENCE();
    }
    psN = bsum;
}
DI void attn_pv(const LAS unsigned char* Vc, const int (&coff)[4], const bf16x8 (&pf)[4], f32x16 (&o)[4]) {
#pragma unroll
    for (int dvb = 0; dvb < 4; ++dvb) { bf16x8 va[4];
#pragma unroll
        for (int i = 0; i < 4; ++i) va[i] = *(const LAS bf16x8*)(Vc + dvb * 4096 + coff[i]);
#pragma unroll
        for (int i = 0; i < 4; ++i) o[dvb] = MFMA32(va[i], pf[i], o[dvb]); }
}
#ifndef PROBE_ATTN_ABL
#define PROBE_ATTN_ABL 0
#endif
template <int ABL, bool NM> DI void attn_unit(const Params& p, LAS unsigned char* lds, int b, int h, int m, int sq0, int nkt) {
    const int tid = otid(), wave = tid >> 6, lane = tid & 63, r32 = lane & 31, h2 = lane >> 5;
    const bf16_t* PA = (const bf16_t*)(p.ws + OFF_PA); const bf16_t* VT = (const bf16_t*)(p.ws + OFF_VT);
    bf16_t* O = (bf16_t*)(p.ws + (ABL ? WS_NEEDED : OFF_OA)) + (size_t)m * RR * 512;
    const size_t rowbase = (size_t)b * TT;
    bf16x8 qf[4];
    {   const bf16_t* qp = PA + (rowbase + sq0 + wave * 32 + r32) * 1536 + (h * 2 + m) * 64 + 8 * h2;
#pragma unroll
        for (int ks = 0; ks < 4; ++ks) qf[ks] = *(const bf16x8*)(qp + 16 * ks); }
    const int srow = tid >> 3, sch = (tid & 7) ^ ((srow >> 1) & 7);
    const bf16_t* kgb = PA + rowbase * 1536 + 512 + (h * 2 + m) * 64;
    const bf16_t* vgb = VT + ((size_t)((b * 4 + h) * 128)) * TT;
    const int kofs = srow * 1536 + sch * 8, vofs = srow * TT + sch * 8;
    LAS unsigned char* Kb = lds; LAS unsigned char* Vb = lds + 24576;
    const int swz = (r32 >> 1) & 7;
    int coff[4];
#pragma unroll
    for (int ks = 0; ks < 4; ++ks) coff[ks] = r32 * 128 + (((2 * ks + h2) ^ swz) << 4);
    f32x16 o[4];
#pragma unroll
    for (int i = 0; i < 4; ++i)
#pragma unroll
        for (int j = 0; j < 16; ++j) o[i][j] = 0.f;
    float m_run = -1e30f, l_run = 0.f, alA = 1.f, alB = 1.f; bool rsA = false, rsB = false;
    f32x16 A0, A1, B0, B1; bf16x8 pf[4];
    int bprev = 2, bcur = 0, bnext = 1;
    const int wu = __builtin_amdgcn_readfirstlane(tid >> 6) * 1024;
#define AT_DMA1(gp, la) asm volatile("s_mov_b32 m0, %0\n\ts_nop 0\n\tglobal_load_lds_dwordx4 %1, off" :: "s"((unsigned)(unsigned long long)(la)), "v"(gp) : "m0", "memory")
#define AT_DMA(t, bi) do { if (ABL & 4) break; \
        AT_DMA1(kgb + (kofs + (t) * 64 * 1536), Kb + (bi) * 8192 + wu); \
        AT_DMA1(vgb + (vofs + (t) * 64), Vb + (bi) * 16384 + wu); \
        AT_DMA1(vgb + (vofs + 64 * TT + (t) * 64), Vb + (bi) * 16384 + 8192 + wu); } while (0)
#define AT_LANDED() do { if (!(ABL & 4)) asm volatile("s_waitcnt vmcnt(0)" ::: "memory"); } while (0)
#define AT_BAR() do { if (!(ABL & 4)) lds_barrier(); } while (0)
#define AT_QK(Kc, N0, N1) do { if (ABL & 2) { _Pragma("unroll") for (int j_ = 0; j_ < 16; ++j_) { asm volatile("" : "+v"(N0[j_])); asm volatile("" : "+v"(N1[j_])); } } else attn_qk(Kc, coff, qf, N0, N1); } while (0)
#define AT_PV(Vc) do { if (ABL & 2) { _Pragma("unroll") for (int i_ = 0; i_ < 4; ++i_) asm volatile("" :: "v"(pf[i_])); } else attn_pv(Vc, coff, pf, o); } while (0)
#define AT_PART(N0, N1, alN, rsN) do { if (ABL & 1) { alN = 1.f; rsN = false; } else if (NM) { rsN = false; attn_partial_nm(N0, N1, alN); } else attn_partial(N0, N1, m_run, alN, rsN); } while (0)
#define AT_FIN(P0, P1, alP) do { if (ABL & 1) { pf[0] = pack_p(P0, 0); pf[1] = pack_p(P0, 1); pf[2] = pack_p(P1, 0); pf[3] = pack_p(P1, 1); l_run = 1.f; } else if (NM) attn_finish_nm(P0, P1, alP, l_run, pf); else attn_finish(P0, P1, alP, l_run, pf); } while (0)
#define AT_ROT() do { const int t_ = bprev; bprev = bcur; bcur = bnext; bnext = t_; } while (0)
#define AT_RESC(al, rs) do { if (__builtin_expect(rs, 0)) { asm volatile("" ::: "memory"); _Pragma("unroll") for (int i_ = 0; i_ < 4; ++i_) _Pragma("unroll") for (int j_ = 0; j_ < 16; ++j_) o[i_][j_] *= (al); } } while (0)
#define AT_STEP(j, P0, P1, alP, N0, N1, alN, rsN) do { \
        if ((j) + 1 < nkt) AT_DMA((j) + 1, bnext); \
        SCHED_FENCE(); \
        if constexpr (NM && ABL == 0) { attn_step_nm(Kb + bcur * 8192, Vb + bprev * 16384, coff, qf, P0, P1, alP, N0, N1, alN, l_run, o); SCHED_FENCE(); AT_LANDED(); AT_BAR(); AT_ROT(); break; } \
        AT_QK(Kb + bcur * 8192, N0, N1); AT_FIN(P0, P1, alP); \
        __builtin_amdgcn_sched_group_barrier(0x100, 8, 0); \
        _Pragma("unroll") for (int g_ = 0; g_ < 8; ++g_) { __builtin_amdgcn_sched_group_barrier(0x8, 1, 0); __builtin_amdgcn_sched_group_barrier(0x402, NM ? 5 : 7, 0); } \
        SCHED_FENCE(); \
        AT_PV(Vb + bprev * 16384); AT_PART(N0, N1, alN, rsN); \
        __builtin_amdgcn_sched_group_barrier(0x100, 4, 0); \
        _Pragma("unroll") for (int g_ = 0; g_ < 16; ++g_) { __builtin_amdgcn_sched_group_barrier(0x8, 1, 0); __builtin_amdgcn_sched_group_barrier(0x100, 1, 0); __builtin_amdgcn_sched_group_barrier(0x402, NM ? 3 : 4, 0); } \
        SCHED_FENCE(); \
        AT_RESC(alN, rsN); \
        AT_LANDED(); AT_BAR(); AT_ROT(); } while (0)
    AT_DMA(0, 0); AT_LANDED(); AT_BAR();
    if (nkt > 1) AT_DMA(1, 1);
    AT_QK(Kb, A0, A1); AT_PART(A0, A1, alA, rsA);
    AT_LANDED(); AT_BAR(); AT_ROT();
    int j = 1;
    for (; j + 1 < nkt; j += 2) { AT_STEP(j, A0, A1, alA, B0, B1, alB, rsB); AT_STEP(j + 1, B0, B1, alB, A0, A1, alA, rsA); }
    if (j < nkt) {
        AT_STEP(j, A0, A1, alA, B0, B1, alB, rsB);
        AT_FIN(B0, B1, alB);
    } else AT_FIN(A0, A1, alA);
    AT_PV(Vb + bprev * 16384);
#undef AT_DMA
#undef AT_DMA1
#undef AT_LANDED
#undef AT_ROT
#undef AT_RESC
#undef AT_STEP
#undef AT_BAR
#undef AT_QK
#undef AT_PV
#undef AT_PART
#undef AT_FIN
    { auto rr = __builtin_amdgcn_permlane32_swap(__float_as_uint(l_run), __float_as_uint(l_run), false, false); l_run = __uint_as_float(rr[0]) + __uint_as_float(rr[1]); }
    const float inv = 1.f / l_run;
    const int tid2 = otid();
    bf16_t* orow = O + (rowbase + sq0 + (tid2 >> 6) * 32 + (tid2 & 31)) * 512 + h * 128 + 4 * ((tid2 >> 5) & 1);
#pragma unroll
    for (int dvb = 0; dvb < 4; ++dvb)
#pragma unroll
        for (int g = 0; g < 4; ++g) { u32x2 w = {pk2(o[dvb][4 * g] * inv, o[dvb][4 * g + 1] * inv), pk2(o[dvb][4 * g + 2] * inv, o[dvb][4 * g + 3] * inv)};
            *(u32x2*)(orow + dvb * 32 + 8 * g) = w; }
    lds_barrier();
}

constexpr int CS_TKK = 0, CS_TR = 2304, CS_TKD = 4608, CS_TKA = 6912, CS_TVN = 9216, CS_TDA = 11264, CS_TVS = 16384, CS_G15 = 21504, CS_TBM = 21760, CS_TCM = 23040, CS_TBC = 24064, CS_BUF = 25344;
constexpr int CS_E = 2 * CS_BUF, CS_YO = CS_E + 4096;
constexpr int CS_RS = 144, CS_RT = 80, CS_C = 16, CS_NCH = TT / CS_C;
static_assert(CS_NCH % 4 == 0 && CS_YO + 4096 <= 131072, "scan");
#ifndef PROBE_SCAN_ABL
#define PROBE_SCAN_ABL 0
#endif
DI void scan_unit(const Params& p, int l, LAS unsigned char* lds, int u, int dup = 0) {
    const int abl = dup ? PROBE_SCAN_ABL : 0;
    const int tid = otid(), wave = tid >> 6, lane = tid & 63, c16 = lane & 15, q = lane >> 4;
    const int chain = u; const int dir = chain & 1, bh = chain >> 1, b = bh >> 3, h = bh & 7;
    auto tok = [&](int i) -> int { return dir == 0 ? i : (i < NCTX ? (NCTX - 1 - i) : (TT + NCTX - 1 - i)); };
    for (int i = tid; i < 2 * 16 * 16; i += 512) { const int bf = i >> 8, r = (i >> 4) & 15, cidx = i & 15; *(LAS unsigned short*)(lds + bf * CS_BUF + CS_TBM + r * CS_RT + (16 + cidx) * 2) = 0; }
    for (int i = tid; i < 2 * 64 * 16; i += 512) { const int bf = i >> 10, r = (i >> 4) & 63, cidx = i & 15; *(LAS unsigned short*)(lds + bf * CS_BUF + CS_TVS + r * CS_RT + (16 + cidx) * 2) = 0; }
    lds_barrier();
    if (wave >= 4) {
        __builtin_amdgcn_s_setprio(1);
        const bf16_t* EW = (const bf16_t*)(p.ws + OFF_EW) + (size_t)dir * RR * 512; const bf16_t* AA = (const bf16_t*)(p.ws + OFF_AA) + (size_t)dir * RR * 512;
        const bf16_t* KK = (const bf16_t*)(p.ws + OFF_KK); const bf16_t* KC = (const bf16_t*)(p.ws + OFF_KC); const bf16_t* RC = (const bf16_t*)(p.ws + OFF_RC); const bf16_t* VC = (const bf16_t*)(p.ws + OFF_VC);
        bf16_t* OS = (bf16_t*)(p.ws + ((dup && PROBE_SCAN_ABL) ? WS_NEEDED : OFF_OS)) + (size_t)dir * RR * 512;
        const int pu = tid - 256, pw = wave - 4, lt = pu >> 4, k4 = (pu & 15) * 4;
        const int posk = 32 * (k4 >> 5) + 8 * (((k4 & 31) >> 2) & 3) + 4 * ((k4 & 31) >> 4);
        const f32x4 ka4 = *(const f32x4*)(p.rwkv_k_a + l * 512 + h * 64 + k4);
        struct Raw { u32x2 re, rk, ra, rkc, rr_, rv; };
        auto gload = [&](int c) -> Raw { const size_t off = ((size_t)b * TT + tok(c * CS_C + lt)) * 512 + h * 64 + k4; Raw w;
            w.re = *(const u32x2*)(EW + off); w.rk = *(const u32x2*)(KK + off); w.ra = *(const u32x2*)(AA + off); w.rkc = *(const u32x2*)(KC + off); w.rr_ = *(const u32x2*)(RC + off); w.rv = *(const u32x2*)(VC + off); return w; };
        float cmask[16];
#pragma unroll
        for (int i = 0; i < 16; ++i) { cmask[i] = (i <= lt) ? 1.f : 0.f; asm volatile("" : "+v"(cmask[i])); }
        auto stage1 = [&](const Raw& w) { float e[4]; unpack4(w.re, e); *(LAS f32x4*)(lds + CS_E + (lt * 64 + k4) * 4) = (f32x4){e[0], e[1], e[2], e[3]}; };
        auto stage2 = [&](const Raw& w, int par) {
            LAS unsigned char* B = lds + par * CS_BUF;
            f32x4 cs = (f32x4){0.f, 0.f, 0.f, 0.f};
#pragma unroll
            for (int i = 0; i < 16; ++i) { const f32x4 ev = *(const LAS f32x4*)(lds + CS_E + (i * 64 + k4) * 4); const float mk = cmask[i]; cs[0] = fmaf(mk, ev[0], cs[0]); cs[1] = fmaf(mk, ev[1], cs[1]); cs[2] = fmaf(mk, ev[2], cs[2]); cs[3] = fmaf(mk, ev[3], cs[3]); }
            float e[4], kk[4], a[4], kc[4], r[4]; unpack4(w.re, e); unpack4(w.rk, kk); unpack4(w.ra, a); unpack4(w.rkc, kc); unpack4(w.rr_, r);
            float tkk[4], tr[4], tkd[4], tka[4]; f32x4 g;
#pragma unroll
            for (int i = 0; i < 4; ++i) { g[i] = __builtin_amdgcn_exp2f(-cs[i]); const float gi = __builtin_amdgcn_exp2f(cs[i]), gp = __builtin_amdgcn_exp2f(e[i] - cs[i]);
                tkk[i] = kk[i] * gp; tr[i] = r[i] * g[i]; tkd[i] = kc[i] * (1.f + (a[i] - 1.f) * ka4[i]) * gi; tka[i] = kk[i] * a[i] * gi; }
            *(LAS u32x2*)(B + CS_TKK + lt * CS_RS + posk * 2) = (u32x2){pk2(tkk[0], tkk[1]), pk2(tkk[2], tkk[3])};
            *(LAS u32x2*)(B + CS_TR + lt * CS_RS + posk * 2) = (u32x2){pk2(tr[0], tr[1]), pk2(tr[2], tr[3])};
            *(LAS u32x2*)(B + CS_TKD + lt * CS_RS + posk * 2) = (u32x2){pk2(tkd[0], tkd[1]), pk2(tkd[2], tkd[3])};
            *(LAS u32x2*)(B + CS_TKA + lt * CS_RS + posk * 2) = (u32x2){pk2(tka[0], tka[1]), pk2(tka[2], tka[3])};
            *(LAS u32x2*)(B + CS_TVN + (lt * 64 + k4) * 2) = w.rv;
            if (lt == 15) *(LAS f32x4*)(B + CS_G15 + k4 * 4) = g;
        };
        auto stage3 = [&](int par) {
            LAS unsigned char* B = lds + par * CS_BUF;
            {   const LAS unsigned char* ta = B + ((pw & 1) ? CS_TKA : CS_TKD) + c16 * CS_RS + q * 16; const LAS unsigned char* tb = B + ((pw & 2) ? CS_TR : CS_TKK) + c16 * CS_RS + q * 16;
                f32x4 m = (f32x4){0.f, 0.f, 0.f, 0.f};
                m = MFMA16(*(const LAS bf16x8*)ta, *(const LAS bf16x8*)tb, m); m = MFMA16(*(const LAS bf16x8*)(ta + 64), *(const LAS bf16x8*)(tb + 64), m);
#pragma unroll
                for (int i = 0; i < 4; ++i) { const int j = 4 * q + i; const bool keep = (pw & 2) ? (j <= c16) : (j < c16); m[i] = keep ? m[i] : 0.f; }
                if (pw == 0) { u32x2 w = {pk2(m[0], m[1]), pk2(m[2], m[3])}; *(LAS u32x2*)(B + CS_TBM + c16 * CS_RT + 8 * q) = w; }
                else if (pw == 1) *(LAS f32x4*)(B + CS_TCM + (c16 * 16 + 4 * q) * 4) = m;
                else if (pw == 2) { u32x2 w = {pk2(m[0], m[1]), pk2(m[2], m[3])}; *(LAS u32x2*)(B + CS_TBC + c16 * CS_RT + 8 * q) = w; }
                else { u32x2 w = {pk2(-m[0], -m[1]), pk2(-m[2], -m[3])}; *(LAS u32x2*)(B + CS_TBC + c16 * CS_RT + 32 + 8 * q) = w; } }
            if (pu < 192) { const bool isv = pu >= 128; const int kk_ = isv ? (pu - 128) : (pu >> 1), half = isv ? 0 : (pu & 1);
                const int pk_ = 32 * (kk_ >> 5) + 8 * (((kk_ & 31) >> 2) & 3) + 4 * ((kk_ & 31) >> 4) + (kk_ & 3);
                const LAS unsigned char* src = isv ? (B + CS_TVN + kk_ * 2) : (B + (half ? CS_TKA : CS_TKD) + pk_ * 2); const int sstr = isv ? 128 : CS_RS;
                unsigned w[8];
#pragma unroll
                for (int t2 = 0; t2 < 8; ++t2) { const unsigned lo = *(const LAS unsigned short*)(src + (2 * t2) * sstr), hi = *(const LAS unsigned short*)(src + (2 * t2 + 1) * sstr); w[t2] = (lo | (hi << 16)) ^ (half ? 0x80008000u : 0u); }
                LAS unsigned char* dst = isv ? (B + CS_TVS + kk_ * CS_RT) : (B + CS_TDA + kk_ * CS_RT + half * 32);
                *(LAS u32x4*)dst = (u32x4){w[0], w[1], w[2], w[3]}; *(LAS u32x4*)(dst + 16) = (u32x4){w[4], w[5], w[6], w[7]}; }
        };
        Raw ring[4]; ring[0] = gload(0); ring[1] = gload(1); ring[2] = gload(2); ring[3] = gload(3);
        stage1(ring[0]); lds_barrier();
        stage2(ring[0], 0); ring[0] = gload(4); lds_barrier();
        stage3(0); stage1(ring[1]); lds_barrier();
#pragma unroll 1
        for (int c4 = 0; c4 < CS_NCH; c4 += 4) {
#pragma unroll
            for (int ci = 0; ci < 4; ++ci) { const int c = c4 + ci;
                if (c + 1 < CS_NCH) { if (!(abl & 2)) stage2(ring[(ci + 1) & 3], (c + 1) & 1); if (c + 5 < CS_NCH && !(abl & 8)) ring[(ci + 1) & 3] = gload(c + 5); }
                lds_barrier();
                if (c + 1 < CS_NCH && !(abl & 4)) stage3((c + 1) & 1);
                lds_barrier();
                if (!(abl & 16)) {   const f32x4 yy = *(const LAS f32x4*)(lds + CS_YO + (lt * 64 + k4) * 4);
                    *(u32x2*)(OS + ((size_t)b * TT + tok(c * CS_C + lt)) * 512 + h * 64 + k4) = (u32x2){pk2(yy[0], yy[1]), pk2(yy[2], yy[3])}; }
                if (c + 2 < CS_NCH) stage1(ring[(ci + 2) & 3]);
                lds_barrier();
            }
        }
        __builtin_amdgcn_s_setprio(0);
    } else {
        const int v = 16 * wave + c16;
        f32x4 sT[4];
#pragma unroll
        for (int i = 0; i < 4; ++i) sT[i] = (f32x4){0.f, 0.f, 0.f, 0.f};
        lds_barrier(); lds_barrier(); lds_barrier();
#pragma unroll 1
        for (int c = 0; c < CS_NCH; ++c) {
            if (abl & 1) { lds_barrier(); lds_barrier(); lds_barrier(); continue; }
            const LAS unsigned char* B = lds + (c & 1) * CS_BUF;
            const LAS unsigned char* tvs = B + CS_TVS + v * CS_RT + q * 16;
            const bf16x8 fkk0 = *(const LAS bf16x8*)(B + CS_TKK + c16 * CS_RS + q * 16), fkk1 = *(const LAS bf16x8*)(B + CS_TKK + c16 * CS_RS + 64 + q * 16);
            const bf16x8 fbm = *(const LAS bf16x8*)(B + CS_TBM + c16 * CS_RT + q * 16), fv0 = *(const LAS bf16x8*)tvs;
            f32x4 cc[4][4], cin[4];
#pragma unroll
            for (int i = 0; i < 4; ++i) { cin[i] = *(const LAS f32x4*)(B + CS_TCM + ((4 * q + i) * 16 + 4 * q) * 4);
#pragma unroll
                for (int jj = 0; jj < 4; ++jj) cc[i][jj] = *(const LAS f32x4*)(B + CS_TCM + ((4 * q + i) * 16 + 4 * jj) * 4); }
            const bf16x8 fr0 = *(const LAS bf16x8*)(B + CS_TR + c16 * CS_RS + q * 16), fr1 = *(const LAS bf16x8*)(B + CS_TR + c16 * CS_RS + 64 + q * 16);
            const bf16x8 fbc = *(const LAS bf16x8*)(B + CS_TBC + c16 * CS_RT + q * 16);
            bf16x8 fda[4]; f32x4 gg[4];
#pragma unroll
            for (int rb = 0; rb < 4; ++rb) { fda[rb] = *(const LAS bf16x8*)(B + CS_TDA + (16 * rb + c16) * CS_RT + q * 16); gg[rb] = *(const LAS f32x4*)(B + CS_G15 + (16 * rb + 4 * q) * 4); }
            bf16x8 sf[2];
#pragma unroll
            for (int s2 = 0; s2 < 2; ++s2) { u32x4 w = {pk2(sT[2 * s2][0], sT[2 * s2][1]), pk2(sT[2 * s2][2], sT[2 * s2][3]), pk2(sT[2 * s2 + 1][0], sT[2 * s2 + 1][1]), pk2(sT[2 * s2 + 1][2], sT[2 * s2 + 1][3])}; sf[s2] = __builtin_bit_cast(bf16x8, w); }
            f32x4 x = (f32x4){0.f, 0.f, 0.f, 0.f};
            x = MFMA16(fkk0, sf[0], x); x = MFMA16(fkk1, sf[1], x); x = MFMA16(fbm, fv0, x);
            f32x4 yv = (f32x4){0.f, 0.f, 0.f, 0.f};
            yv = MFMA16(fr0, sf[0], yv); yv = MFMA16(fr1, sf[1], yv);
            f32x4 sa = (f32x4){0.f, 0.f, 0.f, 0.f};
#pragma unroll
            for (int q0 = 0; q0 < 4; ++q0) {
                f32x4 y; y[0] = x[0]; y[1] = x[1] - y[0] * cin[1][0]; y[2] = x[2] - y[0] * cin[2][0] - y[1] * cin[2][1]; y[3] = x[3] - y[0] * cin[3][0] - y[1] * cin[3][1] - y[2] * cin[3][2];
                if (q == q0) sa = y;
                if (q0 < 3) { const int src = (c16 + 16 * q0) << 2; const float b0 = bperm(y[0], src), b1 = bperm(y[1], src), b2 = bperm(y[2], src), b3 = bperm(y[3], src);
#pragma unroll
                    for (int i = 0; i < 4; ++i) x[i] -= b0 * cc[i][q0][0] + b1 * cc[i][q0][1] + b2 * cc[i][q0][2] + b3 * cc[i][q0][3]; }
            }
            lds_barrier();
            { u32x2 w = {pk2(sa[0], sa[1]), pk2(sa[2], sa[3])}; *(LAS u32x2*)(lds + (c & 1) * CS_BUF + CS_TVS + v * CS_RT + 32 + q * 8) = w; }
            const bf16x8 bvs = *(const LAS bf16x8*)tvs;
            yv = MFMA16(fbc, bvs, yv);
#pragma unroll
            for (int rb = 0; rb < 4; ++rb) sT[rb] = MFMA16(fda[rb], bvs, sT[rb]);
#pragma unroll
            for (int i = 0; i < 4; ++i) *(LAS float*)(lds + CS_YO + ((4 * q + i) * 64 + v) * 4) = yv[i];
            lds_barrier();
#pragma unroll
            for (int rb = 0; rb < 4; ++rb) sT[rb] *= gg[rb];
            lds_barrier();
        }
    }
    lds_barrier();
}

__device__ void ph_mix(const Params& p, int l, LAS unsigned char* lds, LAS unsigned* bcast, int dup) {
    unsigned* ctr = (unsigned*)(p.ws + OFF_CTR) + l * 64 + (dup ? 32 : 0);
    constexpr int N_SCAN = 64, N_LAT = 1024, N_CTX = 32;
    bool nm; { const int lane = otid() & 63; const float mq = wave_max(fabsf(p.q_norm_g[l * 64 + lane])), mk = wave_max(fabsf(p.k_norm_g[l * 64 + lane]));
        nm = __builtin_amdgcn_readfirstlane((8.f * 1.4426950408889634f * mq * mk <= 64.f) ? 1 : 0) != 0; }
    for (;;) {
        if (otid() == 0) *bcast = atomicAdd(ctr, 1u);
        __syncthreads();
        const int u = (int)*bcast;
        __syncthreads();
        if (u >= N_SCAN + N_LAT + N_CTX) break;
#ifdef PROBE_DMODE
        if (dup && PROBE_DMODE == 2 && u >= N_SCAN) break;
        if (dup && PROBE_DMODE == 3 && u < N_SCAN) continue;
#endif
        if (u < N_SCAN) scan_unit(p, l, lds, u, dup);
        else if (u < N_SCAN + N_LAT) { const int v = u - N_SCAN; const int qb = v & 31, m = (v >> 5) & 1, h = (v >> 6) & 3, b = v >> 8;
            if (PROBE_ATTN_ABL != 0 && dup) attn_unit<PROBE_ATTN_ABL, false>(p, lds, b, h, m, NCTX + qb * 256, TT / 64);
            else if (nm) attn_unit<0, true>(p, lds, b, h, m, NCTX + qb * 256, TT / 64); else attn_unit<0, false>(p, lds, b, h, m, NCTX + qb * 256, TT / 64); }
        else { const int v = u - N_SCAN - N_LAT; const int m = v & 1, h = (v >> 1) & 3, b = v >> 3; attn_unit<0, false>(p, lds, b, h, m, 0, NCTX / 64); }
    }
    if (!dup) { conv_expert_weights(p, l, lds); if (l + 1 < NL) conv_mixer_a(p, l + 1, lds); }
}
__device__ void ph_post(const Params& p, int l, int wg, int nwg) {
    const int tid = otid(), wave = tid >> 6, lane = tid & 63;
    const float lam_init = 0.8f - 0.6f * expf(-0.3f * (float)l);
    float lam;
    {   const float* lv = p.diff_lambda + l * 256; const float a = wave_sum(lv[lane] * lv[64 + lane]), c = wave_sum(lv[128 + lane] * lv[192 + lane]); lam = expf(a) - expf(c) + lam_init; }
    const bf16_t* OA0 = (const bf16_t*)(p.ws + OFF_OA); const bf16_t* OA1 = OA0 + (size_t)RR * 512;
    const bf16_t* OS0 = (const bf16_t*)(p.ws + OFF_OS); const bf16_t* OS1 = OS0 + (size_t)RR * 512;
    const bf16_t* YB0 = (const bf16_t*)(p.ws + OFF_YB0); const bf16_t* G = (const bf16_t*)(p.ws + OFF_G);
    bf16_t* YA = (bf16_t*)(p.ws + OFF_YA); bf16_t* YB = (bf16_t*)(p.ws + OFF_YB);
    float sg[8], lg[8];
#pragma unroll
    for (int i = 0; i < 8; ++i) { sg[i] = p.diff_subln_g[l * 128 + (lane & 15) * 8 + i] * (1.f - lam_init); lg[i] = p.rwkv_ln_g[l * 512 + lane * 8 + i]; }
    const int rstep = nwg * 8; int r = wg * 8 + wave;
    u32x4 la, lc, ly0, lgg, lo0, lo1;
    auto ldrow = [&](int rr) { const size_t o = (size_t)rr * 512 + lane * 8; la = *(const u32x4*)(OA0 + o); lc = *(const u32x4*)(OA1 + o); ly0 = *(const u32x4*)(YB0 + o); lgg = *(const u32x4*)(G + o); lo0 = *(const u32x4*)(OS0 + o); lo1 = *(const u32x4*)(OS1 + o); };
    if (r < RR) ldrow(r);
    while (r < RR) {
        const size_t o = (size_t)r * 512 + lane * 8;
        const u32x4 a = la, c = lc, y0 = ly0, gg = lgg, ov0 = lo0, ov1 = lo1;
        if (r + rstep < RR) ldrow(r + rstep);
        {   float v[8]; float ss = 0.f;
#pragma unroll
            for (int i = 0; i < 4; ++i) { v[2 * i] = bflo(a[i]) - lam * bflo(c[i]); v[2 * i + 1] = bfhi(a[i]) - lam * bfhi(c[i]); ss += v[2 * i] * v[2 * i] + v[2 * i + 1] * v[2 * i + 1]; }
            ss = allsum16(ss);
            const float rinv = rsqrtf(ss * (1.f / 128.f) + 1e-6f);
            u32x4 w;
#pragma unroll
            for (int i = 0; i < 4; ++i) w[i] = pk2(v[2 * i] * rinv * sg[2 * i], v[2 * i + 1] * rinv * sg[2 * i + 1]);
            *(u32x4*)(YA + o) = w; }
        {   float y[8];
#pragma unroll
            for (int i = 0; i < 4; ++i) { y[2 * i] = bflo(y0[i]); y[2 * i + 1] = bfhi(y0[i]); }
#pragma unroll
            for (int d = 0; d < 2; ++d) { const u32x4 ov = d ? ov1 : ov0; float v[8]; float sm = 0.f;
#pragma unroll
                for (int i = 0; i < 4; ++i) { v[2 * i] = bflo(ov[i]); v[2 * i + 1] = bfhi(ov[i]); sm += v[2 * i] + v[2 * i + 1]; }
                const float mu = allsum8(sm) * (1.f / 64.f); float sq = 0.f;
#pragma unroll
                for (int i = 0; i < 8; ++i) { v[i] -= mu; sq += v[i] * v[i]; }
                const float rinv = rsqrtf(allsum8(sq) * (1.f / 64.f) + 64e-5f);
#pragma unroll
                for (int i = 0; i < 8; ++i) y[i] += v[i] * rinv * lg[i]; }
            u32x4 w;
#pragma unroll
            for (int i = 0; i < 4; ++i) w[i] = pk2(y[2 * i] * bflo(gg[i]), y[2 * i + 1] * bfhi(gg[i]));
            *(u32x4*)(YB + o) = w; }
        r += rstep;
    }
}

template <int KSTEPS> DI void rows16_mma2(const bf16_t* arow, const bf16_t* brow, int ldb, f32x4 (&acc)[2]) {
#pragma unroll 1
    for (int k0 = 0; k0 < KSTEPS; k0 += 8) { bf16x8 a[8], b0[8], b1[8];
#pragma unroll
        for (int k = 0; k < 8; ++k) { a[k] = *(const bf16x8*)(arow + 32 * (k0 + k)); b0[k] = *(const bf16x8*)(brow + 32 * (k0 + k)); b1[k] = *(const bf16x8*)(brow + ldb + 32 * (k0 + k)); }
#pragma unroll
        for (int k = 0; k < 8; ++k) { acc[0] = MFMA16(a[k], b0[k], acc[0]); acc[1] = MFMA16(a[k], b1[k], acc[1]); } }
}
__device__ void ctx_merge_units(const Params& p, int wg, int nwg) {
    const int tid = otid(), wave = tid >> 6, lane = tid & 63, c16 = lane & 15, q = lane >> 4;
    const unsigned char* PG = p.ws + OFF_PG; bf16_t* M = (bf16_t*)(p.ws + OFF_M); const bf16_t* WBR = (const bf16_t*)(p.ws + OFF_WBR);
    for (int u = wg; u < 256; u += nwg) {
        const int rbk = u >> 2; const int r0 = (rbk >> 4) * TT + (rbk & 15) * 16; const int colw = (u & 3) * 256 + wave * 32 + c16 * 2;
        f32x4 tot[2] = {(f32x4){0.f, 0.f, 0.f, 0.f}, (f32x4){0.f, 0.f, 0.f, 0.f}};
#pragma unroll 1
        for (int br = 0; br < 3; ++br) {
            const bf16_t* Y = (const bf16_t*)(p.ws + (br == 0 ? OFF_YA : (br == 1 ? OFF_YB : OFF_YC)));
            f32x4 acc[2] = {(f32x4){0.f, 0.f, 0.f, 0.f}, (f32x4){0.f, 0.f, 0.f, 0.f}};
            rows16_mma2<16>(Y + (size_t)(r0 + c16) * 512 + 8 * q, WBR + ((size_t)br * 1024 + colw) * 512 + 8 * q, 512, acc);
#pragma unroll
            for (int i = 0; i < 4; ++i) { const unsigned g = *(const unsigned short*)(PG + (size_t)(r0 + 4 * q + i) * 3072 + br * 1024 + colw);
                tot[0][i] += (float)(g & 255u) * (1.f / 255.f) * acc[0][i]; tot[1][i] += (float)(g >> 8) * (1.f / 255.f) * acc[1][i]; }
        }
#pragma unroll
        for (int i = 0; i < 4; ++i) *(unsigned*)(M + (size_t)(r0 + 4 * q + i) * 1024 + colw) = pk2(tot[0][i], tot[1][i]);
    }
}
__device__ void ctx_out_units(const Params& p, int l, int wg, int nwg, float scale) {
    const int tid = otid(), wave = tid >> 6, lane = tid & 63, c16 = lane & 15, q = lane >> 4;
    const bf16_t* M = (const bf16_t*)(p.ws + OFF_M); const bf16_t* WOUT = (const bf16_t*)(p.ws + OFF_WOUT); float* X = (float*)(p.ws + OFF_X);
    const float* g1 = (const float*)(p.ws + OFF_MOD) + ((size_t)l * 5 + 4) * 6144 + 2 * 1024;
    for (int u = wg; u < 256; u += nwg) {
        const int rbk = u >> 2; const int r0 = (rbk >> 4) * TT + (rbk & 15) * 16; const int colw = (u & 3) * 256 + wave * 32 + c16 * 2;
        f32x4 acc[2] = {(f32x4){0.f, 0.f, 0.f, 0.f}, (f32x4){0.f, 0.f, 0.f, 0.f}};
        rows16_mma2<32>(M + (size_t)(r0 + c16) * 1024 + 8 * q, WOUT + (size_t)colw * 1024 + 8 * q, 1024, acc);
        const f32x2v gv = *(const f32x2v*)(g1 + colw);
#pragma unroll
        for (int i = 0; i < 4; ++i) { float* xp = X + (size_t)(r0 + 4 * q + i) * 1024 + colw; f32x2v xv = *(f32x2v*)xp;
            xv[0] += gv[0] * acc[0][i] * scale; xv[1] += gv[1] * acc[1][i] * scale; *(f32x2v*)xp = xv; }
    }
}

constexpr int RW_ES = 260, RW_QS = 16 * RW_ES;
__device__ void ph_norm2(const Params& p, int l, LAS unsigned char* lds, int wg, int nwg) {
    const int tid = otid(), wave = tid >> 6, lane = tid & 63;
    LAS float* RW = (LAS float*)lds;
    LAS float* hrow = RW + 4 * RW_QS + wave * 1024;
    {   const float* rw = p.router_w + (size_t)l * 1024 * 16;
        for (int i = tid; i < 16384; i += 512) { const int k = i >> 4, e = i & 15; RW[(k >> 8) * RW_QS + e * RW_ES + (k & 255)] = rw[i]; } }
    __syncthreads();
    const float* X = (const float*)(p.ws + OFF_X); bf16_t* H = (bf16_t*)(p.ws + OFF_H);
    const float* MOD = (const float*)(p.ws + OFF_MOD) + (size_t)l * 5 * 6144; const float* g = p.norm2_g + l * 1024;
    float* AFFL = (float*)(p.ws + OFF_AFFL); float* AFFC = (float*)(p.ws + OFF_AFFC); int* INV = (int*)(p.ws + OFF_INV);
    const int e = lane & 15, kq = lane >> 4;
    const int rstep = nwg * 8; int r = wg * 8 + wave;
    float4 v[4];
    if (r < RR) { const float4* xr = (const float4*)(X + (size_t)r * 1024);
#pragma unroll
        for (int i = 0; i < 4; ++i) v[i] = xr[lane + 64 * i]; }
    while (r < RR) {
        float4 vn[4];
        if (r + rstep < RR) { const float4* xr = (const float4*)(X + (size_t)(r + rstep) * 1024);
#pragma unroll
            for (int i = 0; i < 4; ++i) vn[i] = xr[lane + 64 * i]; }
        float ss = 0.f;
#pragma unroll
        for (int i = 0; i < 4; ++i) ss += v[i].x * v[i].x + v[i].y * v[i].y + v[i].z * v[i].z + v[i].w * v[i].w;
        ss = wave_sum(ss);
        const float rinv = rsqrtf(ss * (1.f / 1024.f) + 1e-6f);
        const int b = r / TT, s_ = r - b * TT; const float* md = MOD + (s_ < NCTX ? 4 : b) * 6144;
        float4 ggv[4], shv[4], scv[4];
#pragma unroll
        for (int i = 0; i < 4; ++i) { const int col = (lane + 64 * i) * 4; ggv[i] = *(const float4*)(g + col); shv[i] = *(const float4*)(md + 3 * 1024 + col); scv[i] = *(const float4*)(md + 4 * 1024 + col); }
#pragma unroll
        for (int i = 0; i < 4; ++i) { const int col = (lane + 64 * i) * 4;
            const float4 gg = ggv[i], sh = shv[i], sc = scv[i];
            f32x4 y; y[0] = v[i].x * rinv * gg.x * (1.f + sc.x) + sh.x; y[1] = v[i].y * rinv * gg.y * (1.f + sc.y) + sh.y; y[2] = v[i].z * rinv * gg.z * (1.f + sc.z) + sh.z; y[3] = v[i].w * rinv * gg.w * (1.f + sc.w) + sh.w;
            u32x2 w = {pk2(y[0], y[1]), pk2(y[2], y[3])}; *(u32x2*)(H + (size_t)r * 1024 + col) = w;
            *(LAS f32x4*)(hrow + col) = y; }
        f32x4 acc4 = (f32x4){0.f, 0.f, 0.f, 0.f}; const LAS float* hq = hrow + kq * 256; const LAS float* wq = RW + kq * RW_QS + e * RW_ES;
#pragma unroll 8
        for (int k = 0; k < 256; k += 4) acc4 += *(const LAS f32x4*)(hq + k) * *(const LAS f32x4*)(wq + k);
        float acc = (acc4[0] + acc4[1]) + (acc4[2] + acc4[3]);
        acc = sum_x32(sum_x16(acc));
        const float mx = allmax16(acc);
        const float ex = expf(acc - mx); const float sm = allsum16(ex);
        const float aff = ex / sm;
        if (lane < 16) { if (s_ < NCTX) AFFC[((size_t)(b * 16 + e)) * NCTX + s_] = aff; else AFFL[((size_t)(b * 16 + e)) * SEQ + (s_ - NCTX)] = aff;
            INV[(size_t)r * 16 + e] = -1; }
#pragma unroll
        for (int i = 0; i < 4; ++i) v[i] = vn[i];
        r += rstep;
    }
    __syncthreads();
}

DI void topk_unit(const Params& p, LAS unsigned char* lds, int u) {
    const int tid = otid(), wave = tid >> 6, lane = tid & 63;
    const bool lat = u < 64; const int v_ = lat ? u : u - 64; const int b = v_ >> 4, e = v_ & 15;
    const int n = lat ? SEQ : NCTX, cap = lat ? CAPL : CAPC;
    const float* aff = lat ? (const float*)(p.ws + OFF_AFFL) + ((size_t)(b * 16 + e)) * SEQ : (const float*)(p.ws + OFF_AFFC) + ((size_t)(b * 16 + e)) * NCTX;
    LAS unsigned* hist = (LAS unsigned*)lds;
    LAS unsigned* sh = hist + 256;
    unsigned long long key[16];
#pragma unroll
    for (int i = 0; i < 16; ++i) { const int idx = tid + 512 * i; key[i] = (idx < n) ? (((unsigned long long)__float_as_uint(aff[idx]) << 13) | (unsigned long long)(8191 - idx)) : 0ull; }
    unsigned long long prefix = 0ull, mask = 0ull; unsigned need = (unsigned)cap;
#pragma unroll 1
    for (int shift = 40; shift >= 0; shift -= 8) {
        if (tid < 256) hist[tid] = 0u;
        if (tid == 0) sh[2] = 0u;
        __syncthreads();
#pragma unroll
        for (int i = 0; i < 16; ++i) if (tid + 512 * i < n && (key[i] & mask) == prefix) __hip_atomic_fetch_add(&hist[(unsigned)(key[i] >> shift) & 255u], 1u, __ATOMIC_RELAXED, __HIP_MEMORY_SCOPE_WORKGROUP);
        __syncthreads();
        if (wave == 0) {
            unsigned loc[4]; unsigned ls = 0;
#pragma unroll
            for (int j = 0; j < 4; ++j) { loc[j] = hist[255 - 4 * lane - j]; ls += loc[j]; }
            unsigned incl = ls;
#pragma unroll
            for (int o = 1; o < 64; o <<= 1) { const unsigned t = (unsigned)__builtin_amdgcn_ds_bpermute((lane - o) << 2, (int)incl); if (lane >= o) incl += t; }
            const unsigned long long bal = __ballot(incl >= need);
            const int first = __ffsll((long long)bal) - 1;
            if (lane == first) { unsigned run = incl - ls; int bin = 255 - 4 * lane; unsigned above = run;
#pragma unroll
                for (int j = 0; j < 4; ++j) { if (run + loc[j] >= need) { bin = 255 - 4 * lane - j; above = run; break; } run += loc[j]; }
                sh[0] = (unsigned)bin; sh[1] = above; }
        }
        __syncthreads();
        prefix |= ((unsigned long long)sh[0]) << shift; mask |= 255ull << shift; need -= sh[1];
        __syncthreads();
    }
    int* SROW = (int*)(p.ws + OFF_SROW); float* SGATE = (float*)(p.ws + OFF_SGATE); int* INV = (int*)(p.ws + OFF_INV);
    const int sb = lat ? b * CAPL : 4 * CAPL + b * CAPC;
#pragma unroll
    for (int i = 0; i < 16; ++i) { const int idx = tid + 512 * i;
        if (idx < n && key[i] >= prefix) { const unsigned pos = __hip_atomic_fetch_add(&sh[2], 1u, __ATOMIC_RELAXED, __HIP_MEMORY_SCOPE_WORKGROUP); const int slot = sb + (int)pos; const int row = b * TT + (lat ? NCTX + idx : idx);
            SROW[e * ESLOT + slot] = row; SGATE[e * ESLOT + slot] = __uint_as_float((unsigned)(key[i] >> 13)); INV[(size_t)row * 16 + e] = slot; } }
    if (lat && b == 0 && tid < 128) { SROW[e * ESLOT + 4 * CAPL + 4 * CAPC + tid] = -1; SGATE[e * ESLOT + 4 * CAPL + 4 * CAPC + tid] = 0.f; }
    __syncthreads();
}
__device__ void ph_topk(const Params& p, LAS unsigned char* lds, int wg, int nwg) { for (int u = wg; u < 128; u += nwg) topk_unit(p, lds, u); }

__device__ void ph_gather(const Params& p, int wg, int nwg) {
    const int tid = otid(), wave = tid >> 6, lane = tid & 63;
    const int* SROW = (const int*)(p.ws + OFF_SROW); const bf16_t* H = (const bf16_t*)(p.ws + OFF_H); unsigned char* XG = p.ws + OFF_XG;
    const int step = nwg * 8; int i = wg * 8 + wave;
    u32x4 a = {0u, 0u, 0u, 0u}, c = {0u, 0u, 0u, 0u};
    auto ld = [&](int ii) { const int row = SROW[ii]; a = (u32x4){0u, 0u, 0u, 0u}; c = a; if (row >= 0) { const u32x4* src = (const u32x4*)(H + (size_t)row * 1024); a = src[2 * lane]; c = src[2 * lane + 1]; } };
    if (i < EROWS) ld(i);
    while (i < EROWS) {
        const u32x4 ca = a, cc = c;
        if (i + step < EROWS) ld(i + step);
        u32x4 w;
#pragma unroll
        for (int j = 0; j < 2; ++j) { w[j] = pk4_fp8(bflo(ca[2 * j]), bfhi(ca[2 * j]), bflo(ca[2 * j + 1]), bfhi(ca[2 * j + 1])); w[2 + j] = pk4_fp8(bflo(cc[2 * j]), bfhi(cc[2 * j]), bflo(cc[2 * j + 1]), bfhi(cc[2 * j + 1])); }
        *(u32x4*)(XG + (size_t)i * 1024 + lane * 16) = w;
        i += step;
    }
}

__device__ void ph_combine(const Params& p, int l, int wg, int nwg, float scale) {
    const int tid = otid(), wave = tid >> 6, lane = tid & 63;
    const int* INV = (const int*)(p.ws + OFF_INV); const float* SGATE = (const float*)(p.ws + OFF_SGATE); const bf16_t* OUT = (const bf16_t*)(p.ws + OFF_OUT);
    float* X = (float*)(p.ws + OFF_X); const float* MOD = (const float*)(p.ws + OFF_MOD) + (size_t)l * 5 * 6144; bf16_t* H = (bf16_t*)(p.ws + OFF_H);
    const bool nxt = (l + 1 < NL) && (scale != 0.f), last = (l + 1 == NL) && (scale != 0.f); const float* g1n = p.norm1_g + (nxt ? (l + 1) : l) * 1024; const float* MODN = MOD + (nxt ? 5 * 6144 : 0);
    for (int r = wg * 8 + wave; r < RR; r += nwg * 8) {
        const u32x4* iv = (const u32x4*)(INV + (size_t)r * 16); const u32x4 sl0 = iv[0], sl1 = iv[1], sl2 = iv[2], sl3 = iv[3];
        const int mi = row_mod(r); const float* g2 = MOD + mi * 6144 + 5 * 1024; float* xr = X + (size_t)r * 1024; const float* md = MODN + mi * 6144;
        f32x4 xv[4], gv[4], ggv[4], shv[4], scv[4];
#pragma unroll
        for (int j = 0; j < 4; ++j) { const int col = (j >> 1) * 512 + lane * 8 + 4 * (j & 1); xv[j] = *(const f32x4*)(xr + col); gv[j] = *(const f32x4*)(g2 + col);
            if (nxt) { ggv[j] = *(const f32x4*)(g1n + col); shv[j] = *(const f32x4*)(md + col); scv[j] = *(const f32x4*)(md + 1024 + col); } }
        float acc[16];
#pragma unroll
        for (int i = 0; i < 16; ++i) acc[i] = 0.f;
#pragma unroll
        for (int e = 0; e < 16; ++e) { const int slot = (int)(e < 4 ? sl0[e & 3] : (e < 8 ? sl1[e & 3] : (e < 12 ? sl2[e & 3] : sl3[e & 3])));
            if (slot >= 0) { const float gt = SGATE[e * ESLOT + slot]; const u32x4* src = (const u32x4*)(OUT + ((size_t)(e * ESLOT + slot)) * 1024);
                const u32x4 a = src[lane], c = src[64 + lane];
#pragma unroll
                for (int i = 0; i < 4; ++i) { acc[2 * i] += gt * bflo(a[i]); acc[2 * i + 1] += gt * bfhi(a[i]); acc[8 + 2 * i] += gt * bflo(c[i]); acc[9 + 2 * i] += gt * bfhi(c[i]); } } }
        float* orow = p.out + ((size_t)(mi & 3) * SEQ + (size_t)(r - (r / TT) * TT - NCTX)) * 1024;
        float ss = 0.f;
#pragma unroll
        for (int j = 0; j < 4; ++j)
#pragma unroll
            for (int i = 0; i < 4; ++i) { xv[j][i] += gv[j][i] * acc[(j >> 1) * 8 + (j & 1) * 4 + i] * scale; ss += xv[j][i] * xv[j][i]; }
        float y[16]; float inv = 0.f, am = 0.f;
        if (nxt) { ss = wave_sum(ss); const float rinv = rsqrtf(ss * (1.f / 1024.f) + 1e-6f);
#pragma unroll
            for (int j = 0; j < 4; ++j)
#pragma unroll
                for (int i = 0; i < 4; ++i) { const float t = xv[j][i] * rinv * ggv[j][i] * (1.f + scv[j][i]) + shv[j][i]; y[j * 4 + i] = t; am = fmaxf(am, fabsf(t)); }
            am = fmaxf(wave_max(am), 1e-20f); inv = 127.f / am; }
#pragma unroll
        for (int j = 0; j < 4; ++j) { const int col = (j >> 1) * 512 + lane * 8 + 4 * (j & 1);
            if (last) { if (mi < 4) *(f32x4*)(orow + col) = xv[j]; } else *(f32x4*)(xr + col) = xv[j]; }
        if (nxt) { if (lane == 0) ((float*)(p.ws + OFF_SH))[r] = am * (1.f / 127.f);
#pragma unroll
            for (int hh = 0; hh < 2; ++hh) { u32x2 w = {pk4_i8(y[hh * 8] * inv, y[hh * 8 + 1] * inv, y[hh * 8 + 2] * inv, y[hh * 8 + 3] * inv), pk4_i8(y[hh * 8 + 4] * inv, y[hh * 8 + 5] * inv, y[hh * 8 + 6] * inv, y[hh * 8 + 7] * inv)};
                *(u32x2*)((unsigned char*)H + (size_t)r * 1024 + hh * 512 + lane * 8) = w; } }
    }
}
__device__ void ph_output(const Params& p, int wg, int nwg) {
    const float4* X4 = (const float4*)(p.ws + OFF_X); float4* O4 = (float4*)p.out;
    const size_t n4 = (size_t)NB * SEQ * 256;
    for (size_t i = (size_t)wg * 512 + otid(); i < n4; i += (size_t)nwg * 512) { const size_t row = i >> 8; const size_t b = row / SEQ, t = row - b * SEQ; O4[i] = X4[(b * TT + NCTX + t) * 256 + (i & 255)]; }
}
constexpr int LDS_BYTES = 131072 + 256;
enum { PH_PROLOGUE = 0, PH_A, PH_B, PH_C, PH_D, PH_E, PH_F, PH_G, PH_H, PH_I, PH_J, PH_K, PH_L, PH_M, PH_OUT };

#ifndef PROBE_NOST
#define PROBE_NOST 0
#endif
template <int PH> DI void run_phase(const Params& pin, int l, LAS unsigned char* lds, int wg_in, int nwg, int dup = 0) {
    int wg = wg_in; asm volatile("" : "+s"(wg));
    Params p = pin; { unsigned long long w = (unsigned long long)pin.ws; asm volatile("" : "+s"(w)); p.ws = (unsigned char*)(__attribute__((address_space(1))) unsigned char*)w; }
    if constexpr (PH == PH_PROLOGUE) { ph_prologue(p, lds, wg, nwg); conv_mixer_b(p, 0, lds, wg, nwg); conv_mixer_a(p, 0, lds); }
    if constexpr (PH == PH_A) { norm1_rows(p, l, wg, nwg); }
    if constexpr (PH == PH_B) { int kq = 512; asm volatile("" : "+s"(kq));
        pg8::Gemm g{(const bf16_t*)(p.ws + OFF_H), (const bf16_t*)(p.ws + OFF_WIN), RR, NIN, kq}; SchedPlain S; S.init(RR / 256, NIN / 256, nwg, wg); EpiInProj E{p.ws, (PROBE_NOST && dup) ? 1 : 0};
        pg8::gemm_phase<EpiInProj, SchedPlain, false, 2>(lds, g, S, E, nullptr); }
    if constexpr (PH == PH_C) ph_prep(p, l, lds, wg, nwg, dup);
    if constexpr (PH == PH_D) ph_mix(p, l, lds, (LAS unsigned*)(lds + 131072 + 64), dup);
    if constexpr (PH == PH_E) ph_post(p, l, wg, nwg);
    if constexpr (PH == PH_F) { pg8::Gemm g{(const bf16_t*)(p.ws + OFF_YA), (const bf16_t*)(p.ws + OFF_WBR), RR, 1024, 512}; SchedMerge S; S.init(nwg, wg); EpiMerge E{p.ws, (PROBE_NOST == 3 && dup) ? 1 : 0};
        pg8::gemm_phase<EpiMerge, SchedMerge>(lds, g, S, E, nullptr); ctx_merge_units(p, wg, nwg); }
    if constexpr (PH == PH_G) { pg8::Gemm g{(const bf16_t*)(p.ws + OFF_M), (const bf16_t*)(p.ws + OFF_WOUT), RR, 1024, 1024}; SchedLat S; S.init(nwg, wg); EpiOut E{p.ws, l, dup ? 0.f : 1.f};
        pg8::gemm_phase<EpiOut, SchedLat>(lds, g, S, E, nullptr); ctx_out_units(p, l, wg, nwg, dup ? 0.f : 1.f); }
    if constexpr (PH == PH_H) { if (!dup) { conv_expert_weights(p, l, lds); if (l + 1 < NL) { conv_mixer_b(p, l + 1, lds, wg, nwg); conv_mixer_a(p, l + 1, lds); } } ph_norm2(p, l, lds, wg, nwg); }
    if constexpr (PH == PH_I) ph_topk(p, lds, wg, nwg);
    if constexpr (PH == PH_J) ph_gather(p, wg, nwg);
    if constexpr (PH == PH_K) { int kq = 512; asm volatile("" : "+s"(kq));
        pg8::Gemm g{(const bf16_t*)(p.ws + OFF_XG), (const bf16_t*)(p.ws + OFF_W13), EROWS, 2048, kq}; SchedMoe<8> S; S.init(nwg, wg); EpiUp E{p.ws};
        pg8::gemm_phase<EpiUp, SchedMoe<8>, false, 1>(lds, g, S, E, nullptr); }
    if constexpr (PH == PH_L) { int kq = 512; asm volatile("" : "+s"(kq));
        pg8::Gemm g{(const bf16_t*)(p.ws + OFF_HID), (const bf16_t*)(p.ws + OFF_W2), EROWS, 1024, kq}; SchedMoe<4> S; S.init(nwg, wg); EpiDown E{p.ws};
        pg8::gemm_phase<EpiDown, SchedMoe<4>, false, 1>(lds, g, S, E, nullptr); }
    if constexpr (PH == PH_M) ph_combine(p, l, wg, nwg, dup ? 0.f : 1.f);
    if constexpr (PH == PH_OUT) { conv_expert_weights(p, l, lds, 32); if (l + 1 < NL) conv_mixer_b(p, l + 1, lds, wg, nwg); }
}

DI void grid_barrier(const Params& p, LAS unsigned* xbw) {
    unsigned long long w = (unsigned long long)p.ws; asm volatile("" : "+s"(w));
    XcdBarrier b; b.bar = (unsigned*)(__attribute__((address_space(1))) unsigned*)(w + OFF_BAR); b.x = xb_xcc_id(); b.st = (volatile LAS unsigned*)xbw; xcd_barrier(b);
}
#ifndef PROBE_MASK
#define PROBE_MASK 0u
#endif
#ifndef MEGA
#define MEGA 1
#endif
#if !MEGA
template <int PH> __global__ __launch_bounds__(512, 2) void k_phase(Params p, int l) {
    extern __shared__ __attribute__((aligned(16))) unsigned char shm[];
    run_phase<PH>(p, l, (LAS unsigned char*)shm, blockIdx.x, gridDim.x);
}
template <int PH> static void launch_phase(const Params& p, int l, int grid, hipStream_t st) {
    static bool attr = false;
    if (!attr) { (void)hipFuncSetAttribute((const void*)k_phase<PH>, hipFuncAttributeMaxDynamicSharedMemorySize, LDS_BYTES); attr = true; }
    hipLaunchKernelGGL(k_phase<PH>, dim3(grid), dim3(512), LDS_BYTES, st, p, l);
}
#else
__global__ __launch_bounds__(512, 2) void k_mega(Params p) {
    extern __shared__ __attribute__((aligned(16))) unsigned char shm[];
    LAS unsigned char* lds = (LAS unsigned char*)shm;
    LAS unsigned* xbw = (LAS unsigned*)(lds + 131072);
    if (threadIdx.x < 4) xbw[threadIdx.x] = 0u;
    __syncthreads();
    (void)xcd_barrier_post((unsigned*)(p.ws + OFF_BAR), (volatile LAS unsigned*)xbw);
    const int wg = blockIdx.x, nwg = gridDim.x;
    run_phase<PH_PROLOGUE>(p, 0, lds, wg, nwg); grid_barrier(p, xbw);
    if (PROBE_MASK & (1u << PH_PROLOGUE)) { run_phase<PH_PROLOGUE>(p, 0, lds, wg, nwg); grid_barrier(p, xbw); }
#pragma unroll 1
    for (int l = 0; l < NL; ++l) {
        if (l == 0) { run_phase<PH_A>(p, l, lds, wg, nwg); grid_barrier(p, xbw); }
        if (l == 0 && (PROBE_MASK & (1u << PH_A))) { run_phase<PH_A>(p, l, lds, wg, nwg); grid_barrier(p, xbw); }
        run_phase<PH_B>(p, l, lds, wg, nwg); grid_barrier(p, xbw);
        if (PROBE_MASK & (1u << PH_B)) { run_phase<PH_B>(p, l, lds, wg, nwg, 1); grid_barrier(p, xbw); }
        run_phase<PH_C>(p, l, lds, wg, nwg); grid_barrier(p, xbw);
        if (PROBE_MASK & (1u << PH_C)) { run_phase<PH_C>(p, l, lds, wg, nwg, 1); grid_barrier(p, xbw); }
        run_phase<PH_D>(p, l, lds, wg, nwg); grid_barrier(p, xbw);
        if (PROBE_MASK & (1u << PH_D)) { run_phase<PH_D>(p, l, lds, wg, nwg, 1); grid_barrier(p, xbw); }
        run_phase<PH_E>(p, l, lds, wg, nwg); grid_barrier(p, xbw);
        if (PROBE_MASK & (1u << PH_E)) { run_phase<PH_E>(p, l, lds, wg, nwg, 1); grid_barrier(p, xbw); }
        run_phase<PH_F>(p, l, lds, wg, nwg); grid_barrier(p, xbw);
        if (PROBE_MASK & (1u << PH_F)) { run_phase<PH_F>(p, l, lds, wg, nwg, 1); grid_barrier(p, xbw); }
        run_phase<PH_G>(p, l, lds, wg, nwg); grid_barrier(p, xbw);
        if (PROBE_MASK & (1u << PH_G)) { run_phase<PH_G>(p, l, lds, wg, nwg, 1); grid_barrier(p, xbw); }
        run_phase<PH_H>(p, l, lds, wg, nwg); grid_barrier(p, xbw);
        if (PROBE_MASK & (1u << PH_H)) { run_phase<PH_H>(p, l, lds, wg, nwg, 1); grid_barrier(p, xbw); }
        if (PROBE_MASK & (1u << PH_OUT)) { run_phase<PH_OUT>(p, l, lds, wg, nwg, 1); grid_barrier(p, xbw); }
        run_phase<PH_I>(p, l, lds, wg, nwg); grid_barrier(p, xbw);
        if (PROBE_MASK & (1u << PH_I)) { run_phase<PH_I>(p, l, lds, wg, nwg, 1); grid_barrier(p, xbw); }
        run_phase<PH_J>(p, l, lds, wg, nwg); grid_barrier(p, xbw);
        if (PROBE_MASK & (1u << PH_J)) { run_phase<PH_J>(p, l, lds, wg, nwg, 1); grid_barrier(p, xbw); }
        run_phase<PH_K>(p, l, lds, wg, nwg); grid_barrier(p, xbw);
        if (PROBE_MASK & (1u << PH_K)) { run_phase<PH_K>(p, l, lds, wg, nwg, 1); grid_barrier(p, xbw); }
        run_phase<PH_L>(p, l, lds, wg, nwg); grid_barrier(p, xbw);
        if (PROBE_MASK & (1u << PH_L)) { run_phase<PH_L>(p, l, lds, wg, nwg, 1); grid_barrier(p, xbw); }
        run_phase<PH_M>(p, l, lds, wg, nwg); grid_barrier(p, xbw);
        if (PROBE_MASK & (1u << PH_M)) { run_phase<PH_M>(p, l, lds, wg, nwg, 1); grid_barrier(p, xbw); }
    }
}
#endif

extern "C" void kernel_launch(void* const* d_in, const int* in_sizes, int n_in, void* d_out, int out_size, void* d_ws, size_t ws_size, hipStream_t stream) {
    if (n_in < 31 || ws_size < WS_NEEDED) return;
    Params p{};
    const float** f = (const float**)&p;
    for (int i = 0; i < 31; ++i) f[i] = (const float*)d_in[i];
    p.out = (float*)d_out; p.ws = (unsigned char*)d_ws;
    (void)hipMemsetAsync(d_ws, 0, 65536, stream);
#if !MEGA
    const int G = 256;
    launch_phase<PH_PROLOGUE>(p, 0, G, stream);
    for (int l = 0; l < NL; ++l) {
        launch_phase<PH_A>(p, l, G, stream); launch_phase<PH_B>(p, l, G, stream); launch_phase<PH_C>(p, l, G, stream); launch_phase<PH_D>(p, l, G, stream);
        launch_phase<PH_E>(p, l, G, stream); launch_phase<PH_F>(p, l, G, stream); launch_phase<PH_G>(p, l, G, stream); launch_phase<PH_H>(p, l, G, stream);
        launch_phase<PH_I>(p, l, G, stream); launch_phase<PH_J>(p, l, G, stream); launch_phase<PH_K>(p, l, G, stream); launch_phase<PH_L>(p, l, G, stream);
        launch_phase<PH_M>(p, l, G, stream);
    }
    launch_phase<PH_OUT>(p, 0, G, stream);
#else
    static int grid = 0;
    if (!grid) {
        (void)hipFuncSetAttribute((const void*)k_mega, hipFuncAttributeMaxDynamicSharedMemorySize, LDS_BYTES);
        int dev = 0, cus = 0, per_cu = 0; (void)hipGetDevice(&dev); (void)hipDeviceGetAttribute(&cus, hipDeviceAttributeMultiprocessorCount, dev);
        (void)hipOccupancyMaxActiveBlocksPerMultiprocessor(&per_cu, (const void*)k_mega, 512, LDS_BYTES);
        grid = cus * (per_cu < 1 ? per_cu : 1);
    }
    if (grid <= 0) return;
    hipLaunchKernelGGL(k_mega, dim3(grid), dim3(512), LDS_BYTES, stream, p);
#endif
}
```

```cpp
#include <hip/hip_runtime.h>
#include <stdint.h>

#define LAS __attribute__((address_space(3)))
typedef unsigned short bf16_t;
typedef short bf16x8 __attribute__((ext_vector_type(8)));
typedef float f32x4 __attribute__((ext_vector_type(4)));
typedef float f32x16 __attribute__((ext_vector_type(16)));
typedef float f32x2v __attribute__((ext_vector_type(2)));
typedef __bf16 bf16x2v __attribute__((ext_vector_type(2)));
typedef unsigned u32x4 __attribute__((ext_vector_type(4)));
typedef unsigned u32x2 __attribute__((ext_vector_type(2)));

#define DI __device__ __forceinline__
DI int otid() { int t = threadIdx.x; asm volatile("" : "+v"(t)); return t; }
DI float bf2f(bf16_t v) { return __uint_as_float(((unsigned)v) << 16); }
DI float bflo(unsigned w) { return __uint_as_float(w << 16); }
DI float bfhi(unsigned w) { return __uint_as_float(w & 0xffff0000u); }
DI unsigned pk2(float a, float b) { f32x2v v = {a, b}; return __builtin_bit_cast(unsigned, __builtin_convertvector(v, bf16x2v)); }
DI unsigned pk4_fp8(float a, float b, float c, float d) { unsigned w = 0; w = __builtin_amdgcn_cvt_pk_fp8_f32(a, b, w, false); w = __builtin_amdgcn_cvt_pk_fp8_f32(c, d, w, true); return w; }
DI unsigned pk4_i8(float a, float b, float c, float d) { const int ia = (int)rintf(a), ib = (int)rintf(b), ic = (int)rintf(c), id = (int)rintf(d); return (unsigned)(ia & 255) | ((unsigned)(ib & 255) << 8) | ((unsigned)(ic & 255) << 16) | ((unsigned)id << 24); }
DI unsigned pk4_u8(float a, float b, float c, float d) { unsigned w = 0; w = __builtin_amdgcn_cvt_pk_u8_f32(a, 0, w); w = __builtin_amdgcn_cvt_pk_u8_f32(b, 1, w); w = __builtin_amdgcn_cvt_pk_u8_f32(c, 2, w); w = __builtin_amdgcn_cvt_pk_u8_f32(d, 3, w); return w; }
DI bf16_t f2bf(float a) { return (bf16_t)(pk2(a, 0.f) & 0xffffu); }
DI float sigmoidf_(float x) { return __builtin_amdgcn_rcpf(1.f + __expf(-x)); }
template <int CTRL> DI float dppmov(float x) { return __builtin_bit_cast(float, __builtin_amdgcn_update_dpp(0, __builtin_bit_cast(int, x), CTRL, 0xf, 0xf, true)); }
DI float allsum16(float x) { x += dppmov<0xB1>(x); x += dppmov<0x4E>(x); x += dppmov<0x141>(x); x += dppmov<0x140>(x); return x; }
DI float allsum8(float x) { x += dppmov<0xB1>(x); x += dppmov<0x4E>(x); x += dppmov<0x141>(x); return x; }
DI float allmax16(float x) { x = fmaxf(x, dppmov<0xB1>(x)); x = fmaxf(x, dppmov<0x4E>(x)); x = fmaxf(x, dppmov<0x141>(x)); x = fmaxf(x, dppmov<0x140>(x)); return x; }
DI float sum_x16(float x) { auto r = __builtin_amdgcn_permlane16_swap(__float_as_uint(x), __float_as_uint(x), false, false); return __uint_as_float(r[0]) + __uint_as_float(r[1]); }
DI float sum_x32(float x) { auto r = __builtin_amdgcn_permlane32_swap(__float_as_uint(x), __float_as_uint(x), false, false); return __uint_as_float(r[0]) + __uint_as_float(r[1]); }
DI float wave_sum(float v) { return sum_x32(sum_x16(allsum16(v))); }
DI float wave_max(float v) { v = allmax16(v); { auto r = __builtin_amdgcn_permlane16_swap(__float_as_uint(v), __float_as_uint(v), false, false); v = fmaxf(__uint_as_float(r[0]), __uint_as_float(r[1])); }
    { auto r = __builtin_amdgcn_permlane32_swap(__float_as_uint(v), __float_as_uint(v), false, false); v = fmaxf(__uint_as_float(r[0]), __uint_as_float(r[1])); } return v; }
DI float bperm(float v, int byte_addr) { return __builtin_bit_cast(float, __builtin_amdgcn_ds_bpermute(byte_addr, __builtin_bit_cast(int, v))); }

constexpr int NB = 4, SEQ = 8192, NCTX = 256, TT = SEQ + NCTX, RR = NB * TT, DM = 1024, NIN = 7936, NL = 4;
constexpr int NE = 16, CAPL = 1024, CAPC = 32, ESLOT = 4352, EROWS = NE * ESLOT;
static_assert(RR == 33792 && RR % 256 == 0 && EROWS % 256 == 0, "shape");

constexpr size_t MB1 = 1u << 20;
constexpr size_t alignup(size_t x) { return (x + MB1 - 1) / MB1 * MB1; }
constexpr size_t SZ_T = (size_t)RR * 512 * 2;
constexpr size_t OFF_BAR = 0;
constexpr size_t OFF_CTR = 32768;
constexpr size_t OFF_MOD = 65536;
constexpr size_t OFF_ROPE = OFF_MOD + (size_t)NL * 5 * 6144 * 4;
constexpr size_t OFF_AFFL = MB1;
constexpr size_t OFF_AFFC = OFF_AFFL + (size_t)4 * 16 * 8192 * 4;
constexpr size_t OFF_SROW = OFF_AFFC + (size_t)4 * 16 * 256 * 4;
constexpr size_t OFF_SGATE = OFF_SROW + (size_t)EROWS * 4;
constexpr size_t OFF_INV = OFF_SGATE + (size_t)EROWS * 4;
constexpr size_t OFF_LRW = OFF_INV + (size_t)RR * 16 * 4;
constexpr size_t OFF_SW = OFF_LRW + (size_t)(4 * 512 * 64 + 512 * 128) * 2;
constexpr size_t OFF_SH = OFF_SW + (size_t)NIN * 4;
constexpr size_t OFF_X = alignup(OFF_SH + (size_t)RR * 4);
constexpr size_t OFF_H = alignup(OFF_X + (size_t)RR * 1024 * 4);
constexpr size_t OFF_VT = OFF_H;
constexpr size_t OFF_YB0 = OFF_H + SZ_T;
constexpr size_t OFF_M = OFF_H;
constexpr size_t OFF_WIN = alignup(OFF_H + 2 * SZ_T);
constexpr size_t OFF_WBR = alignup(OFF_WIN + (size_t)NIN * 1024 * 2);
constexpr size_t OFF_WOUT = alignup(OFF_WBR + (size_t)3 * 1024 * 512 * 2);
constexpr size_t OFF_PA = alignup(OFF_WOUT + (size_t)1024 * 1024 * 2);
constexpr size_t OFF_PR = alignup(OFF_PA + (size_t)RR * 1536 * 2);
constexpr size_t OFF_PC = alignup(OFF_PR + (size_t)RR * 1792 * 2);
constexpr size_t OFF_PG = alignup(OFF_PC + (size_t)RR * 1536 * 2);
constexpr size_t OFF_PEND = alignup(OFF_PG + (size_t)RR * 3072 * 2);
constexpr size_t OFF_OS = OFF_PR;
constexpr size_t OFF_OA = OFF_OS + 2 * SZ_T;
constexpr size_t OFF_YA = alignup(OFF_OA + 2 * SZ_T);
constexpr size_t OFF_YB = alignup(OFF_YA + SZ_T);
static_assert(OFF_YB + SZ_T <= OFF_PG, "overlay");
constexpr size_t OFF_XG = OFF_PR;
constexpr size_t OFF_HID = alignup(OFF_XG + (size_t)EROWS * 1024);
constexpr size_t OFF_OUT = alignup(OFF_HID + (size_t)EROWS * 1024);
static_assert(OFF_OUT + (size_t)EROWS * 1024 * 2 <= OFF_PEND, "overlay");
constexpr size_t OFF_EW = OFF_PEND;
constexpr size_t OFF_AA = OFF_EW + 2 * SZ_T;
constexpr size_t OFF_KK = OFF_AA + 2 * SZ_T;
constexpr size_t OFF_KC = OFF_KK + SZ_T;
constexpr size_t OFF_RC = OFF_KC + SZ_T;
constexpr size_t OFF_VC = OFF_RC + SZ_T;
constexpr size_t OFF_YC = alignup(OFF_VC + SZ_T);
constexpr size_t OFF_G = alignup(OFF_YC + SZ_T);
constexpr size_t OFF_W13 = alignup(OFF_G + SZ_T);
constexpr size_t OFF_W2 = OFF_W13 + (size_t)16 * 2048 * 1024;
constexpr size_t WS_NEEDED = alignup(OFF_W2 + (size_t)16 * 1024 * 1024);
constexpr int YTILE = 262144;
static_assert((OFF_YB - OFF_YA) % YTILE == 0 && (OFF_YC - OFF_YA) % YTILE == 0 && OFF_YC > OFF_YA, "merge A tiles");

struct Params {
    const float *x, *c, *ctx, *c_ctx, *norm1_g, *norm2_g, *ada_w, *ada_b, *w_in, *q_norm_g, *k_norm_g, *diff_lambda, *diff_subln_g,
        *rwkv_conv_w, *rwkv_w0, *rwkv_w_up, *rwkv_a0, *rwkv_a_up, *rwkv_g_up, *rwkv_k_k, *rwkv_k_a, *rwkv_r_k, *rwkv_ln_g, *rwkv_ln_b,
        *conv_w, *w_branch, *w_out, *router_w, *exp_w1, *exp_w3, *exp_w2;
    float* out;
    unsigned char* ws;
};
#define XB_TMO      128
#define XB_XCNT(j)  (256  + 64 * (j))
#define XB_XSUB(j)  (1280 + 64 * (j))
#define XB_XGEN(j)  (2304 + 64 * (j))
#define XB_TOP      3328
#define XB_TOPGEN   3392
#define XCD_BAR_WORDS 3456
#define XB_SPIN_CAP (1u << 18)

__device__ __forceinline__ unsigned xb_ld(unsigned* p)              { return __hip_atomic_load(p, __ATOMIC_RELAXED, __HIP_MEMORY_SCOPE_AGENT); }
__device__ __forceinline__ unsigned xb_add(unsigned* p, unsigned v) { return __hip_atomic_fetch_add(p, v, __ATOMIC_RELAXED, __HIP_MEMORY_SCOPE_AGENT); }
__device__ __forceinline__ unsigned xb_xcc_id() { return (unsigned)__builtin_amdgcn_s_getreg((3 << 11) | 20) & 0xFu; }
#define XB_SPIN(cond, bar) do { unsigned _sp = 0; while (cond) { __builtin_amdgcn_s_sleep(1); \
    if ((++_sp & 255u) == 0u) { if (xb_ld(&(bar)[XB_TMO])) break; if (_sp > XB_SPIN_CAP) { atomicAdd(&(bar)[XB_TMO], 1u); break; } } } } while (0)

struct XcdBarrier {
    unsigned* bar; unsigned x;
    volatile LAS unsigned* st;
};

__device__ __forceinline__ XcdBarrier xcd_barrier_post(unsigned* bar, volatile LAS unsigned* st) {
    XcdBarrier b; b.bar = bar; b.x = xb_xcc_id(); b.st = st;
    if (threadIdx.x == 0) (void)xb_add(&bar[XB_XCNT(b.x)], 1u);
    return b;
}
__device__ __forceinline__ void xcd_barrier_complete(unsigned* bar, unsigned x, unsigned& nloc, unsigned& nx) {
    const unsigned G = gridDim.x * gridDim.y * gridDim.z;
    unsigned sum, cnt, mine, sp = 0u;
    for (;;) {
        sum = 0u; cnt = 0u; mine = 0u;
#pragma unroll
        for (unsigned j = 0; j < 16; ++j) { const unsigned c = xb_ld(&bar[XB_XCNT(j)]); sum += c; cnt += (c > 0u) ? 1u : 0u; mine = (j == x) ? c : mine; }
        if (sum == G) break;
        __builtin_amdgcn_s_sleep(1);
        if ((++sp & 255u) == 0u) { if (xb_ld(&bar[XB_TMO])) break; if (sp > XB_SPIN_CAP) { atomicAdd(&bar[XB_TMO], 1u); break; } }
    }
    nloc = mine > 0u ? mine : 1u; nx = cnt > 0u ? cnt : 1u;
}

__device__ __forceinline__ void xcd_barrier(const XcdBarrier& b) {
    asm volatile("s_waitcnt vmcnt(0)" ::: "memory");
    __syncthreads();
    if (threadIdx.x == 0) {
        unsigned* bar = b.bar;
        __builtin_amdgcn_s_waitcnt(0);
        unsigned nloc = b.st[0], nx = b.st[1];
        if (nloc == 0u) { xcd_barrier_complete(bar, b.x, nloc, nx); b.st[0] = nloc; b.st[1] = nx; }
        const unsigned old = xb_add(&bar[XB_XSUB(b.x)], 1u);
        const unsigned gen = old / nloc;
        if (old + 1u == (gen + 1u) * nloc) {
            __builtin_amdgcn_fence(__ATOMIC_RELEASE, "agent");
            asm volatile("s_waitcnt vmcnt(0)" ::: "memory");
            const unsigned og = xb_add(&bar[XB_TOP], 1u);
            const unsigned tg = og / nx;
            if (og + 1u == (tg + 1u) * nx) xb_add(&bar[XB_TOPGEN], 1u);
            else XB_SPIN(xb_ld(&bar[XB_TOPGEN]) == tg, bar);
            __builtin_amdgcn_fence(__ATOMIC_ACQUIRE, "agent");
            xb_add(&bar[XB_XGEN(b.x)], 1u);
            asm volatile("s_waitcnt vmcnt(0)" ::: "memory");
        } else {
            XB_SPIN(xb_ld(&bar[XB_XGEN(b.x)]) == gen, bar);
            __builtin_amdgcn_fence(__ATOMIC_ACQUIRE, "agent");
            asm volatile("s_waitcnt vmcnt(0)" ::: "memory");
        }
    }
    __syncthreads();
}
namespace pg8 {
#define PG8_LAS __attribute__((address_space(3)))
constexpr int BM = 256, BK = 64, HALF = 128, HTB = HALF * BK * 2  , STAGE_BYTES = 8 * HTB, NXCD = 8, WGM = 8;
__host__ __device__ __forceinline__ int lds_byte(int r, int c) { const int st = (r >> 4) * 2 + (c >> 5), rr = r & 15, cc = c & 31, ob = rr * 64 + cc * 2; return st * 1024 + (ob ^ (((ob >> 9) & 1) << 5)); }
__host__ __device__ __forceinline__ void stage_rc(int b, int& R, int& C) { const int st = b / 1024, sb = b % 1024, swz = sb ^ (((sb >> 9) & 1) << 5); R = (st >> 1) * 16 + swz / 64; C = (st & 1) * 32 + (swz % 64) / 2; }
__host__ __device__ __forceinline__ int perm32(int rho) { const int n = rho >> 4, i = rho & 15; return 8 * (i >> 2) + 4 * n + (i & 3); }
typedef int v4i_t __attribute__((ext_vector_type(4)));
typedef int v8i_t __attribute__((ext_vector_type(8)));
struct Unit { int pm, pn; int rt, ct, br; };
struct Gemm { const bf16_t* A; const bf16_t* Bt; int M, N, K; };
template <class Epi, class Sched, bool STAMP = false, int QM = 0>
__device__ __forceinline__ void gemm_phase(PG8_LAS unsigned char* lds, const Gemm g, const Sched& S, const Epi& E, unsigned long long* stamps) {
    const int tid = otid(), wid = __builtin_amdgcn_readfirstlane(tid >> 6), lane = tid & 63, wr = wid >> 2, wc = wid & 3, fr = lane & 15, fq = lane >> 4;
    const int K = g.K, nt = K / BK;
    int ts_lo = 0, ts_hi = 0, nts = 0; const unsigned long long rt_entry = STAMP ? (unsigned long long)wall_clock64() : 0ull;
#define PG8_STAMP() do { if (STAMP && wid == 0 && nts < 64) { const unsigned long long _c = (unsigned long long)clock64(); \
        ts_lo = (lane == nts) ? (int)(unsigned)_c : ts_lo; ts_hi = (lane == nts) ? (int)(unsigned)(_c >> 32) : ts_hi; ++nts; } } while (0)
    PG8_STAMP();
    unsigned voffA[2], voffB[2];
#pragma unroll
    for (int i = 0; i < 2; ++i) { int R, C; stage_rc(tid * 16 + i * 8192, R, C); const int Rb = Epi::PERM ? ((R & ~31) + perm32(R & 31)) : R;
        voffA[i] = (unsigned)(R * K + C) * 2u; voffB[i] = (unsigned)(Rb * K + C) * 2u; }
    const size_t kstep = (size_t)(BK * 2);
    const size_t hstep = (size_t)HALF * K * 2;
    const size_t tstep = 2 * hstep;
    const unsigned ldsw = (unsigned)wid * 1024u;
    const int aoff = lds_byte(wr * 64 + fr, fq * 8), boff = lds_byte(wc * 32 + fr, fq * 8);
#define PG8_SA(b, h) (((b) * 2 + (h)) * HTB)
#define PG8_SB(b, h) ((4 + (b) * 2 + (h)) * HTB)
#define PG8_STAGE(bufoff, gbase, voff) do { _Pragma("unroll") for (int _i = 0; _i < 2; ++_i) \
        __builtin_amdgcn_global_load_lds((const unsigned*)((const char*)(gbase) + (voff)[_i]), (PG8_LAS unsigned*)(lds + (bufoff) + ldsw + _i * 8192), 16, 0, 0); } while (0)
#define PG8_LDA(dst, b, h) do { _Pragma("unroll") for (int m = 0; m < 4; ++m) dst[m] = __builtin_shufflevector(*(const PG8_LAS v4i_t*)(lds + PG8_SA(b, h) + aoff + m * 2048), *(const PG8_LAS v4i_t*)(lds + PG8_SA(b, h) + aoff + m * 2048 + 1024), 0, 1, 2, 3, 4, 5, 6, 7); } while (0)
#define PG8_LDB(dst, b, h) do { _Pragma("unroll") for (int n = 0; n < 2; ++n) dst[n] = __builtin_shufflevector(*(const PG8_LAS v4i_t*)(lds + PG8_SB(b, h) + boff + n * 2048), *(const PG8_LAS v4i_t*)(lds + PG8_SB(b, h) + boff + n * 2048 + 1024), 0, 1, 2, 3, 4, 5, 6, 7); } while (0)
#define PG8_MMA(ai, bj, At, Bt) do { __builtin_amdgcn_s_setprio(1); \
        if constexpr (QM == 1) { _Pragma("unroll") for (int m = 0; m < 4; ++m) _Pragma("unroll") for (int n = 0; n < 2; ++n) \
            asm volatile("v_mfma_scale_f32_16x16x128_f8f6f4 %0, %1, %2, %0, %3, %3 op_sel_hi:[0,0,0]" : "+v"(acc[ai][bj][m][n]) : "v"(Bt[n]), "v"(At[m]), "v"(one_scale)); } \
        else if constexpr (QM == 2) { _Pragma("unroll") for (int m = 0; m < 4; ++m) _Pragma("unroll") for (int n = 0; n < 2; ++n) { v4i_t c_ = __builtin_bit_cast(v4i_t, acc[ai][bj][m][n]); \
            c_ = __builtin_amdgcn_mfma_i32_16x16x64_i8(__builtin_shufflevector(Bt[n], Bt[n], 0, 1, 2, 3), __builtin_shufflevector(At[m], At[m], 0, 1, 2, 3), c_, 0, 0, 0); \
            c_ = __builtin_amdgcn_mfma_i32_16x16x64_i8(__builtin_shufflevector(Bt[n], Bt[n], 4, 5, 6, 7), __builtin_shufflevector(At[m], At[m], 4, 5, 6, 7), c_, 0, 0, 0); acc[ai][bj][m][n] = __builtin_bit_cast(f32x4, c_); } } \
        else { _Pragma("unroll") for (int m = 0; m < 4; ++m) _Pragma("unroll") for (int n = 0; n < 2; ++n) { \
            acc[ai][bj][m][n] = __builtin_amdgcn_mfma_f32_16x16x32_bf16(__builtin_bit_cast(bf16x8, __builtin_shufflevector(Bt[n], Bt[n], 0, 1, 2, 3)), __builtin_bit_cast(bf16x8, __builtin_shufflevector(At[m], At[m], 0, 1, 2, 3)), acc[ai][bj][m][n], 0, 0, 0); \
            acc[ai][bj][m][n] = __builtin_amdgcn_mfma_f32_16x16x32_bf16(__builtin_bit_cast(bf16x8, __builtin_shufflevector(Bt[n], Bt[n], 4, 5, 6, 7)), __builtin_bit_cast(bf16x8, __builtin_shufflevector(At[m], At[m], 4, 5, 6, 7)), acc[ai][bj][m][n], 0, 0, 0); } } \
        __builtin_amdgcn_s_setprio(0); } while (0)
#define PG8_WAIT_V(n) asm volatile("s_waitcnt vmcnt(" #n ")" ::: "memory")
#define PG8_WAIT_L(n) asm volatile("s_waitcnt lgkmcnt(" #n ")" ::: "memory")
#define PG8_BAR __builtin_amdgcn_s_barrier()
#define PG8_SCHED __builtin_amdgcn_sched_barrier(0)
    Unit cur, nxt; int ui = 0;
    if (!S.next(0, cur)) return;
    f32x4 acc[2][2][4][2];
#pragma unroll
    for (int a = 0; a < 2; ++a)
#pragma unroll
        for (int b = 0; b < 2; ++b)
#pragma unroll
            for (int m = 0; m < 4; ++m)
#pragma unroll
                for (int n = 0; n < 2; ++n) acc[a][b][m][n] = (f32x4){0.f, 0.f, 0.f, 0.f};
    const int one_scale = 0x7f7f7f7f;
    v8i_t At[4], B0[2], B1[2];
    const char* cA = (const char*)g.A + (size_t)cur.pm * tstep; const char* cB = (const char*)g.Bt + (size_t)cur.pn * tstep;
    S.a_ready(cur);
    PG8_STAGE(PG8_SB(0, 0), cB, voffB); PG8_STAGE(PG8_SA(0, 0), cA, voffA); PG8_STAGE(PG8_SB(0, 1), cB + hstep, voffB); PG8_STAGE(PG8_SA(0, 1), cA + hstep, voffA);
    if (wr == 1) PG8_BAR;
    PG8_WAIT_V(4); PG8_BAR;
    PG8_STAGE(PG8_SB(1, 0), cB + kstep, voffB); PG8_STAGE(PG8_SA(1, 0), cA + kstep, voffA); PG8_STAGE(PG8_SB(1, 1), cB + hstep + kstep, voffB);
    PG8_WAIT_V(6); PG8_BAR;
    PG8_STAMP();
    for (;;) {
        const bool has_next = S.next(ui + 1, nxt);
        const char* nA = has_next ? (const char*)g.A + (size_t)nxt.pm * tstep : cA; const char* nB = has_next ? (const char*)g.Bt + (size_t)nxt.pn * tstep : cB;
        for (int t = 0; t < nt; t += 2) {
            const bool last = (t == nt - 2);
            const char* a1 = cA + (size_t)(t + 1) * kstep;
            const char* a2 = last ? nA : cA + (size_t)(t + 2) * kstep; const char* b2 = last ? nB : cB + (size_t)(t + 2) * kstep;
            const char* a3 = a2 + kstep; const char* b3 = b2 + kstep;
            if (last && has_next) S.a_ready(nxt);
            PG8_LDB(B0, 0, 0); PG8_SCHED; PG8_LDA(At, 0, 0); PG8_STAGE(PG8_SA(1, 1), a1 + hstep, voffA);
            PG8_WAIT_L(8); PG8_BAR; PG8_WAIT_L(0); PG8_MMA(0, 0, At, B0); PG8_BAR; PG8_SCHED;
            PG8_LDB(B1, 0, 1); PG8_STAGE(PG8_SB(0, 0), b2, voffB);
            PG8_BAR; PG8_WAIT_L(0); PG8_MMA(0, 1, At, B1); PG8_BAR;
            PG8_LDA(At, 0, 1); PG8_STAGE(PG8_SA(0, 0), a2, voffA);
            PG8_BAR; PG8_WAIT_L(0); PG8_MMA(1, 0, At, B0); PG8_BAR; PG8_SCHED;
            PG8_STAGE(PG8_SB(0, 1), b2 + hstep, voffB);
            PG8_WAIT_V(6); PG8_BAR; PG8_MMA(1, 1, At, B1); PG8_BAR;
            PG8_LDB(B0, 1, 0); PG8_SCHED; PG8_LDA(At, 1, 0); PG8_STAGE(PG8_SA(0, 1), a2 + hstep, voffA);
            PG8_WAIT_L(8); PG8_BAR; PG8_WAIT_L(0); PG8_MMA(0, 0, At, B0); PG8_BAR; PG8_SCHED;
            PG8_LDB(B1, 1, 1); PG8_STAGE(PG8_SB(1, 0), b3, voffB);
            PG8_BAR; PG8_WAIT_L(0); PG8_MMA(0, 1, At, B1); PG8_BAR;
            PG8_LDA(At, 1, 1); PG8_STAGE(PG8_SA(1, 0), a3, voffA);
            PG8_BAR; PG8_WAIT_L(0); PG8_MMA(1, 0, At, B0); PG8_BAR; PG8_SCHED;
            PG8_STAGE(PG8_SB(1, 1), b3 + hstep, voffB);
            PG8_WAIT_V(6); PG8_BAR; PG8_MMA(1, 1, At, B1); PG8_BAR;
        }
        PG8_STAMP();
        if constexpr (QM == 1) { asm volatile("s_nop 15\n\ts_nop 15" ::: "memory"); }
        if constexpr (!Epi::AFTER_DRAIN) { E(acc, cur, wr, wc, fr, fq); S.done(cur); }
        PG8_STAMP();
        if (!has_next) break;
        if (!Epi::keep_acc(cur)) {
#pragma unroll
        for (int a = 0; a < 2; ++a)
#pragma unroll
            for (int b = 0; b < 2; ++b)
#pragma unroll
                for (int m = 0; m < 4; ++m)
#pragma unroll
                    for (int n = 0; n < 2; ++n) acc[a][b][m][n] = (f32x4){0.f, 0.f, 0.f, 0.f};
        }
        cur = nxt; cA = nA; cB = nB; ++ui;
    }
    PG8_WAIT_V(0);
    if (wr == 0) PG8_BAR;
    PG8_BAR;
    if constexpr (Epi::AFTER_DRAIN) { E.fused(acc, cur, wr, wc, fr, fq, lds, wid, lane); S.done(cur); }
    PG8_STAMP();
    if (STAMP && wid == 0) { stamps[lane] = lane < nts ? (((unsigned long long)(unsigned)ts_hi << 32) | (unsigned)ts_lo) : 0ull;
        if (lane == 62) stamps[62] = rt_entry; if (lane == 63) stamps[63] = (unsigned long long)wall_clock64(); }
#undef PG8_STAMP
#undef PG8_SA
#undef PG8_SB
#undef PG8_STAGE
#undef PG8_LDA
#undef PG8_LDB
#undef PG8_MMA
#undef PG8_WAIT_V
#undef PG8_WAIT_L
#undef PG8_BAR
#undef PG8_SCHED
}
}
using pg8::Unit;

struct SchedPlain {
    int nM, nN, nwg, G, c;
    __device__ void init(int nM_, int nN_, int G_, int c_) { nM = nM_; nN = nN_; nwg = nM * nN; G = G_; c = c_; }
    __device__ bool next(int i, Unit& u) const {
        const long L = (long)i * G + c; if (L >= nwg) return false;
        int wgid = (int)L; { const int q = nwg / 8, r = nwg % 8, xcd = wgid % 8, off = wgid / 8; wgid = (xcd < r ? xcd * (q + 1) : r * (q + 1) + (xcd - r) * q) + off; }
        const int nig = 8 * nN, gid = wgid / nig, fm = gid * 8, gsz = (nM - fm) < 8 ? (nM - fm) : 8;
        u.pm = __builtin_amdgcn_readfirstlane(fm + ((wgid % nig) % gsz)); u.pn = __builtin_amdgcn_readfirstlane((wgid % nig) / gsz); u.rt = u.pm; u.ct = u.pn; u.br = 0; return true;
    }
    DI void a_ready(const Unit&) const {}
    DI void done(const Unit&) const {}
};
struct SchedMerge {
    int G, c, pmb1, pmb2;
    __device__ void init(int G_, int c_) { G = G_; c = (G_ % 8 == 0) ? ((c_ % 8) * (G_ / 8) + c_ / 8) : c_;
        pmb1 = (int)((OFF_YB - OFF_YA) / YTILE); pmb2 = (int)((OFF_YC - OFF_YA) / YTILE); }
    __device__ bool next(int i, Unit& u) const {
        const int tile = (i / 3) * G + c, br = i % 3; if (tile >= 512) return false;
        const int lp = tile >> 2; u.rt = __builtin_amdgcn_readfirstlane(lp + (lp >> 5) + 1); u.ct = __builtin_amdgcn_readfirstlane(tile & 3); u.br = __builtin_amdgcn_readfirstlane(br);
        u.pm = u.rt + (u.br == 0 ? 0 : (u.br == 1 ? pmb1 : pmb2)); u.pn = u.br * 4 + u.ct; return true;
    }
    DI void a_ready(const Unit&) const {}
    DI void done(const Unit&) const {}
};
struct SchedLat {
    int G, c;
    __device__ void init(int G_, int c_) { G = G_; c = (G_ % 8 == 0) ? ((c_ % 8) * (G_ / 8) + c_ / 8) : c_; }
    __device__ bool next(int i, Unit& u) const {
        const int tile = i * G + c; if (tile >= 512) return false;
        const int lp = tile >> 2; u.pm = u.rt = __builtin_amdgcn_readfirstlane(lp + (lp >> 5) + 1); u.pn = u.ct = __builtin_amdgcn_readfirstlane(tile & 3); u.br = 0; return true;
    }
    DI void a_ready(const Unit&) const {}
    DI void done(const Unit&) const {}
};
template <int NCT> struct SchedMoe {
    int G, c;
    __device__ void init(int G_, int c_) { G = G_; c = c_; }
    __device__ bool next(int i, Unit& u) const {
        const int L = i * G + c; if (L >= 16 * 17 * NCT) return false;
        const int e = __builtin_amdgcn_readfirstlane(L / (17 * NCT)), rem = L - e * (17 * NCT); u.rt = __builtin_amdgcn_readfirstlane(rem / NCT); u.ct = rem - u.rt * NCT; u.br = e;
        u.pm = e * 17 + u.rt; u.pn = e * NCT + u.ct; return true;
    }
    DI void a_ready(const Unit&) const {}
    DI void done(const Unit&) const {}
};

DI u32x4 pack8(const f32x4& a, const f32x4& b) { u32x4 w = {pk2(a[0], a[1]), pk2(a[2], a[3]), pk2(b[0], b[1]), pk2(b[2], b[3])}; return w; }

typedef int v4i_q __attribute__((ext_vector_type(4)));
struct EpiInProj {
    static constexpr bool PERM = true, AFTER_DRAIN = false;
    static DI bool keep_acc(const Unit&) { return false; }
    unsigned char* ws; int nost;
    DI void operator()(const f32x4 (&acc)[2][2][4][2], const Unit& u, int wr, int wc, int fr, int fq) const {
        const int pn = u.pn; bf16_t* base; int ld, colt; bool sig = false;
        if (pn < 6) { base = (bf16_t*)(ws + OFF_PA); ld = 1536; colt = pn * 256; }
        else if (pn < 13) { base = (bf16_t*)(ws + OFF_PR); ld = 1792; colt = (pn - 6) * 256; }
        else if (pn < 19) { base = (bf16_t*)(ws + OFF_PC); ld = 1536; colt = (pn - 13) * 256; }
        else { base = (bf16_t*)(ws + OFF_PG); ld = 3072; colt = (pn - 19) * 256; sig = true; }
        const int row0 = u.pm * 256 + wr * 64 + fr, col0 = colt + wc * 32 + 8 * fq;
        const float* sW = (const float*)(ws + OFF_SW) + pn * 256 + wc * 32 + 8 * fq; const float* sH = (const float*)(ws + OFF_SH);
        f32x4 cs[2][2]; float rsv[2][4];
#pragma unroll
        for (int bj = 0; bj < 2; ++bj) { cs[bj][0] = *(const f32x4*)(sW + bj * 128); cs[bj][1] = *(const f32x4*)(sW + bj * 128 + 4); }
#pragma unroll
        for (int ai = 0; ai < 2; ++ai)
#pragma unroll
            for (int m = 0; m < 4; ++m) rsv[ai][m] = sH[row0 + ai * 128 + m * 16];
#pragma unroll
        for (int bj = 0; bj < 2; ++bj) { const f32x4 cs0 = cs[bj][0], cs1 = cs[bj][1];
#pragma unroll
            for (int ai = 0; ai < 2; ++ai)
#pragma unroll
                for (int m = 0; m < 4; ++m) { bf16_t* rowp = base + (size_t)(row0 + ai * 128 + m * 16) * ld + col0; const float rs = rsv[ai][m];
                    const v4i_q i0 = __builtin_bit_cast(v4i_q, acc[ai][bj][m][0]), i1 = __builtin_bit_cast(v4i_q, acc[ai][bj][m][1]); f32x4 v0, v1;
#pragma unroll
                    for (int i = 0; i < 4; ++i) { v0[i] = (float)i0[i] * rs * cs0[i]; v1[i] = (float)i1[i] * rs * cs1[i]; }
                    if (sig) {
#pragma unroll
                        for (int i = 0; i < 4; ++i) { v0[i] = fmaxf(rintf(255.f * sigmoidf_(v0[i])), 1.f); v1[i] = fmaxf(rintf(255.f * sigmoidf_(v1[i])), 1.f); }
                        const u32x2 pk = {pk4_u8(v0[0], v0[1], v0[2], v0[3]), pk4_u8(v1[0], v1[1], v1[2], v1[3])};
                        unsigned char* gp = ws + OFF_PG + (size_t)(row0 + ai * 128 + m * 16) * 3072 + col0 + bj * 128;
                        if (nost) asm volatile("" :: "v"(pk)); else *(u32x2*)gp = pk; }
                    else { const u32x4 pk = pack8(v0, v1); if (nost) asm volatile("" :: "v"(pk)); else *(u32x4*)(rowp + bj * 128) = pk; } } }
    }
};
struct EpiMerge {
    static constexpr bool PERM = true, AFTER_DRAIN = false;
    static DI bool keep_acc(const Unit& u) { return u.br < 2; }
    unsigned char* ws; int nog;
    DI void operator()(f32x4 (&acc)[2][2][4][2], const Unit& u, int wr, int wc, int fr, int fq) const {
        const unsigned char* PG = ws + OFF_PG; bf16_t* M = (bf16_t*)(ws + OFF_M);
        const int row0 = u.rt * 256 + wr * 64 + fr, col0 = u.ct * 256 + wc * 32 + 8 * fq, br = u.br;
#pragma unroll
        for (int ai = 0; ai < 2; ++ai) {
            u32x2 gq[4][2], gnx[4][2];
#pragma unroll
            for (int m = 0; m < 4; ++m)
#pragma unroll
                for (int bj = 0; bj < 2; ++bj) { const size_t r = (size_t)(row0 + ai * 128 + m * 16); const int c = col0 + bj * 128;
                    gq[m][bj] = (u32x2){0x80808080u, 0x80808080u}; gnx[m][bj] = gq[m][bj];
                    if (!nog) { gq[m][bj] = *(const u32x2*)(PG + r * 3072 + br * 1024 + c); if (br < 2) gnx[m][bj] = *(const u32x2*)(PG + r * 3072 + (br + 1) * 1024 + c); } }
#pragma unroll
            for (int m = 0; m < 4; ++m)
#pragma unroll
                for (int bj = 0; bj < 2; ++bj) { const size_t r = (size_t)(row0 + ai * 128 + m * 16); const int c = col0 + bj * 128;
                    const u32x2 g = gq[m][bj], gn = gnx[m][bj];
                    float f[8];
#pragma unroll
                    for (int i = 0; i < 8; ++i) f[i] = (float)((g[i >> 2] >> (8 * (i & 3))) & 255u);
                    if (br < 2) {
#pragma unroll
                        for (int i = 0; i < 8; ++i) f[i] *= __builtin_amdgcn_rcpf((float)((gn[i >> 2] >> (8 * (i & 3))) & 255u)); }
                    else {
#pragma unroll
                        for (int i = 0; i < 8; ++i) f[i] *= (1.f / 255.f); }
                    f32x4& a0 = acc[ai][bj][m][0]; f32x4& a1 = acc[ai][bj][m][1];
#pragma unroll
                    for (int i = 0; i < 4; ++i) { a0[i] *= f[i]; a1[i] *= f[4 + i]; }
                    if (br == 2) *(u32x4*)(M + r * 1024 + c) = pack8(a0, a1); } }
    }
};
struct EpiOut {
    static constexpr bool PERM = false, AFTER_DRAIN = false;
    static DI bool keep_acc(const Unit&) { return false; }
    unsigned char* ws; int l; float scale;
    DI void operator()(const f32x4 (&acc)[2][2][4][2], const Unit& u, int wr, int wc, int fr, int fq) const {
        float* X = (float*)(ws + OFF_X); const float* MOD = (const float*)(ws + OFF_MOD) + (size_t)l * 5 * 6144;
        const int row0 = u.pm * 256 + wr * 64 + fr, col0 = u.pn * 256 + wc * 32 + 4 * fq;
#pragma unroll
        for (int ai = 0; ai < 2; ++ai)
#pragma unroll
            for (int mh = 0; mh < 2; ++mh) {
                f32x4 xv[2][4], gv[2][4];
#pragma unroll
                for (int mm = 0; mm < 2; ++mm) { const int r = row0 + ai * 128 + (2 * mh + mm) * 16; const int b = r / TT, s_ = r - b * TT; const int mi = s_ < NCTX ? 4 : b;
                    const float* g1 = MOD + mi * 6144 + 2 * 1024; const float* xr = X + (size_t)r * 1024;
#pragma unroll
                    for (int j = 0; j < 4; ++j) { const int c = col0 + (j >> 1) * 128 + (j & 1) * 16; gv[mm][j] = *(const f32x4*)(g1 + c); xv[mm][j] = *(const f32x4*)(xr + c); } }
#pragma unroll
                for (int mm = 0; mm < 2; ++mm) { const int m = 2 * mh + mm; const int r = row0 + ai * 128 + m * 16; float* xr = X + (size_t)r * 1024;
#pragma unroll
                    for (int j = 0; j < 4; ++j) { const int c = col0 + (j >> 1) * 128 + (j & 1) * 16; *(f32x4*)(xr + c) = xv[mm][j] + gv[mm][j] * acc[ai][j >> 1][m][j & 1] * scale; } }
            }
    }
};
struct EpiUp {
    static constexpr bool PERM = true, AFTER_DRAIN = false;
    static DI bool keep_acc(const Unit&) { return false; }
    unsigned char* ws;
    DI void operator()(const f32x4 (&acc)[2][2][4][2], const Unit& u, int, int, int, int) const {
        const int t_ = otid(), wid_ = t_ >> 6, wr = wid_ >> 2, wc = wid_ & 3, fr = t_ & 15, fq = (t_ >> 4) & 3;
        unsigned char* HID = ws + OFF_HID;
        const int row0 = u.pm * 256 + wr * 64 + fr, hc0 = u.ct * 128 + wc * 16 + fq * 4;
#pragma unroll
        for (int ai = 0; ai < 2; ++ai)
#pragma unroll
            for (int m = 0; m < 4; ++m) { unsigned char* rowp = HID + (size_t)(row0 + ai * 128 + m * 16) * 1024 + hc0;
#pragma unroll
                for (int bj = 0; bj < 2; ++bj) { const f32x4 a = acc[ai][bj][m][0] * (1.f / 32.f), b = acc[ai][bj][m][1] * (1.f / 32.f); f32x4 h;
#pragma unroll
                    for (int i = 0; i < 4; ++i) h[i] = a[i] * sigmoidf_(a[i]) * b[i];
                    *(unsigned*)(rowp + bj * 64) = pk4_fp8(h[0], h[1], h[2], h[3]); } }
    }
};
struct EpiDown {
    static constexpr bool PERM = true, AFTER_DRAIN = false;
    static DI bool keep_acc(const Unit&) { return false; }
    unsigned char* ws;
    DI void operator()(const f32x4 (&acc)[2][2][4][2], const Unit& u, int, int, int, int) const {
        const int t_ = otid(), wid_ = t_ >> 6, wr = wid_ >> 2, wc = wid_ & 3, fr = t_ & 15, fq = (t_ >> 4) & 3;
        bf16_t* O = (bf16_t*)(ws + OFF_OUT);
        const int row0 = u.pm * 256 + wr * 64 + fr, col0 = u.ct * 256 + wc * 32 + 8 * fq;
#pragma unroll
        for (int ai = 0; ai < 2; ++ai)
#pragma unroll
            for (int m = 0; m < 4; ++m) { bf16_t* rowp = O + (size_t)(row0 + ai * 128 + m * 16) * 1024 + col0;
#pragma unroll
                for (int bj = 0; bj < 2; ++bj) *(u32x4*)(rowp + bj * 128) = pack8(acc[ai][bj][m][0] * (1.f / 32.f), acc[ai][bj][m][1] * (1.f / 32.f)); }
    }
};
DI int row_mod(int r) { const int b = r / TT, s = r - b * TT; return s < NCTX ? 4 : b; }

__device__ void ph_prologue(const Params& p, LAS unsigned char* lds, int wg, int nwg) {
    const int tid = otid();
    if (wg == 0 && tid < 16) {
        float* COS = (float*)(p.ws + OFF_ROPE); float* SIN = COS + 2048;
        const int k = tid; const int q4 = k & 3, dec = k >> 2;
        double th = (q4 == 0) ? 1.0 : (q4 == 1 ? 0.56234132519034908 : (q4 == 2 ? 0.31622776601683794 : 0.17782794100389228));
        for (int i = 0; i < dec; ++i) th *= 0.1;
        double ct = 1.0, st = th, term_c = 1.0, term_s = th; const double t2 = th * th;
        for (int n = 1; n <= 12; ++n) { term_c *= -t2 / (double)((2 * n - 1) * (2 * n)); term_s *= -t2 / (double)((2 * n) * (2 * n + 1)); ct += term_c; st += term_s; }
        double cp = 1.0, sp = 0.0;
        for (int pos = 0; pos < 128; ++pos) { COS[pos * 16 + k] = (float)cp; SIN[pos * 16 + k] = (float)sp; const double c2 = cp * ct - sp * st, s2 = sp * ct + cp * st; cp = c2; sp = s2; }
    }
    {
        LAS float* sc = (LAS float*)lds;
        LAS float* red = sc + 5 * 1024;
        float* MOD = (float*)(p.ws + OFF_MOD);
        for (int i = tid; i < 5 * 1024; i += 512) { const int m = i >> 10, k = i & 1023; const float v = (m < 4) ? p.c[m * 1024 + k] : p.c_ctx[k]; sc[i] = v * sigmoidf_(v); }
        __syncthreads();
        for (int u = wg; u < NL * 48; u += nwg) {
            const int l = u / 48, cb = u % 48; const int cl = tid & 127, col = cb * 128 + cl, kq = tid >> 7;
            const float* W = p.ada_w + (size_t)l * 1024 * 6144 + col;
            float a0 = 0, a1 = 0, a2 = 0, a3 = 0, a4 = 0;
#pragma unroll 1
            for (int k0 = kq * 256; k0 < kq * 256 + 256; k0 += 16) { float wv[16];
#pragma unroll
                for (int j = 0; j < 16; ++j) wv[j] = W[(size_t)(k0 + j) * 6144];
#pragma unroll
                for (int j = 0; j < 16; ++j) { const int k = k0 + j; const float w = wv[j]; a0 += sc[k] * w; a1 += sc[1024 + k] * w; a2 += sc[2048 + k] * w; a3 += sc[3072 + k] * w; a4 += sc[4096 + k] * w; } }
            red[(kq * 5 + 0) * 128 + cl] = a0; red[(kq * 5 + 1) * 128 + cl] = a1; red[(kq * 5 + 2) * 128 + cl] = a2; red[(kq * 5 + 3) * 128 + cl] = a3; red[(kq * 5 + 4) * 128 + cl] = a4;
            __syncthreads();
            if (tid < 128) { const float bb = p.ada_b[l * 6144 + col];
                for (int m = 0; m < 5; ++m) { const float s = red[(0 * 5 + m) * 128 + cl] + red[(1 * 5 + m) * 128 + cl] + red[(2 * 5 + m) * 128 + cl] + red[(3 * 5 + m) * 128 + cl];
                    MOD[((size_t)(l * 5 + m)) * 6144 + col] = s + bb; } }
            __syncthreads();
        }
    }
}

template <class RowMap> DI void tconv_tile(const float* src, int ldn, int k0, int n0, bf16_t* dst, int K, RowMap rm, LAS float* tile  , int tid) {
#pragma unroll
    for (int i = 0; i < 8; ++i) { const int k = (tid >> 6) + 8 * i, n = tid & 63; tile[k * 65 + n] = src[(size_t)(k0 + k) * ldn + n0 + n]; }
    __syncthreads();
    const int n = tid >> 3, k8 = (tid & 7) * 8; float v[8];
#pragma unroll
    for (int j = 0; j < 8; ++j) v[j] = tile[(k8 + j) * 65 + n];
    u32x4 w = {pk2(v[0], v[1]), pk2(v[2], v[3]), pk2(v[4], v[5]), pk2(v[6], v[7])};
    *(u32x4*)(dst + (size_t)rm(n0 + n) * K + k0 + k8) = w;
    __syncthreads();
}
template <class RowMap> DI void tconv_tile_f8(const float* src, int ldn, int k0, int n0, unsigned char* dst, int K, RowMap rm, float scale, LAS float* tile  , int tid) {
#pragma unroll
    for (int i = 0; i < 8; ++i) { const int k = (tid >> 6) + 8 * i, n = tid & 63; tile[k * 65 + n] = src[(size_t)(k0 + k) * ldn + n0 + n]; }
    __syncthreads();
    const int n = tid >> 3, k8 = (tid & 7) * 8; float v[8];
#pragma unroll
    for (int j = 0; j < 8; ++j) v[j] = tile[(k8 + j) * 65 + n] * scale;
    u32x2 w = {pk4_fp8(v[0], v[1], v[2], v[3]), pk4_fp8(v[4], v[5], v[6], v[7])};
    *(u32x2*)(dst + (size_t)rm(n0 + n) * K + k0 + k8) = w;
    __syncthreads();
}
struct RowId { DI int operator()(int n) const { return n; } };
struct RowW13 { int sel; DI int operator()(int j) const { return (j >> 7) * 256 + ((j & 127) >> 2) * 8 + sel * 4 + (j & 3); } };

DI void tblk_load(const float* src, int ldn, int k0, int n0, int tid, f32x4 (&v)[8]) {
    const float* s = src + (size_t)(k0 + 4 * (tid >> 5)) * ldn + n0 + 4 * (tid & 31);
#pragma unroll
    for (int i = 0; i < 2; ++i)
#pragma unroll
        for (int j = 0; j < 4; ++j) v[i * 4 + j] = *(const f32x4*)(s + (size_t)(64 * i + j) * ldn);
}
template <int OB> DI void tblk_to_lds(const f32x4 (&v)[8], float scale, LAS unsigned char* tile, int tid) {
    constexpr int S = 128 * OB + 8; const int c4 = tid & 31, r = tid >> 5;
#pragma unroll
    for (int i = 0; i < 2; ++i) {
        const f32x4 f0 = v[i * 4 + 0], f1 = v[i * 4 + 1], f2 = v[i * 4 + 2], f3 = v[i * 4 + 3];
#pragma unroll
        for (int jn = 0; jn < 4; ++jn) { LAS unsigned char* d = tile + (4 * c4 + jn) * S + (4 * r + 64 * i) * OB;
            if constexpr (OB == 1) *(LAS unsigned*)d = pk4_fp8(f0[jn] * scale, f1[jn] * scale, f2[jn] * scale, f3[jn] * scale);
            else *(LAS u32x2*)d = (u32x2){pk2(f0[jn], f1[jn]), pk2(f2[jn], f3[jn])}; }
    }
}
template <int OB, class RowMap> DI void tblk_from_lds(const LAS unsigned char* tile, unsigned char* dst, int Kb, int k0, int n0, RowMap rm, int tid) {
    constexpr int S = 128 * OB + 8; const int n = tid >> 2, q = tid & 3;
    const LAS unsigned char* t = tile + n * S + q * 32 * OB; unsigned char* d = dst + (size_t)rm(n0 + n) * Kb + k0 * OB + q * 32 * OB;
#pragma unroll
    for (int j = 0; j < 2 * OB; ++j) { const u32x2 a = *(const LAS u32x2*)(t + 16 * j), c = *(const LAS u32x2*)(t + 16 * j + 8); *(u32x4*)(d + 16 * j) = (u32x4){a[0], a[1], c[0], c[1]}; }
}
template <int OB, class RowMap> DI void tblk_unit(const float* src, int ldn, int k0, int n0, unsigned char* dst, int Kb, RowMap rm, float scale, LAS unsigned char* tile, int tid) {
    f32x4 v[8]; tblk_load(src, ldn, k0, n0, tid, v); tblk_to_lds<OB>(v, scale, tile, tid);
    __syncthreads();
    tblk_from_lds<OB>(tile, dst, Kb, k0, n0, rm, tid);
    __syncthreads();
}
DI float max_hi3(float v) {
    v = fmaxf(v, dppmov<0x128>(v));
    { auto r = __builtin_amdgcn_permlane16_swap(__float_as_uint(v), __float_as_uint(v), false, false); v = fmaxf(__uint_as_float(r[0]), __uint_as_float(r[1])); }
    { auto r = __builtin_amdgcn_permlane32_swap(__float_as_uint(v), __float_as_uint(v), false, false); v = fmaxf(__uint_as_float(r[0]), __uint_as_float(r[1])); } return v; }
DI void win_strip(const float* src, float* SW, unsigned char* dst, int n0, LAS unsigned char* tile, int tid) {
    constexpr int S = 1024 + 8; const int c4 = tid & 7, r = tid >> 3; LAS float* red = (LAS float*)(tile + 32 * S);
    f32x4 v[16]; const float* s = src + (size_t)(4 * r) * NIN + n0 + 4 * c4;
#pragma unroll
    for (int i = 0; i < 4; ++i)
#pragma unroll
        for (int j = 0; j < 4; ++j) v[i * 4 + j] = *(const f32x4*)(s + (size_t)(256 * i + j) * NIN);
    float am[4] = {0.f, 0.f, 0.f, 0.f};
#pragma unroll
    for (int i = 0; i < 16; ++i) { am[0] = fmaxf(am[0], fabsf(v[i][0])); am[1] = fmaxf(am[1], fabsf(v[i][1])); am[2] = fmaxf(am[2], fabsf(v[i][2])); am[3] = fmaxf(am[3], fabsf(v[i][3])); }
#pragma unroll
    for (int j = 0; j < 4; ++j) am[j] = max_hi3(am[j]);
    if ((tid & 63) < 8) *(LAS f32x4*)(red + (tid >> 6) * 32 + 4 * c4) = (f32x4){am[0], am[1], am[2], am[3]};
    __syncthreads();
    float inv[4];
#pragma unroll
    for (int j = 0; j < 4; ++j) { float m = red[4 * c4 + j];
#pragma unroll
        for (int w = 1; w < 8; ++w) m = fmaxf(m, red[w * 32 + 4 * c4 + j]);
        m = fmaxf(m, 1e-20f); inv[j] = 127.f / m; if (r == 0) SW[n0 + 4 * c4 + j] = m * (1.f / 127.f); }
#pragma unroll
    for (int i = 0; i < 4; ++i) {
        const f32x4 f0 = v[i * 4 + 0], f1 = v[i * 4 + 1], f2 = v[i * 4 + 2], f3 = v[i * 4 + 3];
#pragma unroll
        for (int jn = 0; jn < 4; ++jn) *(LAS unsigned*)(tile + (4 * c4 + jn) * S + 4 * r + 256 * i) = pk4_i8(f0[jn] * inv[jn], f1[jn] * inv[jn], f2[jn] * inv[jn], f3[jn] * inv[jn]);
    }
    __syncthreads();
    {   const int n = tid >> 4, q = tid & 15; const LAS unsigned char* t = tile + n * S + q * 64; unsigned char* d = dst + (size_t)(n0 + n) * 1024 + q * 64;
#pragma unroll
        for (int j = 0; j < 4; ++j) { const u32x2 a = *(const LAS u32x2*)(t + 16 * j), c = *(const LAS u32x2*)(t + 16 * j + 8); *(u32x4*)(d + 16 * j) = (u32x4){a[0], a[1], c[0], c[1]}; } }
    __syncthreads();
}

__device__ void conv_mixer_a(const Params& p, int l, LAS unsigned char* lds) {
    LAS float* tile = (LAS float*)lds; LAS unsigned* bc = (LAS unsigned*)(lds + 36864); const int tid = otid();
    unsigned* ctr = (unsigned*)(p.ws + OFF_CTR) + (48 + l) * 64;
    constexpr int U_IN = 248, U_LR = 48;
    for (;;) {
        if (tid == 0) *bc = atomicAdd(ctr, 1u);
        __syncthreads();
        const int u = (int)*bc;
        __syncthreads();
        if (u >= U_IN + U_LR) break;
        if (u < U_IN) win_strip(p.w_in + (size_t)l * 1024 * NIN, (float*)(p.ws + OFF_SW), p.ws + OFF_WIN, u * 32, lds, tid);
        else { const int v = u - U_IN; bf16_t* LRW = (bf16_t*)(p.ws + OFF_LRW);
            if (v < 32) { const int mi = v >> 3, nt = v & 7; const float* src = (mi < 2 ? p.rwkv_w_up : p.rwkv_a_up) + ((size_t)(l * 2 + (mi & 1)) * 64) * 512;
                tconv_tile(src, 512, 0, nt * 64, LRW + (size_t)mi * 512 * 64, 64, RowId(), tile, tid); }
            else { const int w = v - 32, kt = w >> 3, nt = w & 7;
                tconv_tile(p.rwkv_g_up + (size_t)l * 128 * 512, 512, kt * 64, nt * 64, LRW + (size_t)4 * 512 * 64, 128, RowId(), tile, tid); } }
    }
}
__device__ void conv_mixer_b(const Params& p, int l, LAS unsigned char* lds, int wg, int nwg) {
    const int tid = otid();
    constexpr int U_BR = 3 * 4 * 8, U_OUT = 64;
    for (int u = wg; u < U_BR + U_OUT; u += nwg) {
        if (u < U_BR) { const int i = u / 32, kt = (u % 32) / 8, nt = u % 8;
            tblk_unit<2>(p.w_branch + ((size_t)(l * 3 + i)) * 512 * 1024, 1024, kt * 128, nt * 128, p.ws + OFF_WBR + (size_t)i * 1024 * 512 * 2, 512 * 2, RowId(), 1.f, lds, tid); }
        else { const int v = u - U_BR, kt = v / 8, nt = v % 8;
            tblk_unit<2>(p.w_out + (size_t)l * 1024 * 1024, 1024, kt * 128, nt * 128, p.ws + OFF_WOUT, 1024 * 2, RowId(), 1.f, lds, tid); }
    }
}
__device__ void conv_expert_weights(const Params& p, int l, LAS unsigned char* lds, int qofs = 16) {
    LAS unsigned* bc = (LAS unsigned*)(lds + 128 * 136); const int tid = otid();
    unsigned* ctr = (unsigned*)(p.ws + OFF_CTR) + (qofs + l) * 64;
    constexpr int NU = 16 * 3 * 64;
    const float* w1 = p.exp_w1 + (size_t)l * 16 * 1024 * 1024; const float* w3 = p.exp_w3 + (size_t)l * 16 * 1024 * 1024; const float* w2 = p.exp_w2 + (size_t)l * 16 * 1024 * 1024;
#define EXP_SRC(u_) (((((u_) % 192) >> 6) == 0 ? w1 : ((((u_) % 192) >> 6) == 1 ? w3 : w2)) + (size_t)((u_) / 192) * 1024 * 1024)
#define EXP_K0(u_) (((((u_) % 192) >> 3) & 7) * 128)
#define EXP_N0(u_) ((((u_) % 192) & 7) * 128)
    if (tid == 0) *bc = atomicAdd(ctr, 1u);
    __syncthreads();
    int u = (int)*bc;
    __syncthreads();
    if (u >= NU) return;
    f32x4 v[8]; tblk_load(EXP_SRC(u), 1024, EXP_K0(u), EXP_N0(u), tid, v);
    for (;;) {
        if (tid == 0) *bc = atomicAdd(ctr, 1u);
        tblk_to_lds<1>(v, 32.f, lds, tid);
        __syncthreads();
        const int un = (int)*bc;
        if (un < NU) tblk_load(EXP_SRC(un), 1024, EXP_K0(un), EXP_N0(un), tid, v);
        {   const int e = u / 192, w = u % 192, which = w >> 6, k0 = ((w >> 3) & 7) * 128, n0 = (w & 7) * 128;
            if (which == 0) tblk_from_lds<1>(lds, p.ws + OFF_W13 + (size_t)e * 2048 * 1024, 1024, k0, n0, RowW13{0}, tid);
            else if (which == 1) tblk_from_lds<1>(lds, p.ws + OFF_W13 + (size_t)e * 2048 * 1024, 1024, k0, n0, RowW13{1}, tid);
            else tblk_from_lds<1>(lds, p.ws + OFF_W2 + (size_t)e * 1024 * 1024, 1024, k0, n0, RowId(), tid); }
        __syncthreads();
        if (un >= NU) break;
        u = un;
    }
#undef EXP_SRC
#undef EXP_K0
#undef EXP_N0
}

__device__ void norm1_rows(const Params& p, int l, int wg, int nwg) {
    const int tid = otid(), wave = tid >> 6, lane = tid & 63;
    float* X = (float*)(p.ws + OFF_X); bf16_t* H = (bf16_t*)(p.ws + OFF_H);
    const float* MOD = (const float*)(p.ws + OFF_MOD) + (size_t)l * 5 * 6144; const float* g = p.norm1_g + l * 1024;
    for (int r = wg * 8 + wave; r < RR; r += nwg * 8) {
        const int b_ = r / TT, s_ = r - b_ * TT;
        const float4* xr = (s_ < NCTX) ? (const float4*)(p.ctx + ((size_t)(b_ * NCTX + s_)) * DM) : (const float4*)(p.x + ((size_t)(b_ * SEQ + s_ - NCTX)) * DM); float4* xw = (float4*)(X + (size_t)r * 1024); float4 v[4]; float ss = 0.f;
#pragma unroll
        for (int i = 0; i < 4; ++i) v[i] = xr[lane + 64 * i];
#pragma unroll
        for (int i = 0; i < 4; ++i) { xw[lane + 64 * i] = v[i]; ss += v[i].x * v[i].x + v[i].y * v[i].y + v[i].z * v[i].z + v[i].w * v[i].w; }
        ss = wave_sum(ss);
        const float rinv = rsqrtf(ss * (1.f / 1024.f) + 1e-6f);
        const float* md = MOD + row_mod(r) * 6144;
        float y[16]; float am = 0.f;
#pragma unroll
        for (int i = 0; i < 4; ++i) { const int col = (lane + 64 * i) * 4;
            const float4 gg = *(const float4*)(g + col), sh = *(const float4*)(md + col), sc = *(const float4*)(md + 1024 + col);
            y[4 * i] = v[i].x * rinv * gg.x * (1.f + sc.x) + sh.x; y[4 * i + 1] = v[i].y * rinv * gg.y * (1.f + sc.y) + sh.y; y[4 * i + 2] = v[i].z * rinv * gg.z * (1.f + sc.z) + sh.z; y[4 * i + 3] = v[i].w * rinv * gg.w * (1.f + sc.w) + sh.w;
#pragma unroll
            for (int j = 0; j < 4; ++j) am = fmaxf(am, fabsf(y[4 * i + j])); }
        am = fmaxf(wave_max(am), 1e-20f); const float inv = 127.f / am;
        if (lane == 0) ((float*)(p.ws + OFF_SH))[r] = am * (1.f / 127.f);
#pragma unroll
        for (int i = 0; i < 4; ++i) *(unsigned*)((unsigned char*)H + (size_t)r * 1024 + (lane + 64 * i) * 4) = pk4_i8(y[4 * i] * inv, y[4 * i + 1] * inv, y[4 * i + 2] * inv, y[4 * i + 3] * inv);
    }
}
#define MFMA16(a, b, c) __builtin_amdgcn_mfma_f32_16x16x32_bf16((a), (b), (c), 0, 0, 0)
DI float tanh_fast(float x) { return 1.f - 2.f * __builtin_amdgcn_rcpf(1.f + __expf(2.f * x)); }
DI void unpack4(const u32x2 w, float (&o)[4]) { o[0] = bflo(w[0]); o[1] = bfhi(w[0]); o[2] = bflo(w[1]); o[3] = bfhi(w[1]); }
DI void prep_rows_unit(const Params& p, int l, LAS unsigned char* lds, int ub, int dup) {
    const int tid = otid(), wave = tid >> 6, lane = tid & 63, c16 = lane & 15, rq = lane >> 4;
    const int r0 = ub * 16; const int b = r0 / TT, s0 = r0 - b * TT;
    const bool isctx = s0 < NCTX; const int seg_lo = isctx ? 0 : NCTX, seg_hi = isctx ? NCTX : TT;
    const bool has_prev = s0 > seg_lo, has_next = (s0 + 16) < seg_hi;
    bf16_t* PA = (bf16_t*)(p.ws + OFF_PA); const bf16_t* PR = (const bf16_t*)(p.ws + OFF_PR); const bf16_t* PC = (const bf16_t*)(p.ws + OFF_PC);
    const int col0 = wave * 64 + c16 * 4, rb = r0 + 4 * rq;
    const bool pv = (rq > 0) || has_prev, nv = (rq < 3) || has_next;
    u32x2 rawc[3][6], rawu[2][6], rawbg[4]; u32x4 rawlr[8], rawqk[4];
#pragma unroll
    for (int g = 0; g < 3; ++g)
#pragma unroll
        for (int j = 0; j < 6; ++j) { const bool ok = (j == 0) ? pv : ((j == 5) ? nv : true); rawc[g][j] = (u32x2){0u, 0u}; if (ok) rawc[g][j] = *(const u32x2*)(PR + (size_t)(rb - 1 + j) * 1792 + g * 512 + col0); }
    {   const bf16_t* lr = PR + (size_t)(r0 + c16) * 1792 + 1536 + 8 * rq;
#pragma unroll
        for (int i = 0; i < 8; ++i) rawlr[i] = *(const u32x4*)(lr + 32 * i); }
#pragma unroll
    for (int j = 0; j < 6; ++j) { const bool ok = (j == 0) ? pv : ((j == 5) ? nv : true); rawu[0][j] = (u32x2){0u, 0u}; rawu[1][j] = (u32x2){0u, 0u};
        if (ok) { rawu[0][j] = *(const u32x2*)(PC + (size_t)(rb - 1 + j) * 1536 + 512 + col0); rawu[1][j] = *(const u32x2*)(PC + (size_t)(rb - 1 + j) * 1536 + 1024 + col0); } }
#pragma unroll
    for (int i = 0; i < 4; ++i) rawbg[i] = *(const u32x2*)(PC + (size_t)(rb + i) * 1536 + col0);
    bf16_t* qkbase = PA + (size_t)(r0 + (tid >> 5)) * 1536 + ((tid & 31) >> 1) * 64 + 16 * (tid & 1);
    if (!dup) { rawqk[0] = *(const u32x4*)qkbase; rawqk[1] = *(const u32x4*)(qkbase + 8); rawqk[2] = *(const u32x4*)(qkbase + 32); rawqk[3] = *(const u32x4*)(qkbase + 40); }
    __builtin_amdgcn_sched_barrier(0);
    float rc[4][4], kc[4][4], vc[4][4];
    {   const float* cw = p.rwkv_conv_w + (size_t)l * 3 * 1536;
#pragma unroll
        for (int g = 0; g < 3; ++g) {
            const int co = g * 512 + col0; const f32x4 w0 = *(const f32x4*)(cw + co), w1 = *(const f32x4*)(cw + 1536 + co), w2 = *(const f32x4*)(cw + 3072 + co);
            float x[6][4];
#pragma unroll
            for (int j = 0; j < 6; ++j) unpack4(rawc[g][j], x[j]);
#pragma unroll
            for (int i = 0; i < 4; ++i)
#pragma unroll
                for (int c = 0; c < 4; ++c) { const float o = w0[c] * x[i][c] + w1[c] * x[i + 1][c] + w2[c] * x[i + 2][c]; if (g == 0) rc[i][c] = o; else if (g == 1) kc[i][c] = o; else vc[i][c] = o; }
        } }
    bf16_t* EW = (bf16_t*)(p.ws + OFF_EW); bf16_t* AA = (bf16_t*)(p.ws + OFF_AA);
    bf16_t* KK = (bf16_t*)(p.ws + OFF_KK); bf16_t* KC = (bf16_t*)(p.ws + OFF_KC); bf16_t* RC = (bf16_t*)(p.ws + OFF_RC); bf16_t* VC = (bf16_t*)(p.ws + OFF_VC);
    {   const f32x4 kkc = *(const f32x4*)(p.rwkv_k_k + l * 512 + col0);
#pragma unroll
        for (int i = 0; i < 4; ++i) { float q[4]; float ss = 0.f;
#pragma unroll
            for (int c = 0; c < 4; ++c) { q[c] = kc[i][c] * kkc[c]; ss += q[c] * q[c]; }
            ss = allsum16(ss); const float rn = 1.f / fmaxf(sqrtf(ss), 1e-12f);
            const size_t o = (size_t)(rb + i) * 512 + col0;
            u32x2 w; w[0] = pk2(q[0] * rn, q[1] * rn); w[1] = pk2(q[2] * rn, q[3] * rn); *(u32x2*)(KK + o) = w;
            w[0] = pk2(kc[i][0], kc[i][1]); w[1] = pk2(kc[i][2], kc[i][3]); *(u32x2*)(KC + o) = w;
            w[0] = pk2(rc[i][0], rc[i][1]); w[1] = pk2(rc[i][2], rc[i][3]); *(u32x2*)(RC + o) = w;
            w[0] = pk2(vc[i][0], vc[i][1]); w[1] = pk2(vc[i][2], vc[i][3]); *(u32x2*)(VC + o) = w; } }
    bf16x8 twf[2], alf[2], sgf[4];
    {
#pragma unroll
        for (int ks = 0; ks < 2; ++ks) { const u32x4 v = rawlr[ks]; u32x4 t;
#pragma unroll
            for (int i = 0; i < 4; ++i) t[i] = pk2(tanh_fast(bflo(v[i])), tanh_fast(bfhi(v[i])));
            twf[ks] = __builtin_bit_cast(bf16x8, t); alf[ks] = __builtin_bit_cast(bf16x8, rawlr[2 + ks]); }
#pragma unroll
        for (int ks = 0; ks < 4; ++ks) { const u32x4 v = rawlr[4 + ks]; u32x4 t;
#pragma unroll
            for (int i = 0; i < 4; ++i) t[i] = pk2(sigmoidf_(bflo(v[i])), sigmoidf_(bfhi(v[i])));
            sgf[ks] = __builtin_bit_cast(bf16x8, t); } }
    const bf16_t* LRW = (const bf16_t*)(p.ws + OFF_LRW);
    float bon[4] = {0.f, 0.f, 0.f, 0.f};
    const f32x4 kac = *(const f32x4*)(p.rwkv_k_a + l * 512 + col0), rkc = *(const f32x4*)(p.rwkv_r_k + l * 512 + col0);
#pragma unroll 1
    for (int d = 0; d < 2; ++d) {
        f32x4 wa[4], aa[4];
#pragma unroll
        for (int cb = 0; cb < 4; ++cb) { wa[cb] = (f32x4){0.f, 0.f, 0.f, 0.f}; aa[cb] = (f32x4){0.f, 0.f, 0.f, 0.f};
            const bf16_t* bw = LRW + ((size_t)d * 512 + col0 + cb) * 64 + 8 * rq; const bf16_t* ba = bw + (size_t)2 * 512 * 64;
#pragma unroll
            for (int ks = 0; ks < 2; ++ks) { wa[cb] = MFMA16(twf[ks], *(const bf16x8*)(bw + 32 * ks), wa[cb]); aa[cb] = MFMA16(alf[ks], *(const bf16x8*)(ba + 32 * ks), aa[cb]); } }
        const f32x4 w0c = *(const f32x4*)(p.rwkv_w0 + (l * 2 + d) * 512 + col0), a0c = *(const f32x4*)(p.rwkv_a0 + (l * 2 + d) * 512 + col0);
#pragma unroll
        for (int i = 0; i < 4; ++i) { float e[4], a[4]; float bs = 0.f;
#pragma unroll
            for (int c = 0; c < 4; ++c) { const float z = w0c[c] + wa[c][i];
                const float sp = fmaxf(-z, 0.f) + __logf(1.f + __expf(-fabsf(z)));
                e[c] = __expf(-sp - 0.5f) * 1.4426950408889634f;
                a[c] = sigmoidf_(a0c[c] + aa[c][i]);
                const float kd = kc[i][c] * (1.f + (a[c] - 1.f) * kac[c]); bs += rc[i][c] * kd * rkc[c]; }
            bon[i] += allsum16(bs);
            const size_t o = (size_t)d * RR * 512 + (size_t)(rb + i) * 512 + col0;
            u32x2 w; w[0] = pk2(e[0], e[1]); w[1] = pk2(e[2], e[3]); *(u32x2*)(EW + o) = w;
            w[0] = pk2(a[0], a[1]); w[1] = pk2(a[2], a[3]); *(u32x2*)(AA + o) = w; }
    }
    {
        f32x4 ga[4];
#pragma unroll
        for (int cb = 0; cb < 4; ++cb) { ga[cb] = (f32x4){0.f, 0.f, 0.f, 0.f}; const bf16_t* bg = LRW + (size_t)4 * 512 * 64 + ((size_t)col0 + cb) * 128 + 8 * rq;
#pragma unroll
            for (int ks = 0; ks < 4; ++ks) ga[cb] = MFMA16(sgf[ks], *(const bf16x8*)(bg + 32 * ks), ga[cb]); }
        bf16_t* G = (bf16_t*)(p.ws + OFF_G); bf16_t* YB0 = (bf16_t*)(p.ws + OFF_YB0); const f32x4 lnb = *(const f32x4*)(p.rwkv_ln_b + l * 512 + col0);
#pragma unroll
        for (int i = 0; i < 4; ++i) { const size_t o = (size_t)(rb + i) * 512 + col0;
            u32x2 w; w[0] = pk2(ga[0][i], ga[1][i]); w[1] = pk2(ga[2][i], ga[3][i]); *(u32x2*)(G + o) = w;
            w[0] = pk2(2.f * lnb[0] + bon[i] * vc[i][0], 2.f * lnb[1] + bon[i] * vc[i][1]); w[1] = pk2(2.f * lnb[2] + bon[i] * vc[i][2], 2.f * lnb[3] + bon[i] * vc[i][3]); *(u32x2*)(YB0 + o) = w; }
    }
    {
        const float* cw = p.conv_w + (size_t)l * 3 * 512; const f32x4 c0 = *(const f32x4*)(cw + col0), c1 = *(const f32x4*)(cw + 512 + col0), c2 = *(const f32x4*)(cw + 1024 + col0);
        float uu[6][4];
#pragma unroll
        for (int j = 0; j < 6; ++j) { float fa[4], fc[4]; unpack4(rawu[0][j], fa); unpack4(rawu[1][j], fc);
#pragma unroll
            for (int q = 0; q < 4; ++q) uu[j][q] = fa[q] * fc[q]; }
        bf16_t* YC = (bf16_t*)(p.ws + OFF_YC);
#pragma unroll
        for (int i = 0; i < 4; ++i) { float bg[4]; unpack4(rawbg[i], bg); float o[4];
#pragma unroll
            for (int q = 0; q < 4; ++q) o[q] = bg[q] * (c0[q] * uu[i][q] + c1[q] * uu[i + 1][q] + c2[q] * uu[i + 2][q]);
            u32x2 w = {pk2(o[0], o[1]), pk2(o[2], o[3])}; *(u32x2*)(YC + (size_t)(rb + i) * 512 + col0) = w; }
    }
    if (!dup) {   const int rr = tid >> 5, g16 = (tid & 31) >> 1, hf = tid & 1; const int s = s0 + rr;
        bf16_t* base = qkbase;
        const u32x4 a0 = rawqk[0], a1 = rawqk[1], b0 = rawqk[2], b1 = rawqk[3];
        float x1[16], x2[16];
#pragma unroll
        for (int i = 0; i < 4; ++i) { x1[2 * i] = bflo(a0[i]); x1[2 * i + 1] = bfhi(a0[i]); x1[8 + 2 * i] = bflo(a1[i]); x1[9 + 2 * i] = bfhi(a1[i]);
            x2[2 * i] = bflo(b0[i]); x2[2 * i + 1] = bfhi(b0[i]); x2[8 + 2 * i] = bflo(b1[i]); x2[9 + 2 * i] = bfhi(b1[i]); }
        float ss = 0.f;
#pragma unroll
        for (int j = 0; j < 16; ++j) ss += x1[j] * x1[j] + x2[j] * x2[j];
        ss += dppmov<0xB1>(ss);
        const float rinv = rsqrtf(ss * (1.f / 64.f) + 1e-6f);
        const float* gg = (g16 < 8 ? p.q_norm_g : p.k_norm_g) + l * 64; const float qs = g16 < 8 ? 0.125f * 1.4426950408889634f : 1.f;
        const float* COS = (const float*)(p.ws + OFF_ROPE); const float* SIN = COS + 2048;
        const int tl = s - NCTX; const int pos = isctx ? 0 : (hf == 0 ? (tl >> 6) : (tl & 63));
#pragma unroll
        for (int j = 0; j < 16; ++j) { const float y1 = x1[j] * rinv * gg[16 * hf + j], y2 = x2[j] * rinv * gg[32 + 16 * hf + j];
            float o1 = y1, o2 = y2;
            if (!isctx) { const float c = COS[pos * 16 + j], sn = SIN[pos * 16 + j]; o1 = y1 * c - y2 * sn; o2 = y2 * c + y1 * sn; }
            x1[j] = o1 * qs; x2[j] = o2 * qs; }
        u32x4 w0, w1, w2, w3;
#pragma unroll
        for (int i = 0; i < 4; ++i) { w0[i] = pk2(x1[2 * i], x1[2 * i + 1]); w1[i] = pk2(x1[8 + 2 * i], x1[9 + 2 * i]); w2[i] = pk2(x2[2 * i], x2[2 * i + 1]); w3[i] = pk2(x2[8 + 2 * i], x2[9 + 2 * i]); }
        *(u32x4*)base = w0; *(u32x4*)(base + 8) = w1; *(u32x4*)(base + 32) = w2; *(u32x4*)(base + 40) = w3;
    }
}
DI void prep_vt_unit(const Params& p, LAS unsigned char* lds, int uv) {
    const int tid = otid(); const int b = uv / 132, tb = uv % 132;
    const bf16_t* PA = (const bf16_t*)(p.ws + OFF_PA); bf16_t* VT = (bf16_t*)(p.ws + OFF_VT);
    LAS unsigned char* img = lds;
#pragma unroll
    for (int i = 0; i < 8; ++i) { const int id = tid + 512 * i, row = id >> 6, ch = id & 63;
        const u32x4 v = *(const u32x4*)(PA + (size_t)(b * TT + tb * 64 + row) * 1536 + 1024 + ch * 8); *(LAS u32x4*)(img + row * 1040 + ch * 16) = v; }
    __syncthreads();
    bf16_t* dst = VT + ((size_t)(b * 512 + tid)) * TT + tb * 64;
#pragma unroll
    for (int g = 0; g < 4; ++g) { unsigned w[8];
#pragma unroll
        for (int q = 0; q < 8; ++q) { const int p0 = 2 * q, p1 = 2 * q + 1;
            const int k0 = 16 * g + (p0 & 3) + 8 * ((p0 >> 2) & 1) + 4 * (p0 >> 3), k1 = 16 * g + (p1 & 3) + 8 * ((p1 >> 2) & 1) + 4 * (p1 >> 3);
            const unsigned lo = *(const LAS unsigned short*)(img + k0 * 1040 + tid * 2), hi = *(const LAS unsigned short*)(img + k1 * 1040 + tid * 2); w[q] = lo | (hi << 16); }
        u32x4 wa = {w[0], w[1], w[2], w[3]}, wb = {w[4], w[5], w[6], w[7]};
        *(u32x4*)(dst + 16 * g) = wa; *(u32x4*)(dst + 16 * g + 8) = wb; }
    __syncthreads();
}
__device__ void ph_prep(const Params& p, int l, LAS unsigned char* lds, int wg, int nwg, int dup) {
    for (int u = wg; u < 528 + RR / 16; u += nwg) { if (u < 528) prep_vt_unit(p, lds, u); else prep_rows_unit(p, l, lds, u - 528, dup); }
}
#define MFMA32(a, b, c) __builtin_amdgcn_mfma_f32_32x32x16_bf16((a), (b), (c), 0, 0, 0)
DI bf16x8 pack_p(const f32x16& x, int s) {
    u32x4 w = {pk2(x[8 * s + 0], x[8 * s + 1]), pk2(x[8 * s + 2], x[8 * s + 3]), pk2(x[8 * s + 4], x[8 * s + 5]), pk2(x[8 * s + 6], x[8 * s + 7])};
    return __builtin_bit_cast(bf16x8, w);
}
#define SCHED_FENCE() __builtin_amdgcn_sched_barrier(0)
DI void lds_barrier() { asm volatile("s_waitcnt lgkmcnt(0)" ::: "memory"); __builtin_amdgcn_s_barrier(); asm volatile("" ::: "memory"); }
DI void attn_qk(const LAS unsigned char* Kc, const int (&coff)[4], const bf16x8 (&qf)[4], f32x16& s0, f32x16& s1) {
    bf16x8 kf[4], kg[4];
#pragma unroll
    for (int ks = 0; ks < 4; ++ks) kf[ks] = *(const LAS bf16x8*)(Kc + coff[ks]);
#pragma unroll
    for (int j = 0; j < 16; ++j) { s0[j] = 0.f; s1[j] = 0.f; }
#pragma unroll
    for (int ks = 0; ks < 4; ++ks) kg[ks] = *(const LAS bf16x8*)(Kc + 4096 + coff[ks]);
#pragma unroll
    for (int ks = 0; ks < 4; ++ks) s0 = MFMA32(kf[ks], qf[ks], s0);
#pragma unroll
    for (int ks = 0; ks < 4; ++ks) s1 = MFMA32(kg[ks], qf[ks], s1);
}
DI void attn_partial(f32x16& s0, f32x16& s1, float& m_run, float& alpha, bool& resc) {
    float tmax = fmaxf(s0[0], s1[0]);
#pragma unroll
    for (int j = 1; j < 16; ++j) tmax = fmaxf(fmaxf(tmax, s0[j]), s1[j]);
    { auto rr = __builtin_amdgcn_permlane32_swap(__float_as_uint(tmax), __float_as_uint(tmax), false, false); tmax = fmaxf(__uint_as_float(rr[0]), __uint_as_float(rr[1])); }
    resc = __any(tmax > m_run); alpha = 1.f;
    if (resc) { const float mn = fmaxf(m_run, tmax); alpha = __builtin_amdgcn_exp2f(m_run - mn); m_run = mn; }
    const f32x2v m2 = {m_run, m_run};
#pragma unroll
    for (int j = 0; j < 8; ++j) { f32x2v a = (f32x2v){s0[2 * j], s0[2 * j + 1]} - m2, c = (f32x2v){s1[2 * j], s1[2 * j + 1]} - m2;
        s0[2 * j] = __builtin_amdgcn_exp2f(a[0]); s0[2 * j + 1] = __builtin_amdgcn_exp2f(a[1]); s1[2 * j] = c[0]; s1[2 * j + 1] = c[1]; }
}
DI void attn_finish(f32x16& s0, f32x16& s1, float alpha, float& l_run, bf16x8 (&pf)[4]) {
    f32x2v ps = {0.f, 0.f};
#pragma unroll
    for (int j = 0; j < 8; ++j) { s1[2 * j] = __builtin_amdgcn_exp2f(s1[2 * j]); s1[2 * j + 1] = __builtin_amdgcn_exp2f(s1[2 * j + 1]);
        ps += (f32x2v){s0[2 * j], s0[2 * j + 1]}; ps += (f32x2v){s1[2 * j], s1[2 * j + 1]}; }
    l_run = l_run * alpha + (ps[0] + ps[1]);
    pf[0] = pack_p(s0, 0); pf[1] = pack_p(s0, 1); pf[2] = pack_p(s1, 0); pf[3] = pack_p(s1, 1);
}
DI void attn_partial_nm(f32x16& s0, f32x16& s1, float& ps) {
#pragma unroll
    for (int j = 0; j < 16; ++j) { s0[j] = __builtin_amdgcn_exp2f(s0[j]); s1[j] = __builtin_amdgcn_exp2f(s1[j]); }
    float a = s0[0];
#pragma unroll
    for (int j = 1; j < 16; ++j) a += s0[j];
    ps = a;
}
DI void attn_finish_nm(f32x16& s0, f32x16& s1, float ps, float& l_run, bf16x8 (&pf)[4]) {
    float a = ps;
#pragma unroll
    for (int j = 0; j < 16; ++j) a += s1[j];
    l_run += a;
    pf[0] = pack_p(s0, 0); pf[1] = pack_p(s0, 1); pf[2] = pack_p(s1, 0); pf[3] = pack_p(s1, 1);
}
#define AT_DMA1(gp, la) asm volatile("s_mov_b32 m0, %0\n\ts_nop 0\n\tglobal_load_lds_dwordx4 %1, off" :: "s"((unsigned)(unsigned long long)(la)), "v"(gp) : "m0", "memory")
DI void attn_step_nm(const LAS unsigned char* Kc, const LAS unsigned char* Vc, const int (&coff)[4], const bf16x8 (&qf)[4],
                     const f32x16& P0, const f32x16& P1, float psP, f32x16& N0, f32x16& N1, float& psN, float& l_run, f32x16 (&o)[4],
                     const bf16_t* kgn, const bf16_t* vgn, int kofs, int vofs, bool dma, unsigned ldsK, unsigned ldsV) {
    bf16x8 kf[8], vf[16]; unsigned w[16];
#pragma unroll
    for (int i = 0; i < 8; ++i) { kf[i] = *(const LAS bf16x8*)(Kc + (i >> 2) * 4096 + coff[i & 3]); SCHED_FENCE(); }
    const f32x16 z = {0.f, 0.f, 0.f, 0.f, 0.f, 0.f, 0.f, 0.f, 0.f, 0.f, 0.f, 0.f, 0.f, 0.f, 0.f, 0.f};
    float a = psP;
#pragma unroll
    for (int g = 0; g < 8; ++g) {
        if (g < 4) N0 = MFMA32(kf[g], qf[g], g == 0 ? z : N0); else N1 = MFMA32(kf[g], qf[g - 4], g == 4 ? z : N1);
        a += P1[2 * g]; a += P1[2 * g + 1];
        if (g < 4) { w[2 * g] = pk2(P0[4 * g], P0[4 * g + 1]); w[2 * g + 1] = pk2(P0[4 * g + 2], P0[4 * g + 3]); }
        else { w[2 * g] = pk2(P1[4 * g - 16], P1[4 * g - 15]); w[2 * g + 1] = pk2(P1[4 * g - 14], P1[4 * g - 13]); }
        if (g >= 4) vf[g - 4] = *(const LAS bf16x8*)(Vc + coff[g - 4]);
        if (g == 1) { if (dma) AT_DMA1(kgn + kofs, ldsK); } else if (g == 2) { if (dma) AT_DMA1(vgn + vofs, ldsV); } else if (g == 3) { if (dma) AT_DMA1(vgn + (vofs + 64 * TT), ldsV + 8192u); }
        SCHED_FENCE();
    }
    l_run += a;
    bf16x8 pf[4];
#pragma unroll
    for (int k = 0; k < 4; ++k) { const u32x4 t = {w[4 * k], w[4 * k + 1], w[4 * k + 2], w[4 * k + 3]}; pf[k] = __builtin_bit_cast(bf16x8, t); }
    float bsum = 0.f;
#pragma unroll
    for (int g = 0; g < 16; ++g) {
        o[g >> 2] = MFMA32(vf[g], pf[g & 3], o[g >> 2]);
        if (g + 4 < 16) vf[g + 4] = *(const LAS bf16x8*)(Vc + ((g + 4) >> 2) * 4096 + coff[(g + 4) & 3]);
        if (g < 8) { N0[2 * g] = __builtin_amdgcn_exp2f(N0[2 * g]); N0[2 * g + 1] = __builtin_amdgcn_exp2f(N0[2 * g + 1]); bsum = (g == 0) ? N0[0] + N0[1] : (bsum + N0[2 * g]) + N0[2 * g + 1]; }
        else { N1[2 * g - 16] = __builtin_amdgcn_exp2f(N1[2 * g - 16]); N1[2 * g - 15] = __builtin_amdgcn_exp2f(N1[2 * g - 15]); }
        SCHED_FENCE();
    }
    psN = bsum;
}
DI void attn_pv(const LAS unsigned char* Vc, const int (&coff)[4], const bf16x8 (&pf)[4], f32x16 (&o)[4]) {
#pragma unroll
    for (int dvb = 0; dvb < 4; ++dvb) { bf16x8 va[4];
#pragma unroll
        for (int i = 0; i < 4; ++i) va[i] = *(const LAS bf16x8*)(Vc + dvb * 4096 + coff[i]);
#pragma unroll
        for (int i = 0; i < 4; ++i) o[dvb] = MFMA32(va[i], pf[i], o[dvb]); }
}
#ifndef PROBE_ATTN_ABL
#define PROBE_ATTN_ABL 0
#endif
template <int ABL, bool NM> DI void attn_unit(const Params& p, LAS unsigned char* lds, int b, int h, int m, int sq0, int nkt) {
    const int tid = otid(), wave = tid >> 6, lane = tid & 63, r32 = lane & 31, h2 = lane >> 5;
    const bf16_t* PA = (const bf16_t*)(p.ws + OFF_PA); const bf16_t* VT = (const bf16_t*)(p.ws + OFF_VT);
    bf16_t* O = (bf16_t*)(p.ws + (ABL ? WS_NEEDED : OFF_OA)) + (size_t)m * RR * 512;
    const size_t rowbase = (size_t)b * TT;
    bf16x8 qf[4];
    {   const bf16_t* qp = PA + (rowbase + sq0 + wave * 32 + r32) * 1536 + (h * 2 + m) * 64 + 8 * h2;
#pragma unroll
        for (int ks = 0; ks < 4; ++ks) qf[ks] = *(const bf16x8*)(qp + 16 * ks); }
    const int srow = tid >> 3, sch = (tid & 7) ^ ((srow >> 1) & 7);
    const bf16_t* kgb = PA + rowbase * 1536 + 512 + (h * 2 + m) * 64;
    const bf16_t* vgb = VT + ((size_t)((b * 4 + h) * 128)) * TT;
    const int kofs = srow * 1536 + sch * 8, vofs = srow * TT + sch * 8;
    LAS unsigned char* Kb = lds; LAS unsigned char* Vb = lds + 24576;
    const int swz = (r32 >> 1) & 7;
    int coff[4];
#pragma unroll
    for (int ks = 0; ks < 4; ++ks) coff[ks] = r32 * 128 + (((2 * ks + h2) ^ swz) << 4);
    f32x16 o[4];
#pragma unroll
    for (int i = 0; i < 4; ++i)
#pragma unroll
        for (int j = 0; j < 16; ++j) o[i][j] = 0.f;
    float m_run = -1e30f, l_run = 0.f, alA = 1.f, alB = 1.f; bool rsA = false, rsB = false;
    f32x16 A0, A1, B0, B1; bf16x8 pf[4];
    int bprev = 2, bcur = 0, bnext = 1;
    const int wu = __builtin_amdgcn_readfirstlane(tid >> 6) * 1024;
#define AT_DMA(t, bi) do { if (ABL & 4) break; \
        AT_DMA1(kgb + (kofs + (t) * 64 * 1536), Kb + (bi) * 8192 + wu); \
        AT_DMA1(vgb + (vofs + (t) * 64), Vb + (bi) * 16384 + wu); \
        AT_DMA1(vgb + (vofs + 64 * TT + (t) * 64), Vb + (bi) * 16384 + 8192 + wu); } while (0)
#define AT_LANDED() do { if (!(ABL & 4)) asm volatile("s_waitcnt vmcnt(0)" ::: "memory"); } while (0)
#define AT_BAR() do { if (!(ABL & 4)) lds_barrier(); } while (0)
#define AT_QK(Kc, N0, N1) do { if (ABL & 2) { _Pragma("unroll") for (int j_ = 0; j_ < 16; ++j_) { asm volatile("" : "+v"(N0[j_])); asm volatile("" : "+v"(N1[j_])); } } else attn_qk(Kc, coff, qf, N0, N1); } while (0)
#define AT_PV(Vc) do { if (ABL & 2) { _Pragma("unroll") for (int i_ = 0; i_ < 4; ++i_) asm volatile("" :: "v"(pf[i_])); } else attn_pv(Vc, coff, pf, o); } while (0)
#define AT_PART(N0, N1, alN, rsN) do { if (ABL & 1) { alN = 1.f; rsN = false; } else if (NM) { rsN = false; attn_partial_nm(N0, N1, alN); } else attn_partial(N0, N1, m_run, alN, rsN); } while (0)
#define AT_FIN(P0, P1, alP) do { if (ABL & 1) { pf[0] = pack_p(P0, 0); pf[1] = pack_p(P0, 1); pf[2] = pack_p(P1, 0); pf[3] = pack_p(P1, 1); l_run = 1.f; } else if (NM) attn_finish_nm(P0, P1, alP, l_run, pf); else attn_finish(P0, P1, alP, l_run, pf); } while (0)
#define AT_ROT() do { const int t_ = bprev; bprev = bcur; bcur = bnext; bnext = t_; } while (0)
#define AT_RESC(al, rs) do { if (__builtin_expect(rs, 0)) { asm volatile("" ::: "memory"); _Pragma("unroll") for (int i_ = 0; i_ < 4; ++i_) _Pragma("unroll") for (int j_ = 0; j_ < 16; ++j_) o[i_][j_] *= (al); } } while (0)
#define AT_STEP(j, P0, P1, alP, N0, N1, alN, rsN) do { \
        if constexpr (NM && ABL == 0) { SCHED_FENCE(); attn_step_nm(Kb + bcur * 8192, Vb + bprev * 16384, coff, qf, P0, P1, alP, N0, N1, alN, l_run, o, \
            kgb + ((j) + 1) * 64 * 1536, vgb + ((j) + 1) * 64, kofs, vofs, (j) + 1 < nkt, (unsigned)(unsigned long long)(Kb + bnext * 8192 + wu), (unsigned)(unsigned long long)(Vb + bnext * 16384 + wu)); \
            SCHED_FENCE(); AT_LANDED(); AT_BAR(); AT_ROT(); break; } \
        if ((j) + 1 < nkt) AT_DMA((j) + 1, bnext); \
        SCHED_FENCE(); \
        AT_QK(Kb + bcur * 8192, N0, N1); AT_FIN(P0, P1, alP); \
        __builtin_amdgcn_sched_group_barrier(0x100, 8, 0); \
        _Pragma("unroll") for (int g_ = 0; g_ < 8; ++g_) { __builtin_amdgcn_sched_group_barrier(0x8, 1, 0); __builtin_amdgcn_sched_group_barrier(0x402, NM ? 5 : 7, 0); } \
        SCHED_FENCE(); \
        AT_PV(Vb + bprev * 16384); AT_PART(N0, N1, alN, rsN); \
        __builtin_amdgcn_sched_group_barrier(0x100, 4, 0); \
        _Pragma("unroll") for (int g_ = 0; g_ < 16; ++g_) { __builtin_amdgcn_sched_group_barrier(0x8, 1, 0); __builtin_amdgcn_sched_group_barrier(0x100, 1, 0); __builtin_amdgcn_sched_group_barrier(0x402, NM ? 3 : 4, 0); } \
        SCHED_FENCE(); \
        AT_RESC(alN, rsN); \
        AT_LANDED(); AT_BAR(); AT_ROT(); } while (0)
    AT_DMA(0, 0); AT_LANDED(); AT_BAR();
    if (nkt > 1) AT_DMA(1, 1);
    AT_QK(Kb, A0, A1); AT_PART(A0, A1, alA, rsA);
    AT_LANDED(); AT_BAR(); AT_ROT();
    int j = 1;
    for (; j + 1 < nkt; j += 2) { AT_STEP(j, A0, A1, alA, B0, B1, alB, rsB); AT_STEP(j + 1, B0, B1, alB, A0, A1, alA, rsA); }
    if (j < nkt) {
        AT_STEP(j, A0, A1, alA, B0, B1, alB, rsB);
        AT_FIN(B0, B1, alB);
    } else AT_FIN(A0, A1, alA);
    AT_PV(Vb + bprev * 16384);
#undef AT_DMA
#undef AT_LANDED
#undef AT_ROT
#undef AT_RESC
#undef AT_STEP
#undef AT_BAR
#undef AT_QK
#undef AT_PV
#undef AT_PART
#undef AT_FIN
    { auto rr = __builtin_amdgcn_permlane32_swap(__float_as_uint(l_run), __float_as_uint(l_run), false, false); l_run = __uint_as_float(rr[0]) + __uint_as_float(rr[1]); }
    const float inv = 1.f / l_run;
    const int tid2 = otid();
    bf16_t* orow = O + (rowbase + sq0 + (tid2 >> 6) * 32 + (tid2 & 31)) * 512 + h * 128 + 4 * ((tid2 >> 5) & 1);
#pragma unroll
    for (int dvb = 0; dvb < 4; ++dvb)
#pragma unroll
        for (int g = 0; g < 4; ++g) { u32x2 w = {pk2(o[dvb][4 * g] * inv, o[dvb][4 * g + 1] * inv), pk2(o[dvb][4 * g + 2] * inv, o[dvb][4 * g + 3] * inv)};
            *(u32x2*)(orow + dvb * 32 + 8 * g) = w; }
    lds_barrier();
}

constexpr int CS_TKK = 0, CS_TR = 2304, CS_TKD = 4608, CS_TKA = 6912, CS_TVN = 9216, CS_TDA = 11264, CS_TVS = 16384, CS_G15 = 21504, CS_TBM = 21760, CS_TCM = 23040, CS_TBC = 24064, CS_BUF = 25344;
constexpr int CS_E = 2 * CS_BUF, CS_YO = CS_E + 4096;
constexpr int CS_RS = 144, CS_RT = 80, CS_C = 16, CS_NCH = TT / CS_C;
static_assert(CS_NCH % 4 == 0 && CS_YO + 4096 <= 131072, "scan");
#ifndef PROBE_SCAN_ABL
#define PROBE_SCAN_ABL 0
#endif
DI void scan_unit(const Params& p, int l, LAS unsigned char* lds, int u, int dup = 0) {
    const int abl = dup ? PROBE_SCAN_ABL : 0;
    const int tid = otid(), wave = tid >> 6, lane = tid & 63, c16 = lane & 15, q = lane >> 4;
    const int chain = u; const int dir = chain & 1, bh = chain >> 1, b = bh >> 3, h = bh & 7;
    auto tok = [&](int i) -> int { return dir == 0 ? i : (i < NCTX ? (NCTX - 1 - i) : (TT + NCTX - 1 - i)); };
    for (int i = tid; i < 2 * 16 * 16; i += 512) { const int bf = i >> 8, r = (i >> 4) & 15, cidx = i & 15; *(LAS unsigned short*)(lds + bf * CS_BUF + CS_TBM + r * CS_RT + (16 + cidx) * 2) = 0; }
    for (int i = tid; i < 2 * 64 * 16; i += 512) { const int bf = i >> 10, r = (i >> 4) & 63, cidx = i & 15; *(LAS unsigned short*)(lds + bf * CS_BUF + CS_TVS + r * CS_RT + (16 + cidx) * 2) = 0; }
    lds_barrier();
    if (wave >= 4) {
        __builtin_amdgcn_s_setprio(1);
        const bf16_t* EW = (const bf16_t*)(p.ws + OFF_EW) + (size_t)dir * RR * 512; const bf16_t* AA = (const bf16_t*)(p.ws + OFF_AA) + (size_t)dir * RR * 512;
        const bf16_t* KK = (const bf16_t*)(p.ws + OFF_KK); const bf16_t* KC = (const bf16_t*)(p.ws + OFF_KC); const bf16_t* RC = (const bf16_t*)(p.ws + OFF_RC); const bf16_t* VC = (const bf16_t*)(p.ws + OFF_VC);
        bf16_t* OS = (bf16_t*)(p.ws + ((dup && PROBE_SCAN_ABL) ? WS_NEEDED : OFF_OS)) + (size_t)dir * RR * 512;
        const int pu = tid - 256, pw = wave - 4, lt = pu >> 4, k4 = (pu & 15) * 4;
        const int posk = 32 * (k4 >> 5) + 8 * (((k4 & 31) >> 2) & 3) + 4 * ((k4 & 31) >> 4);
        const f32x4 ka4 = *(const f32x4*)(p.rwkv_k_a + l * 512 + h * 64 + k4);
        struct Raw { u32x2 re, rk, ra, rkc, rr_, rv; };
        auto gload = [&](int c) -> Raw { const size_t off = ((size_t)b * TT + tok(c * CS_C + lt)) * 512 + h * 64 + k4; Raw w;
            w.re = *(const u32x2*)(EW + off); w.rk = *(const u32x2*)(KK + off); w.ra = *(const u32x2*)(AA + off); w.rkc = *(const u32x2*)(KC + off); w.rr_ = *(const u32x2*)(RC + off); w.rv = *(const u32x2*)(VC + off); return w; };
        float cmask[16];
#pragma unroll
        for (int i = 0; i < 16; ++i) { cmask[i] = (i <= lt) ? 1.f : 0.f; asm volatile("" : "+v"(cmask[i])); }
        auto stage1 = [&](const Raw& w) { float e[4]; unpack4(w.re, e); *(LAS f32x4*)(lds + CS_E + (lt * 64 + k4) * 4) = (f32x4){e[0], e[1], e[2], e[3]}; };
        auto stage2 = [&](const Raw& w, int par) {
            LAS unsigned char* B = lds + par * CS_BUF;
            f32x4 cs = (f32x4){0.f, 0.f, 0.f, 0.f};
#pragma unroll
            for (int i = 0; i < 16; ++i) { const f32x4 ev = *(const LAS f32x4*)(lds + CS_E + (i * 64 + k4) * 4); const float mk = cmask[i]; cs[0] = fmaf(mk, ev[0], cs[0]); cs[1] = fmaf(mk, ev[1], cs[1]); cs[2] = fmaf(mk, ev[2], cs[2]); cs[3] = fmaf(mk, ev[3], cs[3]); }
            float e[4], kk[4], a[4], kc[4], r[4]; unpack4(w.re, e); unpack4(w.rk, kk); unpack4(w.ra, a); unpack4(w.rkc, kc); unpack4(w.rr_, r);
            float tkk[4], tr[4], tkd[4], tka[4]; f32x4 g;
#pragma unroll
            for (int i = 0; i < 4; ++i) { g[i] = __builtin_amdgcn_exp2f(-cs[i]); const float gi = __builtin_amdgcn_exp2f(cs[i]), gp = __builtin_amdgcn_exp2f(e[i] - cs[i]);
                tkk[i] = kk[i] * gp; tr[i] = r[i] * g[i]; tkd[i] = kc[i] * (1.f + (a[i] - 1.f) * ka4[i]) * gi; tka[i] = kk[i] * a[i] * gi; }
            *(LAS u32x2*)(B + CS_TKK + lt * CS_RS + posk * 2) = (u32x2){pk2(tkk[0], tkk[1]), pk2(tkk[2], tkk[3])};
            *(LAS u32x2*)(B + CS_TR + lt * CS_RS + posk * 2) = (u32x2){pk2(tr[0], tr[1]), pk2(tr[2], tr[3])};
            *(LAS u32x2*)(B + CS_TKD + lt * CS_RS + posk * 2) = (u32x2){pk2(tkd[0], tkd[1]), pk2(tkd[2], tkd[3])};
            *(LAS u32x2*)(B + CS_TKA + lt * CS_RS + posk * 2) = (u32x2){pk2(tka[0], tka[1]), pk2(tka[2], tka[3])};
            *(LAS u32x2*)(B + CS_TVN + (lt * 64 + k4) * 2) = w.rv;
            if (lt == 15) *(LAS f32x4*)(B + CS_G15 + k4 * 4) = g;
        };
        auto stage3 = [&](int par) {
            LAS unsigned char* B = lds + par * CS_BUF;
            {   const LAS unsigned char* ta = B + ((pw & 1) ? CS_TKA : CS_TKD) + c16 * CS_RS + q * 16; const LAS unsigned char* tb = B + ((pw & 2) ? CS_TR : CS_TKK) + c16 * CS_RS + q * 16;
                f32x4 m = (f32x4){0.f, 0.f, 0.f, 0.f};
                m = MFMA16(*(const LAS bf16x8*)ta, *(const LAS bf16x8*)tb, m); m = MFMA16(*(const LAS bf16x8*)(ta + 64), *(const LAS bf16x8*)(tb + 64), m);
#pragma unroll
                for (int i = 0; i < 4; ++i) { const int j = 4 * q + i; const bool keep = (pw & 2) ? (j <= c16) : (j < c16); m[i] = keep ? m[i] : 0.f; }
                if (pw == 0) { u32x2 w = {pk2(m[0], m[1]), pk2(m[2], m[3])}; *(LAS u32x2*)(B + CS_TBM + c16 * CS_RT + 8 * q) = w; }
                else if (pw == 1) *(LAS f32x4*)(B + CS_TCM + (c16 * 16 + 4 * q) * 4) = m;
                else if (pw == 2) { u32x2 w = {pk2(m[0], m[1]), pk2(m[2], m[3])}; *(LAS u32x2*)(B + CS_TBC + c16 * CS_RT + 8 * q) = w; }
                else { u32x2 w = {pk2(-m[0], -m[1]), pk2(-m[2], -m[3])}; *(LAS u32x2*)(B + CS_TBC + c16 * CS_RT + 32 + 8 * q) = w; } }
            if (pu < 192) { const bool isv = pu >= 128; const int kk_ = isv ? (pu - 128) : (pu >> 1), half = isv ? 0 : (pu & 1);
                const int pk_ = 32 * (kk_ >> 5) + 8 * (((kk_ & 31) >> 2) & 3) + 4 * ((kk_ & 31) >> 4) + (kk_ & 3);
                const LAS unsigned char* src = isv ? (B + CS_TVN + kk_ * 2) : (B + (half ? CS_TKA : CS_TKD) + pk_ * 2); const int sstr = isv ? 128 : CS_RS;
                unsigned w[8];
#pragma unroll
                for (int t2 = 0; t2 < 8; ++t2) { const unsigned lo = *(const LAS unsigned short*)(src + (2 * t2) * sstr), hi = *(const LAS unsigned short*)(src + (2 * t2 + 1) * sstr); w[t2] = (lo | (hi << 16)) ^ (half ? 0x80008000u : 0u); }
                LAS unsigned char* dst = isv ? (B + CS_TVS + kk_ * CS_RT) : (B + CS_TDA + kk_ * CS_RT + half * 32);
                *(LAS u32x4*)dst = (u32x4){w[0], w[1], w[2], w[3]}; *(LAS u32x4*)(dst + 16) = (u32x4){w[4], w[5], w[6], w[7]}; }
        };
        Raw ring[4]; ring[0] = gload(0); ring[1] = gload(1); ring[2] = gload(2); ring[3] = gload(3);
        stage1(ring[0]); lds_barrier();
        stage2(ring[0], 0); ring[0] = gload(4); lds_barrier();
        stage3(0); stage1(ring[1]); lds_barrier();
#pragma unroll 1
        for (int c4 = 0; c4 < CS_NCH; c4 += 4) {
#pragma unroll
            for (int ci = 0; ci < 4; ++ci) { const int c = c4 + ci;
                if (c + 1 < CS_NCH) { if (!(abl & 2)) stage2(ring[(ci + 1) & 3], (c + 1) & 1); if (c + 5 < CS_NCH && !(abl & 8)) ring[(ci + 1) & 3] = gload(c + 5); }
                lds_barrier();
                if (c + 1 < CS_NCH && !(abl & 4)) stage3((c + 1) & 1);
                lds_barrier();
                if (!(abl & 16)) {   const f32x4 yy = *(const LAS f32x4*)(lds + CS_YO + (lt * 64 + k4) * 4);
                    *(u32x2*)(OS + ((size_t)b * TT + tok(c * CS_C + lt)) * 512 + h * 64 + k4) = (u32x2){pk2(yy[0], yy[1]), pk2(yy[2], yy[3])}; }
                if (c + 2 < CS_NCH) stage1(ring[(ci + 2) & 3]);
                lds_barrier();
            }
        }
        __builtin_amdgcn_s_setprio(0);
    } else {
        const int v = 16 * wave + c16;
        f32x4 sT[4];
#pragma unroll
        for (int i = 0; i < 4; ++i) sT[i] = (f32x4){0.f, 0.f, 0.f, 0.f};
        lds_barrier(); lds_barrier(); lds_barrier();
#pragma unroll 1
        for (int c = 0; c < CS_NCH; ++c) {
            if (abl & 1) { lds_barrier(); lds_barrier(); lds_barrier(); continue; }
            const LAS unsigned char* B = lds + (c & 1) * CS_BUF;
            const LAS unsigned char* tvs = B + CS_TVS + v * CS_RT + q * 16;
            const bf16x8 fkk0 = *(const LAS bf16x8*)(B + CS_TKK + c16 * CS_RS + q * 16), fkk1 = *(const LAS bf16x8*)(B + CS_TKK + c16 * CS_RS + 64 + q * 16);
            const bf16x8 fbm = *(const LAS bf16x8*)(B + CS_TBM + c16 * CS_RT + q * 16), fv0 = *(const LAS bf16x8*)tvs;
            f32x4 cc[4][4], cin[4];
#pragma unroll
            for (int i = 0; i < 4; ++i) { cin[i] = *(const LAS f32x4*)(B + CS_TCM + ((4 * q + i) * 16 + 4 * q) * 4);
#pragma unroll
                for (int jj = 0; jj < 4; ++jj) cc[i][jj] = *(const LAS f32x4*)(B + CS_TCM + ((4 * q + i) * 16 + 4 * jj) * 4); }
            const bf16x8 fr0 = *(const LAS bf16x8*)(B + CS_TR + c16 * CS_RS + q * 16), fr1 = *(const LAS bf16x8*)(B + CS_TR + c16 * CS_RS + 64 + q * 16);
            const bf16x8 fbc = *(const LAS bf16x8*)(B + CS_TBC + c16 * CS_RT + q * 16);
            bf16x8 fda[4]; f32x4 gg[4];
#pragma unroll
            for (int rb = 0; rb < 4; ++rb) { fda[rb] = *(const LAS bf16x8*)(B + CS_TDA + (16 * rb + c16) * CS_RT + q * 16); gg[rb] = *(const LAS f32x4*)(B + CS_G15 + (16 * rb + 4 * q) * 4); }
            bf16x8 sf[2];
#pragma unroll
            for (int s2 = 0; s2 < 2; ++s2) { u32x4 w = {pk2(sT[2 * s2][0], sT[2 * s2][1]), pk2(sT[2 * s2][2], sT[2 * s2][3]), pk2(sT[2 * s2 + 1][0], sT[2 * s2 + 1][1]), pk2(sT[2 * s2 + 1][2], sT[2 * s2 + 1][3])}; sf[s2] = __builtin_bit_cast(bf16x8, w); }
            f32x4 x = (f32x4){0.f, 0.f, 0.f, 0.f};
            x = MFMA16(fkk0, sf[0], x); x = MFMA16(fkk1, sf[1], x); x = MFMA16(fbm, fv0, x);
            f32x4 yv = (f32x4){0.f, 0.f, 0.f, 0.f};
            yv = MFMA16(fr0, sf[0], yv); yv = MFMA16(fr1, sf[1], yv);
            f32x4 sa = (f32x4){0.f, 0.f, 0.f, 0.f};
#pragma unroll
            for (int q0 = 0; q0 < 4; ++q0) {
                f32x4 y; y[0] = x[0]; y[1] = x[1] - y[0] * cin[1][0]; y[2] = x[2] - y[0] * cin[2][0] - y[1] * cin[2][1]; y[3] = x[3] - y[0] * cin[3][0] - y[1] * cin[3][1] - y[2] * cin[3][2];
                if (q == q0) sa = y;
                if (q0 < 3) { const int src = (c16 + 16 * q0) << 2; const float b0 = bperm(y[0], src), b1 = bperm(y[1], src), b2 = bperm(y[2], src), b3 = bperm(y[3], src);
#pragma unroll
                    for (int i = 0; i < 4; ++i) x[i] -= b0 * cc[i][q0][0] + b1 * cc[i][q0][1] + b2 * cc[i][q0][2] + b3 * cc[i][q0][3]; }
            }
            lds_barrier();
            { u32x2 w = {pk2(sa[0], sa[1]), pk2(sa[2], sa[3])}; *(LAS u32x2*)(lds + (c & 1) * CS_BUF + CS_TVS + v * CS_RT + 32 + q * 8) = w; }
            const bf16x8 bvs = *(const LAS bf16x8*)tvs;
            yv = MFMA16(fbc, bvs, yv);
#pragma unroll
            for (int rb = 0; rb < 4; ++rb) sT[rb] = MFMA16(fda[rb], bvs, sT[rb]);
#pragma unroll
            for (int i = 0; i < 4; ++i) *(LAS float*)(lds + CS_YO + ((4 * q + i) * 64 + v) * 4) = yv[i];
            lds_barrier();
#pragma unroll
            for (int rb = 0; rb < 4; ++rb) sT[rb] *= gg[rb];
            lds_barrier();
        }
    }
    lds_barrier();
}

__device__ void ph_mix(const Params& p, int l, LAS unsigned char* lds, LAS unsigned* bcast, int dup) {
    unsigned* ctr = (unsigned*)(p.ws + OFF_CTR) + l * 64 + (dup ? 32 : 0);
    constexpr int N_SCAN = 64, N_LAT = 1024, N_CTX = 32;
    bool nm; { const int lane = otid() & 63; const float mq = wave_max(fabsf(p.q_norm_g[l * 64 + lane])), mk = wave_max(fabsf(p.k_norm_g[l * 64 + lane]));
        nm = __builtin_amdgcn_readfirstlane((8.f * 1.4426950408889634f * mq * mk <= 64.f) ? 1 : 0) != 0; }
    for (;;) {
        if (otid() == 0) *bcast = atomicAdd(ctr, 1u);
        __syncthreads();
        const int u = (int)*bcast;
        __syncthreads();
        if (u >= N_SCAN + N_LAT + N_CTX) break;
#ifdef PROBE_DMODE
        if (dup && PROBE_DMODE == 2 && u >= N_SCAN) break;
        if (dup && PROBE_DMODE == 3 && u < N_SCAN) continue;
#endif
        if (u < N_SCAN) scan_unit(p, l, lds, u, dup);
        else if (u < N_SCAN + N_LAT) { const int v = u - N_SCAN; const int qb = v & 31, m = (v >> 5) & 1, h = (v >> 6) & 3, b = v >> 8;
            if (PROBE_ATTN_ABL != 0 && dup) attn_unit<PROBE_ATTN_ABL, false>(p, lds, b, h, m, NCTX + qb * 256, TT / 64);
            else if (nm) attn_unit<0, true>(p, lds, b, h, m, NCTX + qb * 256, TT / 64); else attn_unit<0, false>(p, lds, b, h, m, NCTX + qb * 256, TT / 64); }
        else { const int v = u - N_SCAN - N_LAT; const int m = v & 1, h = (v >> 1) & 3, b = v >> 3; attn_unit<0, false>(p, lds, b, h, m, 0, NCTX / 64); }
    }
    if (!dup) { conv_expert_weights(p, l, lds); if (l + 1 < NL) conv_mixer_a(p, l + 1, lds); }
}
__device__ void ph_post(const Params& p, int l, int wg, int nwg) {
    const int tid = otid(), wave = tid >> 6, lane = tid & 63;
    const float lam_init = 0.8f - 0.6f * expf(-0.3f * (float)l);
    float lam;
    {   const float* lv = p.diff_lambda + l * 256; const float a = wave_sum(lv[lane] * lv[64 + lane]), c = wave_sum(lv[128 + lane] * lv[192 + lane]); lam = expf(a) - expf(c) + lam_init; }
    const bf16_t* OA0 = (const bf16_t*)(p.ws + OFF_OA); const bf16_t* OA1 = OA0 + (size_t)RR * 512;
    const bf16_t* OS0 = (const bf16_t*)(p.ws + OFF_OS); const bf16_t* OS1 = OS0 + (size_t)RR * 512;
    const bf16_t* YB0 = (const bf16_t*)(p.ws + OFF_YB0); const bf16_t* G = (const bf16_t*)(p.ws + OFF_G);
    bf16_t* YA = (bf16_t*)(p.ws + OFF_YA); bf16_t* YB = (bf16_t*)(p.ws + OFF_YB);
    float sg[8], lg[8];
#pragma unroll
    for (int i = 0; i < 8; ++i) { sg[i] = p.diff_subln_g[l * 128 + (lane & 15) * 8 + i] * (1.f - lam_init); lg[i] = p.rwkv_ln_g[l * 512 + lane * 8 + i]; }
    const int rstep = nwg * 8; int r = wg * 8 + wave;
    u32x4 la, lc, ly0, lgg, lo0, lo1;
    auto ldrow = [&](int rr) { const size_t o = (size_t)rr * 512 + lane * 8; la = *(const u32x4*)(OA0 + o); lc = *(const u32x4*)(OA1 + o); ly0 = *(const u32x4*)(YB0 + o); lgg = *(const u32x4*)(G + o); lo0 = *(const u32x4*)(OS0 + o); lo1 = *(const u32x4*)(OS1 + o); };
    if (r < RR) ldrow(r);
    while (r < RR) {
        const size_t o = (size_t)r * 512 + lane * 8;
        const u32x4 a = la, c = lc, y0 = ly0, gg = lgg, ov0 = lo0, ov1 = lo1;
        if (r + rstep < RR) ldrow(r + rstep);
        {   float v[8]; float ss = 0.f;
#pragma unroll
            for (int i = 0; i < 4; ++i) { v[2 * i] = bflo(a[i]) - lam * bflo(c[i]); v[2 * i + 1] = bfhi(a[i]) - lam * bfhi(c[i]); ss += v[2 * i] * v[2 * i] + v[2 * i + 1] * v[2 * i + 1]; }
            ss = allsum16(ss);
            const float rinv = rsqrtf(ss * (1.f / 128.f) + 1e-6f);
            u32x4 w;
#pragma unroll
            for (int i = 0; i < 4; ++i) w[i] = pk2(v[2 * i] * rinv * sg[2 * i], v[2 * i + 1] * rinv * sg[2 * i + 1]);
            *(u32x4*)(YA + o) = w; }
        {   float y[8];
#pragma unroll
            for (int i = 0; i < 4; ++i) { y[2 * i] = bflo(y0[i]); y[2 * i + 1] = bfhi(y0[i]); }
#pragma unroll
            for (int d = 0; d < 2; ++d) { const u32x4 ov = d ? ov1 : ov0; float v[8]; float sm = 0.f;
#pragma unroll
                for (int i = 0; i < 4; ++i) { v[2 * i] = bflo(ov[i]); v[2 * i + 1] = bfhi(ov[i]); sm += v[2 * i] + v[2 * i + 1]; }
                const float mu = allsum8(sm) * (1.f / 64.f); float sq = 0.f;
#pragma unroll
                for (int i = 0; i < 8; ++i) { v[i] -= mu; sq += v[i] * v[i]; }
                const float rinv = rsqrtf(allsum8(sq) * (1.f / 64.f) + 64e-5f);
#pragma unroll
                for (int i = 0; i < 8; ++i) y[i] += v[i] * rinv * lg[i]; }
            u32x4 w;
#pragma unroll
            for (int i = 0; i < 4; ++i) w[i] = pk2(y[2 * i] * bflo(gg[i]), y[2 * i + 1] * bfhi(gg[i]));
            *(u32x4*)(YB + o) = w; }
        r += rstep;
    }
}

template <int KSTEPS> DI void rows16_mma2(const bf16_t* arow, const bf16_t* brow, int ldb, f32x4 (&acc)[2]) {
#pragma unroll 1
    for (int k0 = 0; k0 < KSTEPS; k0 += 8) { bf16x8 a[8], b0[8], b1[8];
#pragma unroll
        for (int k = 0; k < 8; ++k) { a[k] = *(const bf16x8*)(arow + 32 * (k0 + k)); b0[k] = *(const bf16x8*)(brow + 32 * (k0 + k)); b1[k] = *(const bf16x8*)(brow + ldb + 32 * (k0 + k)); }
#pragma unroll
        for (int k = 0; k < 8; ++k) { acc[0] = MFMA16(a[k], b0[k], acc[0]); acc[1] = MFMA16(a[k], b1[k], acc[1]); } }
}
__device__ void ctx_merge_units(const Params& p, int wg, int nwg) {
    const int tid = otid(), wave = tid >> 6, lane = tid & 63, c16 = lane & 15, q = lane >> 4;
    const unsigned char* PG = p.ws + OFF_PG; bf16_t* M = (bf16_t*)(p.ws + OFF_M); const bf16_t* WBR = (const bf16_t*)(p.ws + OFF_WBR);
    for (int u = wg; u < 256; u += nwg) {
        const int rbk = u >> 2; const int r0 = (rbk >> 4) * TT + (rbk & 15) * 16; const int colw = (u & 3) * 256 + wave * 32 + c16 * 2;
        f32x4 tot[2] = {(f32x4){0.f, 0.f, 0.f, 0.f}, (f32x4){0.f, 0.f, 0.f, 0.f}};
#pragma unroll 1
        for (int br = 0; br < 3; ++br) {
            const bf16_t* Y = (const bf16_t*)(p.ws + (br == 0 ? OFF_YA : (br == 1 ? OFF_YB : OFF_YC)));
            f32x4 acc[2] = {(f32x4){0.f, 0.f, 0.f, 0.f}, (f32x4){0.f, 0.f, 0.f, 0.f}};
            rows16_mma2<16>(Y + (size_t)(r0 + c16) * 512 + 8 * q, WBR + ((size_t)br * 1024 + colw) * 512 + 8 * q, 512, acc);
#pragma unroll
            for (int i = 0; i < 4; ++i) { const unsigned g = *(const unsigned short*)(PG + (size_t)(r0 + 4 * q + i) * 3072 + br * 1024 + colw);
                tot[0][i] += (float)(g & 255u) * (1.f / 255.f) * acc[0][i]; tot[1][i] += (float)(g >> 8) * (1.f / 255.f) * acc[1][i]; }
        }
#pragma unroll
        for (int i = 0; i < 4; ++i) *(unsigned*)(M + (size_t)(r0 + 4 * q + i) * 1024 + colw) = pk2(tot[0][i], tot[1][i]);
    }
}
__device__ void ctx_out_units(const Params& p, int l, int wg, int nwg, float scale) {
    const int tid = otid(), wave = tid >> 6, lane = tid & 63, c16 = lane & 15, q = lane >> 4;
    const bf16_t* M = (const bf16_t*)(p.ws + OFF_M); const bf16_t* WOUT = (const bf16_t*)(p.ws + OFF_WOUT); float* X = (float*)(p.ws + OFF_X);
    const float* g1 = (const float*)(p.ws + OFF_MOD) + ((size_t)l * 5 + 4) * 6144 + 2 * 1024;
    for (int u = wg; u < 256; u += nwg) {
        const int rbk = u >> 2; const int r0 = (rbk >> 4) * TT + (rbk & 15) * 16; const int colw = (u & 3) * 256 + wave * 32 + c16 * 2;
        f32x4 acc[2] = {(f32x4){0.f, 0.f, 0.f, 0.f}, (f32x4){0.f, 0.f, 0.f, 0.f}};
        rows16_mma2<32>(M + (size_t)(r0 + c16) * 1024 + 8 * q, WOUT + (size_t)colw * 1024 + 8 * q, 1024, acc);
        const f32x2v gv = *(const f32x2v*)(g1 + colw);
#pragma unroll
        for (int i = 0; i < 4; ++i) { float* xp = X + (size_t)(r0 + 4 * q + i) * 1024 + colw; f32x2v xv = *(f32x2v*)xp;
            xv[0] += gv[0] * acc[0][i] * scale; xv[1] += gv[1] * acc[1][i] * scale; *(f32x2v*)xp = xv; }
    }
}

constexpr int RW_ES = 260, RW_QS = 16 * RW_ES;
__device__ void ph_norm2(const Params& p, int l, LAS unsigned char* lds, int wg, int nwg) {
    const int tid = otid(), wave = tid >> 6, lane = tid & 63;
    LAS float* RW = (LAS float*)lds;
    LAS float* hrow = RW + 4 * RW_QS + wave * 1024;
    {   const float* rw = p.router_w + (size_t)l * 1024 * 16;
        for (int i = tid; i < 16384; i += 512) { const int k = i >> 4, e = i & 15; RW[(k >> 8) * RW_QS + e * RW_ES + (k & 255)] = rw[i]; } }
    __syncthreads();
    const float* X = (const float*)(p.ws + OFF_X); bf16_t* H = (bf16_t*)(p.ws + OFF_H);
    const float* MOD = (const float*)(p.ws + OFF_MOD) + (size_t)l * 5 * 6144; const float* g = p.norm2_g + l * 1024;
    float* AFFL = (float*)(p.ws + OFF_AFFL); float* AFFC = (float*)(p.ws + OFF_AFFC); int* INV = (int*)(p.ws + OFF_INV);
    const int e = lane & 15, kq = lane >> 4;
    const int rstep = nwg * 8; int r = wg * 8 + wave;
    float4 v[4];
    if (r < RR) { const float4* xr = (const float4*)(X + (size_t)r * 1024);
#pragma unroll
        for (int i = 0; i < 4; ++i) v[i] = xr[lane + 64 * i]; }
    while (r < RR) {
        float4 vn[4];
        if (r + rstep < RR) { const float4* xr = (const float4*)(X + (size_t)(r + rstep) * 1024);
#pragma unroll
            for (int i = 0; i < 4; ++i) vn[i] = xr[lane + 64 * i]; }
        float ss = 0.f;
#pragma unroll
        for (int i = 0; i < 4; ++i) ss += v[i].x * v[i].x + v[i].y * v[i].y + v[i].z * v[i].z + v[i].w * v[i].w;
        ss = wave_sum(ss);
        const float rinv = rsqrtf(ss * (1.f / 1024.f) + 1e-6f);
        const int b = r / TT, s_ = r - b * TT; const float* md = MOD + (s_ < NCTX ? 4 : b) * 6144;
        float4 ggv[4], shv[4], scv[4];
#pragma unroll
        for (int i = 0; i < 4; ++i) { const int col = (lane + 64 * i) * 4; ggv[i] = *(const float4*)(g + col); shv[i] = *(const float4*)(md + 3 * 1024 + col); scv[i] = *(const float4*)(md + 4 * 1024 + col); }
#pragma unroll
        for (int i = 0; i < 4; ++i) { const int col = (lane + 64 * i) * 4;
            const float4 gg = ggv[i], sh = shv[i], sc = scv[i];
            f32x4 y; y[0] = v[i].x * rinv * gg.x * (1.f + sc.x) + sh.x; y[1] = v[i].y * rinv * gg.y * (1.f + sc.y) + sh.y; y[2] = v[i].z * rinv * gg.z * (1.f + sc.z) + sh.z; y[3] = v[i].w * rinv * gg.w * (1.f + sc.w) + sh.w;
            u32x2 w = {pk2(y[0], y[1]), pk2(y[2], y[3])}; *(u32x2*)(H + (size_t)r * 1024 + col) = w;
            *(LAS f32x4*)(hrow + col) = y; }
        f32x4 acc4 = (f32x4){0.f, 0.f, 0.f, 0.f}; const LAS float* hq = hrow + kq * 256; const LAS float* wq = RW + kq * RW_QS + e * RW_ES;
#pragma unroll 8
        for (int k = 0; k < 256; k += 4) acc4 += *(const LAS f32x4*)(hq + k) * *(const LAS f32x4*)(wq + k);
        float acc = (acc4[0] + acc4[1]) + (acc4[2] + acc4[3]);
        acc = sum_x32(sum_x16(acc));
        const float mx = allmax16(acc);
        const float ex = expf(acc - mx); const float sm = allsum16(ex);
        const float aff = ex / sm;
        if (lane < 16) { if (s_ < NCTX) AFFC[((size_t)(b * 16 + e)) * NCTX + s_] = aff; else AFFL[((size_t)(b * 16 + e)) * SEQ + (s_ - NCTX)] = aff;
            INV[(size_t)r * 16 + e] = -1; }
#pragma unroll
        for (int i = 0; i < 4; ++i) v[i] = vn[i];
        r += rstep;
    }
    __syncthreads();
}

DI void topk_unit(const Params& p, LAS unsigned char* lds, int u) {
    const int tid = otid(), wave = tid >> 6, lane = tid & 63;
    const bool lat = u < 64; const int v_ = lat ? u : u - 64; const int b = v_ >> 4, e = v_ & 15;
    const int n = lat ? SEQ : NCTX, cap = lat ? CAPL : CAPC;
    const float* aff = lat ? (const float*)(p.ws + OFF_AFFL) + ((size_t)(b * 16 + e)) * SEQ : (const float*)(p.ws + OFF_AFFC) + ((size_t)(b * 16 + e)) * NCTX;
    LAS unsigned* hist = (LAS unsigned*)lds;
    LAS unsigned* sh = hist + 256;
    unsigned long long key[16];
#pragma unroll
    for (int i = 0; i < 16; ++i) { const int idx = tid + 512 * i; key[i] = (idx < n) ? (((unsigned long long)__float_as_uint(aff[idx]) << 13) | (unsigned long long)(8191 - idx)) : 0ull; }
    unsigned long long prefix = 0ull, mask = 0ull; unsigned need = (unsigned)cap;
#pragma unroll 1
    for (int shift = 40; shift >= 0; shift -= 8) {
        if (tid < 256) hist[tid] = 0u;
        if (tid == 0) sh[2] = 0u;
        __syncthreads();
#pragma unroll
        for (int i = 0; i < 16; ++i) if (tid + 512 * i < n && (key[i] & mask) == prefix) __hip_atomic_fetch_add(&hist[(unsigned)(key[i] >> shift) & 255u], 1u, __ATOMIC_RELAXED, __HIP_MEMORY_SCOPE_WORKGROUP);
        __syncthreads();
        if (wave == 0) {
            unsigned loc[4]; unsigned ls = 0;
#pragma unroll
            for (int j = 0; j < 4; ++j) { loc[j] = hist[255 - 4 * lane - j]; ls += loc[j]; }
            unsigned incl = ls;
#pragma unroll
            for (int o = 1; o < 64; o <<= 1) { const unsigned t = (unsigned)__builtin_amdgcn_ds_bpermute((lane - o) << 2, (int)incl); if (lane >= o) incl += t; }
            const unsigned long long bal = __ballot(incl >= need);
            const int first = __ffsll((long long)bal) - 1;
            if (lane == first) { unsigned run = incl - ls; int bin = 255 - 4 * lane; unsigned above = run;
#pragma unroll
                for (int j = 0; j < 4; ++j) { if (run + loc[j] >= need) { bin = 255 - 4 * lane - j; above = run; break; } run += loc[j]; }
                sh[0] = (unsigned)bin; sh[1] = above; }
        }
        __syncthreads();
        prefix |= ((unsigned long long)sh[0]) << shift; mask |= 255ull << shift; need -= sh[1];
        __syncthreads();
    }
    int* SROW = (int*)(p.ws + OFF_SROW); float* SGATE = (float*)(p.ws + OFF_SGATE); int* INV = (int*)(p.ws + OFF_INV);
    const int sb = lat ? b * CAPL : 4 * CAPL + b * CAPC;
#pragma unroll
    for (int i = 0; i < 16; ++i) { const int idx = tid + 512 * i;
        if (idx < n && key[i] >= prefix) { const unsigned pos = __hip_atomic_fetch_add(&sh[2], 1u, __ATOMIC_RELAXED, __HIP_MEMORY_SCOPE_WORKGROUP); const int slot = sb + (int)pos; const int row = b * TT + (lat ? NCTX + idx : idx);
            SROW[e * ESLOT + slot] = row; SGATE[e * ESLOT + slot] = __uint_as_float((unsigned)(key[i] >> 13)); INV[(size_t)row * 16 + e] = slot; } }
    if (lat && b == 0 && tid < 128) { SROW[e * ESLOT + 4 * CAPL + 4 * CAPC + tid] = -1; SGATE[e * ESLOT + 4 * CAPL + 4 * CAPC + tid] = 0.f; }
    __syncthreads();
}
__device__ void ph_topk(const Params& p, LAS unsigned char* lds, int wg, int nwg) { for (int u = wg; u < 128; u += nwg) topk_unit(p, lds, u); }

__device__ void ph_gather(const Params& p, int wg, int nwg) {
    const int tid = otid(), wave = tid >> 6, lane = tid & 63;
    const int* SROW = (const int*)(p.ws + OFF_SROW); const bf16_t* H = (const bf16_t*)(p.ws + OFF_H); unsigned char* XG = p.ws + OFF_XG;
    const int step = nwg * 8; int i = wg * 8 + wave;
    u32x4 a = {0u, 0u, 0u, 0u}, c = {0u, 0u, 0u, 0u};
    auto ld = [&](int ii) { const int row = SROW[ii]; a = (u32x4){0u, 0u, 0u, 0u}; c = a; if (row >= 0) { const u32x4* src = (const u32x4*)(H + (size_t)row * 1024); a = src[2 * lane]; c = src[2 * lane + 1]; } };
    if (i < EROWS) ld(i);
    while (i < EROWS) {
        const u32x4 ca = a, cc = c;
        if (i + step < EROWS) ld(i + step);
        u32x4 w;
#pragma unroll
        for (int j = 0; j < 2; ++j) { w[j] = pk4_fp8(bflo(ca[2 * j]), bfhi(ca[2 * j]), bflo(ca[2 * j + 1]), bfhi(ca[2 * j + 1])); w[2 + j] = pk4_fp8(bflo(cc[2 * j]), bfhi(cc[2 * j]), bflo(cc[2 * j + 1]), bfhi(cc[2 * j + 1])); }
        *(u32x4*)(XG + (size_t)i * 1024 + lane * 16) = w;
        i += step;
    }
}

__device__ void ph_combine(const Params& p, int l, int wg, int nwg, float scale) {
    const int tid = otid(), wave = tid >> 6, lane = tid & 63;
    const int* INV = (const int*)(p.ws + OFF_INV); const float* SGATE = (const float*)(p.ws + OFF_SGATE); const bf16_t* OUT = (const bf16_t*)(p.ws + OFF_OUT);
    float* X = (float*)(p.ws + OFF_X); const float* MOD = (const float*)(p.ws + OFF_MOD) + (size_t)l * 5 * 6144; bf16_t* H = (bf16_t*)(p.ws + OFF_H);
    const bool nxt = (l + 1 < NL) && (scale != 0.f), last = (l + 1 == NL) && (scale != 0.f); const float* g1n = p.norm1_g + (nxt ? (l + 1) : l) * 1024; const float* MODN = MOD + (nxt ? 5 * 6144 : 0);
    for (int r = wg * 8 + wave; r < RR; r += nwg * 8) {
        const u32x4* iv = (const u32x4*)(INV + (size_t)r * 16); const u32x4 sl0 = iv[0], sl1 = iv[1], sl2 = iv[2], sl3 = iv[3];
        const int mi = row_mod(r); const float* g2 = MOD + mi * 6144 + 5 * 1024; float* xr = X + (size_t)r * 1024; const float* md = MODN + mi * 6144;
        f32x4 xv[4], gv[4], ggv[4], shv[4], scv[4];
#pragma unroll
        for (int j = 0; j < 4; ++j) { const int col = (j >> 1) * 512 + lane * 8 + 4 * (j & 1); xv[j] = *(const f32x4*)(xr + col); gv[j] = *(const f32x4*)(g2 + col);
            if (nxt) { ggv[j] = *(const f32x4*)(g1n + col); shv[j] = *(const f32x4*)(md + col); scv[j] = *(const f32x4*)(md + 1024 + col); } }
        float acc[16];
#pragma unroll
        for (int i = 0; i < 16; ++i) acc[i] = 0.f;
#pragma unroll
        for (int e = 0; e < 16; ++e) { const int slot = (int)(e < 4 ? sl0[e & 3] : (e < 8 ? sl1[e & 3] : (e < 12 ? sl2[e & 3] : sl3[e & 3])));
            if (slot >= 0) { const float gt = SGATE[e * ESLOT + slot]; const u32x4* src = (const u32x4*)(OUT + ((size_t)(e * ESLOT + slot)) * 1024);
                const u32x4 a = src[lane], c = src[64 + lane];
#pragma unroll
                for (int i = 0; i < 4; ++i) { acc[2 * i] += gt * bflo(a[i]); acc[2 * i + 1] += gt * bfhi(a[i]); acc[8 + 2 * i] += gt * bflo(c[i]); acc[9 + 2 * i] += gt * bfhi(c[i]); } } }
        float* orow = p.out + ((size_t)(mi & 3) * SEQ + (size_t)(r - (r / TT) * TT - NCTX)) * 1024;
        float ss = 0.f;
#pragma unroll
        for (int j = 0; j < 4; ++j)
#pragma unroll
            for (int i = 0; i < 4; ++i) { xv[j][i] += gv[j][i] * acc[(j >> 1) * 8 + (j & 1) * 4 + i] * scale; ss += xv[j][i] * xv[j][i]; }
        float y[16]; float inv = 0.f, am = 0.f;
        if (nxt) { ss = wave_sum(ss); const float rinv = rsqrtf(ss * (1.f / 1024.f) + 1e-6f);
#pragma unroll
            for (int j = 0; j < 4; ++j)
#pragma unroll
                for (int i = 0; i < 4; ++i) { const float t = xv[j][i] * rinv * ggv[j][i] * (1.f + scv[j][i]) + shv[j][i]; y[j * 4 + i] = t; am = fmaxf(am, fabsf(t)); }
            am = fmaxf(wave_max(am), 1e-20f); inv = 127.f / am; }
#pragma unroll
        for (int j = 0; j < 4; ++j) { const int col = (j >> 1) * 512 + lane * 8 + 4 * (j & 1);
            if (last) { if (mi < 4) *(f32x4*)(orow + col) = xv[j]; } else *(f32x4*)(xr + col) = xv[j]; }
        if (nxt) { if (lane == 0) ((float*)(p.ws + OFF_SH))[r] = am * (1.f / 127.f);
#pragma unroll
            for (int hh = 0; hh < 2; ++hh) { u32x2 w = {pk4_i8(y[hh * 8] * inv, y[hh * 8 + 1] * inv, y[hh * 8 + 2] * inv, y[hh * 8 + 3] * inv), pk4_i8(y[hh * 8 + 4] * inv, y[hh * 8 + 5] * inv, y[hh * 8 + 6] * inv, y[hh * 8 + 7] * inv)};
                *(u32x2*)((unsigned char*)H + (size_t)r * 1024 + hh * 512 + lane * 8) = w; } }
    }
}
__device__ void ph_output(const Params& p, int wg, int nwg) {
    const float4* X4 = (const float4*)(p.ws + OFF_X); float4* O4 = (float4*)p.out;
    const size_t n4 = (size_t)NB * SEQ * 256;
    for (size_t i = (size_t)wg * 512 + otid(); i < n4; i += (size_t)nwg * 512) { const size_t row = i >> 8; const size_t b = row / SEQ, t = row - b * SEQ; O4[i] = X4[(b * TT + NCTX + t) * 256 + (i & 255)]; }
}
constexpr int LDS_BYTES = 131072 + 256;
enum { PH_PROLOGUE = 0, PH_A, PH_B, PH_C, PH_D, PH_E, PH_F, PH_G, PH_H, PH_I, PH_J, PH_K, PH_L, PH_M, PH_OUT };

#ifndef PROBE_NOST
#define PROBE_NOST 0
#endif
template <int PH> DI void run_phase(const Params& pin, int l, LAS unsigned char* lds, int wg_in, int nwg, int dup = 0) {
    int wg = wg_in; asm volatile("" : "+s"(wg));
    Params p = pin; { unsigned long long w = (unsigned long long)pin.ws; asm volatile("" : "+s"(w)); p.ws = (unsigned char*)(__attribute__((address_space(1))) unsigned char*)w; }
    if constexpr (PH == PH_PROLOGUE) { ph_prologue(p, lds, wg, nwg); conv_mixer_b(p, 0, lds, wg, nwg); conv_mixer_a(p, 0, lds); }
    if constexpr (PH == PH_A) { norm1_rows(p, l, wg, nwg); }
    if constexpr (PH == PH_B) { int kq = 512; asm volatile("" : "+s"(kq));
        pg8::Gemm g{(const bf16_t*)(p.ws + OFF_H), (const bf16_t*)(p.ws + OFF_WIN), RR, NIN, kq}; SchedPlain S; S.init(RR / 256, NIN / 256, nwg, wg); EpiInProj E{p.ws, (PROBE_NOST && dup) ? 1 : 0};
        pg8::gemm_phase<EpiInProj, SchedPlain, false, 2>(lds, g, S, E, nullptr); }
    if constexpr (PH == PH_C) ph_prep(p, l, lds, wg, nwg, dup);
    if constexpr (PH == PH_D) ph_mix(p, l, lds, (LAS unsigned*)(lds + 131072 + 64), dup);
    if constexpr (PH == PH_E) ph_post(p, l, wg, nwg);
    if constexpr (PH == PH_F) { pg8::Gemm g{(const bf16_t*)(p.ws + OFF_YA), (const bf16_t*)(p.ws + OFF_WBR), RR, 1024, 512}; SchedMerge S; S.init(nwg, wg); EpiMerge E{p.ws, (PROBE_NOST == 3 && dup) ? 1 : 0};
        pg8::gemm_phase<EpiMerge, SchedMerge>(lds, g, S, E, nullptr); ctx_merge_units(p, wg, nwg); }
    if constexpr (PH == PH_G) { pg8::Gemm g{(const bf16_t*)(p.ws + OFF_M), (const bf16_t*)(p.ws + OFF_WOUT), RR, 1024, 1024}; SchedLat S; S.init(nwg, wg); EpiOut E{p.ws, l, dup ? 0.f : 1.f};
        pg8::gemm_phase<EpiOut, SchedLat>(lds, g, S, E, nullptr); ctx_out_units(p, l, wg, nwg, dup ? 0.f : 1.f); }
    if constexpr (PH == PH_H) { if (!dup) { conv_expert_weights(p, l, lds); if (l + 1 < NL) { conv_mixer_b(p, l + 1, lds, wg, nwg); conv_mixer_a(p, l + 1, lds); } } ph_norm2(p, l, lds, wg, nwg); }
    if constexpr (PH == PH_I) ph_topk(p, lds, wg, nwg);
    if constexpr (PH == PH_J) ph_gather(p, wg, nwg);
    if constexpr (PH == PH_K) { int kq = 512; asm volatile("" : "+s"(kq));
        pg8::Gemm g{(const bf16_t*)(p.ws + OFF_XG), (const bf16_t*)(p.ws + OFF_W13), EROWS, 2048, kq}; SchedMoe<8> S; S.init(nwg, wg); EpiUp E{p.ws};
        pg8::gemm_phase<EpiUp, SchedMoe<8>, false, 1>(lds, g, S, E, nullptr); }
    if constexpr (PH == PH_L) { int kq = 512; asm volatile("" : "+s"(kq));
        pg8::Gemm g{(const bf16_t*)(p.ws + OFF_HID), (const bf16_t*)(p.ws + OFF_W2), EROWS, 1024, kq}; SchedMoe<4> S; S.init(nwg, wg); EpiDown E{p.ws};
        pg8::gemm_phase<EpiDown, SchedMoe<4>, false, 1>(lds, g, S, E, nullptr); }
    if constexpr (PH == PH_M) ph_combine(p, l, wg, nwg, dup ? 0.f : 1.f);
    if constexpr (PH == PH_OUT) { conv_expert_weights(p, l, lds, 32); if (l + 1 < NL) conv_mixer_b(p, l + 1, lds, wg, nwg); }
}

DI void grid_barrier(const Params& p, LAS unsigned* xbw) {
    unsigned long long w = (unsigned long long)p.ws; asm volatile("" : "+s"(w));
    XcdBarrier b; b.bar = (unsigned*)(__attribute__((address_space(1))) unsigned*)(w + OFF_BAR); b.x = xb_xcc_id(); b.st = (volatile LAS unsigned*)xbw; xcd_barrier(b);
}
#ifndef PROBE_MASK
#define PROBE_MASK 0u
#endif
#ifndef MEGA
#define MEGA 1
#endif
#if !MEGA
template <int PH> __global__ __launch_bounds__(512, 2) void k_phase(Params p, int l) {
    extern __shared__ __attribute__((aligned(16))) unsigned char shm[];
    run_phase<PH>(p, l, (LAS unsigned char*)shm, blockIdx.x, gridDim.x);
}
template <int PH> static void launch_phase(const Params& p, int l, int grid, hipStream_t st) {
    static bool attr = false;
    if (!attr) { (void)hipFuncSetAttribute((const void*)k_phase<PH>, hipFuncAttributeMaxDynamicSharedMemorySize, LDS_BYTES); attr = true; }
    hipLaunchKernelGGL(k_phase<PH>, dim3(grid), dim3(512), LDS_BYTES, st, p, l);
}
#else
__global__ __launch_bounds__(512, 2) void k_mega(Params p) {
    extern __shared__ __attribute__((aligned(16))) unsigned char shm[];
    LAS unsigned char* lds = (LAS unsigned char*)shm;
    LAS unsigned* xbw = (LAS unsigned*)(lds + 131072);
    if (threadIdx.x < 4) xbw[threadIdx.x] = 0u;
    __syncthreads();
    (void)xcd_barrier_post((unsigned*)(p.ws + OFF_BAR), (volatile LAS unsigned*)xbw);
    const int wg = blockIdx.x, nwg = gridDim.x;
    run_phase<PH_PROLOGUE>(p, 0, lds, wg, nwg); grid_barrier(p, xbw);
    if (PROBE_MASK & (1u << PH_PROLOGUE)) { run_phase<PH_PROLOGUE>(p, 0, lds, wg, nwg); grid_barrier(p, xbw); }
#pragma unroll 1
    for (int l = 0; l < NL; ++l) {
        if (l == 0) { run_phase<PH_A>(p, l, lds, wg, nwg); grid_barrier(p, xbw); }
        if (l == 0 && (PROBE_MASK & (1u << PH_A))) { run_phase<PH_A>(p, l, lds, wg, nwg); grid_barrier(p, xbw); }
        run_phase<PH_B>(p, l, lds, wg, nwg); grid_barrier(p, xbw);
        if (PROBE_MASK & (1u << PH_B)) { run_phase<PH_B>(p, l, lds, wg, nwg, 1); grid_barrier(p, xbw); }
        run_phase<PH_C>(p, l, lds, wg, nwg); grid_barrier(p, xbw);
        if (PROBE_MASK & (1u << PH_C)) { run_phase<PH_C>(p, l, lds, wg, nwg, 1); grid_barrier(p, xbw); }
        run_phase<PH_D>(p, l, lds, wg, nwg); grid_barrier(p, xbw);
        if (PROBE_MASK & (1u << PH_D)) { run_phase<PH_D>(p, l, lds, wg, nwg, 1); grid_barrier(p, xbw); }
        run_phase<PH_E>(p, l, lds, wg, nwg); grid_barrier(p, xbw);
        if (PROBE_MASK & (1u << PH_E)) { run_phase<PH_E>(p, l, lds, wg, nwg, 1); grid_barrier(p, xbw); }
        run_phase<PH_F>(p, l, lds, wg, nwg); grid_barrier(p, xbw);
        if (PROBE_MASK & (1u << PH_F)) { run_phase<PH_F>(p, l, lds, wg, nwg, 1); grid_barrier(p, xbw); }
        run_phase<PH_G>(p, l, lds, wg, nwg); grid_barrier(p, xbw);
        if (PROBE_MASK & (1u << PH_G)) { run_phase<PH_G>(p, l, lds, wg, nwg, 1); grid_barrier(p, xbw); }
        run_phase<PH_H>(p, l, lds, wg, nwg); grid_barrier(p, xbw);
        if (PROBE_MASK & (1u << PH_H)) { run_phase<PH_H>(p, l, lds, wg, nwg, 1); grid_barrier(p, xbw); }
        if (PROBE_MASK & (1u << PH_OUT)) { run_phase<PH_OUT>(p, l, lds, wg, nwg, 1); grid_barrier(p, xbw); }
        run_phase<PH_I>(p, l, lds, wg, nwg); grid_barrier(p, xbw);
        if (PROBE_MASK & (1u << PH_I)) { run_phase<PH_I>(p, l, lds, wg, nwg, 1); grid_barrier(p, xbw); }
        run_phase<PH_J>(p, l, lds, wg, nwg); grid_barrier(p, xbw);
        if (PROBE_MASK & (1u << PH_J)) { run_phase<PH_J>(p, l, lds, wg, nwg, 1); grid_barrier(p, xbw); }
        run_phase<PH_K>(p, l, lds, wg, nwg); grid_barrier(p, xbw);
        if (PROBE_MASK & (1u << PH_K)) { run_phase<PH_K>(p, l, lds, wg, nwg, 1); grid_barrier(p, xbw); }
        run_phase<PH_L>(p, l, lds, wg, nwg); grid_barrier(p, xbw);
        if (PROBE_MASK & (1u << PH_L)) { run_phase<PH_L>(p, l, lds, wg, nwg, 1); grid_barrier(p, xbw); }
        run_phase<PH_M>(p, l, lds, wg, nwg); grid_barrier(p, xbw);
        if (PROBE_MASK & (1u << PH_M)) { run_phase<PH_M>(p, l, lds, wg, nwg, 1); grid_barrier(p, xbw); }
    }
}
#endif

extern "C" void kernel_launch(void* const* d_in, const int* in_sizes, int n_in, void* d_out, int out_size, void* d_ws, size_t ws_size, hipStream_t stream) {
    if (n_in < 31 || ws_size < WS_NEEDED) return;
    Params p{};
    const float** f = (const float**)&p;
    for (int i = 0; i < 31; ++i) f[i] = (const float*)d_in[i];
    p.out = (float*)d_out; p.ws = (unsigned char*)d_ws;
    (void)hipMemsetAsync(d_ws, 0, 65536, stream);
#if !MEGA
    const int G = 256;
    launch_phase<PH_PROLOGUE>(p, 0, G, stream);
    for (int l = 0; l < NL; ++l) {
        launch_phase<PH_A>(p, l, G, stream); launch_phase<PH_B>(p, l, G, stream); launch_phase<PH_C>(p, l, G, stream); launch_phase<PH_D>(p, l, G, stream);
        launch_phase<PH_E>(p, l, G, stream); launch_phase<PH_F>(p, l, G, stream); launch_phase<PH_G>(p, l, G, stream); launch_phase<PH_H>(p, l, G, stream);
        launch_phase<PH_I>(p, l, G, stream); launch_phase<PH_J>(p, l, G, stream); launch_phase<PH_K>(p, l, G, stream); launch_phase<PH_L>(p, l, G, stream);
        launch_phase<PH_M>(p, l, G, stream);
    }
    launch_phase<PH_OUT>(p, 0, G, stream);
#else
    static int grid = 0;
    if (!grid) {
        (void)hipFuncSetAttribute((const void*)k_mega, hipFuncAttributeMaxDynamicSharedMemorySize, LDS_BYTES);
        int dev = 0, cus = 0, per_cu = 0; (void)hipGetDevice(&dev); (void)hipDeviceGetAttribute(&cus, hipDeviceAttributeMultiprocessorCount, dev);
        (void)hipOccupancyMaxActiveBlocksPerMultiprocessor(&per_cu, (const void*)k_mega, 512, LDS_BYTES);
        grid = cus * (per_cu < 1 ? per_cu : 1);
    }
    if (grid <= 0) return;
    hipLaunchKernelGGL(k_mega, dim3(grid), dim3(512), LDS_BYTES, stream, p);
#endif
}
```

```cpp
#include <hip/hip_runtime.h>
#include <stdint.h>

#define LAS __attribute__((address_space(3)))
typedef unsigned short bf16_t;
typedef short bf16x8 __attribute__((ext_vector_type(8)));
typedef float f32x4 __attribute__((ext_vector_type(4)));
typedef float f32x16 __attribute__((ext_vector_type(16)));
typedef float f32x2v __attribute__((ext_vector_type(2)));
typedef __bf16 bf16x2v __attribute__((ext_vector_type(2)));
typedef unsigned u32x4 __attribute__((ext_vector_type(4)));
typedef unsigned u32x2 __attribute__((ext_vector_type(2)));

#define DI __device__ __forceinline__
DI int otid() { int t = threadIdx.x; asm volatile("" : "+v"(t)); return t; }
DI float bf2f(bf16_t v) { return __uint_as_float(((unsigned)v) << 16); }
DI float bflo(unsigned w) { return __uint_as_float(w << 16); }
DI float bfhi(unsigned w) { return __uint_as_float(w & 0xffff0000u); }
DI unsigned pk2(float a, float b) { f32x2v v = {a, b}; return __builtin_bit_cast(unsigned, __builtin_convertvector(v, bf16x2v)); }
DI unsigned pk4_fp8(float a, float b, float c, float d) { unsigned w = 0; w = __builtin_amdgcn_cvt_pk_fp8_f32(a, b, w, false); w = __builtin_amdgcn_cvt_pk_fp8_f32(c, d, w, true); return w; }
DI unsigned pk4_i8(float a, float b, float c, float d) { const int ia = (int)rintf(a), ib = (int)rintf(b), ic = (int)rintf(c), id = (int)rintf(d); return (unsigned)(ia & 255) | ((unsigned)(ib & 255) << 8) | ((unsigned)(ic & 255) << 16) | ((unsigned)id << 24); }
DI unsigned pk4_u8(float a, float b, float c, float d) { unsigned w = 0; w = __builtin_amdgcn_cvt_pk_u8_f32(a, 0, w); w = __builtin_amdgcn_cvt_pk_u8_f32(b, 1, w); w = __builtin_amdgcn_cvt_pk_u8_f32(c, 2, w); w = __builtin_amdgcn_cvt_pk_u8_f32(d, 3, w); return w; }
DI bf16_t f2bf(float a) { return (bf16_t)(pk2(a, 0.f) & 0xffffu); }
DI float sigmoidf_(float x) { return __builtin_amdgcn_rcpf(1.f + __expf(-x)); }
template <int CTRL> DI float dppmov(float x) { return __builtin_bit_cast(float, __builtin_amdgcn_update_dpp(0, __builtin_bit_cast(int, x), CTRL, 0xf, 0xf, true)); }
DI float allsum16(float x) { x += dppmov<0xB1>(x); x += dppmov<0x4E>(x); x += dppmov<0x141>(x); x += dppmov<0x140>(x); return x; }
DI float allsum8(float x) { x += dppmov<0xB1>(x); x += dppmov<0x4E>(x); x += dppmov<0x141>(x); return x; }
DI float allmax16(float x) { x = fmaxf(x, dppmov<0xB1>(x)); x = fmaxf(x, dppmov<0x4E>(x)); x = fmaxf(x, dppmov<0x141>(x)); x = fmaxf(x, dppmov<0x140>(x)); return x; }
DI float sum_x16(float x) { auto r = __builtin_amdgcn_permlane16_swap(__float_as_uint(x), __float_as_uint(x), false, false); return __uint_as_float(r[0]) + __uint_as_float(r[1]); }
DI float sum_x32(float x) { auto r = __builtin_amdgcn_permlane32_swap(__float_as_uint(x), __float_as_uint(x), false, false); return __uint_as_float(r[0]) + __uint_as_float(r[1]); }
DI float wave_sum(float v) { return sum_x32(sum_x16(allsum16(v))); }
DI float wave_max(float v) { v = allmax16(v); { auto r = __builtin_amdgcn_permlane16_swap(__float_as_uint(v), __float_as_uint(v), false, false); v = fmaxf(__uint_as_float(r[0]), __uint_as_float(r[1])); }
    { auto r = __builtin_amdgcn_permlane32_swap(__float_as_uint(v), __float_as_uint(v), false, false); v = fmaxf(__uint_as_float(r[0]), __uint_as_float(r[1])); } return v; }
DI float bperm(float v, int byte_addr) { return __builtin_bit_cast(float, __builtin_amdgcn_ds_bpermute(byte_addr, __builtin_bit_cast(int, v))); }

constexpr int NB = 4, SEQ = 8192, NCTX = 256, TT = SEQ + NCTX, RR = NB * TT, DM = 1024, NIN = 7936, NL = 4;
constexpr int NE = 16, CAPL = 1024, CAPC = 32, ESLOT = 4352, EROWS = NE * ESLOT;
static_assert(RR == 33792 && RR % 256 == 0 && EROWS % 256 == 0, "shape");

constexpr size_t MB1 = 1u << 20;
constexpr size_t alignup(size_t x) { return (x + MB1 - 1) / MB1 * MB1; }
constexpr size_t SZ_T = (size_t)RR * 512 * 2;
constexpr size_t OFF_BAR = 0;
constexpr size_t OFF_CTR = 32768;
constexpr size_t OFF_MOD = 65536;
constexpr size_t OFF_ROPE = OFF_MOD + (size_t)NL * 5 * 6144 * 4;
constexpr size_t OFF_AFFL = MB1;
constexpr size_t OFF_AFFC = OFF_AFFL + (size_t)4 * 16 * 8192 * 4;
constexpr size_t OFF_SROW = OFF_AFFC + (size_t)4 * 16 * 256 * 4;
constexpr size_t OFF_SGATE = OFF_SROW + (size_t)EROWS * 4;
constexpr size_t OFF_INV = OFF_SGATE + (size_t)EROWS * 4;
constexpr size_t OFF_LRW = OFF_INV + (size_t)RR * 16 * 4;
constexpr size_t OFF_SW = OFF_LRW + (size_t)(4 * 512 * 64 + 512 * 128) * 2;
constexpr size_t OFF_SH = OFF_SW + (size_t)NIN * 4;
constexpr size_t OFF_X = alignup(OFF_SH + (size_t)RR * 4);
constexpr size_t OFF_H = alignup(OFF_X + (size_t)RR * 1024 * 4);
constexpr size_t OFF_VT = OFF_H;
constexpr size_t OFF_YB0 = OFF_H + SZ_T;
constexpr size_t OFF_M = OFF_H;
constexpr size_t OFF_WIN = alignup(OFF_H + 2 * SZ_T);
constexpr size_t OFF_WBR = alignup(OFF_WIN + (size_t)NIN * 1024 * 2);
constexpr size_t OFF_WOUT = alignup(OFF_WBR + (size_t)3 * 1024 * 512 * 2);
constexpr size_t OFF_PA = alignup(OFF_WOUT + (size_t)1024 * 1024 * 2);
constexpr size_t OFF_PR = alignup(OFF_PA + (size_t)RR * 1536 * 2);
constexpr size_t OFF_PC = alignup(OFF_PR + (size_t)RR * 1792 * 2);
constexpr size_t OFF_PG = alignup(OFF_PC + (size_t)RR * 1536 * 2);
constexpr size_t OFF_PEND = alignup(OFF_PG + (size_t)RR * 3072 * 2);
constexpr size_t OFF_OS = OFF_PR;
constexpr size_t OFF_OA = OFF_OS + 2 * SZ_T;
constexpr size_t OFF_YA = alignup(OFF_OA + 2 * SZ_T);
constexpr size_t OFF_YB = alignup(OFF_YA + SZ_T);
static_assert(OFF_YB + SZ_T <= OFF_PG, "overlay");
constexpr size_t OFF_XG = OFF_PR;
constexpr size_t OFF_HID = alignup(OFF_XG + (size_t)EROWS * 1024);
constexpr size_t OFF_OUT = alignup(OFF_HID + (size_t)EROWS * 1024);
static_assert(OFF_OUT + (size_t)EROWS * 1024 * 2 <= OFF_PEND, "overlay");
constexpr size_t OFF_EW = OFF_PEND;
constexpr size_t OFF_AA = OFF_EW + 2 * SZ_T;
constexpr size_t OFF_KK = OFF_AA + 2 * SZ_T;
constexpr size_t OFF_KC = OFF_KK + SZ_T;
constexpr size_t OFF_RC = OFF_KC + SZ_T;
constexpr size_t OFF_VC = OFF_RC + SZ_T;
constexpr size_t OFF_YC = alignup(OFF_VC + SZ_T);
constexpr size_t OFF_G = alignup(OFF_YC + SZ_T);
constexpr size_t OFF_W13 = alignup(OFF_G + SZ_T);
constexpr size_t OFF_W2 = OFF_W13 + (size_t)16 * 2048 * 1024;
constexpr size_t WS_NEEDED = alignup(OFF_W2 + (size_t)16 * 1024 * 1024);
constexpr int YTILE = 262144;
static_assert((OFF_YB - OFF_YA) % YTILE == 0 && (OFF_YC - OFF_YA) % YTILE == 0 && OFF_YC > OFF_YA, "merge A tiles");

struct Params {
    const float *x, *c, *ctx, *c_ctx, *norm1_g, *norm2_g, *ada_w, *ada_b, *w_in, *q_norm_g, *k_norm_g, *diff_lambda, *diff_subln_g,
        *rwkv_conv_w, *rwkv_w0, *rwkv_w_up, *rwkv_a0, *rwkv_a_up, *rwkv_g_up, *rwkv_k_k, *rwkv_k_a, *rwkv_r_k, *rwkv_ln_g, *rwkv_ln_b,
        *conv_w, *w_branch, *w_out, *router_w, *exp_w1, *exp_w3, *exp_w2;
    float* out;
    unsigned char* ws;
};
#define XB_TMO      128
#define XB_XCNT(j)  (256  + 64 * (j))
#define XB_XSUB(j)  (1280 + 64 * (j))
#define XB_XGEN(j)  (2304 + 64 * (j))
#define XB_TOP      3328
#define XB_TOPGEN   3392
#define XCD_BAR_WORDS 3456
#define XB_SPIN_CAP (1u << 18)

__device__ __forceinline__ unsigned xb_ld(unsigned* p)              { return __hip_atomic_load(p, __ATOMIC_RELAXED, __HIP_MEMORY_SCOPE_AGENT); }
__device__ __forceinline__ unsigned xb_add(unsigned* p, unsigned v) { return __hip_atomic_fetch_add(p, v, __ATOMIC_RELAXED, __HIP_MEMORY_SCOPE_AGENT); }
__device__ __forceinline__ unsigned xb_xcc_id() { return (unsigned)__builtin_amdgcn_s_getreg((3 << 11) | 20) & 0xFu; }
#define XB_SPIN(cond, bar) do { unsigned _sp = 0; while (cond) { __builtin_amdgcn_s_sleep(1); \
    if ((++_sp & 255u) == 0u) { if (xb_ld(&(bar)[XB_TMO])) break; if (_sp > XB_SPIN_CAP) { atomicAdd(&(bar)[XB_TMO], 1u); break; } } } } while (0)

struct XcdBarrier {
    unsigned* bar; unsigned x;
    volatile LAS unsigned* st;
};

__device__ __forceinline__ XcdBarrier xcd_barrier_post(unsigned* bar, volatile LAS unsigned* st) {
    XcdBarrier b; b.bar = bar; b.x = xb_xcc_id(); b.st = st;
    if (threadIdx.x == 0) (void)xb_add(&bar[XB_XCNT(b.x)], 1u);
    return b;
}
__device__ __forceinline__ void xcd_barrier_complete(unsigned* bar, unsigned x, unsigned& nloc, unsigned& nx) {
    const unsigned G = gridDim.x * gridDim.y * gridDim.z;
    unsigned sum, cnt, mine, sp = 0u;
    for (;;) {
        sum = 0u; cnt = 0u; mine = 0u;
#pragma unroll
        for (unsigned j = 0; j < 16; ++j) { const unsigned c = xb_ld(&bar[XB_XCNT(j)]); sum += c; cnt += (c > 0u) ? 1u : 0u; mine = (j == x) ? c : mine; }
        if (sum == G) break;
        __builtin_amdgcn_s_sleep(1);
        if ((++sp & 255u) == 0u) { if (xb_ld(&bar[XB_TMO])) break; if (sp > XB_SPIN_CAP) { atomicAdd(&bar[XB_TMO], 1u); break; } }
    }
    nloc = mine > 0u ? mine : 1u; nx = cnt > 0u ? cnt : 1u;
}

__device__ __forceinline__ void xcd_barrier(const XcdBarrier& b) {
    asm volatile("s_waitcnt vmcnt(0)" ::: "memory");
    __syncthreads();
    if (threadIdx.x == 0) {
        unsigned* bar = b.bar;
        __builtin_amdgcn_s_waitcnt(0);
        unsigned nloc = b.st[0], nx = b.st[1];
        if (nloc == 0u) { xcd_barrier_complete(bar, b.x, nloc, nx); b.st[0] = nloc; b.st[1] = nx; }
        const unsigned old = xb_add(&bar[XB_XSUB(b.x)], 1u);
        const unsigned gen = old / nloc;
        if (old + 1u == (gen + 1u) * nloc) {
            __builtin_amdgcn_fence(__ATOMIC_RELEASE, "agent");
            asm volatile("s_waitcnt vmcnt(0)" ::: "memory");
            const unsigned og = xb_add(&bar[XB_TOP], 1u);
            const unsigned tg = og / nx;
            if (og + 1u == (tg + 1u) * nx) xb_add(&bar[XB_TOPGEN], 1u);
            else XB_SPIN(xb_ld(&bar[XB_TOPGEN]) == tg, bar);
            __builtin_amdgcn_fence(__ATOMIC_ACQUIRE, "agent");
            xb_add(&bar[XB_XGEN(b.x)], 1u);
            asm volatile("s_waitcnt vmcnt(0)" ::: "memory");
        } else {
            XB_SPIN(xb_ld(&bar[XB_XGEN(b.x)]) == gen, bar);
            __builtin_amdgcn_fence(__ATOMIC_ACQUIRE, "agent");
            asm volatile("s_waitcnt vmcnt(0)" ::: "memory");
        }
    }
    __syncthreads();
}
namespace pg8 {
#define PG8_LAS __attribute__((address_space(3)))
constexpr int BM = 256, BK = 64, HALF = 128, HTB = HALF * BK * 2  , STAGE_BYTES = 8 * HTB, NXCD = 8, WGM = 8;
__host__ __device__ __forceinline__ int lds_byte(int r, int c) { const int st = (r >> 4) * 2 + (c >> 5), rr = r & 15, cc = c & 31, ob = rr * 64 + cc * 2; return st * 1024 + (ob ^ (((ob >> 9) & 1) << 5)); }
__host__ __device__ __forceinline__ void stage_rc(int b, int& R, int& C) { const int st = b / 1024, sb = b % 1024, swz = sb ^ (((sb >> 9) & 1) << 5); R = (st >> 1) * 16 + swz / 64; C = (st & 1) * 32 + (swz % 64) / 2; }
__host__ __device__ __forceinline__ int perm32(int rho) { const int n = rho >> 4, i = rho & 15; return 8 * (i >> 2) + 4 * n + (i & 3); }
typedef int v4i_t __attribute__((ext_vector_type(4)));
typedef int v8i_t __attribute__((ext_vector_type(8)));
struct Unit { int pm, pn; int rt, ct, br; };
struct Gemm { const bf16_t* A; const bf16_t* Bt; int M, N, K; };
template <class Epi, class Sched, bool STAMP = false, int QM = 0>
__device__ __forceinline__ void gemm_phase(PG8_LAS unsigned char* lds, const Gemm g, const Sched& S, const Epi& E, unsigned long long* stamps) {
    const int tid = otid(), wid = __builtin_amdgcn_readfirstlane(tid >> 6), lane = tid & 63, wr = wid >> 2, wc = wid & 3, fr = lane & 15, fq = lane >> 4;
    const int K = g.K, nt = K / BK;
    int ts_lo = 0, ts_hi = 0, nts = 0; const unsigned long long rt_entry = STAMP ? (unsigned long long)wall_clock64() : 0ull;
#define PG8_STAMP() do { if (STAMP && wid == 0 && nts < 64) { const unsigned long long _c = (unsigned long long)clock64(); \
        ts_lo = (lane == nts) ? (int)(unsigned)_c : ts_lo; ts_hi = (lane == nts) ? (int)(unsigned)(_c >> 32) : ts_hi; ++nts; } } while (0)
    PG8_STAMP();
    unsigned voffA[2], voffB[2];
#pragma unroll
    for (int i = 0; i < 2; ++i) { int R, C; stage_rc(tid * 16 + i * 8192, R, C); const int Rb = Epi::PERM ? ((R & ~31) + perm32(R & 31)) : R;
        voffA[i] = (unsigned)(R * K + C) * 2u; voffB[i] = (unsigned)(Rb * K + C) * 2u; }
    const size_t kstep = (size_t)(BK * 2);
    const size_t hstep = (size_t)HALF * K * 2;
    const size_t tstep = 2 * hstep;
    const unsigned ldsw = (unsigned)wid * 1024u;
    const int aoff = lds_byte(wr * 64 + fr, fq * 8), boff = lds_byte(wc * 32 + fr, fq * 8);
#define PG8_SA(b, h) (((b) * 2 + (h)) * HTB)
#define PG8_SB(b, h) ((4 + (b) * 2 + (h)) * HTB)
#define PG8_STAGE(bufoff, gbase, voff) do { _Pragma("unroll") for (int _i = 0; _i < 2; ++_i) \
        __builtin_amdgcn_global_load_lds((const unsigned*)((const char*)(gbase) + (voff)[_i]), (PG8_LAS unsigned*)(lds + (bufoff) + ldsw + _i * 8192), 16, 0, 0); } while (0)
#define PG8_LDA(dst, b, h) do { _Pragma("unroll") for (int m = 0; m < 4; ++m) dst[m] = __builtin_shufflevector(*(const PG8_LAS v4i_t*)(lds + PG8_SA(b, h) + aoff + m * 2048), *(const PG8_LAS v4i_t*)(lds + PG8_SA(b, h) + aoff + m * 2048 + 1024), 0, 1, 2, 3, 4, 5, 6, 7); } while (0)
#define PG8_LDB(dst, b, h) do { _Pragma("unroll") for (int n = 0; n < 2; ++n) dst[n] = __builtin_shufflevector(*(const PG8_LAS v4i_t*)(lds + PG8_SB(b, h) + boff + n * 2048), *(const PG8_LAS v4i_t*)(lds + PG8_SB(b, h) + boff + n * 2048 + 1024), 0, 1, 2, 3, 4, 5, 6, 7); } while (0)
#define PG8_MMA(ai, bj, At, Bt) do { __builtin_amdgcn_s_setprio(1); \
        if constexpr (QM == 1) { _Pragma("unroll") for (int m = 0; m < 4; ++m) _Pragma("unroll") for (int n = 0; n < 2; ++n) \
            asm volatile("v_mfma_scale_f32_16x16x128_f8f6f4 %0, %1, %2, %0, %3, %3 op_sel_hi:[0,0,0]" : "+v"(acc[ai][bj][m][n]) : "v"(Bt[n]), "v"(At[m]), "v"(one_scale)); } \
        else if constexpr (QM == 2) { _Pragma("unroll") for (int m = 0; m < 4; ++m) _Pragma("unroll") for (int n = 0; n < 2; ++n) { v4i_t c_ = __builtin_bit_cast(v4i_t, acc[ai][bj][m][n]); \
            c_ = __builtin_amdgcn_mfma_i32_16x16x64_i8(__builtin_shufflevector(Bt[n], Bt[n], 0, 1, 2, 3), __builtin_shufflevector(At[m], At[m], 0, 1, 2, 3), c_, 0, 0, 0); \
            c_ = __builtin_amdgcn_mfma_i32_16x16x64_i8(__builtin_shufflevector(Bt[n], Bt[n], 4, 5, 6, 7), __builtin_shufflevector(At[m], At[m], 4, 5, 6, 7), c_, 0, 0, 0); acc[ai][bj][m][n] = __builtin_bit_cast(f32x4, c_); } } \
        else { _Pragma("unroll") for (int m = 0; m < 4; ++m) _Pragma("unroll") for (int n = 0; n < 2; ++n) { \
            acc[ai][bj][m][n] = __builtin_amdgcn_mfma_f32_16x16x32_bf16(__builtin_bit_cast(bf16x8, __builtin_shufflevector(Bt[n], Bt[n], 0, 1, 2, 3)), __builtin_bit_cast(bf16x8, __builtin_shufflevector(At[m], At[m], 0, 1, 2, 3)), acc[ai][bj][m][n], 0, 0, 0); \
            acc[ai][bj][m][n] = __builtin_amdgcn_mfma_f32_16x16x32_bf16(__builtin_bit_cast(bf16x8, __builtin_shufflevector(Bt[n], Bt[n], 4, 5, 6, 7)), __builtin_bit_cast(bf16x8, __builtin_shufflevector(At[m], At[m], 4, 5, 6, 7)), acc[ai][bj][m][n], 0, 0, 0); } } \
        __builtin_amdgcn_s_setprio(0); } while (0)
#define PG8_WAIT_V(n) asm volatile("s_waitcnt vmcnt(" #n ")" ::: "memory")
#define PG8_WAIT_L(n) asm volatile("s_waitcnt lgkmcnt(" #n ")" ::: "memory")
#define PG8_BAR __builtin_amdgcn_s_barrier()
#define PG8_SCHED __builtin_amdgcn_sched_barrier(0)
    Unit cur, nxt; int ui = 0;
    if (!S.next(0, cur)) return;
    f32x4 acc[2][2][4][2];
#pragma unroll
    for (int a = 0; a < 2; ++a)
#pragma unroll
        for (int b = 0; b < 2; ++b)
#pragma unroll
            for (int m = 0; m < 4; ++m)
#pragma unroll
                for (int n = 0; n < 2; ++n) acc[a][b][m][n] = (f32x4){0.f, 0.f, 0.f, 0.f};
    const int one_scale = 0x7f7f7f7f;
    v8i_t At[4], B0[2], B1[2];
    const char* cA = (const char*)g.A + (size_t)cur.pm * tstep; const char* cB = (const char*)g.Bt + (size_t)cur.pn * tstep;
    S.a_ready(cur);
    PG8_STAGE(PG8_SB(0, 0), cB, voffB); PG8_STAGE(PG8_SA(0, 0), cA, voffA); PG8_STAGE(PG8_SB(0, 1), cB + hstep, voffB); PG8_STAGE(PG8_SA(0, 1), cA + hstep, voffA);
    if (wr == 1) PG8_BAR;
    PG8_WAIT_V(4); PG8_BAR;
    PG8_STAGE(PG8_SB(1, 0), cB + kstep, voffB); PG8_STAGE(PG8_SA(1, 0), cA + kstep, voffA); PG8_STAGE(PG8_SB(1, 1), cB + hstep + kstep, voffB);
    PG8_WAIT_V(6); PG8_BAR;
    PG8_STAMP();
    for (;;) {
        const bool has_next = S.next(ui + 1, nxt);
        const char* nA = has_next ? (const char*)g.A + (size_t)nxt.pm * tstep : cA; const char* nB = has_next ? (const char*)g.Bt + (size_t)nxt.pn * tstep : cB;
        for (int t = 0; t < nt; t += 2) {
            const bool last = (t == nt - 2);
            const char* a1 = cA + (size_t)(t + 1) * kstep;
            const char* a2 = last ? nA : cA + (size_t)(t + 2) * kstep; const char* b2 = last ? nB : cB + (size_t)(t + 2) * kstep;
            const char* a3 = a2 + kstep; const char* b3 = b2 + kstep;
            if (last && has_next) S.a_ready(nxt);
            PG8_LDB(B0, 0, 0); PG8_SCHED; PG8_LDA(At, 0, 0); PG8_STAGE(PG8_SA(1, 1), a1 + hstep, voffA);
            PG8_WAIT_L(8); PG8_BAR; PG8_WAIT_L(0); PG8_MMA(0, 0, At, B0); PG8_BAR; PG8_SCHED;
            PG8_LDB(B1, 0, 1); PG8_STAGE(PG8_SB(0, 0), b2, voffB);
            PG8_BAR; PG8_WAIT_L(0); PG8_MMA(0, 1, At, B1); PG8_BAR;
            PG8_LDA(At, 0, 1); PG8_STAGE(PG8_SA(0, 0), a2, voffA);
            PG8_BAR; PG8_WAIT_L(0); PG8_MMA(1, 0, At, B0); PG8_BAR; PG8_SCHED;
            PG8_STAGE(PG8_SB(0, 1), b2 + hstep, voffB);
            PG8_WAIT_V(6); PG8_BAR; PG8_MMA(1, 1, At, B1); PG8_BAR;
            PG8_LDB(B0, 1, 0); PG8_SCHED; PG8_LDA(At, 1, 0); PG8_STAGE(PG8_SA(0, 1), a2 + hstep, voffA);
            PG8_WAIT_L(8); PG8_BAR; PG8_WAIT_L(0); PG8_MMA(0, 0, At, B0); PG8_BAR; PG8_SCHED;
            PG8_LDB(B1, 1, 1); PG8_STAGE(PG8_SB(1, 0), b3, voffB);
            PG8_BAR; PG8_WAIT_L(0); PG8_MMA(0, 1, At, B1); PG8_BAR;
            PG8_LDA(At, 1, 1); PG8_STAGE(PG8_SA(1, 0), a3, voffA);
            PG8_BAR; PG8_WAIT_L(0); PG8_MMA(1, 0, At, B0); PG8_BAR; PG8_SCHED;
            PG8_STAGE(PG8_SB(1, 1), b3 + hstep, voffB);
            PG8_WAIT_V(6); PG8_BAR; PG8_MMA(1, 1, At, B1); PG8_BAR;
        }
        PG8_STAMP();
        if constexpr (QM == 1) { asm volatile("s_nop 15\n\ts_nop 15" ::: "memory"); }
        if constexpr (!Epi::AFTER_DRAIN) { E(acc, cur, wr, wc, fr, fq); S.done(cur); }
        PG8_STAMP();
        if (!has_next) break;
        if (!Epi::keep_acc(cur)) {
#pragma unroll
        for (int a = 0; a < 2; ++a)
#pragma unroll
            for (int b = 0; b < 2; ++b)
#pragma unroll
                for (int m = 0; m < 4; ++m)
#pragma unroll
                    for (int n = 0; n < 2; ++n) acc[a][b][m][n] = (f32x4){0.f, 0.f, 0.f, 0.f};
        }
        cur = nxt; cA = nA; cB = nB; ++ui;
    }
    PG8_WAIT_V(0);
    if (wr == 0) PG8_BAR;
    PG8_BAR;
    if constexpr (Epi::AFTER_DRAIN) { E.fused(acc, cur, wr, wc, fr, fq, lds, wid, lane); S.done(cur); }
    PG8_STAMP();
    if (STAMP && wid == 0) { stamps[lane] = lane < nts ? (((unsigned long long)(unsigned)ts_hi << 32) | (unsigned)ts_lo) : 0ull;
        if (lane == 62) stamps[62] = rt_entry; if (lane == 63) stamps[63] = (unsigned long long)wall_clock64(); }
#undef PG8_STAMP
#undef PG8_SA
#undef PG8_SB
#undef PG8_STAGE
#undef PG8_LDA
#undef PG8_LDB
#undef PG8_MMA
#undef PG8_WAIT_V
#undef PG8_WAIT_L
#undef PG8_BAR
#undef PG8_SCHED
}
}
using pg8::Unit;

struct SchedPlain {
    int nM, nN, nwg, G, c;
    __device__ void init(int nM_, int nN_, int G_, int c_) { nM = nM_; nN = nN_; nwg = nM * nN; G = G_; c = c_; }
    __device__ bool next(int i, Unit& u) const {
        const long L = (long)i * G + c; if (L >= nwg) return false;
        int wgid = (int)L; { const int q = nwg / 8, r = nwg % 8, xcd = wgid % 8, off = wgid / 8; wgid = (xcd < r ? xcd * (q + 1) : r * (q + 1) + (xcd - r) * q) + off; }
        const int nig = 8 * nN, gid = wgid / nig, fm = gid * 8, gsz = (nM - fm) < 8 ? (nM - fm) : 8;
        u.pm = __builtin_amdgcn_readfirstlane(fm + ((wgid % nig) % gsz)); u.pn = __builtin_amdgcn_readfirstlane((wgid % nig) / gsz); u.rt = u.pm; u.ct = u.pn; u.br = 0; return true;
    }
    DI void a_ready(const Unit&) const {}
    DI void done(const Unit&) const {}
};
struct SchedMerge {
    int G, c, pmb1, pmb2;
    __device__ void init(int G_, int c_) { G = G_; c = (G_ % 8 == 0) ? ((c_ % 8) * (G_ / 8) + c_ / 8) : c_;
        pmb1 = (int)((OFF_YB - OFF_YA) / YTILE); pmb2 = (int)((OFF_YC - OFF_YA) / YTILE); }
    __device__ bool next(int i, Unit& u) const {
        const int tile = (i / 3) * G + c, br = i % 3; if (tile >= 512) return false;
        const int lp = tile >> 2; u.rt = __builtin_amdgcn_readfirstlane(lp + (lp >> 5) + 1); u.ct = __builtin_amdgcn_readfirstlane(tile & 3); u.br = __builtin_amdgcn_readfirstlane(br);
        u.pm = u.rt + (u.br == 0 ? 0 : (u.br == 1 ? pmb1 : pmb2)); u.pn = u.br * 4 + u.ct; return true;
    }
    DI void a_ready(const Unit&) const {}
    DI void done(const Unit&) const {}
};
struct SchedLat {
    int G, c;
    __device__ void init(int G_, int c_) { G = G_; c = (G_ % 8 == 0) ? ((c_ % 8) * (G_ / 8) + c_ / 8) : c_; }
    __device__ bool next(int i, Unit& u) const {
        const int tile = i * G + c; if (tile >= 512) return false;
        const int lp = tile >> 2; u.pm = u.rt = __builtin_amdgcn_readfirstlane(lp + (lp >> 5) + 1); u.pn = u.ct = __builtin_amdgcn_readfirstlane(tile & 3); u.br = 0; return true;
    }
    DI void a_ready(const Unit&) const {}
    DI void done(const Unit&) const {}
};
template <int NCT> struct SchedMoe {
    int G, c;
    __device__ void init(int G_, int c_) { G = G_; c = c_; }
    __device__ bool next(int i, Unit& u) const {
        const int L = i * G + c; if (L >= 16 * 17 * NCT) return false;
        const int e = __builtin_amdgcn_readfirstlane(L / (17 * NCT)), rem = L - e * (17 * NCT); u.rt = __builtin_amdgcn_readfirstlane(rem / NCT); u.ct = rem - u.rt * NCT; u.br = e;
        u.pm = e * 17 + u.rt; u.pn = e * NCT + u.ct; return true;
    }
    DI void a_ready(const Unit&) const {}
    DI void done(const Unit&) const {}
};

DI u32x4 pack8(const f32x4& a, const f32x4& b) { u32x4 w = {pk2(a[0], a[1]), pk2(a[2], a[3]), pk2(b[0], b[1]), pk2(b[2], b[3])}; return w; }

typedef int v4i_q __attribute__((ext_vector_type(4)));
struct EpiInProj {
    static constexpr bool PERM = true, AFTER_DRAIN = false;
    static DI bool keep_acc(const Unit&) { return false; }
    unsigned char* ws; int nost;
    DI void operator()(const f32x4 (&acc)[2][2][4][2], const Unit& u, int wr, int wc, int fr, int fq) const {
        const int pn = u.pn; bf16_t* base; int ld, colt; bool sig = false;
        if (pn < 6) { base = (bf16_t*)(ws + OFF_PA); ld = 1536; colt = pn * 256; }
        else if (pn < 13) { base = (bf16_t*)(ws + OFF_PR); ld = 1792; colt = (pn - 6) * 256; }
        else if (pn < 19) { base = (bf16_t*)(ws + OFF_PC); ld = 1536; colt = (pn - 13) * 256; }
        else { base = (bf16_t*)(ws + OFF_PG); ld = 3072; colt = (pn - 19) * 256; sig = true; }
        const int row0 = u.pm * 256 + wr * 64 + fr, col0 = colt + wc * 32 + 8 * fq;
        const float* sW = (const float*)(ws + OFF_SW) + pn * 256 + wc * 32 + 8 * fq; const float* sH = (const float*)(ws + OFF_SH);
        f32x4 cs[2][2]; float rsv[2][4];
#pragma unroll
        for (int bj = 0; bj < 2; ++bj) { cs[bj][0] = *(const f32x4*)(sW + bj * 128); cs[bj][1] = *(const f32x4*)(sW + bj * 128 + 4); }
#pragma unroll
        for (int ai = 0; ai < 2; ++ai)
#pragma unroll
            for (int m = 0; m < 4; ++m) rsv[ai][m] = sH[row0 + ai * 128 + m * 16];
#pragma unroll
        for (int bj = 0; bj < 2; ++bj) { const f32x4 cs0 = cs[bj][0], cs1 = cs[bj][1];
#pragma unroll
            for (int ai = 0; ai < 2; ++ai)
#pragma unroll
                for (int m = 0; m < 4; ++m) { bf16_t* rowp = base + (size_t)(row0 + ai * 128 + m * 16) * ld + col0; const float rs = rsv[ai][m];
                    const v4i_q i0 = __builtin_bit_cast(v4i_q, acc[ai][bj][m][0]), i1 = __builtin_bit_cast(v4i_q, acc[ai][bj][m][1]); f32x4 v0, v1;
#pragma unroll
                    for (int i = 0; i < 4; ++i) { v0[i] = (float)i0[i] * rs * cs0[i]; v1[i] = (float)i1[i] * rs * cs1[i]; }
                    if (sig) {
#pragma unroll
                        for (int i = 0; i < 4; ++i) { v0[i] = fmaxf(rintf(255.f * sigmoidf_(v0[i])), 1.f); v1[i] = fmaxf(rintf(255.f * sigmoidf_(v1[i])), 1.f); }
                        const u32x2 pk = {pk4_u8(v0[0], v0[1], v0[2], v0[3]), pk4_u8(v1[0], v1[1], v1[2], v1[3])};
                        unsigned char* gp = ws + OFF_PG + (size_t)(row0 + ai * 128 + m * 16) * 3072 + col0 + bj * 128;
                        if (nost) asm volatile("" :: "v"(pk)); else *(u32x2*)gp = pk; }
                    else { const u32x4 pk = pack8(v0, v1); if (nost) asm volatile("" :: "v"(pk)); else *(u32x4*)(rowp + bj * 128) = pk; } } }
    }
};
struct EpiMerge {
    static constexpr bool PERM = true, AFTER_DRAIN = false;
    static DI bool keep_acc(const Unit& u) { return u.br < 2; }
    unsigned char* ws; int nog;
    DI void operator()(f32x4 (&acc)[2][2][4][2], const Unit& u, int wr, int wc, int fr, int fq) const {
        const unsigned char* PG = ws + OFF_PG; bf16_t* M = (bf16_t*)(ws + OFF_M);
        const int row0 = u.rt * 256 + wr * 64 + fr, col0 = u.ct * 256 + wc * 32 + 8 * fq, br = u.br;
#pragma unroll
        for (int ai = 0; ai < 2; ++ai) {
            u32x2 gq[4][2], gnx[4][2];
#pragma unroll
            for (int m = 0; m < 4; ++m)
#pragma unroll
                for (int bj = 0; bj < 2; ++bj) { const size_t r = (size_t)(row0 + ai * 128 + m * 16); const int c = col0 + bj * 128;
                    gq[m][bj] = (u32x2){0x80808080u, 0x80808080u}; gnx[m][bj] = gq[m][bj];
                    if (!nog) { gq[m][bj] = *(const u32x2*)(PG + r * 3072 + br * 1024 + c); if (br < 2) gnx[m][bj] = *(const u32x2*)(PG + r * 3072 + (br + 1) * 1024 + c); } }
#pragma unroll
            for (int m = 0; m < 4; ++m)
#pragma unroll
                for (int bj = 0; bj < 2; ++bj) { const size_t r = (size_t)(row0 + ai * 128 + m * 16); const int c = col0 + bj * 128;
                    const u32x2 g = gq[m][bj], gn = gnx[m][bj];
                    float f[8];
#pragma unroll
                    for (int i = 0; i < 8; ++i) f[i] = (float)((g[i >> 2] >> (8 * (i & 3))) & 255u);
                    if (br < 2) {
#pragma unroll
                        for (int i = 0; i < 8; ++i) f[i] *= __builtin_amdgcn_rcpf((float)((gn[i >> 2] >> (8 * (i & 3))) & 255u)); }
                    else {
#pragma unroll
                        for (int i = 0; i < 8; ++i) f[i] *= (1.f / 255.f); }
                    f32x4& a0 = acc[ai][bj][m][0]; f32x4& a1 = acc[ai][bj][m][1];
#pragma unroll
                    for (int i = 0; i < 4; ++i) { a0[i] *= f[i]; a1[i] *= f[4 + i]; }
                    if (br == 2) *(u32x4*)(M + r * 1024 + c) = pack8(a0, a1); } }
    }
};
struct EpiOut {
    static constexpr bool PERM = false, AFTER_DRAIN = false;
    static DI bool keep_acc(const Unit&) { return false; }
    unsigned char* ws; int l; float scale;
    DI void operator()(const f32x4 (&acc)[2][2][4][2], const Unit& u, int wr, int wc, int fr, int fq) const {
        float* X = (float*)(ws + OFF_X); const float* MOD = (const float*)(ws + OFF_MOD) + (size_t)l * 5 * 6144;
        const int row0 = u.pm * 256 + wr * 64 + fr, col0 = u.pn * 256 + wc * 32 + 4 * fq;
#pragma unroll
        for (int ai = 0; ai < 2; ++ai)
#pragma unroll
            for (int mh = 0; mh < 2; ++mh) {
                f32x4 xv[2][4], gv[2][4];
#pragma unroll
                for (int mm = 0; mm < 2; ++mm) { const int r = row0 + ai * 128 + (2 * mh + mm) * 16; const int b = r / TT, s_ = r - b * TT; const int mi = s_ < NCTX ? 4 : b;
                    const float* g1 = MOD + mi * 6144 + 2 * 1024; const float* xr = X + (size_t)r * 1024;
#pragma unroll
                    for (int j = 0; j < 4; ++j) { const int c = col0 + (j >> 1) * 128 + (j & 1) * 16; gv[mm][j] = *(const f32x4*)(g1 + c); xv[mm][j] = *(const f32x4*)(xr + c); } }
#pragma unroll
                for (int mm = 0; mm < 2; ++mm) { const int m = 2 * mh + mm; const int r = row0 + ai * 128 + m * 16; float* xr = X + (size_t)r * 1024;
#pragma unroll
                    for (int j = 0; j < 4; ++j) { const int c = col0 + (j >> 1) * 128 + (j & 1) * 16; *(f32x4*)(xr + c) = xv[mm][j] + gv[mm][j] * acc[ai][j >> 1][m][j & 1] * scale; } }
            }
    }
};
struct EpiUp {
    static constexpr bool PERM = true, AFTER_DRAIN = false;
    static DI bool keep_acc(const Unit&) { return false; }
    unsigned char* ws;
    DI void operator()(const f32x4 (&acc)[2][2][4][2], const Unit& u, int, int, int, int) const {
        const int t_ = otid(), wid_ = t_ >> 6, wr = wid_ >> 2, wc = wid_ & 3, fr = t_ & 15, fq = (t_ >> 4) & 3;
        unsigned char* HID = ws + OFF_HID;
        const int row0 = u.pm * 256 + wr * 64 + fr, hc0 = u.ct * 128 + wc * 16 + fq * 4;
#pragma unroll
        for (int ai = 0; ai < 2; ++ai)
#pragma unroll
            for (int m = 0; m < 4; ++m) { unsigned char* rowp = HID + (size_t)(row0 + ai * 128 + m * 16) * 1024 + hc0;
#pragma unroll
                for (int bj = 0; bj < 2; ++bj) { const f32x4 a = acc[ai][bj][m][0] * (1.f / 32.f), b = acc[ai][bj][m][1] * (1.f / 32.f); f32x4 h;
#pragma unroll
                    for (int i = 0; i < 4; ++i) h[i] = a[i] * sigmoidf_(a[i]) * b[i];
                    *(unsigned*)(rowp + bj * 64) = pk4_fp8(h[0], h[1], h[2], h[3]); } }
    }
};
struct EpiDown {
    static constexpr bool PERM = true, AFTER_DRAIN = false;
    static DI bool keep_acc(const Unit&) { return false; }
    unsigned char* ws;
    DI void operator()(const f32x4 (&acc)[2][2][4][2], const Unit& u, int, int, int, int) const {
        const int t_ = otid(), wid_ = t_ >> 6, wr = wid_ >> 2, wc = wid_ & 3, fr = t_ & 15, fq = (t_ >> 4) & 3;
        bf16_t* O = (bf16_t*)(ws + OFF_OUT);
        const int row0 = u.pm * 256 + wr * 64 + fr, col0 = u.ct * 256 + wc * 32 + 8 * fq;
#pragma unroll
        for (int ai = 0; ai < 2; ++ai)
#pragma unroll
            for (int m = 0; m < 4; ++m) { bf16_t* rowp = O + (size_t)(row0 + ai * 128 + m * 16) * 1024 + col0;
#pragma unroll
                for (int bj = 0; bj < 2; ++bj) *(u32x4*)(rowp + bj * 128) = pack8(acc[ai][bj][m][0] * (1.f / 32.f), acc[ai][bj][m][1] * (1.f / 32.f)); }
    }
};
DI int row_mod(int r) { const int b = r / TT, s = r - b * TT; return s < NCTX ? 4 : b; }

__device__ void ph_prologue(const Params& p, LAS unsigned char* lds, int wg, int nwg) {
    const int tid = otid();
    if (wg == 0 && tid < 16) {
        float* COS = (float*)(p.ws + OFF_ROPE); float* SIN = COS + 2048;
        const int k = tid; const int q4 = k & 3, dec = k >> 2;
        double th = (q4 == 0) ? 1.0 : (q4 == 1 ? 0.56234132519034908 : (q4 == 2 ? 0.31622776601683794 : 0.17782794100389228));
        for (int i = 0; i < dec; ++i) th *= 0.1;
        double ct = 1.0, st = th, term_c = 1.0, term_s = th; const double t2 = th * th;
        for (int n = 1; n <= 12; ++n) { term_c *= -t2 / (double)((2 * n - 1) * (2 * n)); term_s *= -t2 / (double)((2 * n) * (2 * n + 1)); ct += term_c; st += term_s; }
        double cp = 1.0, sp = 0.0;
        for (int pos = 0; pos < 128; ++pos) { COS[pos * 16 + k] = (float)cp; SIN[pos * 16 + k] = (float)sp; const double c2 = cp * ct - sp * st, s2 = sp * ct + cp * st; cp = c2; sp = s2; }
    }
    {
        LAS float* sc = (LAS float*)lds;
        LAS float* red = sc + 5 * 1024;
        float* MOD = (float*)(p.ws + OFF_MOD);
        for (int i = tid; i < 5 * 1024; i += 512) { const int m = i >> 10, k = i & 1023; const float v = (m < 4) ? p.c[m * 1024 + k] : p.c_ctx[k]; sc[i] = v * sigmoidf_(v); }
        __syncthreads();
        for (int u = wg; u < NL * 48; u += nwg) {
            const int l = u / 48, cb = u % 48; const int cl = tid & 127, col = cb * 128 + cl, kq = tid >> 7;
            const float* W = p.ada_w + (size_t)l * 1024 * 6144 + col;
            float a0 = 0, a1 = 0, a2 = 0, a3 = 0, a4 = 0;
#pragma unroll 1
            for (int k0 = kq * 256; k0 < kq * 256 + 256; k0 += 16) { float wv[16];
#pragma unroll
                for (int j = 0; j < 16; ++j) wv[j] = W[(size_t)(k0 + j) * 6144];
#pragma unroll
                for (int j = 0; j < 16; ++j) { const int k = k0 + j; const float w = wv[j]; a0 += sc[k] * w; a1 += sc[1024 + k] * w; a2 += sc[2048 + k] * w; a3 += sc[3072 + k] * w; a4 += sc[4096 + k] * w; } }
            red[(kq * 5 + 0) * 128 + cl] = a0; red[(kq * 5 + 1) * 128 + cl] = a1; red[(kq * 5 + 2) * 128 + cl] = a2; red[(kq * 5 + 3) * 128 + cl] = a3; red[(kq * 5 + 4) * 128 + cl] = a4;
            __syncthreads();
            if (tid < 128) { const float bb = p.ada_b[l * 6144 + col];
                for (int m = 0; m < 5; ++m) { const float s = red[(0 * 5 + m) * 128 + cl] + red[(1 * 5 + m) * 128 + cl] + red[(2 * 5 + m) * 128 + cl] + red[(3 * 5 + m) * 128 + cl];
                    MOD[((size_t)(l * 5 + m)) * 6144 + col] = s + bb; } }
            __syncthreads();
        }
    }
}

template <class RowMap> DI void tconv_tile(const float* src, int ldn, int k0, int n0, bf16_t* dst, int K, RowMap rm, LAS float* tile  , int tid) {
#pragma unroll
    for (int i = 0; i < 8; ++i) { const int k = (tid >> 6) + 8 * i, n = tid & 63; tile[k * 65 + n] = src[(size_t)(k0 + k) * ldn + n0 + n]; }
    __syncthreads();
    const int n = tid >> 3, k8 = (tid & 7) * 8; float v[8];
#pragma unroll
    for (int j = 0; j < 8; ++j) v[j] = tile[(k8 + j) * 65 + n];
    u32x4 w = {pk2(v[0], v[1]), pk2(v[2], v[3]), pk2(v[4], v[5]), pk2(v[6], v[7])};
    *(u32x4*)(dst + (size_t)rm(n0 + n) * K + k0 + k8) = w;
    __syncthreads();
}
template <class RowMap> DI void tconv_tile_f8(const float* src, int ldn, int k0, int n0, unsigned char* dst, int K, RowMap rm, float scale, LAS float* tile  , int tid) {
#pragma unroll
    for (int i = 0; i < 8; ++i) { const int k = (tid >> 6) + 8 * i, n = tid & 63; tile[k * 65 + n] = src[(size_t)(k0 + k) * ldn + n0 + n]; }
    __syncthreads();
    const int n = tid >> 3, k8 = (tid & 7) * 8; float v[8];
#pragma unroll
    for (int j = 0; j < 8; ++j) v[j] = tile[(k8 + j) * 65 + n] * scale;
    u32x2 w = {pk4_fp8(v[0], v[1], v[2], v[3]), pk4_fp8(v[4], v[5], v[6], v[7])};
    *(u32x2*)(dst + (size_t)rm(n0 + n) * K + k0 + k8) = w;
    __syncthreads();
}
struct RowId { DI int operator()(int n) const { return n; } };
struct RowW13 { int sel; DI int operator()(int j) const { return (j >> 7) * 256 + ((j & 127) >> 2) * 8 + sel * 4 + (j & 3); } };

DI void tblk_load(const float* src, int ldn, int k0, int n0, int tid, f32x4 (&v)[8]) {
    const float* s = src + (size_t)(k0 + 4 * (tid >> 5)) * ldn + n0 + 4 * (tid & 31);
#pragma unroll
    for (int i = 0; i < 2; ++i)
#pragma unroll
        for (int j = 0; j < 4; ++j) v[i * 4 + j] = *(const f32x4*)(s + (size_t)(64 * i + j) * ldn);
}
template <int OB> DI void tblk_to_lds(const f32x4 (&v)[8], float scale, LAS unsigned char* tile, int tid) {
    constexpr int S = 128 * OB + 8; const int c4 = tid & 31, r = tid >> 5;
#pragma unroll
    for (int i = 0; i < 2; ++i) {
        const f32x4 f0 = v[i * 4 + 0], f1 = v[i * 4 + 1], f2 = v[i * 4 + 2], f3 = v[i * 4 + 3];
#pragma unroll
        for (int jn = 0; jn < 4; ++jn) { LAS unsigned char* d = tile + (4 * c4 + jn) * S + (4 * r + 64 * i) * OB;
            if constexpr (OB == 1) *(LAS unsigned*)d = pk4_fp8(f0[jn] * scale, f1[jn] * scale, f2[jn] * scale, f3[jn] * scale);
            else *(LAS u32x2*)d = (u32x2){pk2(f0[jn], f1[jn]), pk2(f2[jn], f3[jn])}; }
    }
}
template <int OB, class RowMap> DI void tblk_from_lds(const LAS unsigned char* tile, unsigned char* dst, int Kb, int k0, int n0, RowMap rm, int tid) {
    constexpr int S = 128 * OB + 8; const int n = tid >> 2, q = tid & 3;
    const LAS unsigned char* t = tile + n * S + q * 32 * OB; unsigned char* d = dst + (size_t)rm(n0 + n) * Kb + k0 * OB + q * 32 * OB;
#pragma unroll
    for (int j = 0; j < 2 * OB; ++j) { const u32x2 a = *(const LAS u32x2*)(t + 16 * j), c = *(const LAS u32x2*)(t + 16 * j + 8); *(u32x4*)(d + 16 * j) = (u32x4){a[0], a[1], c[0], c[1]}; }
}
template <int OB, class RowMap> DI void tblk_unit(const float* src, int ldn, int k0, int n0, unsigned char* dst, int Kb, RowMap rm, float scale, LAS unsigned char* tile, int tid) {
    f32x4 v[8]; tblk_load(src, ldn, k0, n0, tid, v); tblk_to_lds<OB>(v, scale, tile, tid);
    __syncthreads();
    tblk_from_lds<OB>(tile, dst, Kb, k0, n0, rm, tid);
    __syncthreads();
}
DI float max_hi3(float v) {
    v = fmaxf(v, dppmov<0x128>(v));
    { auto r = __builtin_amdgcn_permlane16_swap(__float_as_uint(v), __float_as_uint(v), false, false); v = fmaxf(__uint_as_float(r[0]), __uint_as_float(r[1])); }
    { auto r = __builtin_amdgcn_permlane32_swap(__float_as_uint(v), __float_as_uint(v), false, false); v = fmaxf(__uint_as_float(r[0]), __uint_as_float(r[1])); } return v; }
DI void win_strip(const float* src, float* SW, unsigned char* dst, int n0, LAS unsigned char* tile, int tid) {
    constexpr int S = 1024 + 8; const int c4 = tid & 7, r = tid >> 3; LAS float* red = (LAS float*)(tile + 32 * S);
    f32x4 v[16]; const float* s = src + (size_t)(4 * r) * NIN + n0 + 4 * c4;
#pragma unroll
    for (int i = 0; i < 4; ++i)
#pragma unroll
        for (int j = 0; j < 4; ++j) v[i * 4 + j] = *(const f32x4*)(s + (size_t)(256 * i + j) * NIN);
    float am[4] = {0.f, 0.f, 0.f, 0.f};
#pragma unroll
    for (int i = 0; i < 16; ++i) { am[0] = fmaxf(am[0], fabsf(v[i][0])); am[1] = fmaxf(am[1], fabsf(v[i][1])); am[2] = fmaxf(am[2], fabsf(v[i][2])); am[3] = fmaxf(am[3], fabsf(v[i][3])); }
#pragma unroll
    for (int j = 0; j < 4; ++j) am[j] = max_hi3(am[j]);
    if ((tid & 63) < 8) *(LAS f32x4*)(red + (tid >> 6) * 32 + 4 * c4) = (f32x4){am[0], am[1], am[2], am[3]};
    __syncthreads();
    float inv[4];
#pragma unroll
    for (int j = 0; j < 4; ++j) { float m = red[4 * c4 + j];
#pragma unroll
        for (int w = 1; w < 8; ++w) m = fmaxf(m, red[w * 32 + 4 * c4 + j]);
        m = fmaxf(m, 1e-20f); inv[j] = 127.f / m; if (r == 0) SW[n0 + 4 * c4 + j] = m * (1.f / 127.f); }
#pragma unroll
    for (int i = 0; i < 4; ++i) {
        const f32x4 f0 = v[i * 4 + 0], f1 = v[i * 4 + 1], f2 = v[i * 4 + 2], f3 = v[i * 4 + 3];
#pragma unroll
        for (int jn = 0; jn < 4; ++jn) *(LAS unsigned*)(tile + (4 * c4 + jn) * S + 4 * r + 256 * i) = pk4_i8(f0[jn] * inv[jn], f1[jn] * inv[jn], f2[jn] * inv[jn], f3[jn] * inv[jn]);
    }
    __syncthreads();
    {   const int n = tid >> 4, q = tid & 15; const LAS unsigned char* t = tile + n * S + q * 64; unsigned char* d = dst + (size_t)(n0 + n) * 1024 + q * 64;
#pragma unroll
        for (int j = 0; j < 4; ++j) { const u32x2 a = *(const LAS u32x2*)(t + 16 * j), c = *(const LAS u32x2*)(t + 16 * j + 8); *(u32x4*)(d + 16 * j) = (u32x4){a[0], a[1], c[0], c[1]}; } }
    __syncthreads();
}

__device__ void conv_mixer_a(const Params& p, int l, LAS unsigned char* lds) {
    LAS float* tile = (LAS float*)lds; LAS unsigned* bc = (LAS unsigned*)(lds + 36864); const int tid = otid();
    unsigned* ctr = (unsigned*)(p.ws + OFF_CTR) + (48 + l) * 64;
    constexpr int U_IN = 248, U_LR = 48;
    for (;;) {
        if (tid == 0) *bc = atomicAdd(ctr, 1u);
        __syncthreads();
        const int u = (int)*bc;
        __syncthreads();
        if (u >= U_IN + U_LR) break;
        if (u < U_IN) win_strip(p.w_in + (size_t)l * 1024 * NIN, (float*)(p.ws + OFF_SW), p.ws + OFF_WIN, u * 32, lds, tid);
        else { const int v = u - U_IN; bf16_t* LRW = (bf16_t*)(p.ws + OFF_LRW);
            if (v < 32) { const int mi = v >> 3, nt = v & 7; const float* src = (mi < 2 ? p.rwkv_w_up : p.rwkv_a_up) + ((size_t)(l * 2 + (mi & 1)) * 64) * 512;
                tconv_tile(src, 512, 0, nt * 64, LRW + (size_t)mi * 512 * 64, 64, RowId(), tile, tid); }
            else { const int w = v - 32, kt = w >> 3, nt = w & 7;
                tconv_tile(p.rwkv_g_up + (size_t)l * 128 * 512, 512, kt * 64, nt * 64, LRW + (size_t)4 * 512 * 64, 128, RowId(), tile, tid); } }
    }
}
__device__ void conv_mixer_b(const Params& p, int l, LAS unsigned char* lds, int wg, int nwg) {
    const int tid = otid();
    constexpr int U_BR = 3 * 4 * 8, U_OUT = 64;
    for (int u = wg; u < U_BR + U_OUT; u += nwg) {
        if (u < U_BR) { const int i = u / 32, kt = (u % 32) / 8, nt = u % 8;
            tblk_unit<2>(p.w_branch + ((size_t)(l * 3 + i)) * 512 * 1024, 1024, kt * 128, nt * 128, p.ws + OFF_WBR + (size_t)i * 1024 * 512 * 2, 512 * 2, RowId(), 1.f, lds, tid); }
        else { const int v = u - U_BR, kt = v / 8, nt = v % 8;
            tblk_unit<2>(p.w_out + (size_t)l * 1024 * 1024, 1024, kt * 128, nt * 128, p.ws + OFF_WOUT, 1024 * 2, RowId(), 1.f, lds, tid); }
    }
}
__device__ void conv_expert_weights(const Params& p, int l, LAS unsigned char* lds, int qofs = 16) {
    LAS unsigned* bc = (LAS unsigned*)(lds + 128 * 136); const int tid = otid();
    unsigned* ctr = (unsigned*)(p.ws + OFF_CTR) + (qofs + l) * 64;
    constexpr int NU = 16 * 3 * 64;
    const float* w1 = p.exp_w1 + (size_t)l * 16 * 1024 * 1024; const float* w3 = p.exp_w3 + (size_t)l * 16 * 1024 * 1024; const float* w2 = p.exp_w2 + (size_t)l * 16 * 1024 * 1024;
#define EXP_SRC(u_) (((((u_) % 192) >> 6) == 0 ? w1 : ((((u_) % 192) >> 6) == 1 ? w3 : w2)) + (size_t)((u_) / 192) * 1024 * 1024)
#define EXP_K0(u_) (((((u_) % 192) >> 3) & 7) * 128)
#define EXP_N0(u_) ((((u_) % 192) & 7) * 128)
    if (tid == 0) *bc = atomicAdd(ctr, 1u);
    __syncthreads();
    int u = (int)*bc;
    __syncthreads();
    if (u >= NU) return;
    f32x4 v[8]; tblk_load(EXP_SRC(u), 1024, EXP_K0(u), EXP_N0(u), tid, v);
    for (;;) {
        if (tid == 0) *bc = atomicAdd(ctr, 1u);
        tblk_to_lds<1>(v, 32.f, lds, tid);
        __syncthreads();
        const int un = (int)*bc;
        if (un < NU) tblk_load(EXP_SRC(un), 1024, EXP_K0(un), EXP_N0(un), tid, v);
        {   const int e = u / 192, w = u % 192, which = w >> 6, k0 = ((w >> 3) & 7) * 128, n0 = (w & 7) * 128;
            if (which == 0) tblk_from_lds<1>(lds, p.ws + OFF_W13 + (size_t)e * 2048 * 1024, 1024, k0, n0, RowW13{0}, tid);
            else if (which == 1) tblk_from_lds<1>(lds, p.ws + OFF_W13 + (size_t)e * 2048 * 1024, 1024, k0, n0, RowW13{1}, tid);
            else tblk_from_lds<1>(lds, p.ws + OFF_W2 + (size_t)e * 1024 * 1024, 1024, k0, n0, RowId(), tid); }
        __syncthreads();
        if (un >= NU) break;
        u = un;
    }
#undef EXP_SRC
#undef EXP_K0
#undef EXP_N0
}

__device__ void norm1_rows(const Params& p, int l, int wg, int nwg) {
    const int tid = otid(), wave = tid >> 6, lane = tid & 63;
    float* X = (float*)(p.ws + OFF_X); bf16_t* H = (bf16_t*)(p.ws + OFF_H);
    const float* MOD = (const float*)(p.ws + OFF_MOD) + (size_t)l * 5 * 6144; const float* g = p.norm1_g + l * 1024;
    for (int r = wg * 8 + wave; r < RR; r += nwg * 8) {
        const int b_ = r / TT, s_ = r - b_ * TT;
        const float4* xr = (s_ < NCTX) ? (const float4*)(p.ctx + ((size_t)(b_ * NCTX + s_)) * DM) : (const float4*)(p.x + ((size_t)(b_ * SEQ + s_ - NCTX)) * DM); float4* xw = (float4*)(X + (size_t)r * 1024); float4 v[4]; float ss = 0.f;
#pragma unroll
        for (int i = 0; i < 4; ++i) v[i] = xr[lane + 64 * i];
#pragma unroll
        for (int i = 0; i < 4; ++i) { xw[lane + 64 * i] = v[i]; ss += v[i].x * v[i].x + v[i].y * v[i].y + v[i].z * v[i].z + v[i].w * v[i].w; }
        ss = wave_sum(ss);
        const float rinv = rsqrtf(ss * (1.f / 1024.f) + 1e-6f);
        const float* md = MOD + row_mod(r) * 6144;
        float y[16]; float am = 0.f;
#pragma unroll
        for (int i = 0; i < 4; ++i) { const int col = (lane + 64 * i) * 4;
            const float4 gg = *(const float4*)(g + col), sh = *(const float4*)(md + col), sc = *(const float4*)(md + 1024 + col);
            y[4 * i] = v[i].x * rinv * gg.x * (1.f + sc.x) + sh.x; y[4 * i + 1] = v[i].y * rinv * gg.y * (1.f + sc.y) + sh.y; y[4 * i + 2] = v[i].z * rinv * gg.z * (1.f + sc.z) + sh.z; y[4 * i + 3] = v[i].w * rinv * gg.w * (1.f + sc.w) + sh.w;
#pragma unroll
            for (int j = 0; j < 4; ++j) am = fmaxf(am, fabsf(y[4 * i + j])); }
        am = fmaxf(wave_max(am), 1e-20f); const float inv = 127.f / am;
        if (lane == 0) ((float*)(p.ws + OFF_SH))[r] = am * (1.f / 127.f);
#pragma unroll
        for (int i = 0; i < 4; ++i) *(unsigned*)((unsigned char*)H + (size_t)r * 1024 + (lane + 64 * i) * 4) = pk4_i8(y[4 * i] * inv, y[4 * i + 1] * inv, y[4 * i + 2] * inv, y[4 * i + 3] * inv);
    }
}
#define MFMA16(a, b, c) __builtin_amdgcn_mfma_f32_16x16x32_bf16((a), (b), (c), 0, 0, 0)
DI float tanh_fast(float x) { return 1.f - 2.f * __builtin_amdgcn_rcpf(1.f + __expf(2.f * x)); }
DI void unpack4(const u32x2 w, float (&o)[4]) { o[0] = bflo(w[0]); o[1] = bfhi(w[0]); o[2] = bflo(w[1]); o[3] = bfhi(w[1]); }
DI void prep_rows_unit(const Params& p, int l, LAS unsigned char* lds, int ub, int dup) {
    const int tid = otid(), wave = tid >> 6, lane = tid & 63, c16 = lane & 15, rq = lane >> 4;
    const int r0 = ub * 16; const int b = r0 / TT, s0 = r0 - b * TT;
    const bool isctx = s0 < NCTX; const int seg_lo = isctx ? 0 : NCTX, seg_hi = isctx ? NCTX : TT;
    const bool has_prev = s0 > seg_lo, has_next = (s0 + 16) < seg_hi;
    bf16_t* PA = (bf16_t*)(p.ws + OFF_PA); const bf16_t* PR = (const bf16_t*)(p.ws + OFF_PR); const bf16_t* PC = (const bf16_t*)(p.ws + OFF_PC);
    const int col0 = wave * 64 + c16 * 4, rb = r0 + 4 * rq;
    const bool pv = (rq > 0) || has_prev, nv = (rq < 3) || has_next;
    u32x2 rawc[3][6], rawu[2][6], rawbg[4]; u32x4 rawlr[8], rawqk[4];
#pragma unroll
    for (int g = 0; g < 3; ++g)
#pragma unroll
        for (int j = 0; j < 6; ++j) { const bool ok = (j == 0) ? pv : ((j == 5) ? nv : true); rawc[g][j] = (u32x2){0u, 0u}; if (ok) rawc[g][j] = *(const u32x2*)(PR + (size_t)(rb - 1 + j) * 1792 + g * 512 + col0); }
    {   const bf16_t* lr = PR + (size_t)(r0 + c16) * 1792 + 1536 + 8 * rq;
#pragma unroll
        for (int i = 0; i < 8; ++i) rawlr[i] = *(const u32x4*)(lr + 32 * i); }
#pragma unroll
    for (int j = 0; j < 6; ++j) { const bool ok = (j == 0) ? pv : ((j == 5) ? nv : true); rawu[0][j] = (u32x2){0u, 0u}; rawu[1][j] = (u32x2){0u, 0u};
        if (ok) { rawu[0][j] = *(const u32x2*)(PC + (size_t)(rb - 1 + j) * 1536 + 512 + col0); rawu[1][j] = *(const u32x2*)(PC + (size_t)(rb - 1 + j) * 1536 + 1024 + col0); } }
#pragma unroll
    for (int i = 0; i < 4; ++i) rawbg[i] = *(const u32x2*)(PC + (size_t)(rb + i) * 1536 + col0);
    bf16_t* qkbase = PA + (size_t)(r0 + (tid >> 5)) * 1536 + ((tid & 31) >> 1) * 64 + 16 * (tid & 1);
    if (!dup) { rawqk[0] = *(const u32x4*)qkbase; rawqk[1] = *(const u32x4*)(qkbase + 8); rawqk[2] = *(const u32x4*)(qkbase + 32); rawqk[3] = *(const u32x4*)(qkbase + 40); }
    __builtin_amdgcn_sched_barrier(0);
    float rc[4][4], kc[4][4], vc[4][4];
    {   const float* cw = p.rwkv_conv_w + (size_t)l * 3 * 1536;
#pragma unroll
        for (int g = 0; g < 3; ++g) {
            const int co = g * 512 + col0; const f32x4 w0 = *(const f32x4*)(cw + co), w1 = *(const f32x4*)(cw + 1536 + co), w2 = *(const f32x4*)(cw + 3072 + co);
            float x[6][4];
#pragma unroll
            for (int j = 0; j < 6; ++j) unpack4(rawc[g][j], x[j]);
#pragma unroll
            for (int i = 0; i < 4; ++i)
#pragma unroll
                for (int c = 0; c < 4; ++c) { const float o = w0[c] * x[i][c] + w1[c] * x[i + 1][c] + w2[c] * x[i + 2][c]; if (g == 0) rc[i][c] = o; else if (g == 1) kc[i][c] = o; else vc[i][c] = o; }
        } }
    bf16_t* EW = (bf16_t*)(p.ws + OFF_EW); bf16_t* AA = (bf16_t*)(p.ws + OFF_AA);
    bf16_t* KK = (bf16_t*)(p.ws + OFF_KK); bf16_t* KC = (bf16_t*)(p.ws + OFF_KC); bf16_t* RC = (bf16_t*)(p.ws + OFF_RC); bf16_t* VC = (bf16_t*)(p.ws + OFF_VC);
    {   const f32x4 kkc = *(const f32x4*)(p.rwkv_k_k + l * 512 + col0);
#pragma unroll
        for (int i = 0; i < 4; ++i) { float q[4]; float ss = 0.f;
#pragma unroll
            for (int c = 0; c < 4; ++c) { q[c] = kc[i][c] * kkc[c]; ss += q[c] * q[c]; }
            ss = allsum16(ss); const float rn = 1.f / fmaxf(sqrtf(ss), 1e-12f);
            const size_t o = (size_t)(rb + i) * 512 + col0;
            u32x2 w; w[0] = pk2(q[0] * rn, q[1] * rn); w[1] = pk2(q[2] * rn, q[3] * rn); *(u32x2*)(KK + o) = w;
            w[0] = pk2(kc[i][0], kc[i][1]); w[1] = pk2(kc[i][2], kc[i][3]); *(u32x2*)(KC + o) = w;
            w[0] = pk2(rc[i][0], rc[i][1]); w[1] = pk2(rc[i][2], rc[i][3]); *(u32x2*)(RC + o) = w;
            w[0] = pk2(vc[i][0], vc[i][1]); w[1] = pk2(vc[i][2], vc[i][3]); *(u32x2*)(VC + o) = w; } }
    bf16x8 twf[2], alf[2], sgf[4];
    {
#pragma unroll
        for (int ks = 0; ks < 2; ++ks) { const u32x4 v = rawlr[ks]; u32x4 t;
#pragma unroll
            for (int i = 0; i < 4; ++i) t[i] = pk2(tanh_fast(bflo(v[i])), tanh_fast(bfhi(v[i])));
            twf[ks] = __builtin_bit_cast(bf16x8, t); alf[ks] = __builtin_bit_cast(bf16x8, rawlr[2 + ks]); }
#pragma unroll
        for (int ks = 0; ks < 4; ++ks) { const u32x4 v = rawlr[4 + ks]; u32x4 t;
#pragma unroll
            for (int i = 0; i < 4; ++i) t[i] = pk2(sigmoidf_(bflo(v[i])), sigmoidf_(bfhi(v[i])));
            sgf[ks] = __builtin_bit_cast(bf16x8, t); } }
    const bf16_t* LRW = (const bf16_t*)(p.ws + OFF_LRW);
    float bon[4] = {0.f, 0.f, 0.f, 0.f};
    const f32x4 kac = *(const f32x4*)(p.rwkv_k_a + l * 512 + col0), rkc = *(const f32x4*)(p.rwkv_r_k + l * 512 + col0);
#pragma unroll 1
    for (int d = 0; d < 2; ++d) {
        f32x4 wa[4], aa[4];
#pragma unroll
        for (int cb = 0; cb < 4; ++cb) { wa[cb] = (f32x4){0.f, 0.f, 0.f, 0.f}; aa[cb] = (f32x4){0.f, 0.f, 0.f, 0.f};
            const bf16_t* bw = LRW + ((size_t)d * 512 + col0 + cb) * 64 + 8 * rq; const bf16_t* ba = bw + (size_t)2 * 512 * 64;
#pragma unroll
            for (int ks = 0; ks < 2; ++ks) { wa[cb] = MFMA16(twf[ks], *(const bf16x8*)(bw + 32 * ks), wa[cb]); aa[cb] = MFMA16(alf[ks], *(const bf16x8*)(ba + 32 * ks), aa[cb]); } }
        const f32x4 w0c = *(const f32x4*)(p.rwkv_w0 + (l * 2 + d) * 512 + col0), a0c = *(const f32x4*)(p.rwkv_a0 + (l * 2 + d) * 512 + col0);
#pragma unroll
        for (int i = 0; i < 4; ++i) { float e[4], a[4]; float bs = 0.f;
#pragma unroll
            for (int c = 0; c < 4; ++c) { const float z = w0c[c] + wa[c][i];
                const float sp = fmaxf(-z, 0.f) + __logf(1.f + __expf(-fabsf(z)));
                e[c] = __expf(-sp - 0.5f) * 1.4426950408889634f;
                a[c] = sigmoidf_(a0c[c] + aa[c][i]);
                const float kd = kc[i][c] * (1.f + (a[c] - 1.f) * kac[c]); bs += rc[i][c] * kd * rkc[c]; }
            bon[i] += allsum16(bs);
            const size_t o = (size_t)d * RR * 512 + (size_t)(rb + i) * 512 + col0;
            u32x2 w; w[0] = pk2(e[0], e[1]); w[1] = pk2(e[2], e[3]); *(u32x2*)(EW + o) = w;
            w[0] = pk2(a[0], a[1]); w[1] = pk2(a[2], a[3]); *(u32x2*)(AA + o) = w; }
    }
    {
        f32x4 ga[4];
#pragma unroll
        for (int cb = 0; cb < 4; ++cb) { ga[cb] = (f32x4){0.f, 0.f, 0.f, 0.f}; const bf16_t* bg = LRW + (size_t)4 * 512 * 64 + ((size_t)col0 + cb) * 128 + 8 * rq;
#pragma unroll
            for (int ks = 0; ks < 4; ++ks) ga[cb] = MFMA16(sgf[ks], *(const bf16x8*)(bg + 32 * ks), ga[cb]); }
        bf16_t* G = (bf16_t*)(p.ws + OFF_G); bf16_t* YB0 = (bf16_t*)(p.ws + OFF_YB0); const f32x4 lnb = *(const f32x4*)(p.rwkv_ln_b + l * 512 + col0);
#pragma unroll
        for (int i = 0; i < 4; ++i) { const size_t o = (size_t)(rb + i) * 512 + col0;
            u32x2 w; w[0] = pk2(ga[0][i], ga[1][i]); w[1] = pk2(ga[2][i], ga[3][i]); *(u32x2*)(G + o) = w;
            w[0] = pk2(2.f * lnb[0] + bon[i] * vc[i][0], 2.f * lnb[1] + bon[i] * vc[i][1]); w[1] = pk2(2.f * lnb[2] + bon[i] * vc[i][2], 2.f * lnb[3] + bon[i] * vc[i][3]); *(u32x2*)(YB0 + o) = w; }
    }
    {
        const float* cw = p.conv_w + (size_t)l * 3 * 512; const f32x4 c0 = *(const f32x4*)(cw + col0), c1 = *(const f32x4*)(cw + 512 + col0), c2 = *(const f32x4*)(cw + 1024 + col0);
        float uu[6][4];
#pragma unroll
        for (int j = 0; j < 6; ++j) { float fa[4], fc[4]; unpack4(rawu[0][j], fa); unpack4(rawu[1][j], fc);
#pragma unroll
            for (int q = 0; q < 4; ++q) uu[j][q] = fa[q] * fc[q]; }
        bf16_t* YC = (bf16_t*)(p.ws + OFF_YC);
#pragma unroll
        for (int i = 0; i < 4; ++i) { float bg[4]; unpack4(rawbg[i], bg); float o[4];
#pragma unroll
            for (int q = 0; q < 4; ++q) o[q] = bg[q] * (c0[q] * uu[i][q] + c1[q] * uu[i + 1][q] + c2[q] * uu[i + 2][q]);
            u32x2 w = {pk2(o[0], o[1]), pk2(o[2], o[3])}; *(u32x2*)(YC + (size_t)(rb + i) * 512 + col0) = w; }
    }
    if (!dup) {   const int rr = tid >> 5, g16 = (tid & 31) >> 1, hf = tid & 1; const int s = s0 + rr;
        bf16_t* base = qkbase;
        const u32x4 a0 = rawqk[0], a1 = rawqk[1], b0 = rawqk[2], b1 = rawqk[3];
        float x1[16], x2[16];
#pragma unroll
        for (int i = 0; i < 4; ++i) { x1[2 * i] = bflo(a0[i]); x1[2 * i + 1] = bfhi(a0[i]); x1[8 + 2 * i] = bflo(a1[i]); x1[9 + 2 * i] = bfhi(a1[i]);
            x2[2 * i] = bflo(b0[i]); x2[2 * i + 1] = bfhi(b0[i]); x2[8 + 2 * i] = bflo(b1[i]); x2[9 + 2 * i] = bfhi(b1[i]); }
        float ss = 0.f;
#pragma unroll
        for (int j = 0; j < 16; ++j) ss += x1[j] * x1[j] + x2[j] * x2[j];
        ss += dppmov<0xB1>(ss);
        const float rinv = rsqrtf(ss * (1.f / 64.f) + 1e-6f);
        const float* gg = (g16 < 8 ? p.q_norm_g : p.k_norm_g) + l * 64; const float qs = g16 < 8 ? 0.125f * 1.4426950408889634f : 1.f;
        const float* COS = (const float*)(p.ws + OFF_ROPE); const float* SIN = COS + 2048;
        const int tl = s - NCTX; const int pos = isctx ? 0 : (hf == 0 ? (tl >> 6) : (tl & 63));
#pragma unroll
        for (int j = 0; j < 16; ++j) { const float y1 = x1[j] * rinv * gg[16 * hf + j], y2 = x2[j] * rinv * gg[32 + 16 * hf + j];
            float o1 = y1, o2 = y2;
            if (!isctx) { const float c = COS[pos * 16 + j], sn = SIN[pos * 16 + j]; o1 = y1 * c - y2 * sn; o2 = y2 * c + y1 * sn; }
            x1[j] = o1 * qs; x2[j] = o2 * qs; }
        u32x4 w0, w1, w2, w3;
#pragma unroll
        for (int i = 0; i < 4; ++i) { w0[i] = pk2(x1[2 * i], x1[2 * i + 1]); w1[i] = pk2(x1[8 + 2 * i], x1[9 + 2 * i]); w2[i] = pk2(x2[2 * i], x2[2 * i + 1]); w3[i] = pk2(x2[8 + 2 * i], x2[9 + 2 * i]); }
        *(u32x4*)base = w0; *(u32x4*)(base + 8) = w1; *(u32x4*)(base + 32) = w2; *(u32x4*)(base + 40) = w3;
    }
}
DI void prep_vt_unit(const Params& p, LAS unsigned char* lds, int uv) {
    const int tid = otid(); const int b = uv / 132, tb = uv % 132;
    const bf16_t* PA = (const bf16_t*)(p.ws + OFF_PA); bf16_t* VT = (bf16_t*)(p.ws + OFF_VT);
    LAS unsigned char* img = lds;
#pragma unroll
    for (int i = 0; i < 8; ++i) { const int id = tid + 512 * i, row = id >> 6, ch = id & 63;
        const u32x4 v = *(const u32x4*)(PA + (size_t)(b * TT + tb * 64 + row) * 1536 + 1024 + ch * 8); *(LAS u32x4*)(img + row * 1040 + ch * 16) = v; }
    __syncthreads();
    bf16_t* dst = VT + ((size_t)(b * 512 + tid)) * TT + tb * 64;
#pragma unroll
    for (int g = 0; g < 4; ++g) { unsigned w[8];
#pragma unroll
        for (int q = 0; q < 8; ++q) { const int p0 = 2 * q, p1 = 2 * q + 1;
            const int k0 = 16 * g + (p0 & 3) + 8 * ((p0 >> 2) & 1) + 4 * (p0 >> 3), k1 = 16 * g + (p1 & 3) + 8 * ((p1 >> 2) & 1) + 4 * (p1 >> 3);
            const unsigned lo = *(const LAS unsigned short*)(img + k0 * 1040 + tid * 2), hi = *(const LAS unsigned short*)(img + k1 * 1040 + tid * 2); w[q] = lo | (hi << 16); }
        u32x4 wa = {w[0], w[1], w[2], w[3]}, wb = {w[4], w[5], w[6], w[7]};
        *(u32x4*)(dst + 16 * g) = wa; *(u32x4*)(dst + 16 * g + 8) = wb; }
    __syncthreads();
}
__device__ void ph_prep(const Params& p, int l, LAS unsigned char* lds, int wg, int nwg, int dup) {
    for (int u = wg; u < 528 + RR / 16; u += nwg) { if (u < 528) prep_vt_unit(p, lds, u); else prep_rows_unit(p, l, lds, u - 528, dup); }
}
#define MFMA32(a, b, c) __builtin_amdgcn_mfma_f32_32x32x16_bf16((a), (b), (c), 0, 0, 0)
DI bf16x8 pack_p(const f32x16& x, int s) {
    u32x4 w = {pk2(x[8 * s + 0], x[8 * s + 1]), pk2(x[8 * s + 2], x[8 * s + 3]), pk2(x[8 * s + 4], x[8 * s + 5]), pk2(x[8 * s + 6], x[8 * s + 7])};
    return __builtin_bit_cast(bf16x8, w);
}
#define SCHED_FENCE() __builtin_amdgcn_sched_barrier(0)
DI void lds_barrier() { asm volatile("s_waitcnt lgkmcnt(0)" ::: "memory"); __builtin_amdgcn_s_barrier(); asm volatile("" ::: "memory"); }
DI void attn_qk(const LAS unsigned char* Kc, const int (&coff)[4], const bf16x8 (&qf)[4], f32x16& s0, f32x16& s1) {
    bf16x8 kf[4], kg[4];
#pragma unroll
    for (int ks = 0; ks < 4; ++ks) kf[ks] = *(const LAS bf16x8*)(Kc + coff[ks]);
#pragma unroll
    for (int j = 0; j < 16; ++j) { s0[j] = 0.f; s1[j] = 0.f; }
#pragma unroll
    for (int ks = 0; ks < 4; ++ks) kg[ks] = *(const LAS bf16x8*)(Kc + 4096 + coff[ks]);
#pragma unroll
    for (int ks = 0; ks < 4; ++ks) s0 = MFMA32(kf[ks], qf[ks], s0);
#pragma unroll
    for (int ks = 0; ks < 4; ++ks) s1 = MFMA32(kg[ks], qf[ks], s1);
}
DI void attn_partial(f32x16& s0, f32x16& s1, float& m_run, float& alpha, bool& resc) {
    float tmax = fmaxf(s0[0], s1[0]);
#pragma unroll
    for (int j = 1; j < 16; ++j) tmax = fmaxf(fmaxf(tmax, s0[j]), s1[j]);
    { auto rr = __builtin_amdgcn_permlane32_swap(__float_as_uint(tmax), __float_as_uint(tmax), false, false); tmax = fmaxf(__uint_as_float(rr[0]), __uint_as_float(rr[1])); }
    resc = __any(tmax > m_run); alpha = 1.f;
    if (resc) { const float mn = fmaxf(m_run, tmax); alpha = __builtin_amdgcn_exp2f(m_run - mn); m_run = mn; }
    const f32x2v m2 = {m_run, m_run};
#pragma unroll
    for (int j = 0; j < 8; ++j) { f32x2v a = (f32x2v){s0[2 * j], s0[2 * j + 1]} - m2, c = (f32x2v){s1[2 * j], s1[2 * j + 1]} - m2;
        s0[2 * j] = __builtin_amdgcn_exp2f(a[0]); s0[2 * j + 1] = __builtin_amdgcn_exp2f(a[1]); s1[2 * j] = c[0]; s1[2 * j + 1] = c[1]; }
}
DI void attn_finish(f32x16& s0, f32x16& s1, float alpha, float& l_run, bf16x8 (&pf)[4]) {
    f32x2v ps = {0.f, 0.f};
#pragma unroll
    for (int j = 0; j < 8; ++j) { s1[2 * j] = __builtin_amdgcn_exp2f(s1[2 * j]); s1[2 * j + 1] = __builtin_amdgcn_exp2f(s1[2 * j + 1]);
        ps += (f32x2v){s0[2 * j], s0[2 * j + 1]}; ps += (f32x2v){s1[2 * j], s1[2 * j + 1]}; }
    l_run = l_run * alpha + (ps[0] + ps[1]);
    pf[0] = pack_p(s0, 0); pf[1] = pack_p(s0, 1); pf[2] = pack_p(s1, 0); pf[3] = pack_p(s1, 1);
}
DI void attn_partial_nm(f32x16& s0, f32x16& s1, float& ps) {
#pragma unroll
    for (int j = 0; j < 16; ++j) { s0[j] = __builtin_amdgcn_exp2f(s0[j]); s1[j] = __builtin_amdgcn_exp2f(s1[j]); }
    float a = s0[0];
#pragma unroll
    for (int j = 1; j < 16; ++j) a += s0[j];
    ps = a;
}
DI void attn_finish_nm(f32x16& s0, f32x16& s1, float ps, float& l_run, bf16x8 (&pf)[4]) {
    float a = ps;
#pragma unroll
    for (int j = 0; j < 16; ++j) a += s1[j];
    l_run += a;
    pf[0] = pack_p(s0, 0); pf[1] = pack_p(s0, 1); pf[2] = pack_p(s1, 0); pf[3] = pack_p(s1, 1);
}
#define AT_DMA1(gp, la) asm volatile("s_mov_b32 m0, %0\n\ts_nop 0\n\tglobal_load_lds_dwordx4 %1, off" :: "s"((unsigned)(unsigned long long)(la)), "v"(gp) : "m0", "memory")
DI void attn_step_nm(const LAS unsigned char* Kc, const LAS unsigned char* Vc, const int (&coff)[4], const bf16x8 (&qf)[4],
                     const f32x16& P0, const f32x16& P1, float psP, f32x16& N0, f32x16& N1, float& psN, float& l_run, f32x16 (&o)[4],
                     const bf16_t* kgn, const bf16_t* vgn, int kofs, int vofs, bool dma, unsigned ldsK, unsigned ldsV) {
    bf16x8 kf[8], vf[16]; unsigned w[16];
#pragma unroll
    for (int i = 0; i < 8; ++i) { kf[i] = *(const LAS bf16x8*)(Kc + (i >> 2) * 4096 + coff[i & 3]); SCHED_FENCE(); }
    const f32x16 z = {0.f, 0.f, 0.f, 0.f, 0.f, 0.f, 0.f, 0.f, 0.f, 0.f, 0.f, 0.f, 0.f, 0.f, 0.f, 0.f};
    float a = psP;
#pragma unroll
    for (int g = 0; g < 8; ++g) {
        if (g < 4) N0 = MFMA32(kf[g], qf[g], g == 0 ? z : N0); else N1 = MFMA32(kf[g], qf[g - 4], g == 4 ? z : N1);
        a += P1[2 * g]; a += P1[2 * g + 1];
        if (g < 4) { w[2 * g] = pk2(P0[4 * g], P0[4 * g + 1]); w[2 * g + 1] = pk2(P0[4 * g + 2], P0[4 * g + 3]); }
        else { w[2 * g] = pk2(P1[4 * g - 16], P1[4 * g - 15]); w[2 * g + 1] = pk2(P1[4 * g - 14], P1[4 * g - 13]); }
        if (g >= 4) vf[g - 4] = *(const LAS bf16x8*)(Vc + coff[g - 4]);
        if (g == 1) { if (dma) AT_DMA1(kgn + kofs, ldsK); } else if (g == 2) { if (dma) AT_DMA1(vgn + vofs, ldsV); } else if (g == 3) { if (dma) AT_DMA1(vgn + (vofs + 64 * TT), ldsV + 8192u); }
        SCHED_FENCE();
    }
    l_run += a;
    bf16x8 pf[4];
#pragma unroll
    for (int k = 0; k < 4; ++k) { const u32x4 t = {w[4 * k], w[4 * k + 1], w[4 * k + 2], w[4 * k + 3]}; pf[k] = __builtin_bit_cast(bf16x8, t); }
    float bsum = 0.f;
#pragma unroll
    for (int g = 0; g < 16; ++g) {
        o[g >> 2] = MFMA32(vf[g], pf[g & 3], o[g >> 2]);
        if (g + 4 < 16) vf[g + 4] = *(const LAS bf16x8*)(Vc + ((g + 4) >> 2) * 4096 + coff[(g + 4) & 3]);
        if (g < 8) { N0[2 * g] = __builtin_amdgcn_exp2f(N0[2 * g]); N0[2 * g + 1] = __builtin_amdgcn_exp2f(N0[2 * g + 1]); bsum = (g == 0) ? N0[0] + N0[1] : (bsum + N0[2 * g]) + N0[2 * g + 1]; }
        else { N1[2 * g - 16] = __builtin_amdgcn_exp2f(N1[2 * g - 16]); N1[2 * g - 15] = __builtin_amdgcn_exp2f(N1[2 * g - 15]); }
        SCHED_FENCE();
    }
    psN = bsum;
}
DI void attn_pv(const LAS unsigned char* Vc, const int (&coff)[4], const bf16x8 (&pf)[4], f32x16 (&o)[4]) {
#pragma unroll
    for (int dvb = 0; dvb < 4; ++dvb) { bf16x8 va[4];
#pragma unroll
        for (int i = 0; i < 4; ++i) va[i] = *(const LAS bf16x8*)(Vc + dvb * 4096 + coff[i]);
#pragma unroll
        for (int i = 0; i < 4; ++i) o[dvb] = MFMA32(va[i], pf[i], o[dvb]); }
}
#ifndef PROBE_ATTN_ABL
#define PROBE_ATTN_ABL 0
#endif
template <int ABL, bool NM> DI void attn_unit(const Params& p, LAS unsigned char* lds, int b, int h, int m, int sq0, int nkt) {
    const int tid = otid(), wave = tid >> 6, lane = tid & 63, r32 = lane & 31, h2 = lane >> 5;
    const bf16_t* PA = (const bf16_t*)(p.ws + OFF_PA); const bf16_t* VT = (const bf16_t*)(p.ws + OFF_VT);
    bf16_t* O = (bf16_t*)(p.ws + (ABL ? WS_NEEDED : OFF_OA)) + (size_t)m * RR * 512;
    const size_t rowbase = (size_t)b * TT;
    bf16x8 qf[4];
    {   const bf16_t* qp = PA + (rowbase + sq0 + wave * 32 + r32) * 1536 + (h * 2 + m) * 64 + 8 * h2;
#pragma unroll
        for (int ks = 0; ks < 4; ++ks) qf[ks] = *(const bf16x8*)(qp + 16 * ks); }
    const int srow = tid >> 3, sch = (tid & 7) ^ ((srow >> 1) & 7);
    const bf16_t* kgb = PA + rowbase * 1536 + 512 + (h * 2 + m) * 64;
    const bf16_t* vgb = VT + ((size_t)((b * 4 + h) * 128)) * TT;
    const int kofs = srow * 1536 + sch * 8, vofs = srow * TT + sch * 8;
    LAS unsigned char* Kb = lds; LAS unsigned char* Vb = lds + 24576;
    const int swz = (r32 >> 1) & 7;
    int coff[4];
#pragma unroll
    for (int ks = 0; ks < 4; ++ks) coff[ks] = r32 * 128 + (((2 * ks + h2) ^ swz) << 4);
    f32x16 o[4];
#pragma unroll
    for (int i = 0; i < 4; ++i)
#pragma unroll
        for (int j = 0; j < 16; ++j) o[i][j] = 0.f;
    float m_run = -1e30f, l_run = 0.f, alA = 1.f, alB = 1.f; bool rsA = false, rsB = false;
    f32x16 A0, A1, B0, B1; bf16x8 pf[4];
    int bprev = 2, bcur = 0, bnext = 1;
    const int wu = __builtin_amdgcn_readfirstlane(tid >> 6) * 1024;
#define AT_DMA(t, bi) do { if (ABL & 4) break; \
        AT_DMA1(kgb + (kofs + (t) * 64 * 1536), Kb + (bi) * 8192 + wu); \
        AT_DMA1(vgb + (vofs + (t) * 64), Vb + (bi) * 16384 + wu); \
        AT_DMA1(vgb + (vofs + 64 * TT + (t) * 64), Vb + (bi) * 16384 + 8192 + wu); } while (0)
#define AT_LANDED() do { if (!(ABL & 4)) asm volatile("s_waitcnt vmcnt(0)" ::: "memory"); } while (0)
#define AT_BAR() do { if (!(ABL & 4)) lds_barrier(); } while (0)
#define AT_QK(Kc, N0, N1) do { if (ABL & 2) { _Pragma("unroll") for (int j_ = 0; j_ < 16; ++j_) { asm volatile("" : "+v"(N0[j_])); asm volatile("" : "+v"(N1[j_])); } } else attn_qk(Kc, coff, qf, N0, N1); } while (0)
#define AT_PV(Vc) do { if (ABL & 2) { _Pragma("unroll") for (int i_ = 0; i_ < 4; ++i_) asm volatile("" :: "v"(pf[i_])); } else attn_pv(Vc, coff, pf, o); } while (0)
#define AT_PART(N0, N1, alN, rsN) do { if (ABL & 1) { alN = 1.f; rsN = false; } else if (NM) { rsN = false; attn_partial_nm(N0, N1, alN); } else attn_partial(N0, N1, m_run, alN, rsN); } while (0)
#define AT_FIN(P0, P1, alP) do { if (ABL & 1) { pf[0] = pack_p(P0, 0); pf[1] = pack_p(P0, 1); pf[2] = pack_p(P1, 0); pf[3] = pack_p(P1, 1); l_run = 1.f; } else if (NM) attn_finish_nm(P0, P1, alP, l_run, pf); else attn_finish(P0, P1, alP, l_run, pf); } while (0)
#define AT_ROT() do { const int t_ = bprev; bprev = bcur; bcur = bnext; bnext = t_; } while (0)
#define AT_RESC(al, rs) do { if (__builtin_expect(rs, 0)) { asm volatile("" ::: "memory"); _Pragma("unroll") for (int i_ = 0; i_ < 4; ++i_) _Pragma("unroll") for (int j_ = 0; j_ < 16; ++j_) o[i_][j_] *= (al); } } while (0)
#define AT_STEP(j, P0, P1, alP, N0, N1, alN, rsN) do { \
        if constexpr (NM && ABL == 0) { SCHED_FENCE(); attn_step_nm(Kb + bcur * 8192, Vb + bprev * 16384, coff, qf, P0, P1, alP, N0, N1, alN, l_run, o, \
            kgb + ((j) + 1) * 64 * 1536, vgb + ((j) + 1) * 64, kofs, vofs, (j) + 1 < nkt, (unsigned)(unsigned long long)(Kb + bnext * 8192 + wu), (unsigned)(unsigned long long)(Vb + bnext * 16384 + wu)); \
            SCHED_FENCE(); AT_LANDED(); AT_BAR(); AT_ROT(); break; } \
        if ((j) + 1 < nkt) AT_DMA((j) + 1, bnext); \
        SCHED_FENCE(); \
        AT_QK(Kb + bcur * 8192, N0, N1); AT_FIN(P0, P1, alP); \
        __builtin_amdgcn_sched_group_barrier(0x100, 8, 0); \
        _Pragma("unroll") for (int g_ = 0; g_ < 8; ++g_) { __builtin_amdgcn_sched_group_barrier(0x8, 1, 0); __builtin_amdgcn_sched_group_barrier(0x402, NM ? 5 : 7, 0); } \
        SCHED_FENCE(); \
        AT_PV(Vb + bprev * 16384); AT_PART(N0, N1, alN, rsN); \
        __builtin_amdgcn_sched_group_barrier(0x100, 4, 0); \
        _Pragma("unroll") for (int g_ = 0; g_ < 16; ++g_) { __builtin_amdgcn_sched_group_barrier(0x8, 1, 0); __builtin_amdgcn_sched_group_barrier(0x100, 1, 0); __builtin_amdgcn_sched_group_barrier(0x402, NM ? 3 : 4, 0); } \
        SCHED_FENCE(); \
        AT_RESC(alN, rsN); \
        AT_LANDED(); AT_BAR(); AT_ROT(); } while (0)
    AT_DMA(0, 0); AT_LANDED(); AT_BAR();
    if (nkt > 1) AT_DMA(1, 1);
    AT_QK(Kb, A0, A1); AT_PART(A0, A1, alA, rsA);
    AT_LANDED(); AT_BAR(); AT_ROT();
    int j = 1;
    for (; j + 1 < nkt; j += 2) { AT_STEP(j, A0, A1, alA, B0, B1, alB, rsB); AT_STEP(j + 1, B0, B1, alB, A0, A1, alA, rsA); }
    if (j < nkt) {
        AT_STEP(j, A0, A1, alA, B0, B1, alB, rsB);
        AT_FIN(B0, B1, alB);
    } else AT_FIN(A0, A1, alA);
    AT_PV(Vb + bprev * 16384);
#undef AT_DMA
#undef AT_LANDED
#undef AT_ROT
#undef AT_RESC
#undef AT_STEP
#undef AT_BAR
#undef AT_QK
#undef AT_PV
#undef AT_PART
#undef AT_FIN
    { auto rr = __builtin_amdgcn_permlane32_swap(__float_as_uint(l_run), __float_as_uint(l_run), false, false); l_run = __uint_as_float(rr[0]) + __uint_as_float(rr[1]); }
    const float inv = 1.f / l_run;
    const int tid2 = otid();
    bf16_t* orow = O + (rowbase + sq0 + (tid2 >> 6) * 32 + (tid2 & 31)) * 512 + h * 128 + 4 * ((tid2 >> 5) & 1);
#pragma unroll
    for (int dvb = 0; dvb < 4; ++dvb)
#pragma unroll
        for (int g = 0; g < 4; ++g) { u32x2 w = {pk2(o[dvb][4 * g] * inv, o[dvb][4 * g + 1] * inv), pk2(o[dvb][4 * g + 2] * inv, o[dvb][4 * g + 3] * inv)};
            *(u32x2*)(orow + dvb * 32 + 8 * g) = w; }
    lds_barrier();
}

constexpr int CS_TKK = 0, CS_TR = 2304, CS_TKD = 4608, CS_TKA = 6912, CS_TVN = 9216, CS_TDA = 11264, CS_TVS = 16384, CS_G15 = 21504, CS_TBM = 21760, CS_TCM = 23040, CS_TBC = 24064, CS_BUF = 25344;
constexpr int CS_E = 2 * CS_BUF, CS_YO = CS_E + 4096;
constexpr int CS_RS = 144, CS_RT = 80, CS_C = 16, CS_NCH = TT / CS_C;
static_assert(CS_NCH % 4 == 0 && CS_YO + 4096 <= 131072, "scan");
#ifndef PROBE_SCAN_ABL
#define PROBE_SCAN_ABL 0
#endif
DI void scan_unit(const Params& p, int l, LAS unsigned char* lds, int u, int dup = 0) {
    const int abl = dup ? PROBE_SCAN_ABL : 0;
    const int tid = otid(), wave = tid >> 6, lane = tid & 63, c16 = lane & 15, q = lane >> 4;
    const int chain = u; const int dir = chain & 1, bh = chain >> 1, b = bh >> 3, h = bh & 7;
    auto tok = [&](int i) -> int { return dir == 0 ? i : (i < NCTX ? (NCTX - 1 - i) : (TT + NCTX - 1 - i)); };
    for (int i = tid; i < 2 * 16 * 16; i += 512) { const int bf = i >> 8, r = (i >> 4) & 15, cidx = i & 15; *(LAS unsigned short*)(lds + bf * CS_BUF + CS_TBM + r * CS_RT + (16 + cidx) * 2) = 0; }
    for (int i = tid; i < 2 * 64 * 16; i += 512) { const int bf = i >> 10, r = (i >> 4) & 63, cidx = i & 15; *(LAS unsigned short*)(lds + bf * CS_BUF + CS_TVS + r * CS_RT + (16 + cidx) * 2) = 0; }
    lds_barrier();
    if (wave >= 4) {
        __builtin_amdgcn_s_setprio(1);
        const bf16_t* EW = (const bf16_t*)(p.ws + OFF_EW) + (size_t)dir * RR * 512; const bf16_t* AA = (const bf16_t*)(p.ws + OFF_AA) + (size_t)dir * RR * 512;
        const bf16_t* KK = (const bf16_t*)(p.ws + OFF_KK); const bf16_t* KC = (const bf16_t*)(p.ws + OFF_KC); const bf16_t* RC = (const bf16_t*)(p.ws + OFF_RC); const bf16_t* VC = (const bf16_t*)(p.ws + OFF_VC);
        bf16_t* OS = (bf16_t*)(p.ws + ((dup && PROBE_SCAN_ABL) ? WS_NEEDED : OFF_OS)) + (size_t)dir * RR * 512;
        const int pu = tid - 256, pw = wave - 4, lt = pu >> 4, k4 = (pu & 15) * 4;
        const int posk = 32 * (k4 >> 5) + 8 * (((k4 & 31) >> 2) & 3) + 4 * ((k4 & 31) >> 4);
        const f32x4 ka4 = *(const f32x4*)(p.rwkv_k_a + l * 512 + h * 64 + k4);
        struct Raw { u32x2 re, rk, ra, rkc, rr_, rv; };
        auto gload = [&](int c) -> Raw { const size_t off = ((size_t)b * TT + tok(c * CS_C + lt)) * 512 + h * 64 + k4; Raw w;
            w.re = *(const u32x2*)(EW + off); w.rk = *(const u32x2*)(KK + off); w.ra = *(const u32x2*)(AA + off); w.rkc = *(const u32x2*)(KC + off); w.rr_ = *(const u32x2*)(RC + off); w.rv = *(const u32x2*)(VC + off); return w; };
        float cmask[16];
#pragma unroll
        for (int i = 0; i < 16; ++i) { cmask[i] = (i <= lt) ? 1.f : 0.f; asm volatile("" : "+v"(cmask[i])); }
        auto stage1 = [&](const Raw& w) { float e[4]; unpack4(w.re, e); *(LAS f32x4*)(lds + CS_E + (lt * 64 + k4) * 4) = (f32x4){e[0], e[1], e[2], e[3]}; };
        auto stage2 = [&](const Raw& w, int par) {
            LAS unsigned char* B = lds + par * CS_BUF;
            f32x4 cs = (f32x4){0.f, 0.f, 0.f, 0.f};
            f32x2v c01 = {0.f, 0.f}, c23 = {0.f, 0.f};
#pragma unroll
            for (int i = 0; i < 16; ++i) { const f32x4 ev = *(const LAS f32x4*)(lds + CS_E + (i * 64 + k4) * 4); const f32x2v mk2 = {cmask[i], cmask[i]};
                c01 = __builtin_elementwise_fma(mk2, (f32x2v){ev[0], ev[1]}, c01); c23 = __builtin_elementwise_fma(mk2, (f32x2v){ev[2], ev[3]}, c23); }
            cs = (f32x4){c01[0], c01[1], c23[0], c23[1]};
            float e[4], kk[4], a[4], kc[4], r[4]; unpack4(w.re, e); unpack4(w.rk, kk); unpack4(w.ra, a); unpack4(w.rkc, kc); unpack4(w.rr_, r);
            float tkk[4], tr[4], tkd[4], tka[4]; f32x4 g;
#pragma unroll
            for (int i = 0; i < 4; ++i) { g[i] = __builtin_amdgcn_exp2f(-cs[i]); const float gi = __builtin_amdgcn_exp2f(cs[i]), gp = __builtin_amdgcn_exp2f(e[i] - cs[i]);
                tkk[i] = kk[i] * gp; tr[i] = r[i] * g[i]; tkd[i] = kc[i] * (1.f + (a[i] - 1.f) * ka4[i]) * gi; tka[i] = kk[i] * a[i] * gi; }
            *(LAS u32x2*)(B + CS_TKK + lt * CS_RS + posk * 2) = (u32x2){pk2(tkk[0], tkk[1]), pk2(tkk[2], tkk[3])};
            *(LAS u32x2*)(B + CS_TR + lt * CS_RS + posk * 2) = (u32x2){pk2(tr[0], tr[1]), pk2(tr[2], tr[3])};
            *(LAS u32x2*)(B + CS_TKD + lt * CS_RS + posk * 2) = (u32x2){pk2(tkd[0], tkd[1]), pk2(tkd[2], tkd[3])};
            *(LAS u32x2*)(B + CS_TKA + lt * CS_RS + posk * 2) = (u32x2){pk2(tka[0], tka[1]), pk2(tka[2], tka[3])};
            *(LAS u32x2*)(B + CS_TVN + (lt * 64 + k4) * 2) = w.rv;
            if (lt == 15) *(LAS f32x4*)(B + CS_G15 + k4 * 4) = g;
        };
        auto stage3 = [&](int par) {
            LAS unsigned char* B = lds + par * CS_BUF;
            {   const LAS unsigned char* ta = B + ((pw & 1) ? CS_TKA : CS_TKD) + c16 * CS_RS + q * 16; const LAS unsigned char* tb = B + ((pw & 2) ? CS_TR : CS_TKK) + c16 * CS_RS + q * 16;
                f32x4 m = (f32x4){0.f, 0.f, 0.f, 0.f};
                m = MFMA16(*(const LAS bf16x8*)ta, *(const LAS bf16x8*)tb, m); m = MFMA16(*(const LAS bf16x8*)(ta + 64), *(const LAS bf16x8*)(tb + 64), m);
#pragma unroll
                for (int i = 0; i < 4; ++i) { const int j = 4 * q + i; const bool keep = (pw & 2) ? (j <= c16) : (j < c16); m[i] = keep ? m[i] : 0.f; }
                if (pw == 0) { u32x2 w = {pk2(m[0], m[1]), pk2(m[2], m[3])}; *(LAS u32x2*)(B + CS_TBM + c16 * CS_RT + 8 * q) = w; }
                else if (pw == 1) *(LAS f32x4*)(B + CS_TCM + (c16 * 16 + 4 * q) * 4) = m;
                else if (pw == 2) { u32x2 w = {pk2(m[0], m[1]), pk2(m[2], m[3])}; *(LAS u32x2*)(B + CS_TBC + c16 * CS_RT + 8 * q) = w; }
                else { u32x2 w = {pk2(-m[0], -m[1]), pk2(-m[2], -m[3])}; *(LAS u32x2*)(B + CS_TBC + c16 * CS_RT + 32 + 8 * q) = w; } }
            if (pu < 192) { const bool isv = pu >= 128; const int kk_ = isv ? (pu - 128) : (pu >> 1), half = isv ? 0 : (pu & 1);
                const int pk_ = 32 * (kk_ >> 5) + 8 * (((kk_ & 31) >> 2) & 3) + 4 * ((kk_ & 31) >> 4) + (kk_ & 3);
                const LAS unsigned char* src = isv ? (B + CS_TVN + kk_ * 2) : (B + (half ? CS_TKA : CS_TKD) + pk_ * 2); const int sstr = isv ? 128 : CS_RS;
                unsigned w[8];
#pragma unroll
                for (int t2 = 0; t2 < 8; ++t2) { const unsigned lo = *(const LAS unsigned short*)(src + (2 * t2) * sstr), hi = *(const LAS unsigned short*)(src + (2 * t2 + 1) * sstr); w[t2] = (lo | (hi << 16)) ^ (half ? 0x80008000u : 0u); }
                LAS unsigned char* dst = isv ? (B + CS_TVS + kk_ * CS_RT) : (B + CS_TDA + kk_ * CS_RT + half * 32);
                *(LAS u32x4*)dst = (u32x4){w[0], w[1], w[2], w[3]}; *(LAS u32x4*)(dst + 16) = (u32x4){w[4], w[5], w[6], w[7]}; }
        };
        Raw ring[4]; ring[0] = gload(0); ring[1] = gload(1); ring[2] = gload(2); ring[3] = gload(3);
        stage1(ring[0]); lds_barrier();
        stage2(ring[0], 0); ring[0] = gload(4); lds_barrier();
        stage3(0); stage1(ring[1]); lds_barrier();
#pragma unroll 1
        for (int c4 = 0; c4 < CS_NCH; c4 += 4) {
#pragma unroll
            for (int ci = 0; ci < 4; ++ci) { const int c = c4 + ci;
                if (c + 1 < CS_NCH) { if (!(abl & 2)) stage2(ring[(ci + 1) & 3], (c + 1) & 1); if (c + 5 < CS_NCH && !(abl & 8)) ring[(ci + 1) & 3] = gload(c + 5); }
                lds_barrier();
                if (c + 1 < CS_NCH && !(abl & 4)) stage3((c + 1) & 1);
                lds_barrier();
                if (!(abl & 16)) {   const f32x4 yy = *(const LAS f32x4*)(lds + CS_YO + (lt * 64 + k4) * 4);
                    *(u32x2*)(OS + ((size_t)b * TT + tok(c * CS_C + lt)) * 512 + h * 64 + k4) = (u32x2){pk2(yy[0], yy[1]), pk2(yy[2], yy[3])}; }
                if (c + 2 < CS_NCH) stage1(ring[(ci + 2) & 3]);
                lds_barrier();
            }
        }
        __builtin_amdgcn_s_setprio(0);
    } else {
        const int v = 16 * wave + c16;
        f32x4 sT[4];
#pragma unroll
        for (int i = 0; i < 4; ++i) sT[i] = (f32x4){0.f, 0.f, 0.f, 0.f};
        lds_barrier(); lds_barrier(); lds_barrier();
#pragma unroll 1
        for (int c = 0; c < CS_NCH; ++c) {
            if (abl & 1) { lds_barrier(); lds_barrier(); lds_barrier(); continue; }
            const LAS unsigned char* B = lds + (c & 1) * CS_BUF;
            const LAS unsigned char* tvs = B + CS_TVS + v * CS_RT + q * 16;
            const bf16x8 fkk0 = *(const LAS bf16x8*)(B + CS_TKK + c16 * CS_RS + q * 16), fkk1 = *(const LAS bf16x8*)(B + CS_TKK + c16 * CS_RS + 64 + q * 16);
            const bf16x8 fbm = *(const LAS bf16x8*)(B + CS_TBM + c16 * CS_RT + q * 16), fv0 = *(const LAS bf16x8*)tvs;
            f32x4 cc[4][4], cin[4];
#pragma unroll
            for (int i = 0; i < 4; ++i) { cin[i] = *(const LAS f32x4*)(B + CS_TCM + ((4 * q + i) * 16 + 4 * q) * 4);
#pragma unroll
                for (int jj = 0; jj < 4; ++jj) cc[i][jj] = *(const LAS f32x4*)(B + CS_TCM + ((4 * q + i) * 16 + 4 * jj) * 4); }
            const bf16x8 fr0 = *(const LAS bf16x8*)(B + CS_TR + c16 * CS_RS + q * 16), fr1 = *(const LAS bf16x8*)(B + CS_TR + c16 * CS_RS + 64 + q * 16);
            const bf16x8 fbc = *(const LAS bf16x8*)(B + CS_TBC + c16 * CS_RT + q * 16);
            bf16x8 fda[4]; f32x4 gg[4];
#pragma unroll
            for (int rb = 0; rb < 4; ++rb) { fda[rb] = *(const LAS bf16x8*)(B + CS_TDA + (16 * rb + c16) * CS_RT + q * 16); gg[rb] = *(const LAS f32x4*)(B + CS_G15 + (16 * rb + 4 * q) * 4); }
            bf16x8 sf[2];
#pragma unroll
            for (int s2 = 0; s2 < 2; ++s2) { u32x4 w = {pk2(sT[2 * s2][0], sT[2 * s2][1]), pk2(sT[2 * s2][2], sT[2 * s2][3]), pk2(sT[2 * s2 + 1][0], sT[2 * s2 + 1][1]), pk2(sT[2 * s2 + 1][2], sT[2 * s2 + 1][3])}; sf[s2] = __builtin_bit_cast(bf16x8, w); }
            f32x4 x = (f32x4){0.f, 0.f, 0.f, 0.f};
            x = MFMA16(fkk0, sf[0], x); x = MFMA16(fkk1, sf[1], x); x = MFMA16(fbm, fv0, x);
            f32x4 yv = (f32x4){0.f, 0.f, 0.f, 0.f};
            yv = MFMA16(fr0, sf[0], yv); yv = MFMA16(fr1, sf[1], yv);
            f32x4 sa = (f32x4){0.f, 0.f, 0.f, 0.f};
#pragma unroll
            for (int q0 = 0; q0 < 4; ++q0) {
                f32x4 y; y[0] = x[0]; y[1] = x[1] - y[0] * cin[1][0]; y[2] = x[2] - y[0] * cin[2][0] - y[1] * cin[2][1]; y[3] = x[3] - y[0] * cin[3][0] - y[1] * cin[3][1] - y[2] * cin[3][2];
                if (q == q0) sa = y;
                if (q0 < 3) { const int src = (c16 + 16 * q0) << 2; const float b0 = bperm(y[0], src), b1 = bperm(y[1], src), b2 = bperm(y[2], src), b3 = bperm(y[3], src);
#pragma unroll
                    for (int i = 0; i < 4; ++i) x[i] -= b0 * cc[i][q0][0] + b1 * cc[i][q0][1] + b2 * cc[i][q0][2] + b3 * cc[i][q0][3]; }
            }
            lds_barrier();
            { u32x2 w = {pk2(sa[0], sa[1]), pk2(sa[2], sa[3])}; *(LAS u32x2*)(lds + (c & 1) * CS_BUF + CS_TVS + v * CS_RT + 32 + q * 8) = w; }
            const bf16x8 bvs = *(const LAS bf16x8*)tvs;
            yv = MFMA16(fbc, bvs, yv);
#pragma unroll
            for (int rb = 0; rb < 4; ++rb) sT[rb] = MFMA16(fda[rb], bvs, sT[rb]);
#pragma unroll
            for (int i = 0; i < 4; ++i) *(LAS float*)(lds + CS_YO + ((4 * q + i) * 64 + v) * 4) = yv[i];
            lds_barrier();
#pragma unroll
            for (int rb = 0; rb < 4; ++rb) sT[rb] *= gg[rb];
            lds_barrier();
        }
    }
    lds_barrier();
}

__device__ void ph_mix(const Params& p, int l, LAS unsigned char* lds, LAS unsigned* bcast, int dup) {
    unsigned* ctr = (unsigned*)(p.ws + OFF_CTR) + l * 64 + (dup ? 32 : 0);
    constexpr int N_SCAN = 64, N_LAT = 1024, N_CTX = 32;
    bool nm; { const int lane = otid() & 63; const float mq = wave_max(fabsf(p.q_norm_g[l * 64 + lane])), mk = wave_max(fabsf(p.k_norm_g[l * 64 + lane]));
        nm = __builtin_amdgcn_readfirstlane((8.f * 1.4426950408889634f * mq * mk <= 64.f) ? 1 : 0) != 0; }
    for (;;) {
        if (otid() == 0) *bcast = atomicAdd(ctr, 1u);
        __syncthreads();
        const int u = (int)*bcast;
        __syncthreads();
        if (u >= N_SCAN + N_LAT + N_CTX) break;
#ifdef PROBE_DMODE
        if (dup && PROBE_DMODE == 2 && u >= N_SCAN) break;
        if (dup && PROBE_DMODE == 3 && u < N_SCAN) continue;
#endif
        if (u < N_SCAN) scan_unit(p, l, lds, u, dup);
        else if (u < N_SCAN + N_LAT) { const int v = u - N_SCAN; const int qb = v & 31, m = (v >> 5) & 1, h = (v >> 6) & 3, b = v >> 8;
            if (PROBE_ATTN_ABL != 0 && dup) attn_unit<PROBE_ATTN_ABL, false>(p, lds, b, h, m, NCTX + qb * 256, TT / 64);
            else if (nm) attn_unit<0, true>(p, lds, b, h, m, NCTX + qb * 256, TT / 64); else attn_unit<0, false>(p, lds, b, h, m, NCTX + qb * 256, TT / 64); }
        else { const int v = u - N_SCAN - N_LAT; const int m = v & 1, h = (v >> 1) & 3, b = v >> 3; attn_unit<0, false>(p, lds, b, h, m, 0, NCTX / 64); }
    }
    if (!dup) { conv_expert_weights(p, l, lds); if (l + 1 < NL) conv_mixer_a(p, l + 1, lds); }
}
__device__ void ph_post(const Params& p, int l, int wg, int nwg) {
    const int tid = otid(), wave = tid >> 6, lane = tid & 63;
    const float lam_init = 0.8f - 0.6f * expf(-0.3f * (float)l);
    float lam;
    {   const float* lv = p.diff_lambda + l * 256; const float a = wave_sum(lv[lane] * lv[64 + lane]), c = wave_sum(lv[128 + lane] * lv[192 + lane]); lam = expf(a) - expf(c) + lam_init; }
    const bf16_t* OA0 = (const bf16_t*)(p.ws + OFF_OA); const bf16_t* OA1 = OA0 + (size_t)RR * 512;
    const bf16_t* OS0 = (const bf16_t*)(p.ws + OFF_OS); const bf16_t* OS1 = OS0 + (size_t)RR * 512;
    const bf16_t* YB0 = (const bf16_t*)(p.ws + OFF_YB0); const bf16_t* G = (const bf16_t*)(p.ws + OFF_G);
    bf16_t* YA = (bf16_t*)(p.ws + OFF_YA); bf16_t* YB = (bf16_t*)(p.ws + OFF_YB);
    float sg[8], lg[8];
#pragma unroll
    for (int i = 0; i < 8; ++i) { sg[i] = p.diff_subln_g[l * 128 + (lane & 15) * 8 + i] * (1.f - lam_init); lg[i] = p.rwkv_ln_g[l * 512 + lane * 8 + i]; }
    const int rstep = nwg * 8; int r = wg * 8 + wave;
    u32x4 la, lc, ly0, lgg, lo0, lo1;
    auto ldrow = [&](int rr) { const size_t o = (size_t)rr * 512 + lane * 8; la = *(const u32x4*)(OA0 + o); lc = *(const u32x4*)(OA1 + o); ly0 = *(const u32x4*)(YB0 + o); lgg = *(const u32x4*)(G + o); lo0 = *(const u32x4*)(OS0 + o); lo1 = *(const u32x4*)(OS1 + o); };
    if (r < RR) ldrow(r);
    while (r < RR) {
        const size_t o = (size_t)r * 512 + lane * 8;
        const u32x4 a = la, c = lc, y0 = ly0, gg = lgg, ov0 = lo0, ov1 = lo1;
        if (r + rstep < RR) ldrow(r + rstep);
        {   float v[8]; float ss = 0.f;
#pragma unroll
            for (int i = 0; i < 4; ++i) { v[2 * i] = bflo(a[i]) - lam * bflo(c[i]); v[2 * i + 1] = bfhi(a[i]) - lam * bfhi(c[i]); ss += v[2 * i] * v[2 * i] + v[2 * i + 1] * v[2 * i + 1]; }
            ss = allsum16(ss);
            const float rinv = rsqrtf(ss * (1.f / 128.f) + 1e-6f);
            u32x4 w;
#pragma unroll
            for (int i = 0; i < 4; ++i) w[i] = pk2(v[2 * i] * rinv * sg[2 * i], v[2 * i + 1] * rinv * sg[2 * i + 1]);
            *(u32x4*)(YA + o) = w; }
        {   float y[8];
#pragma unroll
            for (int i = 0; i < 4; ++i) { y[2 * i] = bflo(y0[i]); y[2 * i + 1] = bfhi(y0[i]); }
#pragma unroll
            for (int d = 0; d < 2; ++d) { const u32x4 ov = d ? ov1 : ov0; float v[8]; float sm = 0.f;
#pragma unroll
                for (int i = 0; i < 4; ++i) { v[2 * i] = bflo(ov[i]); v[2 * i + 1] = bfhi(ov[i]); sm += v[2 * i] + v[2 * i + 1]; }
                const float mu = allsum8(sm) * (1.f / 64.f); float sq = 0.f;
#pragma unroll
                for (int i = 0; i < 8; ++i) { v[i] -= mu; sq += v[i] * v[i]; }
                const float rinv = rsqrtf(allsum8(sq) * (1.f / 64.f) + 64e-5f);
#pragma unroll
                for (int i = 0; i < 8; ++i) y[i] += v[i] * rinv * lg[i]; }
            u32x4 w;
#pragma unroll
            for (int i = 0; i < 4; ++i) w[i] = pk2(y[2 * i] * bflo(gg[i]), y[2 * i + 1] * bfhi(gg[i]));
            *(u32x4*)(YB + o) = w; }
        r += rstep;
    }
}

template <int KSTEPS> DI void rows16_mma2(const bf16_t* arow, const bf16_t* brow, int ldb, f32x4 (&acc)[2]) {
#pragma unroll 1
    for (int k0 = 0; k0 < KSTEPS; k0 += 8) { bf16x8 a[8], b0[8], b1[8];
#pragma unroll
        for (int k = 0; k < 8; ++k) { a[k] = *(const bf16x8*)(arow + 32 * (k0 + k)); b0[k] = *(const bf16x8*)(brow + 32 * (k0 + k)); b1[k] = *(const bf16x8*)(brow + ldb + 32 * (k0 + k)); }
#pragma unroll
        for (int k = 0; k < 8; ++k) { acc[0] = MFMA16(a[k], b0[k], acc[0]); acc[1] = MFMA16(a[k], b1[k], acc[1]); } }
}
__device__ void ctx_merge_units(const Params& p, int wg, int nwg) {
    const int tid = otid(), wave = tid >> 6, lane = tid & 63, c16 = lane & 15, q = lane >> 4;
    const unsigned char* PG = p.ws + OFF_PG; bf16_t* M = (bf16_t*)(p.ws + OFF_M); const bf16_t* WBR = (const bf16_t*)(p.ws + OFF_WBR);
    for (int u = wg; u < 256; u += nwg) {
        const int rbk = u >> 2; const int r0 = (rbk >> 4) * TT + (rbk & 15) * 16; const int colw = (u & 3) * 256 + wave * 32 + c16 * 2;
        f32x4 tot[2] = {(f32x4){0.f, 0.f, 0.f, 0.f}, (f32x4){0.f, 0.f, 0.f, 0.f}};
#pragma unroll 1
        for (int br = 0; br < 3; ++br) {
            const bf16_t* Y = (const bf16_t*)(p.ws + (br == 0 ? OFF_YA : (br == 1 ? OFF_YB : OFF_YC)));
            f32x4 acc[2] = {(f32x4){0.f, 0.f, 0.f, 0.f}, (f32x4){0.f, 0.f, 0.f, 0.f}};
            rows16_mma2<16>(Y + (size_t)(r0 + c16) * 512 + 8 * q, WBR + ((size_t)br * 1024 + colw) * 512 + 8 * q, 512, acc);
#pragma unroll
            for (int i = 0; i < 4; ++i) { const unsigned g = *(const unsigned short*)(PG + (size_t)(r0 + 4 * q + i) * 3072 + br * 1024 + colw);
                tot[0][i] += (float)(g & 255u) * (1.f / 255.f) * acc[0][i]; tot[1][i] += (float)(g >> 8) * (1.f / 255.f) * acc[1][i]; }
        }
#pragma unroll
        for (int i = 0; i < 4; ++i) *(unsigned*)(M + (size_t)(r0 + 4 * q + i) * 1024 + colw) = pk2(tot[0][i], tot[1][i]);
    }
}
__device__ void ctx_out_units(const Params& p, int l, int wg, int nwg, float scale) {
    const int tid = otid(), wave = tid >> 6, lane = tid & 63, c16 = lane & 15, q = lane >> 4;
    const bf16_t* M = (const bf16_t*)(p.ws + OFF_M); const bf16_t* WOUT = (const bf16_t*)(p.ws + OFF_WOUT); float* X = (float*)(p.ws + OFF_X);
    const float* g1 = (const float*)(p.ws + OFF_MOD) + ((size_t)l * 5 + 4) * 6144 + 2 * 1024;
    for (int u = wg; u < 256; u += nwg) {
        const int rbk = u >> 2; const int r0 = (rbk >> 4) * TT + (rbk & 15) * 16; const int colw = (u & 3) * 256 + wave * 32 + c16 * 2;
        f32x4 acc[2] = {(f32x4){0.f, 0.f, 0.f, 0.f}, (f32x4){0.f, 0.f, 0.f, 0.f}};
        rows16_mma2<32>(M + (size_t)(r0 + c16) * 1024 + 8 * q, WOUT + (size_t)colw * 1024 + 8 * q, 1024, acc);
        const f32x2v gv = *(const f32x2v*)(g1 + colw);
#pragma unroll
        for (int i = 0; i < 4; ++i) { float* xp = X + (size_t)(r0 + 4 * q + i) * 1024 + colw; f32x2v xv = *(f32x2v*)xp;
            xv[0] += gv[0] * acc[0][i] * scale; xv[1] += gv[1] * acc[1][i] * scale; *(f32x2v*)xp = xv; }
    }
}

constexpr int RW_ES = 260, RW_QS = 16 * RW_ES;
__device__ void ph_norm2(const Params& p, int l, LAS unsigned char* lds, int wg, int nwg) {
    const int tid = otid(), wave = tid >> 6, lane = tid & 63;
    LAS float* RW = (LAS float*)lds;
    LAS float* hrow = RW + 4 * RW_QS + wave * 1024;
    {   const float* rw = p.router_w + (size_t)l * 1024 * 16;
        for (int i = tid; i < 16384; i += 512) { const int k = i >> 4, e = i & 15; RW[(k >> 8) * RW_QS + e * RW_ES + (k & 255)] = rw[i]; } }
    __syncthreads();
    const float* X = (const float*)(p.ws + OFF_X); bf16_t* H = (bf16_t*)(p.ws + OFF_H);
    const float* MOD = (const float*)(p.ws + OFF_MOD) + (size_t)l * 5 * 6144; const float* g = p.norm2_g + l * 1024;
    float* AFFL = (float*)(p.ws + OFF_AFFL); float* AFFC = (float*)(p.ws + OFF_AFFC); int* INV = (int*)(p.ws + OFF_INV);
    const int e = lane & 15, kq = lane >> 4;
    const int rstep = nwg * 8; int r = wg * 8 + wave;
    float4 v[4];
    if (r < RR) { const float4* xr = (const float4*)(X + (size_t)r * 1024);
#pragma unroll
        for (int i = 0; i < 4; ++i) v[i] = xr[lane + 64 * i]; }
    while (r < RR) {
        float4 vn[4];
        if (r + rstep < RR) { const float4* xr = (const float4*)(X + (size_t)(r + rstep) * 1024);
#pragma unroll
            for (int i = 0; i < 4; ++i) vn[i] = xr[lane + 64 * i]; }
        float ss = 0.f;
#pragma unroll
        for (int i = 0; i < 4; ++i) ss += v[i].x * v[i].x + v[i].y * v[i].y + v[i].z * v[i].z + v[i].w * v[i].w;
        ss = wave_sum(ss);
        const float rinv = rsqrtf(ss * (1.f / 1024.f) + 1e-6f);
        const int b = r / TT, s_ = r - b * TT; const float* md = MOD + (s_ < NCTX ? 4 : b) * 6144;
        float4 ggv[4], shv[4], scv[4];
#pragma unroll
        for (int i = 0; i < 4; ++i) { const int col = (lane + 64 * i) * 4; ggv[i] = *(const float4*)(g + col); shv[i] = *(const float4*)(md + 3 * 1024 + col); scv[i] = *(const float4*)(md + 4 * 1024 + col); }
#pragma unroll
        for (int i = 0; i < 4; ++i) { const int col = (lane + 64 * i) * 4;
            const float4 gg = ggv[i], sh = shv[i], sc = scv[i];
            f32x4 y; y[0] = v[i].x * rinv * gg.x * (1.f + sc.x) + sh.x; y[1] = v[i].y * rinv * gg.y * (1.f + sc.y) + sh.y; y[2] = v[i].z * rinv * gg.z * (1.f + sc.z) + sh.z; y[3] = v[i].w * rinv * gg.w * (1.f + sc.w) + sh.w;
            u32x2 w = {pk2(y[0], y[1]), pk2(y[2], y[3])}; *(u32x2*)(H + (size_t)r * 1024 + col) = w;
            *(LAS f32x4*)(hrow + col) = y; }
        f32x4 acc4 = (f32x4){0.f, 0.f, 0.f, 0.f}; const LAS float* hq = hrow + kq * 256; const LAS float* wq = RW + kq * RW_QS + e * RW_ES;
#pragma unroll 8
        for (int k = 0; k < 256; k += 4) acc4 += *(const LAS f32x4*)(hq + k) * *(const LAS f32x4*)(wq + k);
        float acc = (acc4[0] + acc4[1]) + (acc4[2] + acc4[3]);
        acc = sum_x32(sum_x16(acc));
        const float mx = allmax16(acc);
        const float ex = expf(acc - mx); const float sm = allsum16(ex);
        const float aff = ex / sm;
        if (lane < 16) { if (s_ < NCTX) AFFC[((size_t)(b * 16 + e)) * NCTX + s_] = aff; else AFFL[((size_t)(b * 16 + e)) * SEQ + (s_ - NCTX)] = aff;
            INV[(size_t)r * 16 + e] = -1; }
#pragma unroll
        for (int i = 0; i < 4; ++i) v[i] = vn[i];
        r += rstep;
    }
    __syncthreads();
}

DI void topk_unit(const Params& p, LAS unsigned char* lds, int u) {
    const int tid = otid(), wave = tid >> 6, lane = tid & 63;
    const bool lat = u < 64; const int v_ = lat ? u : u - 64; const int b = v_ >> 4, e = v_ & 15;
    const int n = lat ? SEQ : NCTX, cap = lat ? CAPL : CAPC;
    const float* aff = lat ? (const float*)(p.ws + OFF_AFFL) + ((size_t)(b * 16 + e)) * SEQ : (const float*)(p.ws + OFF_AFFC) + ((size_t)(b * 16 + e)) * NCTX;
    LAS unsigned* hist = (LAS unsigned*)lds;
    LAS unsigned* sh = hist + 256;
    unsigned long long key[16];
#pragma unroll
    for (int i = 0; i < 16; ++i) { const int idx = tid + 512 * i; key[i] = (idx < n) ? (((unsigned long long)__float_as_uint(aff[idx]) << 13) | (unsigned long long)(8191 - idx)) : 0ull; }
    unsigned long long prefix = 0ull, mask = 0ull; unsigned need = (unsigned)cap;
#pragma unroll 1
    for (int shift = 40; shift >= 0; shift -= 8) {
        if (tid < 256) hist[tid] = 0u;
        if (tid == 0) sh[2] = 0u;
        __syncthreads();
#pragma unroll
        for (int i = 0; i < 16; ++i) if (tid + 512 * i < n && (key[i] & mask) == prefix) __hip_atomic_fetch_add(&hist[(unsigned)(key[i] >> shift) & 255u], 1u, __ATOMIC_RELAXED, __HIP_MEMORY_SCOPE_WORKGROUP);
        __syncthreads();
        if (wave == 0) {
            unsigned loc[4]; unsigned ls = 0;
#pragma unroll
            for (int j = 0; j < 4; ++j) { loc[j] = hist[255 - 4 * lane - j]; ls += loc[j]; }
            unsigned incl = ls;
#pragma unroll
            for (int o = 1; o < 64; o <<= 1) { const unsigned t = (unsigned)__builtin_amdgcn_ds_bpermute((lane - o) << 2, (int)incl); if (lane >= o) incl += t; }
            const unsigned long long bal = __ballot(incl >= need);
            const int first = __ffsll((long long)bal) - 1;
            if (lane == first) { unsigned run = incl - ls; int bin = 255 - 4 * lane; unsigned above = run;
#pragma unroll
                for (int j = 0; j < 4; ++j) { if (run + loc[j] >= need) { bin = 255 - 4 * lane - j; above = run; break; } run += loc[j]; }
                sh[0] = (unsigned)bin; sh[1] = above; }
        }
        __syncthreads();
        prefix |= ((unsigned long long)sh[0]) << shift; mask |= 255ull << shift; need -= sh[1];
        __syncthreads();
    }
    int* SROW = (int*)(p.ws + OFF_SROW); float* SGATE = (float*)(p.ws + OFF_SGATE); int* INV = (int*)(p.ws + OFF_INV);
    const int sb = lat ? b * CAPL : 4 * CAPL + b * CAPC;
#pragma unroll
    for (int i = 0; i < 16; ++i) { const int idx = tid + 512 * i;
        if (idx < n && key[i] >= prefix) { const unsigned pos = __hip_atomic_fetch_add(&sh[2], 1u, __ATOMIC_RELAXED, __HIP_MEMORY_SCOPE_WORKGROUP); const int slot = sb + (int)pos; const int row = b * TT + (lat ? NCTX + idx : idx);
            SROW[e * ESLOT + slot] = row; SGATE[e * ESLOT + slot] = __uint_as_float((unsigned)(key[i] >> 13)); INV[(size_t)row * 16 + e] = slot; } }
    if (lat && b == 0 && tid < 128) { SROW[e * ESLOT + 4 * CAPL + 4 * CAPC + tid] = -1; SGATE[e * ESLOT + 4 * CAPL + 4 * CAPC + tid] = 0.f; }
    __syncthreads();
}
__device__ void ph_topk(const Params& p, LAS unsigned char* lds, int wg, int nwg) { for (int u = wg; u < 128; u += nwg) topk_unit(p, lds, u); }

__device__ void ph_gather(const Params& p, int wg, int nwg) {
    const int tid = otid(), wave = tid >> 6, lane = tid & 63;
    const int* SROW = (const int*)(p.ws + OFF_SROW); const bf16_t* H = (const bf16_t*)(p.ws + OFF_H); unsigned char* XG = p.ws + OFF_XG;
    const int step = nwg * 8; int i = wg * 8 + wave;
    u32x4 a = {0u, 0u, 0u, 0u}, c = {0u, 0u, 0u, 0u};
    auto ld = [&](int ii) { const int row = SROW[ii]; a = (u32x4){0u, 0u, 0u, 0u}; c = a; if (row >= 0) { const u32x4* src = (const u32x4*)(H + (size_t)row * 1024); a = src[2 * lane]; c = src[2 * lane + 1]; } };
    if (i < EROWS) ld(i);
    while (i < EROWS) {
        const u32x4 ca = a, cc = c;
        if (i + step < EROWS) ld(i + step);
        u32x4 w;
#pragma unroll
        for (int j = 0; j < 2; ++j) { w[j] = pk4_fp8(bflo(ca[2 * j]), bfhi(ca[2 * j]), bflo(ca[2 * j + 1]), bfhi(ca[2 * j + 1])); w[2 + j] = pk4_fp8(bflo(cc[2 * j]), bfhi(cc[2 * j]), bflo(cc[2 * j + 1]), bfhi(cc[2 * j + 1])); }
        *(u32x4*)(XG + (size_t)i * 1024 + lane * 16) = w;
        i += step;
    }
}

__device__ void ph_combine(const Params& p, int l, int wg, int nwg, float scale) {
    const int tid = otid(), wave = tid >> 6, lane = tid & 63;
    const int* INV = (const int*)(p.ws + OFF_INV); const float* SGATE = (const float*)(p.ws + OFF_SGATE); const bf16_t* OUT = (const bf16_t*)(p.ws + OFF_OUT);
    float* X = (float*)(p.ws + OFF_X); const float* MOD = (const float*)(p.ws + OFF_MOD) + (size_t)l * 5 * 6144; bf16_t* H = (bf16_t*)(p.ws + OFF_H);
    const bool nxt = (l + 1 < NL) && (scale != 0.f), last = (l + 1 == NL) && (scale != 0.f); const float* g1n = p.norm1_g + (nxt ? (l + 1) : l) * 1024; const float* MODN = MOD + (nxt ? 5 * 6144 : 0);
    for (int r = wg * 8 + wave; r < RR; r += nwg * 8) {
        const u32x4* iv = (const u32x4*)(INV + (size_t)r * 16); const u32x4 sl0 = iv[0], sl1 = iv[1], sl2 = iv[2], sl3 = iv[3];
        const int mi = row_mod(r); const float* g2 = MOD + mi * 6144 + 5 * 1024; float* xr = X + (size_t)r * 1024; const float* md = MODN + mi * 6144;
        f32x4 xv[4], gv[4], ggv[4], shv[4], scv[4];
#pragma unroll
        for (int j = 0; j < 4; ++j) { const int col = (j >> 1) * 512 + lane * 8 + 4 * (j & 1); xv[j] = *(const f32x4*)(xr + col); gv[j] = *(const f32x4*)(g2 + col);
            if (nxt) { ggv[j] = *(const f32x4*)(g1n + col); shv[j] = *(const f32x4*)(md + col); scv[j] = *(const f32x4*)(md + 1024 + col); } }
        float acc[16];
#pragma unroll
        for (int i = 0; i < 16; ++i) acc[i] = 0.f;
#pragma unroll
        for (int e = 0; e < 16; ++e) { const int slot = (int)(e < 4 ? sl0[e & 3] : (e < 8 ? sl1[e & 3] : (e < 12 ? sl2[e & 3] : sl3[e & 3])));
            if (slot >= 0) { const float gt = SGATE[e * ESLOT + slot]; const u32x4* src = (const u32x4*)(OUT + ((size_t)(e * ESLOT + slot)) * 1024);
                const u32x4 a = src[lane], c = src[64 + lane];
#pragma unroll
                for (int i = 0; i < 4; ++i) { acc[2 * i] += gt * bflo(a[i]); acc[2 * i + 1] += gt * bfhi(a[i]); acc[8 + 2 * i] += gt * bflo(c[i]); acc[9 + 2 * i] += gt * bfhi(c[i]); } } }
        float* orow = p.out + ((size_t)(mi & 3) * SEQ + (size_t)(r - (r / TT) * TT - NCTX)) * 1024;
        float ss = 0.f;
#pragma unroll
        for (int j = 0; j < 4; ++j)
#pragma unroll
            for (int i = 0; i < 4; ++i) { xv[j][i] += gv[j][i] * acc[(j >> 1) * 8 + (j & 1) * 4 + i] * scale; ss += xv[j][i] * xv[j][i]; }
        float y[16]; float inv = 0.f, am = 0.f;
        if (nxt) { ss = wave_sum(ss); const float rinv = rsqrtf(ss * (1.f / 1024.f) + 1e-6f);
#pragma unroll
            for (int j = 0; j < 4; ++j)
#pragma unroll
                for (int i = 0; i < 4; ++i) { const float t = xv[j][i] * rinv * ggv[j][i] * (1.f + scv[j][i]) + shv[j][i]; y[j * 4 + i] = t; am = fmaxf(am, fabsf(t)); }
            am = fmaxf(wave_max(am), 1e-20f); inv = 127.f / am; }
#pragma unroll
        for (int j = 0; j < 4; ++j) { const int col = (j >> 1) * 512 + lane * 8 + 4 * (j & 1);
            if (last) { if (mi < 4) *(f32x4*)(orow + col) = xv[j]; } else *(f32x4*)(xr + col) = xv[j]; }
        if (nxt) { if (lane == 0) ((float*)(p.ws + OFF_SH))[r] = am * (1.f / 127.f);
#pragma unroll
            for (int hh = 0; hh < 2; ++hh) { u32x2 w = {pk4_i8(y[hh * 8] * inv, y[hh * 8 + 1] * inv, y[hh * 8 + 2] * inv, y[hh * 8 + 3] * inv), pk4_i8(y[hh * 8 + 4] * inv, y[hh * 8 + 5] * inv, y[hh * 8 + 6] * inv, y[hh * 8 + 7] * inv)};
                *(u32x2*)((unsigned char*)H + (size_t)r * 1024 + hh * 512 + lane * 8) = w; } }
    }
}
__device__ void ph_output(const Params& p, int wg, int nwg) {
    const float4* X4 = (const float4*)(p.ws + OFF_X); float4* O4 = (float4*)p.out;
    const size_t n4 = (size_t)NB * SEQ * 256;
    for (size_t i = (size_t)wg * 512 + otid(); i < n4; i += (size_t)nwg * 512) { const size_t row = i >> 8; const size_t b = row / SEQ, t = row - b * SEQ; O4[i] = X4[(b * TT + NCTX + t) * 256 + (i & 255)]; }
}
constexpr int LDS_BYTES = 131072 + 256;
enum { PH_PROLOGUE = 0, PH_A, PH_B, PH_C, PH_D, PH_E, PH_F, PH_G, PH_H, PH_I, PH_J, PH_K, PH_L, PH_M, PH_OUT };

#ifndef PROBE_NOST
#define PROBE_NOST 0
#endif
template <int PH> DI void run_phase(const Params& pin, int l, LAS unsigned char* lds, int wg_in, int nwg, int dup = 0) {
    int wg = wg_in; asm volatile("" : "+s"(wg));
    Params p = pin; { unsigned long long w = (unsigned long long)pin.ws; asm volatile("" : "+s"(w)); p.ws = (unsigned char*)(__attribute__((address_space(1))) unsigned char*)w; }
    if constexpr (PH == PH_PROLOGUE) { ph_prologue(p, lds, wg, nwg); conv_mixer_b(p, 0, lds, wg, nwg); conv_mixer_a(p, 0, lds); }
    if constexpr (PH == PH_A) { norm1_rows(p, l, wg, nwg); }
    if constexpr (PH == PH_B) { int kq = 512; asm volatile("" : "+s"(kq));
        pg8::Gemm g{(const bf16_t*)(p.ws + OFF_H), (const bf16_t*)(p.ws + OFF_WIN), RR, NIN, kq}; SchedPlain S; S.init(RR / 256, NIN / 256, nwg, wg); EpiInProj E{p.ws, (PROBE_NOST && dup) ? 1 : 0};
        pg8::gemm_phase<EpiInProj, SchedPlain, false, 2>(lds, g, S, E, nullptr); }
    if constexpr (PH == PH_C) ph_prep(p, l, lds, wg, nwg, dup);
    if constexpr (PH == PH_D) ph_mix(p, l, lds, (LAS unsigned*)(lds + 131072 + 64), dup);
    if constexpr (PH == PH_E) ph_post(p, l, wg, nwg);
    if constexpr (PH == PH_F) { pg8::Gemm g{(const bf16_t*)(p.ws + OFF_YA), (const bf16_t*)(p.ws + OFF_WBR), RR, 1024, 512}; SchedMerge S; S.init(nwg, wg); EpiMerge E{p.ws, (PROBE_NOST == 3 && dup) ? 1 : 0};
        pg8::gemm_phase<EpiMerge, SchedMerge>(lds, g, S, E, nullptr); ctx_merge_units(p, wg, nwg); }
    if constexpr (PH == PH_G) { pg8::Gemm g{(const bf16_t*)(p.ws + OFF_M), (const bf16_t*)(p.ws + OFF_WOUT), RR, 1024, 1024}; SchedLat S; S.init(nwg, wg); EpiOut E{p.ws, l, dup ? 0.f : 1.f};
        pg8::gemm_phase<EpiOut, SchedLat>(lds, g, S, E, nullptr); ctx_out_units(p, l, wg, nwg, dup ? 0.f : 1.f); }
    if constexpr (PH == PH_H) { if (!dup) { conv_expert_weights(p, l, lds); if (l + 1 < NL) { conv_mixer_b(p, l + 1, lds, wg, nwg); conv_mixer_a(p, l + 1, lds); } } ph_norm2(p, l, lds, wg, nwg); }
    if constexpr (PH == PH_I) ph_topk(p, lds, wg, nwg);
    if constexpr (PH == PH_J) ph_gather(p, wg, nwg);
    if constexpr (PH == PH_K) { int kq = 512; asm volatile("" : "+s"(kq));
        pg8::Gemm g{(const bf16_t*)(p.ws + OFF_XG), (const bf16_t*)(p.ws + OFF_W13), EROWS, 2048, kq}; SchedMoe<8> S; S.init(nwg, wg); EpiUp E{p.ws};
        pg8::gemm_phase<EpiUp, SchedMoe<8>, false, 1>(lds, g, S, E, nullptr); }
    if constexpr (PH == PH_L) { int kq = 512; asm volatile("" : "+s"(kq));
        pg8::Gemm g{(const bf16_t*)(p.ws + OFF_HID), (const bf16_t*)(p.ws + OFF_W2), EROWS, 1024, kq}; SchedMoe<4> S; S.init(nwg, wg); EpiDown E{p.ws};
        pg8::gemm_phase<EpiDown, SchedMoe<4>, false, 1>(lds, g, S, E, nullptr); }
    if constexpr (PH == PH_M) ph_combine(p, l, wg, nwg, dup ? 0.f : 1.f);
    if constexpr (PH == PH_OUT) { conv_expert_weights(p, l, lds, 32); if (l + 1 < NL) conv_mixer_b(p, l + 1, lds, wg, nwg); }
}

DI void grid_barrier(const Params& p, LAS unsigned* xbw) {
    unsigned long long w = (unsigned long long)p.ws; asm volatile("" : "+s"(w));
    XcdBarrier b; b.bar = (unsigned*)(__attribute__((address_space(1))) unsigned*)(w + OFF_BAR); b.x = xb_xcc_id(); b.st = (volatile LAS unsigned*)xbw; xcd_barrier(b);
}
#ifndef PROBE_MASK
#define PROBE_MASK 0u
#endif
#ifndef MEGA
#define MEGA 1
#endif
#if !MEGA
template <int PH> __global__ __launch_bounds__(512, 2) void k_phase(Params p, int l) {
    extern __shared__ __attribute__((aligned(16))) unsigned char shm[];
    run_phase<PH>(p, l, (LAS unsigned char*)shm, blockIdx.x, gridDim.x);
}
template <int PH> static void launch_phase(const Params& p, int l, int grid, hipStream_t st) {
    static bool attr = false;
    if (!attr) { (void)hipFuncSetAttribute((const void*)k_phase<PH>, hipFuncAttributeMaxDynamicSharedMemorySize, LDS_BYTES); attr = true; }
    hipLaunchKernelGGL(k_phase<PH>, dim3(grid), dim3(512), LDS_BYTES, st, p, l);
}
#else
__global__ __launch_bounds__(512, 2) void k_mega(Params p) {
    extern __shared__ __attribute__((aligned(16))) unsigned char shm[];
    LAS unsigned char* lds = (LAS unsigned char*)shm;
    LAS unsigned* xbw = (LAS unsigned*)(lds + 131072);
    if (threadIdx.x < 4) xbw[threadIdx.x] = 0u;
    __syncthreads();
    (void)xcd_barrier_post((unsigned*)(p.ws + OFF_BAR), (volatile LAS unsigned*)xbw);
    const int wg = blockIdx.x, nwg = gridDim.x;
    run_phase<PH_PROLOGUE>(p, 0, lds, wg, nwg); grid_barrier(p, xbw);
    if (PROBE_MASK & (1u << PH_PROLOGUE)) { run_phase<PH_PROLOGUE>(p, 0, lds, wg, nwg); grid_barrier(p, xbw); }
#pragma unroll 1
    for (int l = 0; l < NL; ++l) {
        if (l == 0) { run_phase<PH_A>(p, l, lds, wg, nwg); grid_barrier(p, xbw); }
        if (l == 0 && (PROBE_MASK & (1u << PH_A))) { run_phase<PH_A>(p, l, lds, wg, nwg); grid_barrier(p, xbw); }
        run_phase<PH_B>(p, l, lds, wg, nwg); grid_barrier(p, xbw);
        if (PROBE_MASK & (1u << PH_B)) { run_phase<PH_B>(p, l, lds, wg, nwg, 1); grid_barrier(p, xbw); }
        run_phase<PH_C>(p, l, lds, wg, nwg); grid_barrier(p, xbw);
        if (PROBE_MASK & (1u << PH_C)) { run_phase<PH_C>(p, l, lds, wg, nwg, 1); grid_barrier(p, xbw); }
        run_phase<PH_D>(p, l, lds, wg, nwg); grid_barrier(p, xbw);
        if (PROBE_MASK & (1u << PH_D)) { run_phase<PH_D>(p, l, lds, wg, nwg, 1); grid_barrier(p, xbw); }
        run_phase<PH_E>(p, l, lds, wg, nwg); grid_barrier(p, xbw);
        if (PROBE_MASK & (1u << PH_E)) { run_phase<PH_E>(p, l, lds, wg, nwg, 1); grid_barrier(p, xbw); }
        run_phase<PH_F>(p, l, lds, wg, nwg); grid_barrier(p, xbw);
        if (PROBE_MASK & (1u << PH_F)) { run_phase<PH_F>(p, l, lds, wg, nwg, 1); grid_barrier(p, xbw); }
        run_phase<PH_G>(p, l, lds, wg, nwg); grid_barrier(p, xbw);
        if (PROBE_MASK & (1u << PH_G)) { run_phase<PH_G>(p, l, lds, wg, nwg, 1); grid_barrier(p, xbw); }
        run_phase<PH_H>(p, l, lds, wg, nwg); grid_barrier(p, xbw);
        if (PROBE_MASK & (1u << PH_H)) { run_phase<PH_H>(p, l, lds, wg, nwg, 1); grid_barrier(p, xbw); }
        if (PROBE_MASK & (1u << PH_OUT)) { run_phase<PH_OUT>(p, l, lds, wg, nwg, 1); grid_barrier(p, xbw); }
        run_phase<PH_I>(p, l, lds, wg, nwg); grid_barrier(p, xbw);
        if (PROBE_MASK & (1u << PH_I)) { run_phase<PH_I>(p, l, lds, wg, nwg, 1); grid_barrier(p, xbw); }
        run_phase<PH_J>(p, l, lds, wg, nwg); grid_barrier(p, xbw);
        if (PROBE_MASK & (1u << PH_J)) { run_phase<PH_J>(p, l, lds, wg, nwg, 1); grid_barrier(p, xbw); }
        run_phase<PH_K>(p, l, lds, wg, nwg); grid_barrier(p, xbw);
        if (PROBE_MASK & (1u << PH_K)) { run_phase<PH_K>(p, l, lds, wg, nwg, 1); grid_barrier(p, xbw); }
        run_phase<PH_L>(p, l, lds, wg, nwg); grid_barrier(p, xbw);
        if (PROBE_MASK & (1u << PH_L)) { run_phase<PH_L>(p, l, lds, wg, nwg, 1); grid_barrier(p, xbw); }
        run_phase<PH_M>(p, l, lds, wg, nwg); grid_barrier(p, xbw);
        if (PROBE_MASK & (1u << PH_M)) { run_phase<PH_M>(p, l, lds, wg, nwg, 1); grid_barrier(p, xbw); }
    }
}
#endif

extern "C" void kernel_launch(void* const* d_in, const int* in_sizes, int n_in, void* d_out, int out_size, void* d_ws, size_t ws_size, hipStream_t stream) {
    if (n_in < 31 || ws_size < WS_NEEDED) return;
    Params p{};
    const float** f = (const float**)&p;
    for (int i = 0; i < 31; ++i) f[i] = (const float*)d_in[i];
    p.out = (float*)d_out; p.ws = (unsigned char*)d_ws;
    (void)hipMemsetAsync(d_ws, 0, 65536, stream);
#if !MEGA
    const int G = 256;
    launch_phase<PH_PROLOGUE>(p, 0, G, stream);
    for (int l = 0; l < NL; ++l) {
        launch_phase<PH_A>(p, l, G, stream); launch_phase<PH_B>(p, l, G, stream); launch_phase<PH_C>(p, l, G, stream); launch_phase<PH_D>(p, l, G, stream);
        launch_phase<PH_E>(p, l, G, stream); launch_phase<PH_F>(p, l, G, stream); launch_phase<PH_G>(p, l, G, stream); launch_phase<PH_H>(p, l, G, stream);
        launch_phase<PH_I>(p, l, G, stream); launch_phase<PH_J>(p, l, G, stream); launch_phase<PH_K>(p, l, G, stream); launch_phase<PH_L>(p, l, G, stream);
        launch_phase<PH_M>(p, l, G, stream);
    }
    launch_phase<PH_OUT>(p, 0, G, stream);
#else
    static int grid = 0;
    if (!grid) {
        (void)hipFuncSetAttribute((const void*)k_mega, hipFuncAttributeMaxDynamicSharedMemorySize, LDS_BYTES);
        int dev = 0, cus = 0, per_cu = 0; (void)hipGetDevice(&dev); (void)hipDeviceGetAttribute(&cus, hipDeviceAttributeMultiprocessorCount, dev);
        (void)hipOccupancyMaxActiveBlocksPerMultiprocessor(&per_cu, (const void*)k_mega, 512, LDS_BYTES);
        grid = cus * (per_cu < 1 ? per_cu : 1);
    }
    if (grid <= 0) return;
    hipLaunchKernelGGL(k_mega, dim3(grid), dim3(512), LDS_BYTES, stream, p);
#endif
}
```
